# Optimizing an MI355X kernel written in HIP

```python
import jax, jax.numpy as jnp
from jax import lax
import numpy as np


D_MODEL = 1024
BATCH = 4
SEQ = 4096
DEPTH = 4

GLA_HEADS = 4
GLA_DK = 64
GLA_DV = 128
GLA_RANK = 16
GLA_TAU = 16.0
GLA_CHUNK = 64
ML_HEADS = 4
ML_DK = 64
ML_DV = 128
ML_CONV = 4
ML_CHUNK = 64
MOBA_HEADS = 8
MOBA_HD = D_MODEL // MOBA_HEADS
MOBA_BLOCK = 256
MOBA_TOPK = 3
MOBA_QCHUNK = 16
D_FF = -(-8 * D_MODEL // (3 * 256)) * 256

N_EVEN = (DEPTH + 1) // 2
N_ODD = DEPTH // 2
GLA_QK = GLA_HEADS * GLA_DK
GLA_V = GLA_HEADS * GLA_DV
ML_QK = ML_HEADS * ML_DK
ML_V = ML_HEADS * ML_DV
HYB_SPLITS = (GLA_QK, GLA_QK, GLA_V, GLA_V, GLA_RANK, ML_QK, ML_QK, ML_V, ML_V, ML_HEADS, ML_HEADS)
HYB_IN = sum(HYB_SPLITS)
EPS = 1e-6
NEG = -1e30

kernel_name = 'hybrid_gla_mlstm_moba_swiglu'


def rms_norm(x, g):
    xf = x.astype(jnp.float32)
    y = xf * lax.rsqrt(jnp.mean(xf * xf, axis=-1, keepdims=True) + EPS)
    return (y * g.astype(jnp.float32)).astype(x.dtype)


def split_heads(t, h):
    b, s, _ = t.shape
    return t.reshape(b, s, h, -1).transpose(0, 2, 1, 3)


def merge_heads(t):
    b, h, s, d = t.shape
    return t.transpose(0, 2, 1, 3).reshape(b, s, h * d)


def to_chunks(t, c):
    b, h, s = t.shape[:3]
    return jnp.moveaxis(t.reshape(b, h, s // c, c, *t.shape[3:]), 2, 0)


def from_chunks(t):
    n, b, h, c = t.shape[:4]
    return jnp.moveaxis(t, 0, 2).reshape(b, h, n * c, *t.shape[4:])


def causal_conv(x, w):
    c = x.shape[-1]
    return lax.conv_general_dilated(x, w[:, None, :].astype(x.dtype), (1,), [(w.shape[0] - 1, 0)],
                                    dimension_numbers=('NWC', 'WIO', 'NWC'), feature_group_count=c)


def alibi_slopes(n):
    return jnp.asarray([2.0 ** (-8.0 * (i + 1) / n) for i in range(n)], jnp.float32)


def gla_chunked(q, k, v, log_a):
    b, h, s, dk = q.shape
    dv = v.shape[-1]
    c = GLA_CHUNK
    mask = jnp.tril(jnp.ones((c, c), bool))[:, :, None]

    def step(state, inp):
        qc, kc, vc, gc = inp
        bc = jnp.cumsum(gc, axis=2)
        diff = bc[:, :, :, None, :] - bc[:, :, None, :, :]
        decay = jnp.where(mask, jnp.exp(jnp.where(mask, diff, 0.0)), 0.0)
        scores = jnp.einsum('bhtk,bhsk,bhtsk->bhts', qc, kc, decay)
        out = (jnp.einsum('bhts,bhsv->bhtv', scores, vc)
               + jnp.einsum('bhtk,bhkv->bhtv', qc * jnp.exp(bc), state))
        last = bc[:, :, -1:, :]
        state = (jnp.exp(last[:, :, 0, :])[..., None] * state
                 + jnp.einsum('bhsk,bhsv->bhkv', kc * jnp.exp(last - bc), vc))
        return state, out

    state0 = jnp.zeros((b, h, dk, dv), jnp.float32)
    _, out = lax.scan(step, state0, tuple(to_chunks(t, c) for t in (q, k, v, log_a)))
    return from_chunks(out)


def mlstm_chunked(q, k, v, i_pre, log_f):
    b, h, s, dk = q.shape
    dv = v.shape[-1]
    c = ML_CHUNK
    mask = jnp.tril(jnp.ones((c, c), bool))

    def step(carry, inp):
        cs, ns, m = carry
        qc, kc, vc, ic, fc = inp
        bc = jnp.cumsum(fc, axis=-1)
        dmat = jnp.where(mask, bc[..., :, None] - bc[..., None, :] + ic[..., None, :], -jnp.inf)
        inter_log = bc + m[..., None]
        m_t = jnp.maximum(inter_log, jnp.max(dmat, axis=-1))
        w = jnp.einsum('bhtk,bhsk->bhts', qc, kc) * jnp.exp(dmat - m_t[..., None])
        inter = jnp.exp(inter_log - m_t)
        num = inter[..., None] * jnp.einsum('bhtk,bhkv->bhtv', qc, cs) + jnp.einsum('bhts,bhsv->bhtv', w, vc)
        den = inter * jnp.einsum('bhtk,bhk->bht', qc, ns) + jnp.sum(w, axis=-1)
        hout = num / jnp.maximum(jnp.abs(den), jnp.exp(-m_t))[..., None]
        g = bc[..., -1:] - bc + ic
        m_new = jnp.maximum(bc[..., -1] + m, jnp.max(g, axis=-1))
        carry_scale = jnp.exp(bc[..., -1] + m - m_new)
        wk = kc * jnp.exp(g - m_new[..., None])[..., None]
        cs = carry_scale[..., None, None] * cs + jnp.einsum('bhsk,bhsv->bhkv', wk, vc)
        ns = carry_scale[..., None] * ns + jnp.sum(wk, axis=2)
        return (cs, ns, m_new), hout

    carry0 = (jnp.zeros((b, h, dk, dv), jnp.float32), jnp.zeros((b, h, dk), jnp.float32),
              jnp.zeros((b, h), jnp.float32))
    _, out = lax.scan(step, carry0, tuple(to_chunks(t, c) for t in (q, k, v, i_pre, log_f)))
    return from_chunks(out)


def hybrid_mixer(xn, w_in, w_gate2, b_gate, gla_gain, conv_w, b_if, ml_gain, w_out):
    b, s, _ = xn.shape
    f32 = jnp.float32
    proj = xn @ w_in
    cuts = [int(i) for i in np.cumsum(HYB_SPLITS)[:-1]]
    gq, gk, gv, gr, glr, mq, mk, mv, mo, mi, mf = jnp.split(proj, cuts, axis=-1)
    log_a = jax.nn.log_sigmoid((glr @ w_gate2 + b_gate).astype(f32)) / GLA_TAU
    o_gla = gla_chunked(split_heads(gq, GLA_HEADS).astype(f32) * GLA_DK ** -0.5,
                        split_heads(gk, GLA_HEADS).astype(f32),
                        split_heads(gv, GLA_HEADS).astype(f32),
                        split_heads(log_a, GLA_HEADS))
    y_gla = rms_norm(o_gla.astype(xn.dtype).transpose(0, 2, 1, 3), gla_gain.reshape(GLA_HEADS, GLA_DV))
    y_gla = y_gla.reshape(b, s, GLA_V) * jax.nn.silu(gr)
    qk = jax.nn.silu(causal_conv(jnp.concatenate([mq, mk], axis=-1), conv_w))
    mq, mk = jnp.split(qk, 2, axis=-1)
    gates = (jnp.concatenate([mi, mf], axis=-1) + b_if).astype(f32).transpose(0, 2, 1)
    i_pre, f_pre = gates[:, :ML_HEADS], gates[:, ML_HEADS:]
    h_ml = mlstm_chunked(split_heads(mq, ML_HEADS).astype(f32),
                         split_heads(mk, ML_HEADS).astype(f32) * ML_DK ** -0.5,
                         split_heads(mv, ML_HEADS).astype(f32),
                         i_pre, jax.nn.log_sigmoid(f_pre))
    h_ml = h_ml.astype(xn.dtype).transpose(0, 2, 1, 3) * jax.nn.sigmoid(mo).reshape(b, s, ML_HEADS, ML_DV)
    y_ml = rms_norm(h_ml, ml_gain.reshape(ML_HEADS, ML_DV)).reshape(b, s, ML_V)
    return jnp.concatenate([y_gla, y_ml], axis=-1) @ w_out


def moba_attention(q, k, v):
    b, h, s, d = q.shape
    f32 = jnp.float32
    s_pad = -(-s // MOBA_BLOCK) * MOBA_BLOCK
    pad = ((0, 0), (0, 0), (0, s_pad - s), (0, 0))
    q, k, v = jnp.pad(q, pad), jnp.pad(k, pad), jnp.pad(v, pad)
    nb = s_pad // MOBA_BLOCK
    kb = k.reshape(b, h, nb, MOBA_BLOCK, d)
    vb = v.reshape(b, h, nb, MOBA_BLOCK, d)
    kmean = jnp.mean(kb.astype(f32), axis=3)
    pos = jnp.arange(s_pad, dtype=jnp.int32)
    qblk = pos // MOBA_BLOCK
    gate = jnp.einsum('bhtd,bhnd->bhtn', q.astype(f32), kmean)
    fully_past = jnp.arange(nb)[None, :] < qblk[:, None]
    gate = jnp.where(fully_past, gate, -jnp.inf)
    n_sel = min(MOBA_TOPK, nb)
    _, top = lax.top_k(gate, n_sel)
    idx = jnp.concatenate([top.astype(jnp.int32),
                           jnp.broadcast_to(qblk[:, None], (b, h, s_pad, 1))], axis=-1)
    valid = jnp.concatenate([jnp.arange(n_sel)[None, :] < qblk[:, None],
                             jnp.ones((s_pad, 1), bool)], axis=-1)
    slopes = alibi_slopes(h)[:, None, None, None]
    nq = s_pad // MOBA_QCHUNK
    q_c = jnp.moveaxis(q.reshape(b, h, nq, MOBA_QCHUNK, d), 2, 0)
    i_c = jnp.moveaxis(idx.reshape(b, h, nq, MOBA_QCHUNK, -1), 2, 0)
    t_c = pos.reshape(nq, MOBA_QCHUNK)
    v_c = valid.reshape(nq, MOBA_QCHUNK, -1)
    gather = jax.vmap(jax.vmap(lambda blocks, i: blocks[i]))

    def attend(inp):
        qq, ii, tt, vv = inp
        kg = gather(kb, ii)
        vg = gather(vb, ii)
        sc = jnp.einsum('bhqd,bhqrkd->bhqrk', qq, kg).astype(f32)
        kpos = ii[..., None] * MOBA_BLOCK + jnp.arange(MOBA_BLOCK, dtype=jnp.int32)
        dist = tt[:, None, None] - kpos
        allowed = vv[:, :, None] & (dist >= 0)
        sc = jnp.where(allowed, sc - slopes * dist.astype(f32), NEG)
        p = jax.nn.softmax(sc.reshape(*sc.shape[:3], -1), axis=-1).reshape(sc.shape)
        return jnp.einsum('bhqrk,bhqrkd->bhqd', p.astype(vg.dtype), vg)

    out = lax.map(attend, (q_c, i_c, t_c, v_c))
    return jnp.moveaxis(out, 0, 2).reshape(b, h, s_pad, d)[:, :, :s]


def moba_mixer(xn, w_qkv, q_gain, k_gain, w_o):
    q, k, v = jnp.split(xn @ w_qkv, 3, axis=-1)
    q = rms_norm(split_heads(q, MOBA_HEADS), q_gain) * MOBA_HD ** -0.5
    k = rms_norm(split_heads(k, MOBA_HEADS), k_gain)
    o = moba_attention(q, k, split_heads(v, MOBA_HEADS))
    return merge_heads(o) @ w_o


def swiglu(xn, wg, wu, wd):
    return (jax.nn.silu(xn @ wg) * (xn @ wu)) @ wd


def setup_inputs(seed: int = 0) -> dict:
    key = jax.random.key(seed)
    ks = jax.random.split(key, 24)

    def nrm(k, shape, scale):
        return jax.random.normal(k, shape, jnp.float32) * scale

    b_i = nrm(ks[8], (N_EVEN, ML_HEADS), 0.1)
    b_f = jnp.linspace(3.0, 6.0, ML_HEADS, dtype=jnp.float32)[None, :] + nrm(ks[9], (N_EVEN, ML_HEADS), 0.1)
    return {
        'x': nrm(ks[0], (BATCH, SEQ, D_MODEL), 1.0),
        'norm_mix': 1.0 + nrm(ks[1], (DEPTH, D_MODEL), 0.02),
        'norm_ffn': 1.0 + nrm(ks[2], (DEPTH, D_MODEL), 0.02),
        'hyb_w_in': nrm(ks[3], (N_EVEN, D_MODEL, HYB_IN), D_MODEL ** -0.5),
        'gla_w_gate2': nrm(ks[4], (N_EVEN, GLA_RANK, GLA_QK), GLA_RANK ** -0.5),
        'gla_b_gate': nrm(ks[5], (N_EVEN, GLA_QK), 0.1),
        'gla_norm': 1.0 + nrm(ks[6], (N_EVEN, GLA_V), 0.02),
        'ml_conv': nrm(ks[7], (N_EVEN, ML_CONV, 2 * ML_QK), ML_CONV ** -0.5),
        'ml_b_if': jnp.concatenate([b_i, b_f], axis=-1),
        'ml_norm': 1.0 + nrm(ks[10], (N_EVEN, ML_V), 0.02),
        'hyb_w_out': nrm(ks[11], (N_EVEN, GLA_V + ML_V, D_MODEL), (GLA_V + ML_V) ** -0.5),
        'moba_w_qkv': nrm(ks[12], (N_ODD, D_MODEL, 3 * D_MODEL), D_MODEL ** -0.5),
        'moba_q_norm': 1.0 + nrm(ks[13], (N_ODD, MOBA_HD), 0.02),
        'moba_k_norm': 1.0 + nrm(ks[14], (N_ODD, MOBA_HD), 0.02),
        'moba_w_o': nrm(ks[15], (N_ODD, D_MODEL, D_MODEL), D_MODEL ** -0.5),
        'ffn_w_gate': nrm(ks[16], (DEPTH, D_MODEL, D_FF), D_MODEL ** -0.5),
        'ffn_w_up': nrm(ks[17], (DEPTH, D_MODEL, D_FF), D_MODEL ** -0.5),
        'ffn_w_down': nrm(ks[18], (DEPTH, D_FF, D_MODEL), D_FF ** -0.5),
    }


def reference(x, norm_mix, norm_ffn, hyb_w_in, gla_w_gate2, gla_b_gate, gla_norm, ml_conv, ml_b_if,
              ml_norm, hyb_w_out, moba_w_qkv, moba_q_norm, moba_k_norm, moba_w_o,
              ffn_w_gate, ffn_w_up, ffn_w_down):
    for l in range(DEPTH):
        xn = rms_norm(x, norm_mix[l])
        j = l // 2
        if l % 2 == 0:
            x = x + hybrid_mixer(xn, hyb_w_in[j], gla_w_gate2[j], gla_b_gate[j], gla_norm[j],
                                 ml_conv[j], ml_b_if[j], ml_norm[j], hyb_w_out[j])
        else:
            x = x + moba_mixer(xn, moba_w_qkv[j], moba_q_norm[j], moba_k_norm[j], moba_w_o[j])
        xn = rms_norm(x, norm_ffn[l])
        x = x + swiglu(xn, ffn_w_gate[l], ffn_w_up[l], ffn_w_down[l])
    return x
```

```cpp
#include <hip/hip_runtime.h>
#include <cstdio>
#include <cstdint>

typedef unsigned short bf16_t;
typedef float f32x4 __attribute__((ext_vector_type(4)));

constexpr int BATCH = 4, SEQ = 4096, DM = 1024, M = BATCH * SEQ, DEPTH = 4;
constexpr int DFF = 2816;
constexpr int HYB_IN = 3096;
constexpr int NCH = 64, CH = 64;
constexpr float EPS = 1e-6f;
constexpr int PP = 3072;
constexpr int C_GQ = 0, C_GK = 256, C_GV = 512, C_MQ = 1024, C_MK = 1280, C_MV = 1536, C_GR = 2048, C_MO = 2560;
constexpr int SMALLP = 32;

constexpr size_t MiB = 1u << 20;
constexpr size_t WS_CTL = 0, WS_RSS = 1 * MiB, WS_SMALL = 2 * MiB, WS_KMEAN = 4 * MiB, WS_DEC = 5 * MiB, WS_NS = 6 * MiB;
constexpr size_t WS_XB = 8 * MiB, WS_P = 40 * MiB, WS_W = 136 * MiB;

__device__ __forceinline__ float bf2f(bf16_t v) { return __uint_as_float((unsigned)v << 16); }
__device__ __forceinline__ bf16_t f2bf(float f) { unsigned u = __float_as_uint(f); return (bf16_t)((u + 0x7fffu + ((u >> 16) & 1u)) >> 16); }
__device__ __forceinline__ float sigmoidf_(float x) { return 1.f / (1.f + __expf(-x)); }
__device__ __forceinline__ float siluf_(float x) { return x / (1.f + __expf(-x)); }
__device__ __forceinline__ float logsigmoidf_(float x) { return fminf(x, 0.f) - log1pf(__expf(-fabsf(x))); }
__device__ __forceinline__ float wave_sum(float v) {
#pragma unroll
    for (int o = 1; o < 64; o <<= 1) v += __shfl_xor(v, o);
    return v;
}
__device__ __forceinline__ float wave_max(float v) {
#pragma unroll
    for (int o = 1; o < 64; o <<= 1) v = fmaxf(v, __shfl_xor(v, o));
    return v;
}

__global__ __launch_bounds__(256) void k_prep_rows(const float* __restrict__ x, bf16_t* __restrict__ xb, float* __restrict__ rss) {
    const int wave = threadIdx.x >> 6, lane = threadIdx.x & 63;
    const int row = blockIdx.x * 4 + wave;
    const float* xr = x + (size_t)row * DM;
    float s = 0.f;
#pragma unroll
    for (int j = 0; j < 4; ++j) {
        f32x4 v = *(const f32x4*)(xr + j * 256 + lane * 4);
        s += v.x * v.x + v.y * v.y + v.z * v.z + v.w * v.w;
        bf16_t* o = xb + (size_t)row * DM + j * 256 + lane * 4;
        o[0] = f2bf(v.x); o[1] = f2bf(v.y); o[2] = f2bf(v.z); o[3] = f2bf(v.w);
    }
    s = wave_sum(s);
    if (lane < 16) rss[(size_t)row * 16 + lane] = lane == 0 ? s : 0.f;
}
__device__ __forceinline__ float row_rstd(const float* rss, int row) {
    const f32x4* p = (const f32x4*)(rss + (size_t)row * 16);
    f32x4 a = p[0], b = p[1], c = p[2], d = p[3];
    float s = (a.x + a.y + a.z + a.w) + (b.x + b.y + b.z + b.w) + (c.x + c.y + c.z + c.w) + (d.x + d.y + d.z + d.w);
    return rsqrtf(s * (1.f / DM) + EPS);
}

template <bool DUAL, class Epi>
__global__ __launch_bounds__(256) void k_gemm_simple(const bf16_t* __restrict__ A, int lda, const float* __restrict__ W, const float* __restrict__ W2, int N, int K,
                                                     const float* __restrict__ gain, Epi epi) {
    __shared__ float As[16][68];
    __shared__ float Ws[16][64];
    __shared__ float Ws2[DUAL ? 16 : 1][64];
    const int tx = threadIdx.x & 15, ty = threadIdx.x >> 4;
    const int row0 = blockIdx.y * 64, col0 = blockIdx.x * 64;
    float acc[4][4], acc2[4][4];
#pragma unroll
    for (int i = 0; i < 4; ++i)
#pragma unroll
        for (int j = 0; j < 4; ++j) { acc[i][j] = 0.f; acc2[i][j] = 0.f; }
    for (int k0 = 0; k0 < K; k0 += 16) {
        for (int i = threadIdx.x; i < 1024; i += 256) { const int r = i >> 4, c = i & 15; As[c][r] = bf2f(A[(size_t)(row0 + r) * lda + k0 + c]); }
        for (int i = threadIdx.x; i < 1024; i += 256) {
            const int r = i >> 6, c = i & 63; const int n = col0 + c;
            const float g = gain ? gain[k0 + r] : 1.f;
            Ws[r][c] = n < N ? W[(size_t)(k0 + r) * N + n] * g : 0.f;
            if (DUAL) Ws2[r][c] = n < N ? W2[(size_t)(k0 + r) * N + n] * g : 0.f;
        }
        __syncthreads();
#pragma unroll
        for (int kk = 0; kk < 16; ++kk) {
            float a[4], b[4], b2[4];
#pragma unroll
            for (int i = 0; i < 4; ++i) { a[i] = As[kk][ty * 4 + i]; b[i] = Ws[kk][tx * 4 + i]; if (DUAL) b2[i] = Ws2[kk][tx * 4 + i]; }
#pragma unroll
            for (int i = 0; i < 4; ++i)
#pragma unroll
                for (int j = 0; j < 4; ++j) { acc[i][j] += a[i] * b[j]; if (DUAL) acc2[i][j] += a[i] * b2[j]; }
        }
        __syncthreads();
    }
#pragma unroll
    for (int i = 0; i < 4; ++i) {
        const int row = row0 + ty * 4 + i;
        const float rs = epi.rowscale(row);
#pragma unroll
        for (int j = 0; j < 4; ++j) { const int n = col0 + tx * 4 + j; if (n < N) epi.store(row, n, acc[i][j] * rs, acc2[i][j] * rs); }
    }
}
struct EpiProjS {
    bf16_t* P; float* small; const float* rss;
    __device__ float rowscale(int row) const { return row_rstd(rss, row); }
    __device__ void store(int row, int n, float v, float) const {
        int c;
        if (n < 256) c = C_GQ + n; else if (n < 512) c = C_GK + n - 256; else if (n < 1024) c = C_GV + n - 512; else if (n < 1536) c = C_GR + n - 1024;
        else if (n < 1552) { small[(size_t)row * SMALLP + (n - 1536)] = v; return; }
        else if (n < 1808) c = C_MQ + n - 1552; else if (n < 2064) c = C_MK + n - 1808; else if (n < 2576) c = C_MV + n - 2064; else if (n < 3088) c = C_MO + n - 2576;
        else { small[(size_t)row * SMALLP + 16 + (n - 3088)] = v; return; }
        P[(size_t)row * PP + c] = f2bf(v);
    }
};
struct EpiPlainS {
    bf16_t* P; const float* rss;
    __device__ float rowscale(int row) const { return row_rstd(rss, row); }
    __device__ void store(int row, int n, float v, float) const { P[(size_t)row * PP + n] = f2bf(v); }
};
struct EpiResS {
    const float* xin; float* xout; bf16_t* xb;
    __device__ float rowscale(int) const { return 1.f; }
    __device__ void store(int row, int n, float v, float) const { const float xn = xin[(size_t)row * DM + n] + v; xout[(size_t)row * DM + n] = xn; xb[(size_t)row * DM + n] = f2bf(xn); }
};
struct EpiFfnS {
    bf16_t* H; const float* rss;
    __device__ float rowscale(int row) const { return row_rstd(rss, row); }
    __device__ void store(int row, int n, float g, float u) const { H[(size_t)row * DFF + n] = f2bf(siluf_(g) * u); }
};
__global__ __launch_bounds__(256) void k_rowss(const float* __restrict__ x, float* __restrict__ rss) {
    const int wave = threadIdx.x >> 6, lane = threadIdx.x & 63;
    const int row = blockIdx.x * 4 + wave;
    const float* xr = x + (size_t)row * DM;
    float s = 0.f;
#pragma unroll
    for (int j = 0; j < 4; ++j) { f32x4 v = *(const f32x4*)(xr + j * 256 + lane * 4); s += v.x * v.x + v.y * v.y + v.z * v.z + v.w * v.w; }
    s = wave_sum(s);
    if (lane < 16) rss[(size_t)row * 16 + lane] = lane == 0 ? s : 0.f;
}

struct ScanArgs {
    bf16_t* P; const float* small;
    const float* w2; const float* bgate; const float* gla_gain; const float* convw; const float* bif; const float* ml_gain;
    bf16_t* ST; float* dec; float* NS;
};
__device__ __forceinline__ size_t st_off(int grp, int bh, int c) { return ((size_t)((grp * 16 + bh) * NCH + c)) * 8192; }

template <bool NEED_A>
__device__ __forceinline__ void gate_stage(const ScanArgs& a, int b, int c, int hh, float* At, float* Bm, float* blk, float* lastv) {
    const int tid = threadIdx.x, tb = tid >> 6, k = tid & 63;
    const int grp = hh >> 2, h = hh & 3;
    const int row0 = b * SEQ + c * CH;
    float la[8];
    if (grp == 0) {
        float w2r[16];
#pragma unroll
        for (int r = 0; r < 16; ++r) w2r[r] = a.w2[r * 256 + h * 64 + k];
        const float bg = a.bgate[h * 64 + k];
#pragma unroll
        for (int i = 0; i < 8; ++i) {
            const float* g = a.small + (size_t)(row0 + tb * 8 + i) * SMALLP;
            float z = bg;
#pragma unroll
            for (int r = 0; r < 16; ++r) z += g[r] * w2r[r];
            la[i] = logsigmoidf_(z) * (1.f / 16.f);
            asm volatile("" ::: "memory");
        }
    } else {
#pragma unroll
        for (int i = 0; i < 8; ++i) {
            const float* g = a.small + (size_t)(row0 + tb * 8 + i) * SMALLP;
            la[i] = logsigmoidf_(g[20 + h] + a.bif[4 + h]);
        }
    }
    float cs[8]; float run = 0.f;
#pragma unroll
    for (int i = 0; i < 8; ++i) { run += la[i]; cs[i] = run; }
    blk[tb * 64 + k] = run;
    __syncthreads();
    float pre = 0.f, tot = 0.f;
#pragma unroll
    for (int j = 0; j < 8; ++j) { const float v = blk[j * 64 + k]; tot += v; if (j < tb) pre += v; }
    if (tb == 0) lastv[k] = tot;
#pragma unroll
    for (int i = 0; i < 8; ++i) {
        const int t = tb * 8 + i; const int row = row0 + t; const float bc = pre + cs[i];
        const bf16_t* pr = a.P + (size_t)row * PP;
        if (grp == 0) {
            const float kv = bf2f(pr[C_GK + h * 64 + k]);
            Bm[t * 65 + k] = kv * __expf(-bc);
            if (NEED_A) { const float qv = bf2f(pr[C_GQ + h * 64 + k]); At[t * 65 + k] = qv * 0.125f * __expf(bc); }
        } else {
            const float ip = a.small[(size_t)row * SMALLP + 16 + h] + a.bif[h];
            const int tt = c * CH + t;
            float ck = 0.f, cq = 0.f;
#pragma unroll
            for (int j = 0; j < 4; ++j) {
                const int ts = tt - 3 + j;
                if (ts >= 0) {
                    const bf16_t* ps = a.P + (size_t)(b * SEQ + ts) * PP;
                    ck += a.convw[j * 512 + 256 + h * 64 + k] * bf2f(ps[C_MK + h * 64 + k]);
                    if (NEED_A) cq += a.convw[j * 512 + h * 64 + k] * bf2f(ps[C_MQ + h * 64 + k]);
                }
            }
            Bm[t * 65 + k] = siluf_(ck) * 0.125f * __expf(ip - bc);
            if (NEED_A) At[t * 65 + k] = siluf_(cq) * __expf(bc);
        }
    }
}

__global__ __launch_bounds__(512) void k_scan1(ScanArgs a) {
    extern __shared__ __attribute__((aligned(16))) float sm[];
    float* Bm = sm;
    float* Vs = sm + 64 * 65;
    float* blk = Vs + 64 * 128;
    float* lastv = blk + 512;
    const int b = blockIdx.x / NCH, c = blockIdx.x % NCH, tid = threadIdx.x, lane = tid & 63, kg = tid >> 6;
    const int row0 = b * SEQ + c * CH;
    for (int hh = 0; hh < 8; ++hh) {
        const int grp = hh >> 2, h = hh & 3, bh = b * 4 + h;
        gate_stage<false>(a, b, c, hh, nullptr, Bm, blk, lastv);
        const int voff = (grp == 0 ? C_GV : C_MV) + h * 128;
#pragma unroll 4
        for (int i = tid; i < 64 * 128; i += 512) { const int s = i >> 7, v = i & 127; Vs[i] = bf2f(a.P[(size_t)(row0 + s) * PP + voff + v]); }
        __syncthreads();
        if (tid < 64) a.dec[((size_t)(grp * 16 + bh) * NCH + c) * 64 + tid] = __expf(lastv[tid]);
        if (grp == 1 && tid < 64) { float s = 0.f; for (int t = 0; t < 64; ++t) s += Bm[t * 65 + tid]; a.NS[((size_t)bh * NCH + c) * 64 + tid] = s; }
        float acc[8][2];
#pragma unroll
        for (int i = 0; i < 8; ++i) { acc[i][0] = 0.f; acc[i][1] = 0.f; }
#pragma unroll 2
        for (int s = 0; s < 64; ++s) {
            const float v0 = Vs[s * 128 + lane], v1 = Vs[s * 128 + 64 + lane];
#pragma unroll
            for (int i = 0; i < 8; ++i) { const float bv = Bm[s * 65 + kg * 8 + i]; acc[i][0] += bv * v0; acc[i][1] += bv * v1; }
        }
        bf16_t* st = a.ST + st_off(grp, bh, c);
#pragma unroll
        for (int i = 0; i < 8; ++i) { st[(size_t)lane * 64 + kg * 8 + i] = f2bf(acc[i][0]); st[(size_t)(lane + 64) * 64 + kg * 8 + i] = f2bf(acc[i][1]); }
        __syncthreads();
    }
}

__global__ __launch_bounds__(512) void k_scan2(ScanArgs a) {
    const int gid = blockIdx.x * 512 + threadIdx.x;
    const int grp = gid >> 16, rem = gid & 65535, bh = rem >> 12, r2 = rem & 4095, v = r2 >> 5, k = (r2 & 31) * 2;
    float s0 = 0.f, s1 = 0.f;
    for (int c = 0; c < NCH; ++c) {
        unsigned* p = (unsigned*)(a.ST + st_off(grp, bh, c) + v * 64 + k);
        const unsigned w = *p;
        const float l0 = __uint_as_float(w << 16), l1 = __uint_as_float(w & 0xffff0000u);
        *p = (unsigned)f2bf(s0) | ((unsigned)f2bf(s1) << 16);
        const float* d = a.dec + ((size_t)(grp * 16 + bh) * NCH + c) * 64 + k;
        s0 = d[0] * (s0 + l0); s1 = d[1] * (s1 + l1);
    }
    if (gid < 1024) {
        const int bh2 = gid >> 6, k2 = gid & 63; float ns = 0.f;
        for (int c = 0; c < NCH; ++c) {
            float* p = a.NS + ((size_t)bh2 * NCH + c) * 64 + k2; const float l = *p; *p = ns;
            ns = a.dec[((size_t)(16 + bh2) * NCH + c) * 64 + k2] * (ns + l);
        }
    }
}

__global__ __launch_bounds__(512) void k_scan3(ScanArgs a) {
    extern __shared__ __attribute__((aligned(16))) float sm[];
    float* At = sm;
    float* Bm = At + 64 * 65;
    float* Pm = Bm + 64 * 65;
    float* Vs = Pm + 64 * 65;
    float* Ss = Vs + 64 * 128;
    float* blk = Ss + 64 * 128;
    float* lastv = blk + 512;
    float* nsv = lastv + 64;
    const int b = blockIdx.x / NCH, c = blockIdx.x % NCH, tid = threadIdx.x, lane = tid & 63, tg = tid >> 6;
    const int row0 = b * SEQ + c * CH;
    for (int hh = 0; hh < 8; ++hh) {
        const int grp = hh >> 2, h = hh & 3, bh = b * 4 + h;
        gate_stage<true>(a, b, c, hh, At, Bm, blk, lastv);
        const int voff = (grp == 0 ? C_GV : C_MV) + h * 128;
#pragma unroll 4
        for (int i = tid; i < 64 * 128; i += 512) { const int s = i >> 7, v = i & 127; Vs[i] = bf2f(a.P[(size_t)(row0 + s) * PP + voff + v]); }
        const bf16_t* st = a.ST + st_off(grp, bh, c);
#pragma unroll 4
        for (int i = tid; i < 64 * 128; i += 512) { const int v = i >> 6, k = i & 63; Ss[k * 128 + v] = bf2f(st[i]); }
        if (tid < 64) nsv[tid] = grp == 1 ? a.NS[((size_t)bh * NCH + c) * 64 + tid] : 0.f;
        __syncthreads();
        {
            const int t = tid >> 3, sg = tid & 7;
            float p[8];
#pragma unroll
            for (int i = 0; i < 8; ++i) p[i] = 0.f;
#pragma unroll 2
            for (int k = 0; k < 64; ++k) {
                const float av = At[t * 65 + k];
#pragma unroll
                for (int i = 0; i < 8; ++i) p[i] += av * Bm[(sg * 8 + i) * 65 + k];
            }
#pragma unroll
            for (int i = 0; i < 8; ++i) { const int s = sg * 8 + i; Pm[t * 65 + s] = s <= t ? p[i] : 0.f; }
        }
        __syncthreads();
        float acc[8][2], den[8];
#pragma unroll
        for (int i = 0; i < 8; ++i) { acc[i][0] = 0.f; acc[i][1] = 0.f; den[i] = 0.f; }
#pragma unroll 2
        for (int s = 0; s < 64; ++s) {
            const float v0 = Vs[s * 128 + lane], v1 = Vs[s * 128 + 64 + lane];
#pragma unroll
            for (int i = 0; i < 8; ++i) { const float pv = Pm[(tg * 8 + i) * 65 + s]; acc[i][0] += pv * v0; acc[i][1] += pv * v1; den[i] += pv; }
        }
#pragma unroll 2
        for (int k = 0; k < 64; ++k) {
            const float s0 = Ss[k * 128 + lane], s1 = Ss[k * 128 + 64 + lane], nk = nsv[k];
#pragma unroll
            for (int i = 0; i < 8; ++i) { const float av = At[(tg * 8 + i) * 65 + k]; acc[i][0] += av * s0; acc[i][1] += av * s1; den[i] += av * nk; }
        }
#pragma unroll
        for (int i = 0; i < 8; ++i) {
            const int row = row0 + tg * 8 + i;
            bf16_t* pr = a.P + (size_t)row * PP;
            float o0 = acc[i][0], o1 = acc[i][1];
            if (grp == 0) {
                const float ss = wave_sum(o0 * o0 + o1 * o1);
                const float rstd = rsqrtf(ss * (1.f / 128.f) + EPS);
                const float g0 = bf2f(pr[C_GR + h * 128 + lane]), g1 = bf2f(pr[C_GR + h * 128 + 64 + lane]);
                pr[C_GR + h * 128 + lane] = f2bf(o0 * rstd * a.gla_gain[h * 128 + lane] * siluf_(g0));
                pr[C_GR + h * 128 + 64 + lane] = f2bf(o1 * rstd * a.gla_gain[h * 128 + 64 + lane] * siluf_(g1));
            } else {
                const float dd = 1.f / fmaxf(fabsf(den[i]), 1.f);
                const float g0 = bf2f(pr[C_MO + h * 128 + lane]), g1 = bf2f(pr[C_MO + h * 128 + 64 + lane]);
                o0 = o0 * dd * sigmoidf_(g0); o1 = o1 * dd * sigmoidf_(g1);
                const float ss = wave_sum(o0 * o0 + o1 * o1);
                const float rstd = rsqrtf(ss * (1.f / 128.f) + EPS);
                pr[C_MO + h * 128 + lane] = f2bf(o0 * rstd * a.ml_gain[h * 128 + lane]);
                pr[C_MO + h * 128 + 64 + lane] = f2bf(o1 * rstd * a.ml_gain[h * 128 + 64 + lane]);
            }
        }
        __syncthreads();
    }
}

__global__ __launch_bounds__(256) void k_qkn(bf16_t* __restrict__ P, const float* __restrict__ qg, const float* __restrict__ kg) {
    const int wave = threadIdx.x >> 6, lane = threadIdx.x & 63;
    const int item = blockIdx.x * 4 + wave;
    const int row = item >> 4, hd = item & 15;
    unsigned* p = (unsigned*)(P + (size_t)row * PP + hd * 128 + lane * 2);
    const unsigned w = *p;
    const float a = __uint_as_float(w << 16), b = __uint_as_float(w & 0xffff0000u);
    const float ss = wave_sum(a * a + b * b);
    float r = rsqrtf(ss * (1.f / 128.f) + EPS);
    const float* g = hd < 8 ? qg : kg;
    if (hd < 8) r *= 0.08838834764831845f;
    *p = (unsigned)f2bf(a * r * g[lane * 2]) | ((unsigned)f2bf(b * r * g[lane * 2 + 1]) << 16);
}
__global__ __launch_bounds__(128) void k_kmean(const bf16_t* __restrict__ P, float* __restrict__ kmean) {
    const int u = blockIdx.x;
    const int blk = u & 15, h = (u >> 4) & 7, b = u >> 7, d = threadIdx.x;
    float s = 0.f;
    for (int r = 0; r < 256; ++r) s += bf2f(P[(size_t)(b * SEQ + blk * 256 + r) * PP + 1024 + h * 128 + d]);
    kmean[(size_t)u * 128 + d] = s * (1.f / 256.f);
}
__global__ __launch_bounds__(256) void k_attn_simple(bf16_t* __restrict__ P, const float* __restrict__ kmean) {
    __shared__ float qs_[4][128];
    __shared__ float sc_[4][1024];
    const int wave = threadIdx.x >> 6, lane = threadIdx.x & 63;
    const int item = blockIdx.x * 4 + wave;
    const int t = item & (SEQ - 1), h = (item >> 12) & 7, b = item >> 15;
    float* qs = qs_[wave]; float* sc = sc_[wave];
    const size_t row = (size_t)b * SEQ + t;
    {
        const unsigned w = *(const unsigned*)(P + row * PP + h * 128 + lane * 2);
        qs[lane * 2] = __uint_as_float(w << 16); qs[lane * 2 + 1] = __uint_as_float(w & 0xffff0000u);
    }
    __builtin_amdgcn_s_waitcnt(0xc07f);
    __builtin_amdgcn_wave_barrier();
    const int qblk = t >> 8;
    float g = -INFINITY;
    if (lane < qblk) { const float* km = kmean + ((size_t)((b * 8 + h) * 16 + lane)) * 128; float s = 0.f; for (int d = 0; d < 128; ++d) s += qs[d] * km[d]; g = s; }
    int sel0 = 0, sel1 = 0, sel2 = 0; const int nsel = qblk < 3 ? qblk : 3;
    {
        float gv[16];
#pragma unroll
        for (int n = 0; n < 16; ++n) gv[n] = __shfl(g, n);
        unsigned taken = 0u;
#pragma unroll
        for (int r = 0; r < 3; ++r) {
            int best = 0; float bv = -INFINITY; bool found = false;
#pragma unroll
            for (int n = 0; n < 16; ++n) { const bool ok = !((taken >> n) & 1u) && n < qblk; if (ok && (!found || gv[n] > bv)) { bv = gv[n]; best = n; found = true; } }
            if (r == 0) sel0 = best; else if (r == 1) sel1 = best; else sel2 = best;
            if (found) taken |= 1u << best;
        }
    }
    const float slope = exp2f(-(float)(h + 1));
    float mx = -1e30f;
    for (int r = 0; r <= nsel; ++r) {
        const int blk = r < nsel ? (r == 0 ? sel0 : (r == 1 ? sel1 : sel2)) : qblk;
        for (int sub = 0; sub < 4; ++sub) {
            const int key = blk * 256 + sub * 64 + lane; const int dist = t - key;
            const bf16_t* kr = P + ((size_t)b * SEQ + key) * PP + 1024 + h * 128;
            float s = 0.f;
            for (int d8 = 0; d8 < 16; ++d8) {
                const uint4 w = *(const uint4*)(kr + d8 * 8);
                const unsigned ww[4] = {w.x, w.y, w.z, w.w};
#pragma unroll
                for (int e = 0; e < 4; ++e) { s += qs[d8 * 8 + 2 * e] * __uint_as_float(ww[e] << 16); s += qs[d8 * 8 + 2 * e + 1] * __uint_as_float(ww[e] & 0xffff0000u); }
            }
            s = dist >= 0 ? s - slope * (float)dist : -1e30f;
            sc[r * 256 + sub * 64 + lane] = s; mx = fmaxf(mx, s);
        }
    }
    mx = wave_max(mx);
    float sum = 0.f;
    for (int i = lane; i < (nsel + 1) * 256; i += 64) { const float p = __expf(sc[i] - mx); sc[i] = p; sum += p; }
    sum = wave_sum(sum);
    __builtin_amdgcn_s_waitcnt(0xc07f);
    __builtin_amdgcn_wave_barrier();
    float a0 = 0.f, a1 = 0.f;
    for (int r = 0; r <= nsel; ++r) {
        const int blk = r < nsel ? (r == 0 ? sel0 : (r == 1 ? sel1 : sel2)) : qblk;
        const bf16_t* vr = P + ((size_t)b * SEQ + blk * 256) * PP + 2048 + h * 128 + lane * 2;
        for (int j = 0; j < 256; ++j) {
            const float p = sc[r * 256 + j];
            const unsigned w = *(const unsigned*)(vr + (size_t)j * PP);
            a0 += p * __uint_as_float(w << 16); a1 += p * __uint_as_float(w & 0xffff0000u);
        }
    }
    const float inv = 1.f / sum;
    *(unsigned*)(P + row * PP + h * 128 + lane * 2) = (unsigned)f2bf(a0 * inv) | ((unsigned)f2bf(a1 * inv) << 16);
}

extern "C" void kernel_launch(void* const* d_in, const int* in_sizes, int n_in, void* d_out, int out_size, void* d_ws, size_t ws_size, hipStream_t stream) {
    const float* x = (const float*)d_in[0];
    const float* norm_mix = (const float*)d_in[1];
    const float* norm_ffn = (const float*)d_in[2];
    const float* hyb_w_in = (const float*)d_in[3];
    const float* gla_w_gate2 = (const float*)d_in[4];
    const float* gla_b_gate = (const float*)d_in[5];
    const float* gla_norm = (const float*)d_in[6];
    const float* ml_conv = (const float*)d_in[7];
    const float* ml_b_if = (const float*)d_in[8];
    const float* ml_norm = (const float*)d_in[9];
    const float* hyb_w_out = (const float*)d_in[10];
    const float* moba_w_qkv = (const float*)d_in[11];
    const float* moba_q_norm = (const float*)d_in[12];
    const float* moba_k_norm = (const float*)d_in[13];
    const float* moba_w_o = (const float*)d_in[14];
    const float* ffn_w_gate = (const float*)d_in[15];
    const float* ffn_w_up = (const float*)d_in[16];
    const float* ffn_w_down = (const float*)d_in[17];
    float* out = (float*)d_out;
    char* ws = (char*)d_ws;
    float* rss = (float*)(ws + WS_RSS);
    float* small = (float*)(ws + WS_SMALL);
    float* kmean = (float*)(ws + WS_KMEAN);
    float* dec = (float*)(ws + WS_DEC);
    float* NS = (float*)(ws + WS_NS);
    bf16_t* xb = (bf16_t*)(ws + WS_XB);
    bf16_t* ST = (bf16_t*)(ws + WS_XB);
    bf16_t* P = (bf16_t*)(ws + WS_P);
    bf16_t* H = (bf16_t*)(ws + WS_P);

    static bool attr_done = false;
    constexpr int S1_LDS = (64 * 65 + 64 * 128 + 512 + 64) * 4;
    constexpr int S3_LDS = (3 * 64 * 65 + 2 * 64 * 128 + 512 + 128) * 4;
    if (!attr_done) {
        hipFuncSetAttribute((const void*)k_scan3, hipFuncAttributeMaxDynamicSharedMemorySize, S3_LDS);
        hipFuncSetAttribute((const void*)k_scan1, hipFuncAttributeMaxDynamicSharedMemorySize, S1_LDS);
        attr_done = true;
    }

    k_prep_rows<<<M / 4, 256, 0, stream>>>(x, xb, rss);
    const float* xcur = x;
    for (int l = 0; l < DEPTH; ++l) {
        const int j = l / 2;
        if ((l & 1) == 0) {
            EpiProjS e{P, small, rss};
            k_gemm_simple<false, EpiProjS><<<dim3((HYB_IN + 63) / 64, M / 64), 256, 0, stream>>>(xb, DM, hyb_w_in + (size_t)j * DM * HYB_IN, nullptr, HYB_IN, DM, norm_mix + l * DM, e);
            ScanArgs a{P, small, gla_w_gate2 + (size_t)j * 16 * 256, gla_b_gate + j * 256, gla_norm + j * 512, ml_conv + (size_t)j * 4 * 512, ml_b_if + j * 8, ml_norm + j * 512, ST, dec, NS};
            k_scan1<<<BATCH * NCH, 512, S1_LDS, stream>>>(a);
            k_scan2<<<256, 512, 0, stream>>>(a);
            k_scan3<<<BATCH * NCH, 512, S3_LDS, stream>>>(a);
            EpiResS er{xcur, out, xb};
            k_gemm_simple<false, EpiResS><<<dim3(DM / 64, M / 64), 256, 0, stream>>>(P + C_GR, PP, hyb_w_out + (size_t)j * DM * DM, nullptr, DM, DM, nullptr, er);
        } else {
            EpiPlainS e{P, rss};
            k_gemm_simple<false, EpiPlainS><<<dim3(3 * DM / 64, M / 64), 256, 0, stream>>>(xb, DM, moba_w_qkv + (size_t)j * DM * 3 * DM, nullptr, 3 * DM, DM, norm_mix + l * DM, e);
            k_qkn<<<M * 16 / 4, 256, 0, stream>>>(P, moba_q_norm + j * 128, moba_k_norm + j * 128);
            k_kmean<<<BATCH * 8 * 16, 128, 0, stream>>>(P, kmean);
            k_attn_simple<<<BATCH * 8 * SEQ / 4, 256, 0, stream>>>(P, kmean);
            EpiResS er{xcur, out, xb};
            k_gemm_simple<false, EpiResS><<<dim3(DM / 64, M / 64), 256, 0, stream>>>(P, PP, moba_w_o + (size_t)j * DM * DM, nullptr, DM, DM, nullptr, er);
        }
        xcur = out;
        k_rowss<<<M / 4, 256, 0, stream>>>(out, rss);
        EpiFfnS ef{H, rss};
        k_gemm_simple<true, EpiFfnS><<<dim3(DFF / 64, M / 64), 256, 0, stream>>>(xb, DM, ffn_w_gate + (size_t)l * DM * DFF, ffn_w_up + (size_t)l * DM * DFF, DFF, DM, norm_ffn + l * DM, ef);
        EpiResS er2{out, out, xb};
        k_gemm_simple<false, EpiResS><<<dim3(DM / 64, M / 64), 256, 0, stream>>>(H, DFF, ffn_w_down + (size_t)l * DFF * DM, nullptr, DM, DFF, nullptr, er2);
        k_rowss<<<M / 4, 256, 0, stream>>>(out, rss);
    }
}
```

```cpp
#include <hip/hip_runtime.h>
#include <cstdio>
#include <cstdint>

namespace pg8 {
#define PG8_LAS __attribute__((address_space(3)))
typedef unsigned short bf16_t;
typedef short bf16x8 __attribute__((ext_vector_type(8)));
typedef float f32x4 __attribute__((ext_vector_type(4)));
typedef unsigned u32x4 __attribute__((ext_vector_type(4)));
constexpr int BM = 256, BK = 64, HALF = 128, HTB = HALF * BK * 2  , STAGE_BYTES = 8 * HTB, NXCD = 8, WGM = 8;

__host__ __device__ __forceinline__ int lds_byte(int r, int c) { const int st = (r >> 4) * 2 + (c >> 5), rr = r & 15, cc = c & 31, ob = rr * 64 + cc * 2; return st * 1024 + (ob ^ (((ob >> 9) & 1) << 5)); }
__host__ __device__ __forceinline__ void stage_rc(int b, int& R, int& C) { const int st = b / 1024, sb = b % 1024, swz = sb ^ (((sb >> 9) & 1) << 5); R = (st >> 1) * 16 + swz / 64; C = (st & 1) * 32 + (swz % 64) / 2; }
__host__ __device__ __forceinline__ int perm32(int rho) { const int n = rho >> 4, i = rho & 15; return 8 * (i >> 2) + 4 * n + (i & 3); }

struct Unit { int pm, pn; };
struct Gemm { const bf16_t* A; const bf16_t* Bt; int M, N, K, lda; };

struct StaticOrder {
    int nM, nN, nwg, G, c;
    __host__ __device__ void init(int M, int N, int G_, int c_) { nM = M / BM; nN = N / BM; nwg = nM * nN; G = G_; c = c_; }
    __host__ __device__ bool next(int i, Unit& u) const {
        const long L = (long)i * G + c; if (L >= nwg) return false;
        int wgid = (int)L; { const int q = nwg / NXCD, r = nwg % NXCD, xcd = wgid % NXCD, off = wgid / NXCD; wgid = (xcd < r ? xcd * (q + 1) : r * (q + 1) + (xcd - r) * q) + off; }
        const int nig = WGM * nN, gid = wgid / nig, fm = gid * WGM, gsz = (nM - fm) < WGM ? (nM - fm) : WGM;
        u.pm = fm + ((wgid % nig) % gsz); u.pn = (wgid % nig) / gsz; return true;
    }
    __device__ __forceinline__ void a_ready(const Unit&) const {}
    __device__ __forceinline__ void done(const Unit&) const {}
};
__device__ __forceinline__ unsigned cvt_pk_bf16(float lo, float hi) { unsigned r; asm volatile("v_cvt_pk_bf16_f32 %0, %1, %2" : "=v"(r) : "v"(lo), "v"(hi)); return r; }
template <class Epi, class Sched, bool ALIGN_EPI = false, bool SP2 = false>
__device__ __forceinline__ void gemm_phase(PG8_LAS unsigned char* lds, const Gemm g, const Sched& S, const Epi& E) {
    int tid_ = threadIdx.x; asm volatile("" : "+v"(tid_));
    const int tid = tid_, wid = __builtin_amdgcn_readfirstlane(tid >> 6), lane = tid & 63, wr = wid >> 2, wc = wid & 3, fr = lane & 15, fq = lane >> 4;
    const int K = g.K, nt = K / BK;
    unsigned voffA[2], voffB[2];
#pragma unroll
    for (int i = 0; i < 2; ++i) { int R, C; stage_rc(tid * 16 + i * 8192, R, C); const int Rb = Epi::PERM ? ((R & ~31) + perm32(R & 31)) : R;
        voffA[i] = (unsigned)(R * g.lda + C) * 2u; voffB[i] = (unsigned)(Rb * K + C) * 2u; }
    const size_t kstep = (size_t)(BK * 2);
    const size_t hstepB = (size_t)HALF * K * 2, hstepA = (size_t)HALF * g.lda * 2;
    const size_t tstepA = 2 * hstepA, tstepB = 2 * hstepB;
    const unsigned ldsw = (unsigned)wid * 1024u;
    const int aoff = lds_byte(wr * 64 + fr, fq * 8), boff = lds_byte(wc * 32 + fr, fq * 8);
#define PG8_SA(b, h) (((b) * 2 + (h)) * HTB)
#define PG8_SB(b, h) ((4 + (b) * 2 + (h)) * HTB)
#define PG8_STAGE(bufoff, gbase, voff) do { _Pragma("unroll") for (int _i = 0; _i < 2; ++_i) \
        __builtin_amdgcn_global_load_lds((const unsigned*)((const char*)(gbase) + (voff)[_i]), (PG8_LAS unsigned*)(lds + (bufoff) + ldsw + _i * 8192), 16, 0, 0); } while (0)
#define PG8_LDA(dst, b, h) do { _Pragma("unroll") for (int m = 0; m < 4; ++m) _Pragma("unroll") for (int k = 0; k < 2; ++k) dst[m][k] = *(const PG8_LAS bf16x8*)(lds + PG8_SA(b, h) + aoff + m * 2048 + k * 1024); } while (0)
#define PG8_LDB(dst, b, h) do { _Pragma("unroll") for (int n = 0; n < 2; ++n) _Pragma("unroll") for (int k = 0; k < 2; ++k) dst[n][k] = *(const PG8_LAS bf16x8*)(lds + PG8_SB(b, h) + boff + n * 2048 + k * 1024); } while (0)
#define PG8_MMA(ai, bj, At, Bt) do { __builtin_amdgcn_s_setprio(1); _Pragma("unroll") for (int m = 0; m < 4; ++m) _Pragma("unroll") for (int n = 0; n < 2; ++n) _Pragma("unroll") for (int k = 0; k < 2; ++k) \
        acc[ai][bj][m][n] = __builtin_amdgcn_mfma_f32_16x16x32_bf16(Bt[n][k], At[m][k], acc[ai][bj][m][n], 0, 0, 0); __builtin_amdgcn_s_setprio(0); } while (0)
#define PG8_WAIT_V(n) asm volatile("s_waitcnt vmcnt(" #n ")" ::: "memory")
#define PG8_WAIT_L(n) asm volatile("s_waitcnt lgkmcnt(" #n ")" ::: "memory")
#define PG8_BAR __builtin_amdgcn_s_barrier()
#define PG8_SCHED __builtin_amdgcn_sched_barrier(0)
    Unit cur, nxt; int ui = 0;
    if (!S.next(0, cur)) return;
    f32x4 acc[2][2][4][2];
#pragma unroll
    for (int a = 0; a < 2; ++a)
#pragma unroll
        for (int b = 0; b < 2; ++b)
#pragma unroll
            for (int m = 0; m < 4; ++m)
#pragma unroll
                for (int n = 0; n < 2; ++n) acc[a][b][m][n] = (f32x4){0.f, 0.f, 0.f, 0.f};
    bf16x8 At[4][2], B0[2][2], B1[2][2];
    const char* cA = (const char*)g.A + (size_t)cur.pm * tstepA; const char* cB = (const char*)g.Bt + (size_t)cur.pn * tstepB;
    S.a_ready(cur);
    if constexpr (SP2) {
        PG8_STAGE(PG8_SB(0, 0), cB, voffB); PG8_STAGE(PG8_SB(0, 1), cB + hstepB, voffB); PG8_STAGE(PG8_SA(0, 0), cA, voffA); PG8_STAGE(PG8_SA(0, 1), cA + hstepA, voffA);
        if (wr == 1) PG8_BAR;
        PG8_WAIT_V(2); PG8_BAR;
        PG8_STAGE(PG8_SB(1, 0), cB + kstep, voffB); PG8_STAGE(PG8_SA(1, 0), cA + kstep, voffA); PG8_STAGE(PG8_SB(1, 1), cB + hstepB + kstep, voffB);
        PG8_WAIT_V(6); PG8_BAR;
    } else {
        PG8_STAGE(PG8_SB(0, 0), cB, voffB); PG8_STAGE(PG8_SA(0, 0), cA, voffA); PG8_STAGE(PG8_SB(0, 1), cB + hstepB, voffB); PG8_STAGE(PG8_SA(0, 1), cA + hstepA, voffA);
        if (wr == 1) PG8_BAR;
        PG8_WAIT_V(4); PG8_BAR;
        PG8_STAGE(PG8_SB(1, 0), cB + kstep, voffB); PG8_STAGE(PG8_SA(1, 0), cA + kstep, voffA); PG8_STAGE(PG8_SB(1, 1), cB + hstepB + kstep, voffB);
        PG8_WAIT_V(6); PG8_BAR;
    }
    for (;;) {
        const bool has_next = S.next(ui + 1, nxt);
        const char* nA = has_next ? (const char*)g.A + (size_t)nxt.pm * tstepA : cA; const char* nB = has_next ? (const char*)g.Bt + (size_t)nxt.pn * tstepB : cB;
        for (int t = 0; t < nt; t += 2) {
            const bool last = (t == nt - 2);
            const char* a1 = cA + (size_t)(t + 1) * kstep;
            const char* a2 = last ? nA : cA + (size_t)(t + 2) * kstep; const char* b2 = last ? nB : cB + (size_t)(t + 2) * kstep;
            const char* a3 = a2 + kstep; const char* b3 = b2 + kstep;
            if (last && has_next) S.a_ready(nxt);
            if constexpr (SP2) {
            PG8_LDB(B0, 0, 0); PG8_LDB(B1, 0, 1); PG8_SCHED; PG8_LDA(At, 0, 0); PG8_STAGE(PG8_SA(1, 1), a1 + hstepA, voffA);
            PG8_WAIT_V(8); PG8_WAIT_L(0); PG8_BAR; PG8_MMA(0, 0, At, B0); PG8_MMA(0, 1, At, B1); PG8_BAR; PG8_SCHED;
            PG8_LDA(At, 0, 1); PG8_STAGE(PG8_SB(0, 0), b2, voffB); PG8_STAGE(PG8_SB(0, 1), b2 + hstepB, voffB); PG8_STAGE(PG8_SA(0, 0), a2, voffA);
            PG8_WAIT_V(8); PG8_WAIT_L(0); PG8_BAR; PG8_MMA(1, 0, At, B0); PG8_MMA(1, 1, At, B1); PG8_BAR; PG8_SCHED;
            PG8_LDB(B0, 1, 0); PG8_LDB(B1, 1, 1); PG8_SCHED; PG8_LDA(At, 1, 0); PG8_STAGE(PG8_SA(0, 1), a2 + hstepA, voffA);
            PG8_WAIT_V(8); PG8_WAIT_L(0); PG8_BAR; PG8_MMA(0, 0, At, B0); PG8_MMA(0, 1, At, B1); PG8_BAR; PG8_SCHED;
            PG8_LDA(At, 1, 1); PG8_STAGE(PG8_SB(1, 0), b3, voffB); PG8_STAGE(PG8_SB(1, 1), b3 + hstepB, voffB); PG8_STAGE(PG8_SA(1, 0), a3, voffA);
            PG8_WAIT_V(8); PG8_WAIT_L(0); PG8_BAR; PG8_MMA(1, 0, At, B0); PG8_MMA(1, 1, At, B1); PG8_BAR; PG8_SCHED;
            } else {
            PG8_LDB(B0, 0, 0); PG8_SCHED; PG8_LDA(At, 0, 0); PG8_STAGE(PG8_SA(1, 1), a1 + hstepA, voffA);
            PG8_WAIT_L(8); PG8_BAR; PG8_WAIT_L(0); PG8_MMA(0, 0, At, B0); PG8_BAR; PG8_SCHED;
            PG8_LDB(B1, 0, 1); PG8_STAGE(PG8_SB(0, 0), b2, voffB);
            PG8_BAR; PG8_WAIT_L(0); PG8_MMA(0, 1, At, B1); PG8_BAR;
            PG8_LDA(At, 0, 1); PG8_STAGE(PG8_SA(0, 0), a2, voffA);
            PG8_BAR; PG8_WAIT_L(0); PG8_MMA(1, 0, At, B0); PG8_BAR; PG8_SCHED;
            PG8_STAGE(PG8_SB(0, 1), b2 + hstepB, voffB);
            PG8_WAIT_V(6); PG8_BAR; PG8_MMA(1, 1, At, B1); PG8_BAR;
            PG8_LDB(B0, 1, 0); PG8_SCHED; PG8_LDA(At, 1, 0); PG8_STAGE(PG8_SA(0, 1), a2 + hstepA, voffA);
            PG8_WAIT_L(8); PG8_BAR; PG8_WAIT_L(0); PG8_MMA(0, 0, At, B0); PG8_BAR; PG8_SCHED;
            PG8_LDB(B1, 1, 1); PG8_STAGE(PG8_SB(1, 0), b3, voffB);
            PG8_BAR; PG8_WAIT_L(0); PG8_MMA(0, 1, At, B1); PG8_BAR;
            PG8_LDA(At, 1, 1); PG8_STAGE(PG8_SA(1, 0), a3, voffA);
            PG8_BAR; PG8_WAIT_L(0); PG8_MMA(1, 0, At, B0); PG8_BAR; PG8_SCHED;
            PG8_STAGE(PG8_SB(1, 1), b3 + hstepB, voffB);
            PG8_WAIT_V(6); PG8_BAR; PG8_MMA(1, 1, At, B1); PG8_BAR;
            }
        }
        if constexpr (ALIGN_EPI) { if (wr == 0) PG8_BAR; }
        if constexpr (!Epi::AFTER_DRAIN) { E(acc, cur, wr, wc, fr, fq); S.done(cur); }
        if (!has_next) break;
#pragma unroll
        for (int a = 0; a < 2; ++a)
#pragma unroll
            for (int b = 0; b < 2; ++b)
#pragma unroll
                for (int m = 0; m < 4; ++m)
#pragma unroll
                    for (int n = 0; n < 2; ++n) acc[a][b][m][n] = (f32x4){0.f, 0.f, 0.f, 0.f};
        cur = nxt; cA = nA; cB = nB; ++ui;
        if constexpr (ALIGN_EPI) { if (wr == 1) PG8_BAR; }
    }
    PG8_WAIT_V(0);
    if constexpr (!ALIGN_EPI) { if (wr == 0) PG8_BAR; }
    PG8_BAR;
    if constexpr (Epi::AFTER_DRAIN) { E.fused(acc, cur, wr, wc, fr, fq, lds, wid, lane); S.done(cur); }
#undef PG8_SA
#undef PG8_SB
#undef PG8_STAGE
#undef PG8_LDA
#undef PG8_LDB
#undef PG8_MMA
#undef PG8_WAIT_V
#undef PG8_WAIT_L
#undef PG8_BAR
#undef PG8_SCHED
}
}


typedef unsigned short bf16_t;
typedef float f32x4 __attribute__((ext_vector_type(4)));
typedef unsigned u32x4 __attribute__((ext_vector_type(4)));
#define LAS __attribute__((address_space(3)))
#define GAS __attribute__((address_space(1)))

#ifndef PH_MASK
#define PH_MASK 0xffff
#endif
#ifndef ATTN_SIMPLE
#define ATTN_SIMPLE 0
#endif
#ifndef MK_MULTI
#define MK_MULTI 0
#endif

constexpr int BATCH = 4, SEQ = 4096, DM = 1024, M = BATCH * SEQ, DEPTH = 4;
constexpr int DFF = 2816;
constexpr int HYB_IN = 3096, HYB_PAD = 3328;
constexpr int NCH = 64, CH = 64;
constexpr float EPS = 1e-6f;
constexpr int PP = 3072;
constexpr int C_GQ = 0, C_GK = 256, C_GV = 512, C_MQ = 1024, C_MK = 1280, C_MV = 1536, C_GR = 2048, C_MO = 2560;
constexpr int SMALLP = 32;

constexpr size_t MiB = 1u << 20;
constexpr size_t WS_CTL = 0, CTL_ZERO_BYTES = 65536, WS_RSS = 1 * MiB, WS_SMALL = 2 * MiB, WS_KMEAN = 4 * MiB, WS_DEC = 5 * MiB, WS_NS = 6 * MiB;
constexpr size_t WS_XB = 8 * MiB, WS_P = 40 * MiB, WS_W = 136 * MiB;
constexpr size_t W_IN = 0, W_OUT = W_IN + (size_t)HYB_PAD * DM * 2, W_QKV = W_OUT + (size_t)DM * DM * 2, W_O = W_QKV + (size_t)3 * DM * DM * 2, W_MIXSZ = W_O + (size_t)DM * DM * 2;
constexpr size_t W_FFN0 = 2 * W_MIXSZ, W_GU = 0, W_D = (size_t)2 * DFF * DM * 2, W_FFNSZ = W_D + (size_t)DM * DFF * 2;
constexpr size_t WS_END = WS_W + W_FFN0 + 4 * W_FFNSZ;
static_assert(WS_END <= 256 * MiB, "workspace map");

constexpr int RING_BYTES = 131072, MISC_OFF = RING_BYTES + 320, LDS_BYTES = 147456;
constexpr int NWAVES = 8, NTHR = 512;

__device__ __forceinline__ float bf2f(bf16_t v) { return __uint_as_float((unsigned)v << 16); }
__device__ __forceinline__ unsigned f2bf(float f) { unsigned u = __float_as_uint(f); return (u + 0x7fffu + ((u >> 16) & 1u)) >> 16; }
__device__ __forceinline__ unsigned pk2(float lo, float hi) { return f2bf(lo) | (f2bf(hi) << 16); }
__device__ __forceinline__ float sigmoidf_(float x) { return 1.f / (1.f + __expf(-x)); }
__device__ __forceinline__ float siluf_(float x) { return x / (1.f + __expf(-x)); }
__device__ __forceinline__ float logsigmoidf_(float x) { return fminf(x, 0.f) - log1pf(__expf(-fabsf(x))); }
__device__ __forceinline__ float wave_sum(float v) {
#pragma unroll
    for (int o = 1; o < 64; o <<= 1) v += __shfl_xor(v, o);
    return v;
}
__device__ __forceinline__ float wave_max(float v) {
#pragma unroll
    for (int o = 1; o < 64; o <<= 1) v = fmaxf(v, __shfl_xor(v, o));
    return v;
}
__device__ __forceinline__ int opaque_i(int v) { asm volatile("" : "+v"(v)); return v; }
__device__ __forceinline__ float row_rstd(const float* rss, int row) {
    const f32x4* p = (const f32x4*)(rss + (size_t)row * 16);
    const f32x4 a = p[0], b = p[1], c = p[2], d = p[3];
    const float s = ((a.x + a.y) + (a.z + a.w)) + ((b.x + b.y) + (b.z + b.w)) + ((c.x + c.y) + (c.z + c.w)) + ((d.x + d.y) + (d.z + d.w));
    return rsqrtf(s * (1.f / DM) + EPS);
}

#define XB_TMO      128
#define XB_XCNT(j)  (256  + 64 * (j))
#define XB_XSUB(j)  (1280 + 64 * (j))
#define XB_XGEN(j)  (2304 + 64 * (j))
#define XB_TOP      3328
#define XB_TOPGEN   3392
#define XCD_BAR_WORDS 3456
#define XB_SPIN_CAP (1u << 18)
__device__ __forceinline__ unsigned xb_ld(unsigned* p)              { return __hip_atomic_load(p, __ATOMIC_RELAXED, __HIP_MEMORY_SCOPE_AGENT); }
__device__ __forceinline__ unsigned xb_add(unsigned* p, unsigned v) { return __hip_atomic_fetch_add(p, v, __ATOMIC_RELAXED, __HIP_MEMORY_SCOPE_AGENT); }
__device__ __forceinline__ unsigned xb_xcc_id() { return (unsigned)__builtin_amdgcn_s_getreg((3 << 11) | 20) & 0xFu; }
#define XB_SPIN(cond, bar) do { unsigned _sp = 0; while (cond) { __builtin_amdgcn_s_sleep(1); \
    if ((++_sp & 255u) == 0u) { if (xb_ld(&(bar)[XB_TMO])) break; if (_sp > XB_SPIN_CAP) { atomicAdd(&(bar)[XB_TMO], 1u); break; } } } } while (0)
struct XcdBarrier { unsigned* bar; unsigned x; volatile LAS unsigned* st; };
__device__ __forceinline__ XcdBarrier xcd_barrier_post(unsigned* bar, volatile LAS unsigned* st) {
    XcdBarrier b; b.bar = bar; b.x = xb_xcc_id(); b.st = st;
    if (threadIdx.x == 0) (void)xb_add(&bar[XB_XCNT(b.x)], 1u);
    return b;
}
__device__ __forceinline__ void xcd_barrier_complete(unsigned* bar, unsigned x, unsigned& nloc, unsigned& nx) {
    const unsigned G = gridDim.x * gridDim.y * gridDim.z;
    unsigned sum, cnt, mine, sp = 0u;
    for (;;) {
        sum = 0u; cnt = 0u; mine = 0u;
#pragma unroll
        for (unsigned j = 0; j < 16; ++j) { const unsigned c = xb_ld(&bar[XB_XCNT(j)]); sum += c; cnt += (c > 0u) ? 1u : 0u; mine = (j == x) ? c : mine; }
        if (sum == G) break;
        __builtin_amdgcn_s_sleep(1);
        if ((++sp & 255u) == 0u) { if (xb_ld(&bar[XB_TMO])) break; if (sp > XB_SPIN_CAP) { atomicAdd(&bar[XB_TMO], 1u); break; } }
    }
    nloc = mine > 0u ? mine : 1u; nx = cnt > 0u ? cnt : 1u;
}
__device__ __forceinline__ void xcd_barrier(const XcdBarrier& b) {
    asm volatile("s_waitcnt vmcnt(0)" ::: "memory");
    __syncthreads();
    if (threadIdx.x == 0) {
        unsigned* bar = b.bar;
        __builtin_amdgcn_s_waitcnt(0);
        unsigned nloc = b.st[0], nx = b.st[1];
        if (nloc == 0u) { xcd_barrier_complete(bar, b.x, nloc, nx); b.st[0] = nloc; b.st[1] = nx; }
        const unsigned old = xb_add(&bar[XB_XSUB(b.x)], 1u);
        const unsigned gen = old / nloc;
        if (old + 1u == (gen + 1u) * nloc) {
            __builtin_amdgcn_fence(__ATOMIC_RELEASE, "agent");
            asm volatile("s_waitcnt vmcnt(0)" ::: "memory");
            const unsigned og = xb_add(&bar[XB_TOP], 1u);
            const unsigned tg = og / nx;
            if (og + 1u == (tg + 1u) * nx) xb_add(&bar[XB_TOPGEN], 1u);
            else XB_SPIN(xb_ld(&bar[XB_TOPGEN]) == tg, bar);
            __builtin_amdgcn_fence(__ATOMIC_ACQUIRE, "agent");
            xb_add(&bar[XB_XGEN(b.x)], 1u);
            asm volatile("s_waitcnt vmcnt(0)" ::: "memory");
        } else {
            XB_SPIN(xb_ld(&bar[XB_XGEN(b.x)]) == gen, bar);
            __builtin_amdgcn_fence(__ATOMIC_ACQUIRE, "agent");
            asm volatile("s_waitcnt vmcnt(0)" ::: "memory");
        }
    }
    __syncthreads();
}

struct EpiRowBf16 {
    static constexpr bool PERM = true, AFTER_DRAIN = false;
    bf16_t* O; int ldc; const float* rss; float* small; int small_pn;
    __device__ __forceinline__ void operator()(const pg8::f32x4 (&acc)[2][2][4][2], const pg8::Unit& u, int wr, int wc, int fr, int fq) const {
        const int row0 = u.pm * 256 + wr * 64 + fr;
        if (u.pn == small_pn) {
            if (wc == 0) {
#pragma unroll
                for (int ai = 0; ai < 2; ++ai)
#pragma unroll
                    for (int m = 0; m < 4; ++m) { const int row = row0 + ai * 128 + m * 16; const float rs = row_rstd(rss, row);
#pragma unroll
                        for (int n = 0; n < 2; ++n) *(f32x4*)(small + (size_t)row * SMALLP + 8 * fq + 4 * n) = acc[ai][0][m][n] * rs; }
            }
            return;
        }
        const int col0 = u.pn * 256 + wc * 32 + 8 * fq;
#pragma unroll
        for (int ai = 0; ai < 2; ++ai)
#pragma unroll
            for (int m = 0; m < 4; ++m) { const int row = row0 + ai * 128 + m * 16; const float rs = row_rstd(rss, row);
                bf16_t* rowp = O + (size_t)row * ldc + col0;
#pragma unroll
                for (int bj = 0; bj < 2; ++bj) { const f32x4 v0 = acc[ai][bj][m][0] * rs, v1 = acc[ai][bj][m][1] * rs;
                    u32x4 w; w.x = pg8::cvt_pk_bf16(v0[0], v0[1]); w.y = pg8::cvt_pk_bf16(v0[2], v0[3]); w.z = pg8::cvt_pk_bf16(v1[0], v1[1]); w.w = pg8::cvt_pk_bf16(v1[2], v1[3]);
                    *(u32x4*)(rowp + bj * 128) = w; } }
    }
};
struct EpiRes {
    static constexpr bool PERM = true, AFTER_DRAIN = false;
    const float* xin; float* xout; bf16_t* xb; float* rss;
    __device__ __forceinline__ void operator()(const pg8::f32x4 (&acc)[2][2][4][2], const pg8::Unit& u, int wr, int wc, int fr, int fq) const {
        const int row0 = u.pm * 256 + wr * 64 + fr, col0 = u.pn * 256 + wc * 32 + 8 * fq;
#pragma unroll
        for (int ai = 0; ai < 2; ++ai)
#pragma unroll
            for (int m = 0; m < 4; ++m) { const int row = row0 + ai * 128 + m * 16; float ss = 0.f;
#pragma unroll
                for (int bj = 0; bj < 2; ++bj) { const size_t off = (size_t)row * DM + col0 + bj * 128;
                    f32x4 a = *(const f32x4*)(xin + off), b = *(const f32x4*)(xin + off + 4);
                    a = a + acc[ai][bj][m][0]; b = b + acc[ai][bj][m][1];
                    *(f32x4*)(xout + off) = a; *(f32x4*)(xout + off + 4) = b;
                    u32x4 w; w.x = pg8::cvt_pk_bf16(a[0], a[1]); w.y = pg8::cvt_pk_bf16(a[2], a[3]); w.z = pg8::cvt_pk_bf16(b[0], b[1]); w.w = pg8::cvt_pk_bf16(b[2], b[3]);
                    *(u32x4*)(xb + off) = w;
                    ss += (a[0] * a[0] + a[1] * a[1]) + (a[2] * a[2] + a[3] * a[3]) + (b[0] * b[0] + b[1] * b[1]) + (b[2] * b[2] + b[3] * b[3]); }
                ss += __shfl_xor(ss, 16); ss += __shfl_xor(ss, 32);
                if (fq == 0) rss[(size_t)row * 16 + u.pn * 4 + wc] = ss; }
    }
};
struct EpiFfn {
    static constexpr bool PERM = true, AFTER_DRAIN = false;
    bf16_t* H; const float* rss;
    __device__ __forceinline__ void operator()(const pg8::f32x4 (&acc)[2][2][4][2], const pg8::Unit& u, int wr, int wc, int fr, int fq) const {
        const int row0 = u.pm * 256 + wr * 64 + fr, col0 = u.pn * 128 + wc * 32 + 8 * fq;
#pragma unroll
        for (int ai = 0; ai < 2; ++ai)
#pragma unroll
            for (int m = 0; m < 4; ++m) { const int row = row0 + ai * 128 + m * 16; const float rs = row_rstd(rss, row);
                float hv[8];
#pragma unroll
                for (int n = 0; n < 2; ++n)
#pragma unroll
                    for (int e = 0; e < 4; ++e) { const float g = acc[ai][0][m][n][e] * rs, uu = acc[ai][1][m][n][e] * rs; hv[n * 4 + e] = siluf_(g) * uu; }
                u32x4 w; w.x = pg8::cvt_pk_bf16(hv[0], hv[1]); w.y = pg8::cvt_pk_bf16(hv[2], hv[3]); w.z = pg8::cvt_pk_bf16(hv[4], hv[5]); w.w = pg8::cvt_pk_bf16(hv[6], hv[7]);
                *(u32x4*)(H + (size_t)row * DFF + col0) = w; }
    }
};

struct Args { const float* in[18]; float* out; unsigned char* ws; int ph_lo, ph_hi; };
struct Frame {
    LAS unsigned char* lds; unsigned char* ldsg;
    int tid, lane, wave, G, bid;
};


typedef const __attribute__((address_space(4))) unsigned char* kargp_t;
__device__ __forceinline__ kargp_t karg_base() { kargp_t p = (kargp_t)__builtin_amdgcn_kernarg_segment_ptr(); asm volatile("" : "+s"(p)); return p; }
__device__ __forceinline__ const float* karg_in(kargp_t p, int i) { return *(const float* const __attribute__((address_space(4)))*)(p + 8 * i); }
__device__ __forceinline__ float* karg_out(kargp_t p) { return *(float* const __attribute__((address_space(4)))*)(p + 8 * 18); }
__device__ __forceinline__ unsigned char* karg_ws(kargp_t p) { return *(unsigned char* const __attribute__((address_space(4)))*)(p + 8 * 19); }

__device__ __forceinline__ int map_row(int kind, int n) {
    if (kind == 0) return n;
    if (kind == 2) return (n >> 7) * 256 + (n & 127);
    if (kind == 3) return (n >> 7) * 256 + 128 + (n & 127);
    if (n < 256) return C_GQ + n; if (n < 512) return C_GK + n - 256; if (n < 1024) return C_GV + n - 512; if (n < 1536) return C_GR + n - 1024;
    if (n < 1552) return 3072 + (n - 1536);
    if (n < 1808) return C_MQ + n - 1552; if (n < 2064) return C_MK + n - 1808; if (n < 2576) return C_MV + n - 2064; if (n < 3088) return C_MO + n - 2576;
    return 3072 + 16 + (n - 3088);
}
__device__ __forceinline__ void cvt_item(const float* W, int K, int N, const float* gain, bf16_t* WT, int kind, LAS float* scr, int item, int lane) {
    const int nblk = (N + 31) / 32, kb = item / nblk, nb = item % nblk, k0 = 64 * kb, n0 = 32 * nb;
    const int nn = n0 + (lane & 31);
#pragma unroll 8
    for (int i = 0; i < 32; ++i) { const int kk = 2 * i + (lane >> 5);
        float v = 0.f; if (nn < N) { v = W[(size_t)(k0 + kk) * N + nn]; if (gain) v *= gain[k0 + kk]; }
        scr[kk * 33 + (lane & 31)] = v; }
    asm volatile("s_waitcnt lgkmcnt(0)" ::: "memory");
    const int c = lane & 7;
#pragma unroll
    for (int j = 0; j < 4; ++j) { const int nl = (lane >> 3) + 8 * j; const LAS float* s = scr + (8 * c) * 33 + nl;
        if (n0 + nl < N) {
            u32x4 o; o.x = pk2(s[0 * 33], s[1 * 33]); o.y = pk2(s[2 * 33], s[3 * 33]); o.z = pk2(s[4 * 33], s[5 * 33]); o.w = pk2(s[6 * 33], s[7 * 33]);
            *(u32x4*)(WT + (size_t)map_row(kind, n0 + nl) * K + k0 + 8 * c) = o; } }
    asm volatile("s_waitcnt lgkmcnt(0)" ::: "memory");
}
__device__ __forceinline__ void cvt_matrix(Frame& F, const float* W, int K, int N, const float* gain, bf16_t* WT, int kind) {
    LAS float* scr = (LAS float*)(F.lds + F.wave * 16384);
    const int gw = F.bid * NWAVES + F.wave, NGW = F.G * NWAVES;
    const int nitems = (K / 64) * ((N + 31) / 32);
    for (int it = gw; it < nitems; it += NGW) cvt_item(W, K, N, gain, WT, kind, scr, it, F.lane);
}
__device__ __forceinline__ void phase_prologue(Frame& F) {
    kargp_t kp = karg_base();
    unsigned char* wsw = karg_ws(kp) + WS_W;
    for (int j = 0; j < 2; ++j) {
        unsigned char* wj = wsw + j * W_MIXSZ;
        cvt_matrix(F, karg_in(kp, 3) + (size_t)j * DM * HYB_IN, DM, HYB_IN, karg_in(kp, 1) + (2 * j) * DM, (bf16_t*)(wj + W_IN), 1);
        cvt_matrix(F, karg_in(kp, 10) + (size_t)j * DM * DM, DM, DM, nullptr, (bf16_t*)(wj + W_OUT), 0);
        cvt_matrix(F, karg_in(kp, 11) + (size_t)j * DM * 3 * DM, DM, 3 * DM, karg_in(kp, 1) + (2 * j + 1) * DM, (bf16_t*)(wj + W_QKV), 0);
        cvt_matrix(F, karg_in(kp, 14) + (size_t)j * DM * DM, DM, DM, nullptr, (bf16_t*)(wj + W_O), 0);
        u32x4* z = (u32x4*)(wj + W_IN + (size_t)(3072 + 24) * DM * 2);
        const int nz = (HYB_PAD - 3096) * DM * 2 / 16;
        for (int i = F.bid * NTHR + F.tid; i < nz; i += F.G * NTHR) z[i] = (u32x4){0u, 0u, 0u, 0u};
    }
    for (int l = 0; l < 4; ++l) {
        unsigned char* wl = wsw + W_FFN0 + l * W_FFNSZ;
        cvt_matrix(F, karg_in(kp, 15) + (size_t)l * DM * DFF, DM, DFF, karg_in(kp, 2) + l * DM, (bf16_t*)(wl + W_GU), 2);
        cvt_matrix(F, karg_in(kp, 16) + (size_t)l * DM * DFF, DM, DFF, karg_in(kp, 2) + l * DM, (bf16_t*)(wl + W_GU), 3);
        cvt_matrix(F, karg_in(kp, 17) + (size_t)l * DFF * DM, DFF, DM, nullptr, (bf16_t*)(wl + W_D), 0);
    }
    const float* x = karg_in(kp, 0); bf16_t* xb = (bf16_t*)(karg_ws(kp) + WS_XB); float* rss = (float*)(karg_ws(kp) + WS_RSS);
    const int gw = F.bid * NWAVES + F.wave, NGW = F.G * NWAVES;
    for (int row = gw; row < M; row += NGW) {
        const float* xr = x + (size_t)row * DM; float s = 0.f;
#pragma unroll
        for (int j = 0; j < 4; ++j) { const f32x4 v = *(const f32x4*)(xr + j * 256 + F.lane * 4);
            s += (v.x * v.x + v.y * v.y) + (v.z * v.z + v.w * v.w);
            unsigned long long o = (unsigned long long)pk2(v.x, v.y) | ((unsigned long long)pk2(v.z, v.w) << 32);
            *(unsigned long long*)(xb + (size_t)row * DM + j * 256 + F.lane * 4) = o; }
        s = wave_sum(s);
        if (F.lane < 16) rss[(size_t)row * 16 + F.lane] = F.lane == 0 ? s : 0.f;
    }
}

struct ScanArgs {
    bf16_t* P; const float* small;
    const float* w2; const float* bgate; const float* gla_gain; const float* convw; const float* bif; const float* ml_gain;
    bf16_t* ST; float* dec; float* NS;
};
__device__ __forceinline__ size_t st_off(int grp, int bh, int c) { return ((size_t)((grp * 16 + bh) * NCH + c)) * 8192; }

template <bool NEED_A>
__device__ __forceinline__ void gate_stage(const ScanArgs& a, int b, int c, int hh, float* At, float* Bm, float* blk, float* lastv) {
    int tid_ = threadIdx.x; asm volatile("" : "+v"(tid_));
    const int tid = tid_, tb = tid >> 6, k = tid & 63;
    const int grp = hh >> 2, h = hh & 3;
    const int row0 = b * SEQ + c * CH;
    float la[8];
    if (grp == 0) {
        float w2r[16];
#pragma unroll
        for (int r = 0; r < 16; ++r) w2r[r] = a.w2[r * 256 + h * 64 + k];
        const float bg = a.bgate[h * 64 + k];
#pragma unroll
        for (int i = 0; i < 8; ++i) {
            const float* g = a.small + (size_t)(row0 + tb * 8 + i) * SMALLP;
            float z = bg;
#pragma unroll
            for (int r = 0; r < 16; ++r) z += g[r] * w2r[r];
            la[i] = logsigmoidf_(z) * (1.f / 16.f);
            asm volatile("" ::: "memory");
        }
    } else {
#pragma unroll
        for (int i = 0; i < 8; ++i) {
            const float* g = a.small + (size_t)(row0 + tb * 8 + i) * SMALLP;
            la[i] = logsigmoidf_(g[20 + h] + a.bif[4 + h]);
        }
    }
    float cs[8]; float run = 0.f;
#pragma unroll
    for (int i = 0; i < 8; ++i) { run += la[i]; cs[i] = run; }
    blk[tb * 64 + k] = run;
    __syncthreads();
    float pre = 0.f, tot = 0.f;
#pragma unroll
    for (int j = 0; j < 8; ++j) { const float v = blk[j * 64 + k]; tot += v; if (j < tb) pre += v; }
    if (tb == 0) lastv[k] = tot;
#pragma unroll
    for (int i = 0; i < 8; ++i) {
        const int t = tb * 8 + i; const int row = row0 + t; const float bc = pre + cs[i];
        const bf16_t* pr = a.P + (size_t)row * PP;
        if (grp == 0) {
            const float kv = bf2f(pr[C_GK + h * 64 + k]);
            Bm[t * 65 + k] = kv * __expf(-bc);
            if (NEED_A) { const float qv = bf2f(pr[C_GQ + h * 64 + k]); At[t * 65 + k] = qv * 0.125f * __expf(bc); }
        } else {
            const float ip = a.small[(size_t)row * SMALLP + 16 + h] + a.bif[h];
            const int tt = c * CH + t;
            float ck = 0.f, cq = 0.f;
#pragma unroll
            for (int j = 0; j < 4; ++j) {
                const int ts = tt - 3 + j;
                if (ts >= 0) {
                    const bf16_t* ps = a.P + (size_t)(b * SEQ + ts) * PP;
                    ck += a.convw[j * 512 + 256 + h * 64 + k] * bf2f(ps[C_MK + h * 64 + k]);
                    if (NEED_A) cq += a.convw[j * 512 + h * 64 + k] * bf2f(ps[C_MQ + h * 64 + k]);
                }
            }
            Bm[t * 65 + k] = siluf_(ck) * 0.125f * __expf(ip - bc);
            if (NEED_A) At[t * 65 + k] = siluf_(cq) * __expf(bc);
        }
    }
}

__device__ __forceinline__ void phase_scan1(Frame& F, const ScanArgs& a) {
    float* sm = (float*)F.ldsg;
    float* Bm = sm; float* Vs = sm + 64 * 65; float* blk = Vs + 64 * 128; float* lastv = blk + 512;
    int tid_ = threadIdx.x; asm volatile("" : "+v"(tid_));
    const int tid = tid_, lane = tid & 63, kg = tid >> 6;
    for (int unit = F.bid; unit < BATCH * NCH; unit += F.G) {
        const int b = unit / NCH, c = unit % NCH;
        const int row0 = b * SEQ + c * CH;
        for (int hh = 0; hh < 8; ++hh) {
            const int grp = hh >> 2, h = hh & 3, bh = b * 4 + h;
            gate_stage<false>(a, b, c, hh, nullptr, Bm, blk, lastv);
            const int voff = (grp == 0 ? C_GV : C_MV) + h * 128;
#pragma unroll 4
            for (int i = tid; i < 64 * 128; i += 512) { const int s = i >> 7, v = i & 127; Vs[i] = bf2f(a.P[(size_t)(row0 + s) * PP + voff + v]); }
            __syncthreads();
            if (tid < 64) a.dec[((size_t)(grp * 16 + bh) * NCH + c) * 64 + tid] = __expf(lastv[tid]);
            if (grp == 1 && tid < 64) { float s = 0.f; for (int t = 0; t < 64; ++t) s += Bm[t * 65 + tid]; a.NS[((size_t)bh * NCH + c) * 64 + tid] = s; }
            float acc[8][2];
#pragma unroll
            for (int i = 0; i < 8; ++i) { acc[i][0] = 0.f; acc[i][1] = 0.f; }
#pragma unroll 2
            for (int s = 0; s < 64; ++s) {
                const float v0 = Vs[s * 128 + lane], v1 = Vs[s * 128 + 64 + lane];
#pragma unroll
                for (int i = 0; i < 8; ++i) { const float bv = Bm[s * 65 + kg * 8 + i]; acc[i][0] += bv * v0; acc[i][1] += bv * v1; }
            }
            bf16_t* st = a.ST + st_off(grp, bh, c);
            u32x4 w0, w1;
            w0.x = pk2(acc[0][0], acc[1][0]); w0.y = pk2(acc[2][0], acc[3][0]); w0.z = pk2(acc[4][0], acc[5][0]); w0.w = pk2(acc[6][0], acc[7][0]);
            w1.x = pk2(acc[0][1], acc[1][1]); w1.y = pk2(acc[2][1], acc[3][1]); w1.z = pk2(acc[4][1], acc[5][1]); w1.w = pk2(acc[6][1], acc[7][1]);
            *(u32x4*)(st + (size_t)lane * 64 + kg * 8) = w0; *(u32x4*)(st + (size_t)(lane + 64) * 64 + kg * 8) = w1;
            __syncthreads();
        }
    }
}
__device__ __forceinline__ void phase_scan2(Frame& F, const ScanArgs& a) {
    for (int gid = F.bid * NTHR + opaque_i(F.tid); gid < 131072; gid += F.G * NTHR) {
        const int grp = gid >> 16, rem = gid & 65535, bh = rem >> 12, r2 = rem & 4095, v = r2 >> 5, k = (r2 & 31) * 2;
        float s0 = 0.f, s1 = 0.f;
#pragma unroll 4
        for (int c = 0; c < NCH; ++c) {
            unsigned* p = (unsigned*)(a.ST + st_off(grp, bh, c) + v * 64 + k);
            const unsigned w = *p;
            const float l0 = __uint_as_float(w << 16), l1 = __uint_as_float(w & 0xffff0000u);
            *p = pk2(s0, s1);
            const float* d = a.dec + ((size_t)(grp * 16 + bh) * NCH + c) * 64 + k;
            s0 = d[0] * (s0 + l0); s1 = d[1] * (s1 + l1);
        }
        if (gid < 1024) {
            const int bh2 = gid >> 6, k2 = gid & 63; float ns = 0.f;
            for (int c = 0; c < NCH; ++c) {
                float* p = a.NS + ((size_t)bh2 * NCH + c) * 64 + k2; const float l = *p; *p = ns;
                ns = a.dec[((size_t)(16 + bh2) * NCH + c) * 64 + k2] * (ns + l);
            }
        }
    }
}
__device__ __forceinline__ void phase_scan3(Frame& F, const ScanArgs& a) {
    float* sm = (float*)F.ldsg;
    float* At = sm; float* Bm = At + 64 * 65; float* Pm = Bm + 64 * 65; float* Vs = Pm + 64 * 65; float* Ss = Vs + 64 * 128;
    float* blk = Ss + 64 * 128; float* lastv = blk + 512; float* nsv = lastv + 64;
    int tid_ = threadIdx.x; asm volatile("" : "+v"(tid_));
    const int tid = tid_, lane = tid & 63, tg = tid >> 6;
    for (int unit = F.bid; unit < BATCH * NCH; unit += F.G) {
        const int b = unit / NCH, c = unit % NCH;
        const int row0 = b * SEQ + c * CH;
        for (int hh = 0; hh < 8; ++hh) {
            const int grp = hh >> 2, h = hh & 3, bh = b * 4 + h;
            gate_stage<true>(a, b, c, hh, At, Bm, blk, lastv);
            const int voff = (grp == 0 ? C_GV : C_MV) + h * 128;
#pragma unroll 4
            for (int i = tid; i < 64 * 128; i += 512) { const int s = i >> 7, v = i & 127; Vs[i] = bf2f(a.P[(size_t)(row0 + s) * PP + voff + v]); }
            const bf16_t* st = a.ST + st_off(grp, bh, c);
#pragma unroll 4
            for (int i = tid; i < 64 * 128; i += 512) { const int v = i >> 6, k = i & 63; Ss[k * 128 + v] = bf2f(st[i]); }
            if (tid < 64) nsv[tid] = grp == 1 ? a.NS[((size_t)bh * NCH + c) * 64 + tid] : 0.f;
            __syncthreads();
            {
                const int t = tid >> 3, sg = tid & 7;
                float p[8];
#pragma unroll
                for (int i = 0; i < 8; ++i) p[i] = 0.f;
#pragma unroll 2
                for (int k = 0; k < 64; ++k) {
                    const float av = At[t * 65 + k];
#pragma unroll
                    for (int i = 0; i < 8; ++i) p[i] += av * Bm[(sg * 8 + i) * 65 + k];
                }
#pragma unroll
                for (int i = 0; i < 8; ++i) { const int s = sg * 8 + i; Pm[t * 65 + s] = s <= t ? p[i] : 0.f; }
            }
            __syncthreads();
            float acc[8][2], den[8];
#pragma unroll
            for (int i = 0; i < 8; ++i) { acc[i][0] = 0.f; acc[i][1] = 0.f; den[i] = 0.f; }
#pragma unroll 2
            for (int s = 0; s < 64; ++s) {
                const float v0 = Vs[s * 128 + lane], v1 = Vs[s * 128 + 64 + lane];
#pragma unroll
                for (int i = 0; i < 8; ++i) { const float pv = Pm[(tg * 8 + i) * 65 + s]; acc[i][0] += pv * v0; acc[i][1] += pv * v1; den[i] += pv; }
            }
#pragma unroll 2
            for (int k = 0; k < 64; ++k) {
                const float s0 = Ss[k * 128 + lane], s1 = Ss[k * 128 + 64 + lane], nk = nsv[k];
#pragma unroll
                for (int i = 0; i < 8; ++i) { const float av = At[(tg * 8 + i) * 65 + k]; acc[i][0] += av * s0; acc[i][1] += av * s1; den[i] += av * nk; }
            }
#pragma unroll
            for (int i = 0; i < 8; ++i) {
                asm volatile("" ::: "memory");
                const int row = row0 + tg * 8 + i;
                bf16_t* pr = a.P + (size_t)row * PP;
                float o0 = acc[i][0], o1 = acc[i][1];
                if (grp == 0) {
                    const float ss = wave_sum(o0 * o0 + o1 * o1);
                    const float rstd = rsqrtf(ss * (1.f / 128.f) + EPS);
                    const float g0 = bf2f(pr[C_GR + h * 128 + lane]), g1 = bf2f(pr[C_GR + h * 128 + 64 + lane]);
                    pr[C_GR + h * 128 + lane] = (bf16_t)f2bf(o0 * rstd * a.gla_gain[h * 128 + lane] * siluf_(g0));
                    pr[C_GR + h * 128 + 64 + lane] = (bf16_t)f2bf(o1 * rstd * a.gla_gain[h * 128 + 64 + lane] * siluf_(g1));
                } else {
                    const float dd = 1.f / fmaxf(fabsf(den[i]), 1.f);
                    const float g0 = bf2f(pr[C_MO + h * 128 + lane]), g1 = bf2f(pr[C_MO + h * 128 + 64 + lane]);
                    o0 = o0 * dd * sigmoidf_(g0); o1 = o1 * dd * sigmoidf_(g1);
                    const float ss = wave_sum(o0 * o0 + o1 * o1);
                    const float rstd = rsqrtf(ss * (1.f / 128.f) + EPS);
                    pr[C_MO + h * 128 + lane] = (bf16_t)f2bf(o0 * rstd * a.ml_gain[h * 128 + lane]);
                    pr[C_MO + h * 128 + 64 + lane] = (bf16_t)f2bf(o1 * rstd * a.ml_gain[h * 128 + 64 + lane]);
                }
            }
            __syncthreads();
        }
    }
}

__device__ __forceinline__ void phase_qkn(Frame& F, bf16_t* P, const float* qg, const float* kg, float* kmean) {
    const int gw = F.bid * NWAVES + F.wave, NGW = F.G * NWAVES, lane = opaque_i(F.lane);
    for (int u = gw; u < BATCH * 16 * 16; u += NGW) {
        const int hd = u & 15, blk = (u >> 4) & 15, b = u >> 8;
        const float* g = hd < 8 ? qg : kg;
        const float g0 = g[lane * 2], g1 = g[lane * 2 + 1];
        const float sc = hd < 8 ? 0.08838834764831845f : 1.f;
        float m0 = 0.f, m1 = 0.f;
        for (int r = 0; r < 256; ++r) {
            unsigned* p = (unsigned*)(P + (size_t)(b * SEQ + blk * 256 + r) * PP + hd * 128 + lane * 2);
            const unsigned w = *p;
            const float x0 = __uint_as_float(w << 16), x1 = __uint_as_float(w & 0xffff0000u);
            const float ss = wave_sum(x0 * x0 + x1 * x1);
            const float rr = rsqrtf(ss * (1.f / 128.f) + EPS) * sc;
            const float y0 = x0 * rr * g0, y1 = x1 * rr * g1;
            m0 += y0; m1 += y1;
            *p = pk2(y0, y1);
        }
        if (hd >= 8) { float* km = kmean + ((size_t)((b * 8 + (hd - 8)) * 16 + blk)) * 128 + lane * 2; km[0] = m0 * (1.f / 256.f); km[1] = m1 * (1.f / 256.f); }
    }
}
__device__ __forceinline__ void phase_attn_simple(Frame& F, bf16_t* P, const float* kmean) {
    float* qs = (float*)F.ldsg + F.wave * 1152; float* sc = qs + 128;
    const int gw = F.bid * NWAVES + F.wave, NGW = F.G * NWAVES, lane = opaque_i(F.lane);
    for (int item = gw; item < BATCH * 8 * SEQ; item += NGW) {
        const int t = item & (SEQ - 1), h = (item >> 12) & 7, b = item >> 15;
        const size_t row = (size_t)b * SEQ + t;
        {
            const unsigned w = *(const unsigned*)(P + row * PP + h * 128 + lane * 2);
            qs[lane * 2] = __uint_as_float(w << 16); qs[lane * 2 + 1] = __uint_as_float(w & 0xffff0000u);
        }
        const int qblk = t >> 8;
        float g = -INFINITY;
        if (lane < qblk) { const float* km = kmean + ((size_t)((b * 8 + h) * 16 + lane)) * 128; float s = 0.f; for (int d = 0; d < 128; ++d) s += qs[d] * km[d]; g = s; }
        int sel0 = 0, sel1 = 0, sel2 = 0; const int nsel = qblk < 3 ? qblk : 3;
        {
            float gv[16];
#pragma unroll
            for (int n = 0; n < 16; ++n) gv[n] = __shfl(g, n);
            unsigned taken = 0u;
#pragma unroll
            for (int r = 0; r < 3; ++r) {
                int best = 0; float bv = -INFINITY; bool found = false;
#pragma unroll
                for (int n = 0; n < 16; ++n) { const bool ok = !((taken >> n) & 1u) && n < qblk; if (ok && (!found || gv[n] > bv)) { bv = gv[n]; best = n; found = true; } }
                if (r == 0) sel0 = best; else if (r == 1) sel1 = best; else sel2 = best;
                if (found) taken |= 1u << best;
            }
        }
        const float slope = exp2f(-(float)(h + 1));
        float mx = -1e30f;
        for (int r = 0; r <= nsel; ++r) {
            const int blk = r < nsel ? (r == 0 ? sel0 : (r == 1 ? sel1 : sel2)) : qblk;
            for (int sub = 0; sub < 4; ++sub) {
                const int key = blk * 256 + sub * 64 + lane; const int dist = t - key;
                const bf16_t* kr = P + ((size_t)b * SEQ + key) * PP + 1024 + h * 128;
                float s = 0.f;
                for (int d8 = 0; d8 < 16; ++d8) {
                    const u32x4 w = *(const u32x4*)(kr + d8 * 8);
#pragma unroll
                    for (int e = 0; e < 4; ++e) { s += qs[d8 * 8 + 2 * e] * __uint_as_float(w[e] << 16); s += qs[d8 * 8 + 2 * e + 1] * __uint_as_float(w[e] & 0xffff0000u); }
                }
                s = dist >= 0 ? s - slope * (float)dist : -1e30f;
                sc[r * 256 + sub * 64 + lane] = s; mx = fmaxf(mx, s);
            }
        }
        mx = wave_max(mx);
        float sum = 0.f;
        for (int i = lane; i < (nsel + 1) * 256; i += 64) { const float p = __expf(sc[i] - mx); sc[i] = p; sum += p; }
        sum = wave_sum(sum);
        float a0 = 0.f, a1 = 0.f;
        for (int r = 0; r <= nsel; ++r) {
            const int blk = r < nsel ? (r == 0 ? sel0 : (r == 1 ? sel1 : sel2)) : qblk;
            const bf16_t* vr = P + ((size_t)b * SEQ + blk * 256) * PP + 2048 + h * 128 + lane * 2;
#pragma unroll 4
            for (int j = 0; j < 256; ++j) {
                const float p = sc[r * 256 + j];
                const unsigned w = *(const unsigned*)(vr + (size_t)j * PP);
                a0 += p * __uint_as_float(w << 16); a1 += p * __uint_as_float(w & 0xffff0000u);
            }
        }
        const float inv = 1.f / sum;
        *(unsigned*)(P + row * PP + h * 128 + lane * 2) = pk2(a0 * inv, a1 * inv);
    }
}


namespace att {
typedef short bf16x8 __attribute__((ext_vector_type(8)));
typedef short s16x4 __attribute__((ext_vector_type(4)));
typedef float f32x16 __attribute__((ext_vector_type(16)));
constexpr int SHM_V = 16384, SHM_K = 16384, OFF_V = 0, OFF_K = 2 * SHM_V, OFF_WS = 2 * SHM_V + 2 * SHM_K;
constexpr float THR = 8.f;
#define KSWZ(row, colB) ((row) * 256 + ((colB) ^ (((row) & 7) << 4)))
#define SBAR() __builtin_amdgcn_sched_barrier(0)
typedef LAS char* lptr;
__device__ __forceinline__ int crow(int r, int hi) { return (r & 3) + 8 * (r >> 2) + 4 * hi; }
__device__ __forceinline__ unsigned cvtpk(float lo, float hi) { unsigned r; asm volatile("v_cvt_pk_bf16_f32 %0, %1, %2" : "=v"(r) : "v"(lo), "v"(hi)); return r; }
__device__ __forceinline__ void partialSM(f32x16& p0, f32x16& p1, float& m_reg, float& mn, float& alpha, float slope, float base, bool ok, bool diag, int dq) {
    constexpr float C = 1.4426950408889634f;
#pragma unroll
    for (int r = 0; r < 16; ++r) { const int c = (r & 3) + 8 * (r >> 2); if (c) p0[r] = fmaf(slope, (float)c, p0[r]); p1[r] = fmaf(slope, (float)(c + 32), p1[r]); }
    if (diag) {
#pragma unroll
        for (int r = 0; r < 16; ++r) { const int c = (r & 3) + 8 * (r >> 2); if (c > dq) p0[r] = -INFINITY; if (c + 32 > dq) p1[r] = -INFINITY; }
    }
    float pmax = p0[0];
#pragma unroll
    for (int r = 1; r < 16; ++r) pmax = fmaxf(pmax, p0[r]);
#pragma unroll
    for (int r = 0; r < 16; ++r) pmax = fmaxf(pmax, p1[r]);
    const float bm = ok ? base : -INFINITY;
    pmax += bm;
    { auto rr = __builtin_amdgcn_permlane32_swap(__float_as_uint(pmax), __float_as_uint(pmax), false, false);
      pmax = fmaxf(__uint_as_float(rr[0]), __uint_as_float(rr[1])); }
    if (__builtin_expect(__all(pmax - m_reg <= THR), 1)) { mn = m_reg; alpha = 1.f; }
    else { mn = fmaxf(m_reg, pmax); alpha = __builtin_amdgcn_exp2f((m_reg - mn) * C); m_reg = mn; }
    const float add = (bm - mn) * C;
#pragma unroll
    for (int r = 0; r < 16; ++r) p0[r] = fmaf(p0[r], C, add);
#pragma unroll
    for (int r = 0; r < 16; ++r) p1[r] = fmaf(p1[r], C, add);
#pragma unroll
    for (int r = 0; r < 16; ++r) p0[r] = __builtin_amdgcn_exp2f(p0[r]);
}
__device__ __forceinline__ void finishSM(f32x16& p0, f32x16& p1, float alpha, float& l_reg, bf16x8& pa0, bf16x8& pa1, bf16x8& pa2, bf16x8& pa3) {
#pragma unroll
    for (int r = 0; r < 16; ++r) p1[r] = __builtin_amdgcn_exp2f(p1[r]);
    float ps = 0;
#pragma unroll
    for (int r = 0; r < 16; ++r) ps += p0[r];
#pragma unroll
    for (int r = 0; r < 16; ++r) ps += p1[r];
    { auto rr = __builtin_amdgcn_permlane32_swap(__float_as_uint(ps), __float_as_uint(ps), false, false);
      ps = __uint_as_float(rr[0]) + __uint_as_float(rr[1]); }
    l_reg = l_reg * alpha + ps;
#define PK4(P, BASE, OUT) do { unsigned a0 = cvtpk(P[BASE + 0], P[BASE + 1]), a1 = cvtpk(P[BASE + 2], P[BASE + 3]);   \
    unsigned b0 = cvtpk(P[BASE + 4], P[BASE + 5]), b1 = cvtpk(P[BASE + 6], P[BASE + 7]);                              \
    auto r0 = __builtin_amdgcn_permlane32_swap(a0, b0, false, false); auto r1 = __builtin_amdgcn_permlane32_swap(a1, b1, false, false); \
    u32x4 w = {r0[0], r1[0], r0[1], r1[1]}; OUT = *reinterpret_cast<bf16x8*>(&w); } while (0)
    PK4(p0, 0, pa0); PK4(p0, 8, pa1); PK4(p1, 0, pa2); PK4(p1, 8, pa3);
#undef PK4
}
__device__ __forceinline__ void qkt(f32x16& p0, f32x16& p1, lptr Ks, const bf16x8* qr, int r32, int hi) {
    p0 = f32x16{}; p1 = f32x16{};
#pragma unroll
    for (int d0 = 0; d0 < 8; ++d0) { const int cb = (d0 * 16 + hi * 8) * 2;
        const bf16x8 b0 = *(const LAS bf16x8*)(Ks + KSWZ(r32, cb));
        const bf16x8 b1 = *(const LAS bf16x8*)(Ks + KSWZ(32 + r32, cb));
        p0 = __builtin_amdgcn_mfma_f32_32x32x16_bf16(b0, qr[d0], p0, 0, 0, 0);
        p1 = __builtin_amdgcn_mfma_f32_32x32x16_bf16(b1, qr[d0], p1, 0, 0, 0); }
}
__device__ __forceinline__ int v_st(int k, int c) { const int kk = (k & ~0xC) | ((k & 4) << 1) | ((k & 8) >> 1); return ((kk >> 3) * 4 + (c >> 5)) * 512 + ((kk & 7) * 32 + (c & 31)) * 2; }
__device__ __forceinline__ int v_rd_base(int lane) { return ((lane & 3) << 3) | (((lane >> 2) & 3) << 6) | (((lane >> 4) & 1) << 5) | (((lane >> 5) & 1) << 8); }
constexpr int v_rd_off(int d0, int ks, int half) { return d0 * 512 + ks * 4096 + half * 2048; }
template <int OFF> __device__ __forceinline__ s16x4 tr_read(int vb) {
    s16x4 r; asm volatile("ds_read_b64_tr_b16 %0, %1 offset:%2" : "=&v"(r) : "v"(vb), "i"(OFF) : "memory"); return r;
}
template <int D0> __device__ __forceinline__ void pv_one(f32x16& od, int vb, bf16x8 pa0, bf16x8 pa1, bf16x8 pa2, bf16x8 pa3) {
    const s16x4 l0 = tr_read<v_rd_off(D0, 0, 0)>(vb), h0 = tr_read<v_rd_off(D0, 0, 1)>(vb), l1 = tr_read<v_rd_off(D0, 1, 0)>(vb), h1 = tr_read<v_rd_off(D0, 1, 1)>(vb);
    const s16x4 l2 = tr_read<v_rd_off(D0, 2, 0)>(vb), h2 = tr_read<v_rd_off(D0, 2, 1)>(vb), l3 = tr_read<v_rd_off(D0, 3, 0)>(vb), h3 = tr_read<v_rd_off(D0, 3, 1)>(vb);
    asm volatile("s_waitcnt lgkmcnt(0)" ::: "memory"); SBAR();
#define PK(L, H) (bf16x8){L[0], L[1], L[2], L[3], H[0], H[1], H[2], H[3]}
    od = __builtin_amdgcn_mfma_f32_32x32x16_bf16(pa0, PK(l0, h0), od, 0, 0, 0);
    od = __builtin_amdgcn_mfma_f32_32x32x16_bf16(pa1, PK(l1, h1), od, 0, 0, 0);
    od = __builtin_amdgcn_mfma_f32_32x32x16_bf16(pa2, PK(l2, h2), od, 0, 0, 0);
    od = __builtin_amdgcn_mfma_f32_32x32x16_bf16(pa3, PK(l3, h3), od, 0, 0, 0);
#undef PK
}
__device__ __forceinline__ void pv_d0(f32x16* o, int vb, bf16x8 pa0, bf16x8 pa1, bf16x8 pa2, bf16x8 pa3) {
    pv_one<0>(o[0], vb, pa0, pa1, pa2, pa3); pv_one<1>(o[1], vb, pa0, pa1, pa2, pa3); pv_one<2>(o[2], vb, pa0, pa1, pa2, pa3); pv_one<3>(o[3], vb, pa0, pa1, pa2, pa3);
}

__device__ __forceinline__ void unit(bf16_t* P, const float* kmean, int b, int h, int qb, lptr lds, unsigned ldsaddr) {
    int tid_ = threadIdx.x; asm volatile("" : "+v"(tid_));
    const int tid = tid_, wid = __builtin_amdgcn_readfirstlane(tid >> 6), lane = tid & 63, r32 = lane & 31, hi = lane >> 5;
    lptr V_lds = lds + OFF_V; lptr K_lds = lds + OFF_K;
    LAS float* wsl = (LAS float*)(lds + OFF_WS) + wid * 64; LAS float* li_l = wsl; LAS float* al_l = wsl + 32;
    const int q0 = qb * 256, tpos = q0 + wid * 32 + r32;
    const bf16_t* Qw = P + (size_t)(b * SEQ + tpos) * PP + h * 128 + hi * 8;
    const bf16_t* Kh = P + (size_t)(b * SEQ) * PP + 1024 + h * 128;
    const bf16_t* Vh = P + (size_t)(b * SEQ) * PP + 2048 + h * 128;
    float m_reg = -1e30f, l_reg = 0; f32x16 o[4] = {}; bf16x8 qr[8];
#pragma unroll
    for (int d0 = 0; d0 < 8; ++d0) qr[d0] = *(const bf16x8*)(Qw + d0 * 16);
    const float slope = exp2f(-(float)(h + 1));
    unsigned selmask = 0u;
    {
        float v0 = -INFINITY, v1 = -INFINITY, v2 = -INFINITY; int i0 = -1, i1 = -1, i2 = -1;
        for (int n = 0; n < qb; ++n) {
            const float* km = kmean + ((size_t)((b * 8 + h) * 16 + n)) * 128 + hi * 8;
            float s = 0.f;
#pragma unroll
            for (int d0 = 0; d0 < 8; ++d0) { const f32x4 ka = *(const f32x4*)(km + d0 * 16), kb = *(const f32x4*)(km + d0 * 16 + 4);
                const bf16x8 q = qr[d0];
                s += bf2f((bf16_t)q[0]) * ka[0]; s += bf2f((bf16_t)q[1]) * ka[1]; s += bf2f((bf16_t)q[2]) * ka[2]; s += bf2f((bf16_t)q[3]) * ka[3];
                s += bf2f((bf16_t)q[4]) * kb[0]; s += bf2f((bf16_t)q[5]) * kb[1]; s += bf2f((bf16_t)q[6]) * kb[2]; s += bf2f((bf16_t)q[7]) * kb[3]; }
            s += __shfl_xor(s, 32);
            if (s > v0) { v2 = v1; i2 = i1; v1 = v0; i1 = i0; v0 = s; i0 = n; }
            else if (s > v1) { v2 = v1; i2 = i1; v1 = s; i1 = n; }
            else if (s > v2) { v2 = s; i2 = n; }
        }
        if (i0 >= 0) selmask |= 1u << i0; if (i1 >= 0) selmask |= 1u << i1; if (i2 >= 0) selmask |= 1u << i2;
    }
    const int sr = tid >> 4, sc = (tid & 15) * 8, vst0 = v_st(sr, sc), vst1 = v_st(32 + sr, sc);
    const int vb0 = (int)ldsaddr + OFF_V + v_rd_base(lane);
    struct { bf16x8 vs0, vs1, ks0, ks1; } sr_[2];
#define SLOAD(i, k0) do { sr_[i].vs0 = *(const bf16x8*)(&Vh[(size_t)((k0) + sr) * PP + sc]); sr_[i].vs1 = *(const bf16x8*)(&Vh[(size_t)((k0) + 32 + sr) * PP + sc]); \
    sr_[i].ks0 = *(const bf16x8*)(&Kh[(size_t)((k0) + sr) * PP + sc]); sr_[i].ks1 = *(const bf16x8*)(&Kh[(size_t)((k0) + 32 + sr) * PP + sc]); } while (0)
#define SWRITE(bb, i) do { *(LAS bf16x8*)(V_lds + (bb) * SHM_V + vst0) = sr_[i].vs0;          \
    *(LAS bf16x8*)(V_lds + (bb) * SHM_V + vst1) = sr_[i].vs1; const int kc = sc * 2;               \
    *(LAS bf16x8*)(K_lds + (bb) * SHM_K + KSWZ(sr, kc)) = sr_[i].ks0;                       \
    *(LAS bf16x8*)(K_lds + (bb) * SHM_K + KSWZ(32 + sr, kc)) = sr_[i].ks1; } while (0)
#define SWAIT() asm volatile("s_waitcnt vmcnt(4)" ::: "memory")
#define RESC(a) do { if (__any((a) < 1.f)) { if (hi == 0) al_l[r32] = (a); asm volatile("s_waitcnt lgkmcnt(0)" ::: "memory"); \
    _Pragma("unroll") for (int d = 0; d < 4; ++d) _Pragma("unroll") for (int r = 0; r < 16; ++r) o[d][r] *= al_l[crow(r, hi)]; } } while (0)
#define PSM(P0, P1, MN, AL, jj) do { const int j_ = (jj), n_ = j_ >> 2, k0_ = j_ * 64; const bool isd_ = n_ == qb; \
    const bool ok_ = isd_ || ((selmask >> n_) & 1u); const float base_ = slope * (float)(k0_ + 4 * hi - tpos); \
    const bool nm_ = isd_ && (k0_ + 63 > q0 + wid * 32); \
    partialSM(P0, P1, m_reg, MN, AL, slope, base_, ok_, nm_, tpos - k0_ - 4 * hi); } while (0)
    f32x16 pA0, pA1, pB0, pB1; float mnA, mnB, alA, alB; bf16x8 pa0, pa1, pa2, pa3; const int NT = 4 * (qb + 1);
    constexpr int SE = 0, SO = 1;
    SLOAD(SE, 0); asm volatile("s_waitcnt vmcnt(0)" ::: "memory"); SWRITE(0, SE); __syncthreads();
    qkt(pA0, pA1, K_lds, qr, r32, hi); PSM(pA0, pA1, mnA, alA, 0);
    SLOAD(SO, 64); if (2 < NT) SLOAD(SE, 128);
    SWAIT(); SWRITE(1, SO); __syncthreads();
    for (int j = 1; j + 1 < NT; j += 2) {
        SBAR(); qkt(pB0, pB1, K_lds + SHM_K, qr, r32, hi);
        finishSM(pA0, pA1, alA, l_reg, pa0, pa1, pa2, pa3); SBAR();
        SLOAD(SO, (j + 2) * 64); SBAR();
        pv_d0(o, vb0, pa0, pa1, pa2, pa3); PSM(pB0, pB1, mnB, alB, j);
        __syncthreads(); SWAIT(); SWRITE(0, SE);
        RESC(alB); __syncthreads();
        SBAR(); qkt(pA0, pA1, K_lds, qr, r32, hi);
        finishSM(pB0, pB1, alB, l_reg, pa0, pa1, pa2, pa3); SBAR();
        if (j + 3 < NT) SLOAD(SE, (j + 3) * 64); SBAR();
        pv_d0(o, vb0 + SHM_V, pa0, pa1, pa2, pa3); PSM(pA0, pA1, mnA, alA, j + 1);
        __syncthreads(); SWAIT(); SWRITE(1, SO);
        RESC(alA); __syncthreads();
    }
    SBAR(); qkt(pB0, pB1, K_lds + SHM_K, qr, r32, hi);
    finishSM(pA0, pA1, alA, l_reg, pa0, pa1, pa2, pa3); SBAR();
    pv_d0(o, vb0, pa0, pa1, pa2, pa3); PSM(pB0, pB1, mnB, alB, NT - 1);
    __syncthreads(); RESC(alB);
    finishSM(pB0, pB1, alB, l_reg, pa0, pa1, pa2, pa3); SBAR();
    pv_d0(o, vb0 + SHM_V, pa0, pa1, pa2, pa3);
    if (hi == 0) li_l[r32] = l_reg; asm volatile("s_waitcnt lgkmcnt(0)" ::: "memory");
    float rli[16];
#pragma unroll
    for (int r = 0; r < 16; ++r) rli[r] = __builtin_amdgcn_rcpf(li_l[crow(r, hi)]);
    bf16_t* Ow = P + (size_t)(b * SEQ + q0 + wid * 32) * PP + h * 128;
#pragma unroll
    for (int r = 0; r < 16; ++r) { const int orow = crow(r, hi);
#pragma unroll
        for (int d0 = 0; d0 < 4; ++d0) Ow[(size_t)orow * PP + d0 * 32 + r32] = (bf16_t)f2bf(o[d0][r] * rli[r]); }
    __syncthreads();
#undef SLOAD
#undef SWRITE
#undef SWAIT
#undef RESC
#undef PSM
}
}
__device__ __forceinline__ void phase_attn(Frame& F, bf16_t* P, const float* kmean) {
    for (int pi = F.bid; pi < 256; pi += F.G) {
        const int xcd = pi & 7, slot = pi >> 3, bh = xcd * 4 + (slot >> 3), p = slot & 7;
        att::unit(P, kmean, bh >> 3, bh & 7, 15 - p, (att::lptr)F.lds, (unsigned)(uintptr_t)F.ldsg);
        att::unit(P, kmean, bh >> 3, bh & 7, p, (att::lptr)F.lds, (unsigned)(uintptr_t)F.ldsg);
    }
}

__global__ void __launch_bounds__(NTHR, 2) mk_fwd(Args args) {
    extern __shared__ __attribute__((aligned(16))) unsigned char lds[];
    Frame F;
    F.lds = (LAS unsigned char*)lds; F.ldsg = lds;
    F.tid = threadIdx.x; F.lane = F.tid & 63; F.wave = __builtin_amdgcn_readfirstlane(F.tid >> 6);
    F.G = gridDim.x; F.bid = blockIdx.x;
    volatile LAS unsigned* MISC = (volatile LAS unsigned*)(F.lds + MISC_OFF);
    for (int u = F.tid; u < (LDS_BYTES - RING_BYTES) / 4; u += NTHR) ((LAS unsigned*)(F.lds + RING_BYTES))[u] = 0u;
    __syncthreads();
    kargp_t kp0 = karg_base();
    unsigned char* ws = karg_ws(kp0);
    XcdBarrier bar; bar.bar = (unsigned*)(ws + WS_CTL) + 4096; bar.x = 0; bar.st = nullptr;
    if (!MK_MULTI) bar = xcd_barrier_post((unsigned*)(ws + WS_CTL) + 4096, MISC + 8);
    const int lo = args.ph_lo, hi = args.ph_hi;
#define IN(k) (lo <= (k) && (k) < hi)
#define SEAM(k) do { if (!MK_MULTI && (k) + 1 < hi) xcd_barrier(bar); } while (0)

    float* rss = (float*)(ws + WS_RSS); float* small = (float*)(ws + WS_SMALL); float* kmean = (float*)(ws + WS_KMEAN);
    bf16_t* xb = (bf16_t*)(ws + WS_XB); bf16_t* P = (bf16_t*)(ws + WS_P);
    float* out = karg_out(kp0);

    if (IN(0)) { if (PH_MASK & 1) phase_prologue(F); SEAM(0); }

    for (int l = 0; l < DEPTH; ++l) {
        const int j = l >> 1, base = 1 + l * 8;
        unsigned char* wj = ws + WS_W + j * W_MIXSZ;
        unsigned char* wl = ws + WS_W + W_FFN0 + l * W_FFNSZ;
        kargp_t kp = karg_base();
        const float* xin = l == 0 ? karg_in(kp, 0) : out;
        if ((l & 1) == 0) {
            ScanArgs sa{P, small, karg_in(kp, 4) + (size_t)j * 16 * 256, karg_in(kp, 5) + j * 256, karg_in(kp, 6) + j * 512, karg_in(kp, 7) + (size_t)j * 4 * 512, karg_in(kp, 8) + j * 8, karg_in(kp, 9) + j * 512,
                        (bf16_t*)(ws + WS_XB), (float*)(ws + WS_DEC), (float*)(ws + WS_NS)};
            if (IN(base + 0)) {
                pg8::Gemm g{xb, (const bf16_t*)(wj + W_IN), M, HYB_PAD, DM, DM}; pg8::StaticOrder S; S.init(M, HYB_PAD, F.G, F.bid);
                EpiRowBf16 E{P, PP, rss, small, 12};
                if (PH_MASK & 64) pg8::gemm_phase<EpiRowBf16, pg8::StaticOrder, true, true>(F.lds, g, S, E);
                SEAM(base + 0);
            }
            if (IN(base + 1)) { if (PH_MASK & 2) phase_scan1(F, sa); SEAM(base + 1); }
            if (IN(base + 2)) { if (PH_MASK & 4) phase_scan2(F, sa); SEAM(base + 2); }
            if (IN(base + 3)) { if (PH_MASK & 8) phase_scan3(F, sa); SEAM(base + 3); }
            if (IN(base + 4)) {
                pg8::Gemm g{P + C_GR, (const bf16_t*)(wj + W_OUT), M, DM, DM, PP}; pg8::StaticOrder S; S.init(M, DM, F.G, F.bid);
                EpiRes E{xin, out, xb, rss};
                if (PH_MASK & 128) pg8::gemm_phase<EpiRes, pg8::StaticOrder, true, true>(F.lds, g, S, E);
                SEAM(base + 4);
            }
        } else {
            if (IN(base + 0)) {
                pg8::Gemm g{xb, (const bf16_t*)(wj + W_QKV), M, 3 * DM, DM, DM}; pg8::StaticOrder S; S.init(M, 3 * DM, F.G, F.bid);
                EpiRowBf16 E{P, PP, rss, small, -1};
                if (PH_MASK & 256) pg8::gemm_phase<EpiRowBf16, pg8::StaticOrder, true, true>(F.lds, g, S, E);
                SEAM(base + 0);
            }
            if (IN(base + 1)) { if (PH_MASK & 16) phase_qkn(F, P, karg_in(kp, 12) + j * 128, karg_in(kp, 13) + j * 128, kmean); SEAM(base + 1); }
            if (IN(base + 2)) { if (PH_MASK & 32) { if (ATTN_SIMPLE) phase_attn_simple(F, P, kmean); else phase_attn(F, P, kmean); } SEAM(base + 2); }
            if (IN(base + 3)) {
                pg8::Gemm g{P, (const bf16_t*)(wj + W_O), M, DM, DM, PP}; pg8::StaticOrder S; S.init(M, DM, F.G, F.bid);
                EpiRes E{xin, out, xb, rss};
                if (PH_MASK & 512) pg8::gemm_phase<EpiRes, pg8::StaticOrder, true, true>(F.lds, g, S, E);
                SEAM(base + 3);
            }
        }
        if (IN(base + 5)) {
            pg8::Gemm g{xb, (const bf16_t*)(wl + W_GU), M, 2 * DFF, DM, DM}; pg8::StaticOrder S; S.init(M, 2 * DFF, F.G, F.bid);
            EpiFfn E{P, rss};
            if (PH_MASK & 1024) pg8::gemm_phase<EpiFfn, pg8::StaticOrder, true, true>(F.lds, g, S, E);
            SEAM(base + 5);
        }
        if (IN(base + 6)) {
            pg8::Gemm g{P, (const bf16_t*)(wl + W_D), M, DM, DFF, DFF}; pg8::StaticOrder S; S.init(M, DM, F.G, F.bid);
            EpiRes E{out, out, xb, rss};
            if (PH_MASK & 2048) pg8::gemm_phase<EpiRes, pg8::StaticOrder, true, true>(F.lds, g, S, E);
            SEAM(base + 6);
        }
    }
#undef IN
#undef SEAM
}

extern "C" void kernel_launch(void* const* d_in, const int* in_sizes, int n_in, void* d_out, int out_size, void* d_ws, size_t ws_size, hipStream_t stream) {
    static int grid = 0;
    if (grid == 0) {
        int dev = 0, cus = 0;
        if (n_in != 18 || ws_size < WS_END) { fprintf(stderr, "kernel_launch: unexpected inputs (%d) or workspace (%zu < %zu)\n", n_in, ws_size, (size_t)WS_END); grid = -1; return; }
        if (hipGetDevice(&dev) != hipSuccess || hipDeviceGetAttribute(&cus, hipDeviceAttributeMultiprocessorCount, dev) != hipSuccess) { grid = -1; return; }
        if (hipFuncSetAttribute((const void*)mk_fwd, hipFuncAttributeMaxDynamicSharedMemorySize, LDS_BYTES) != hipSuccess) { grid = -1; return; }
        int per_cu = 0;
        if (hipOccupancyMaxActiveBlocksPerMultiprocessor(&per_cu, (const void*)mk_fwd, NTHR, LDS_BYTES) != hipSuccess || per_cu < 1) { fprintf(stderr, "kernel_launch: occupancy query says %d\n", per_cu); }
        (void)hipGetLastError();
        grid = cus;
    }
    if (grid < 0) return;
    (void)hipMemsetAsync((char*)d_ws + WS_CTL, 0, CTL_ZERO_BYTES, stream);
    Args a{};
    for (int i = 0; i < 18; ++i) a.in[i] = (const float*)d_in[i];
    a.out = (float*)d_out; a.ws = (unsigned char*)d_ws;
#if MK_MULTI
    for (int ph = 0; ph < 1 + DEPTH * 8; ++ph) {
        if (ph > 0) { const int l = (ph - 1) >> 3, s = (ph - 1) & 7; if (s == 7) continue; if ((l & 1) == 0 && s == 7) continue; if ((l & 1) == 1 && s == 4) continue; }
        a.ph_lo = ph; a.ph_hi = ph + 1;
        hipLaunchKernelGGL(mk_fwd, dim3(grid), dim3(NTHR), LDS_BYTES, stream, a);
    }
#else
    a.ph_lo = 0; a.ph_hi = DEPTH * 8;
    hipLaunchKernelGGL(mk_fwd, dim3(grid), dim3(NTHR), LDS_BYTES, stream, a);
#endif
}
```

```cpp
#include <hip/hip_runtime.h>
#include <cstdio>
#include <cstdint>

namespace pg8 {
#define PG8_LAS __attribute__((address_space(3)))
typedef unsigned short bf16_t;
typedef short bf16x8 __attribute__((ext_vector_type(8)));
typedef float f32x4 __attribute__((ext_vector_type(4)));
typedef unsigned u32x4 __attribute__((ext_vector_type(4)));
constexpr int BM = 256, BK = 64, HALF = 128, HTB = HALF * BK * 2  , STAGE_BYTES = 8 * HTB, NXCD = 8, WGM = 8;

__host__ __device__ __forceinline__ int lds_byte(int r, int c) { const int st = (r >> 4) * 2 + (c >> 5), rr = r & 15, cc = c & 31, ob = rr * 64 + cc * 2; return st * 1024 + (ob ^ (((ob >> 9) & 1) << 5)); }
__host__ __device__ __forceinline__ void stage_rc(int b, int& R, int& C) { const int st = b / 1024, sb = b % 1024, swz = sb ^ (((sb >> 9) & 1) << 5); R = (st >> 1) * 16 + swz / 64; C = (st & 1) * 32 + (swz % 64) / 2; }
__host__ __device__ __forceinline__ int perm32(int rho) { const int n = rho >> 4, i = rho & 15; return 8 * (i >> 2) + 4 * n + (i & 3); }

struct Unit { int pm, pn; };
struct Gemm { const bf16_t* A; const bf16_t* Bt; int M, N, K, lda; };

struct StaticOrder {
    int nM, nN, nwg, G, c;
    __host__ __device__ void init(int M, int N, int G_, int c_) { nM = M / BM; nN = N / BM; nwg = nM * nN; G = G_; c = c_; }
    __host__ __device__ bool next(int i, Unit& u) const {
        const long L = (long)i * G + c; if (L >= nwg) return false;
        int wgid = (int)L; { const int q = nwg / NXCD, r = nwg % NXCD, xcd = wgid % NXCD, off = wgid / NXCD; wgid = (xcd < r ? xcd * (q + 1) : r * (q + 1) + (xcd - r) * q) + off; }
        const int nig = WGM * nN, gid = wgid / nig, fm = gid * WGM, gsz = (nM - fm) < WGM ? (nM - fm) : WGM;
        u.pm = fm + ((wgid % nig) % gsz); u.pn = (wgid % nig) / gsz; return true;
    }
    __device__ __forceinline__ void a_ready(const Unit&) const {}
    __device__ __forceinline__ void done(const Unit&) const {}
};
__device__ __forceinline__ unsigned cvt_pk_bf16(float lo, float hi) { unsigned r; asm volatile("v_cvt_pk_bf16_f32 %0, %1, %2" : "=v"(r) : "v"(lo), "v"(hi)); return r; }
template <class Epi, class Sched, bool ALIGN_EPI = false, bool SP2 = false>
__device__ __forceinline__ void gemm_phase(PG8_LAS unsigned char* lds, const Gemm g, const Sched& S, const Epi& E) {
    int tid_ = threadIdx.x; asm volatile("" : "+v"(tid_));
    const int tid = tid_, wid = __builtin_amdgcn_readfirstlane(tid >> 6), lane = tid & 63, wr = wid >> 2, wc = wid & 3, fr = lane & 15, fq = lane >> 4;
    const int K = g.K, nt = K / BK;
    unsigned voffA[2], voffB[2];
#pragma unroll
    for (int i = 0; i < 2; ++i) { int R, C; stage_rc(tid * 16 + i * 8192, R, C); const int Rb = Epi::PERM ? ((R & ~31) + perm32(R & 31)) : R;
        voffA[i] = (unsigned)(R * g.lda + C) * 2u; voffB[i] = (unsigned)(Rb * K + C) * 2u; }
    const size_t kstep = (size_t)(BK * 2);
    const size_t hstepB = (size_t)HALF * K * 2, hstepA = (size_t)HALF * g.lda * 2;
    const size_t tstepA = 2 * hstepA, tstepB = 2 * hstepB;
    const unsigned ldsw = (unsigned)wid * 1024u;
    const int aoff = lds_byte(wr * 64 + fr, fq * 8), boff = lds_byte(wc * 32 + fr, fq * 8);
#define PG8_SA(b, h) (((b) * 2 + (h)) * HTB)
#define PG8_SB(b, h) ((4 + (b) * 2 + (h)) * HTB)
#define PG8_STAGE(bufoff, gbase, voff) do { _Pragma("unroll") for (int _i = 0; _i < 2; ++_i) \
        __builtin_amdgcn_global_load_lds((const unsigned*)((const char*)(gbase) + (voff)[_i]), (PG8_LAS unsigned*)(lds + (bufoff) + ldsw + _i * 8192), 16, 0, 0); } while (0)
#define PG8_LDA(dst, b, h) do { _Pragma("unroll") for (int m = 0; m < 4; ++m) _Pragma("unroll") for (int k = 0; k < 2; ++k) dst[m][k] = *(const PG8_LAS bf16x8*)(lds + PG8_SA(b, h) + aoff + m * 2048 + k * 1024); } while (0)
#define PG8_LDB(dst, b, h) do { _Pragma("unroll") for (int n = 0; n < 2; ++n) _Pragma("unroll") for (int k = 0; k < 2; ++k) dst[n][k] = *(const PG8_LAS bf16x8*)(lds + PG8_SB(b, h) + boff + n * 2048 + k * 1024); } while (0)
#define PG8_MMA(ai, bj, At, Bt) do { __builtin_amdgcn_s_setprio(1); _Pragma("unroll") for (int m = 0; m < 4; ++m) _Pragma("unroll") for (int n = 0; n < 2; ++n) _Pragma("unroll") for (int k = 0; k < 2; ++k) \
        acc[ai][bj][m][n] = __builtin_amdgcn_mfma_f32_16x16x32_bf16(Bt[n][k], At[m][k], acc[ai][bj][m][n], 0, 0, 0); __builtin_amdgcn_s_setprio(0); } while (0)
#define PG8_WAIT_V(n) asm volatile("s_waitcnt vmcnt(" #n ")" ::: "memory")
#define PG8_WAIT_L(n) asm volatile("s_waitcnt lgkmcnt(" #n ")" ::: "memory")
#define PG8_BAR __builtin_amdgcn_s_barrier()
#define PG8_SCHED __builtin_amdgcn_sched_barrier(0)
    Unit cur, nxt; int ui = 0;
    if (!S.next(0, cur)) return;
    f32x4 acc[2][2][4][2];
#pragma unroll
    for (int a = 0; a < 2; ++a)
#pragma unroll
        for (int b = 0; b < 2; ++b)
#pragma unroll
            for (int m = 0; m < 4; ++m)
#pragma unroll
                for (int n = 0; n < 2; ++n) acc[a][b][m][n] = (f32x4){0.f, 0.f, 0.f, 0.f};
    bf16x8 At[4][2], B0[2][2], B1[2][2];
    const char* cA = (const char*)g.A + (size_t)cur.pm * tstepA; const char* cB = (const char*)g.Bt + (size_t)cur.pn * tstepB;
    S.a_ready(cur);
    if constexpr (SP2) {
        PG8_STAGE(PG8_SB(0, 0), cB, voffB); PG8_STAGE(PG8_SB(0, 1), cB + hstepB, voffB); PG8_STAGE(PG8_SA(0, 0), cA, voffA); PG8_STAGE(PG8_SA(0, 1), cA + hstepA, voffA);
        if (wr == 1) PG8_BAR;
        PG8_WAIT_V(2); PG8_BAR;
        PG8_STAGE(PG8_SB(1, 0), cB + kstep, voffB); PG8_STAGE(PG8_SA(1, 0), cA + kstep, voffA); PG8_STAGE(PG8_SB(1, 1), cB + hstepB + kstep, voffB);
        PG8_WAIT_V(6); PG8_BAR;
    } else {
        PG8_STAGE(PG8_SB(0, 0), cB, voffB); PG8_STAGE(PG8_SA(0, 0), cA, voffA); PG8_STAGE(PG8_SB(0, 1), cB + hstepB, voffB); PG8_STAGE(PG8_SA(0, 1), cA + hstepA, voffA);
        if (wr == 1) PG8_BAR;
        PG8_WAIT_V(4); PG8_BAR;
        PG8_STAGE(PG8_SB(1, 0), cB + kstep, voffB); PG8_STAGE(PG8_SA(1, 0), cA + kstep, voffA); PG8_STAGE(PG8_SB(1, 1), cB + hstepB + kstep, voffB);
        PG8_WAIT_V(6); PG8_BAR;
    }
    for (;;) {
        const bool has_next = S.next(ui + 1, nxt);
        const char* nA = has_next ? (const char*)g.A + (size_t)nxt.pm * tstepA : cA; const char* nB = has_next ? (const char*)g.Bt + (size_t)nxt.pn * tstepB : cB;
        for (int t = 0; t < nt; t += 2) {
            const bool last = (t == nt - 2);
            const char* a1 = cA + (size_t)(t + 1) * kstep;
            const char* a2 = last ? nA : cA + (size_t)(t + 2) * kstep; const char* b2 = last ? nB : cB + (size_t)(t + 2) * kstep;
            const char* a3 = a2 + kstep; const char* b3 = b2 + kstep;
            if (last && has_next) S.a_ready(nxt);
            if constexpr (SP2) {
            PG8_LDB(B0, 0, 0); PG8_LDB(B1, 0, 1); PG8_SCHED; PG8_LDA(At, 0, 0); PG8_STAGE(PG8_SA(1, 1), a1 + hstepA, voffA);
            PG8_WAIT_V(8); PG8_WAIT_L(0); PG8_BAR; PG8_MMA(0, 0, At, B0); PG8_MMA(0, 1, At, B1); PG8_BAR; PG8_SCHED;
            PG8_LDA(At, 0, 1); PG8_STAGE(PG8_SB(0, 0), b2, voffB); PG8_STAGE(PG8_SB(0, 1), b2 + hstepB, voffB); PG8_STAGE(PG8_SA(0, 0), a2, voffA);
            PG8_WAIT_V(8); PG8_WAIT_L(0); PG8_BAR; PG8_MMA(1, 0, At, B0); PG8_MMA(1, 1, At, B1); PG8_BAR; PG8_SCHED;
            PG8_LDB(B0, 1, 0); PG8_LDB(B1, 1, 1); PG8_SCHED; PG8_LDA(At, 1, 0); PG8_STAGE(PG8_SA(0, 1), a2 + hstepA, voffA);
            PG8_WAIT_V(8); PG8_WAIT_L(0); PG8_BAR; PG8_MMA(0, 0, At, B0); PG8_MMA(0, 1, At, B1); PG8_BAR; PG8_SCHED;
            PG8_LDA(At, 1, 1); PG8_STAGE(PG8_SB(1, 0), b3, voffB); PG8_STAGE(PG8_SB(1, 1), b3 + hstepB, voffB); PG8_STAGE(PG8_SA(1, 0), a3, voffA);
            PG8_WAIT_V(8); PG8_WAIT_L(0); PG8_BAR; PG8_MMA(1, 0, At, B0); PG8_MMA(1, 1, At, B1); PG8_BAR; PG8_SCHED;
            } else {
            PG8_LDB(B0, 0, 0); PG8_SCHED; PG8_LDA(At, 0, 0); PG8_STAGE(PG8_SA(1, 1), a1 + hstepA, voffA);
            PG8_WAIT_L(8); PG8_BAR; PG8_WAIT_L(0); PG8_MMA(0, 0, At, B0); PG8_BAR; PG8_SCHED;
            PG8_LDB(B1, 0, 1); PG8_STAGE(PG8_SB(0, 0), b2, voffB);
            PG8_BAR; PG8_WAIT_L(0); PG8_MMA(0, 1, At, B1); PG8_BAR;
            PG8_LDA(At, 0, 1); PG8_STAGE(PG8_SA(0, 0), a2, voffA);
            PG8_BAR; PG8_WAIT_L(0); PG8_MMA(1, 0, At, B0); PG8_BAR; PG8_SCHED;
            PG8_STAGE(PG8_SB(0, 1), b2 + hstepB, voffB);
            PG8_WAIT_V(6); PG8_BAR; PG8_MMA(1, 1, At, B1); PG8_BAR;
            PG8_LDB(B0, 1, 0); PG8_SCHED; PG8_LDA(At, 1, 0); PG8_STAGE(PG8_SA(0, 1), a2 + hstepA, voffA);
            PG8_WAIT_L(8); PG8_BAR; PG8_WAIT_L(0); PG8_MMA(0, 0, At, B0); PG8_BAR; PG8_SCHED;
            PG8_LDB(B1, 1, 1); PG8_STAGE(PG8_SB(1, 0), b3, voffB);
            PG8_BAR; PG8_WAIT_L(0); PG8_MMA(0, 1, At, B1); PG8_BAR;
            PG8_LDA(At, 1, 1); PG8_STAGE(PG8_SA(1, 0), a3, voffA);
            PG8_BAR; PG8_WAIT_L(0); PG8_MMA(1, 0, At, B0); PG8_BAR; PG8_SCHED;
            PG8_STAGE(PG8_SB(1, 1), b3 + hstepB, voffB);
            PG8_WAIT_V(6); PG8_BAR; PG8_MMA(1, 1, At, B1); PG8_BAR;
            }
        }
        if constexpr (ALIGN_EPI) { if (wr == 0) PG8_BAR; }
        if constexpr (!Epi::AFTER_DRAIN) { E(acc, cur, wr, wc, fr, fq); S.done(cur); }
        if (!has_next) break;
#pragma unroll
        for (int a = 0; a < 2; ++a)
#pragma unroll
            for (int b = 0; b < 2; ++b)
#pragma unroll
                for (int m = 0; m < 4; ++m)
#pragma unroll
                    for (int n = 0; n < 2; ++n) acc[a][b][m][n] = (f32x4){0.f, 0.f, 0.f, 0.f};
        cur = nxt; cA = nA; cB = nB; ++ui;
        if constexpr (ALIGN_EPI) { if (wr == 1) PG8_BAR; }
    }
    PG8_WAIT_V(0);
    if constexpr (!ALIGN_EPI) { if (wr == 0) PG8_BAR; }
    PG8_BAR;
    if constexpr (Epi::AFTER_DRAIN) { E.fused(acc, cur, wr, wc, fr, fq, lds, wid, lane); S.done(cur); }
#undef PG8_SA
#undef PG8_SB
#undef PG8_STAGE
#undef PG8_LDA
#undef PG8_LDB
#undef PG8_MMA
#undef PG8_WAIT_V
#undef PG8_WAIT_L
#undef PG8_BAR
#undef PG8_SCHED
}
}


typedef unsigned short bf16_t;
typedef float f32x4 __attribute__((ext_vector_type(4)));
typedef unsigned u32x4 __attribute__((ext_vector_type(4)));
#define LAS __attribute__((address_space(3)))
#define GAS __attribute__((address_space(1)))

#ifndef PH_MASK
#define PH_MASK 0xffff
#endif
#ifndef ATTN_SIMPLE
#define ATTN_SIMPLE 0
#endif
#ifndef SCAN_SIMPLE
#define SCAN_SIMPLE 0
#endif
#ifndef MK_MULTI
#define MK_MULTI 0
#endif

constexpr int BATCH = 4, SEQ = 4096, DM = 1024, M = BATCH * SEQ, DEPTH = 4;
constexpr int DFF = 2816;
constexpr int HYB_IN = 3096, HYB_PAD = 3328;
constexpr int NCH = 64, CH = 64;
constexpr float EPS = 1e-6f;
constexpr int PP = 3072;
constexpr int C_GQ = 0, C_GK = 256, C_GV = 512, C_MQ = 1024, C_MK = 1280, C_MV = 1536, C_GR = 2048, C_MO = 2560;
constexpr int SMALLP = 32;

constexpr size_t MiB = 1u << 20;
constexpr size_t WS_CTL = 0, CTL_ZERO_BYTES = 65536, WS_RSS = 1 * MiB, WS_SMALL = 2 * MiB, WS_KMEAN = 4 * MiB, WS_DEC = 5 * MiB, WS_NS = 6 * MiB;
constexpr size_t WS_XB = 8 * MiB, WS_P = 40 * MiB, WS_W = 136 * MiB;
constexpr size_t W_IN = 0, W_OUT = W_IN + (size_t)HYB_PAD * DM * 2, W_QKV = W_OUT + (size_t)DM * DM * 2, W_O = W_QKV + (size_t)3 * DM * DM * 2, W_MIXSZ = W_O + (size_t)DM * DM * 2;
constexpr size_t W_FFN0 = 2 * W_MIXSZ, W_GU = 0, W_D = (size_t)2 * DFF * DM * 2, W_FFNSZ = W_D + (size_t)DM * DFF * 2;
constexpr size_t WS_END = WS_W + W_FFN0 + 4 * W_FFNSZ;
static_assert(WS_END <= 256 * MiB, "workspace map");

constexpr int RING_BYTES = 131072, LDS_BYTES = 147456, MISC_OFF = LDS_BYTES - 256;
constexpr int NWAVES = 8, NTHR = 512;

__device__ __forceinline__ float bf2f(bf16_t v) { return __uint_as_float((unsigned)v << 16); }
__device__ __forceinline__ unsigned f2bf(float f) { unsigned u = __float_as_uint(f); return (u + 0x7fffu + ((u >> 16) & 1u)) >> 16; }
__device__ __forceinline__ unsigned pk2(float lo, float hi) { return f2bf(lo) | (f2bf(hi) << 16); }
__device__ __forceinline__ float sigmoidf_(float x) { return 1.f / (1.f + __expf(-x)); }
__device__ __forceinline__ float siluf_(float x) { return x / (1.f + __expf(-x)); }
__device__ __forceinline__ float logsigmoidf_(float x) { return fminf(x, 0.f) - log1pf(__expf(-fabsf(x))); }
__device__ __forceinline__ float wave_sum(float v) {
#pragma unroll
    for (int o = 1; o < 64; o <<= 1) v += __shfl_xor(v, o);
    return v;
}
__device__ __forceinline__ float wave_max(float v) {
#pragma unroll
    for (int o = 1; o < 64; o <<= 1) v = fmaxf(v, __shfl_xor(v, o));
    return v;
}
__device__ __forceinline__ int opaque_i(int v) { asm volatile("" : "+v"(v)); return v; }
__device__ __forceinline__ float row_rstd(const float* rss, int row) {
    const f32x4* p = (const f32x4*)(rss + (size_t)row * 16);
    const f32x4 a = p[0], b = p[1], c = p[2], d = p[3];
    const float s = ((a.x + a.y) + (a.z + a.w)) + ((b.x + b.y) + (b.z + b.w)) + ((c.x + c.y) + (c.z + c.w)) + ((d.x + d.y) + (d.z + d.w));
    return rsqrtf(s * (1.f / DM) + EPS);
}

#define XB_TMO      128
#define XB_XCNT(j)  (256  + 64 * (j))
#define XB_XSUB(j)  (1280 + 64 * (j))
#define XB_XGEN(j)  (2304 + 64 * (j))
#define XB_TOP      3328
#define XB_TOPGEN   3392
#define XCD_BAR_WORDS 3456
#define XB_SPIN_CAP (1u << 18)
__device__ __forceinline__ unsigned xb_ld(unsigned* p)              { return __hip_atomic_load(p, __ATOMIC_RELAXED, __HIP_MEMORY_SCOPE_AGENT); }
__device__ __forceinline__ unsigned xb_add(unsigned* p, unsigned v) { return __hip_atomic_fetch_add(p, v, __ATOMIC_RELAXED, __HIP_MEMORY_SCOPE_AGENT); }
__device__ __forceinline__ unsigned xb_xcc_id() { return (unsigned)__builtin_amdgcn_s_getreg((3 << 11) | 20) & 0xFu; }
#define XB_SPIN(cond, bar) do { unsigned _sp = 0; while (cond) { __builtin_amdgcn_s_sleep(1); \
    if ((++_sp & 255u) == 0u) { if (xb_ld(&(bar)[XB_TMO])) break; if (_sp > XB_SPIN_CAP) { atomicAdd(&(bar)[XB_TMO], 1u); break; } } } } while (0)
struct XcdBarrier { unsigned* bar; unsigned x; volatile LAS unsigned* st; };
__device__ __forceinline__ XcdBarrier xcd_barrier_post(unsigned* bar, volatile LAS unsigned* st) {
    XcdBarrier b; b.bar = bar; b.x = xb_xcc_id(); b.st = st;
    if (threadIdx.x == 0) (void)xb_add(&bar[XB_XCNT(b.x)], 1u);
    return b;
}
__device__ __forceinline__ void xcd_barrier_complete(unsigned* bar, unsigned x, unsigned& nloc, unsigned& nx) {
    const unsigned G = gridDim.x * gridDim.y * gridDim.z;
    unsigned sum, cnt, mine, sp = 0u;
    for (;;) {
        sum = 0u; cnt = 0u; mine = 0u;
#pragma unroll
        for (unsigned j = 0; j < 16; ++j) { const unsigned c = xb_ld(&bar[XB_XCNT(j)]); sum += c; cnt += (c > 0u) ? 1u : 0u; mine = (j == x) ? c : mine; }
        if (sum == G) break;
        __builtin_amdgcn_s_sleep(1);
        if ((++sp & 255u) == 0u) { if (xb_ld(&bar[XB_TMO])) break; if (sp > XB_SPIN_CAP) { atomicAdd(&bar[XB_TMO], 1u); break; } }
    }
    nloc = mine > 0u ? mine : 1u; nx = cnt > 0u ? cnt : 1u;
}
__device__ __forceinline__ void xcd_barrier(const XcdBarrier& b) {
    asm volatile("s_waitcnt vmcnt(0)" ::: "memory");
    __syncthreads();
    if (threadIdx.x == 0) {
        unsigned* bar = b.bar;
        __builtin_amdgcn_s_waitcnt(0);
        unsigned nloc = b.st[0], nx = b.st[1];
        if (nloc == 0u) { xcd_barrier_complete(bar, b.x, nloc, nx); b.st[0] = nloc; b.st[1] = nx; }
        const unsigned old = xb_add(&bar[XB_XSUB(b.x)], 1u);
        const unsigned gen = old / nloc;
        if (old + 1u == (gen + 1u) * nloc) {
            __builtin_amdgcn_fence(__ATOMIC_RELEASE, "agent");
            asm volatile("s_waitcnt vmcnt(0)" ::: "memory");
            const unsigned og = xb_add(&bar[XB_TOP], 1u);
            const unsigned tg = og / nx;
            if (og + 1u == (tg + 1u) * nx) xb_add(&bar[XB_TOPGEN], 1u);
            else XB_SPIN(xb_ld(&bar[XB_TOPGEN]) == tg, bar);
            __builtin_amdgcn_fence(__ATOMIC_ACQUIRE, "agent");
            xb_add(&bar[XB_XGEN(b.x)], 1u);
            asm volatile("s_waitcnt vmcnt(0)" ::: "memory");
        } else {
            XB_SPIN(xb_ld(&bar[XB_XGEN(b.x)]) == gen, bar);
            __builtin_amdgcn_fence(__ATOMIC_ACQUIRE, "agent");
            asm volatile("s_waitcnt vmcnt(0)" ::: "memory");
        }
    }
    __syncthreads();
}

struct EpiRowBf16 {
    static constexpr bool PERM = true, AFTER_DRAIN = false;
    bf16_t* O; int ldc; const float* rss; float* small; int small_pn;
    __device__ __forceinline__ void operator()(const pg8::f32x4 (&acc)[2][2][4][2], const pg8::Unit& u, int wr, int wc, int fr, int fq) const {
        const int row0 = u.pm * 256 + wr * 64 + fr;
        if (u.pn == small_pn) {
            if (wc == 0) {
#pragma unroll
                for (int ai = 0; ai < 2; ++ai)
#pragma unroll
                    for (int m = 0; m < 4; ++m) { const int row = row0 + ai * 128 + m * 16; const float rs = row_rstd(rss, row);
#pragma unroll
                        for (int n = 0; n < 2; ++n) *(f32x4*)(small + (size_t)row * SMALLP + 8 * fq + 4 * n) = acc[ai][0][m][n] * rs; }
            }
            return;
        }
        const int col0 = u.pn * 256 + wc * 32 + 8 * fq;
#pragma unroll
        for (int ai = 0; ai < 2; ++ai)
#pragma unroll
            for (int m = 0; m < 4; ++m) { const int row = row0 + ai * 128 + m * 16; const float rs = row_rstd(rss, row);
                bf16_t* rowp = O + (size_t)row * ldc + col0;
#pragma unroll
                for (int bj = 0; bj < 2; ++bj) { const f32x4 v0 = acc[ai][bj][m][0] * rs, v1 = acc[ai][bj][m][1] * rs;
                    u32x4 w; w.x = pg8::cvt_pk_bf16(v0[0], v0[1]); w.y = pg8::cvt_pk_bf16(v0[2], v0[3]); w.z = pg8::cvt_pk_bf16(v1[0], v1[1]); w.w = pg8::cvt_pk_bf16(v1[2], v1[3]);
                    *(u32x4*)(rowp + bj * 128) = w; } }
    }
};
struct EpiRes {
    static constexpr bool PERM = true, AFTER_DRAIN = false;
    const float* xin; float* xout; bf16_t* xb; float* rss;
    __device__ __forceinline__ void operator()(const pg8::f32x4 (&acc)[2][2][4][2], const pg8::Unit& u, int wr, int wc, int fr, int fq) const {
        const int row0 = u.pm * 256 + wr * 64 + fr, col0 = u.pn * 256 + wc * 32 + 8 * fq;
#pragma unroll
        for (int ai = 0; ai < 2; ++ai)
#pragma unroll
            for (int m = 0; m < 4; ++m) { const int row = row0 + ai * 128 + m * 16; float ss = 0.f;
#pragma unroll
                for (int bj = 0; bj < 2; ++bj) { const size_t off = (size_t)row * DM + col0 + bj * 128;
                    f32x4 a = *(const f32x4*)(xin + off), b = *(const f32x4*)(xin + off + 4);
                    a = a + acc[ai][bj][m][0]; b = b + acc[ai][bj][m][1];
                    *(f32x4*)(xout + off) = a; *(f32x4*)(xout + off + 4) = b;
                    u32x4 w; w.x = pg8::cvt_pk_bf16(a[0], a[1]); w.y = pg8::cvt_pk_bf16(a[2], a[3]); w.z = pg8::cvt_pk_bf16(b[0], b[1]); w.w = pg8::cvt_pk_bf16(b[2], b[3]);
                    *(u32x4*)(xb + off) = w;
                    ss += (a[0] * a[0] + a[1] * a[1]) + (a[2] * a[2] + a[3] * a[3]) + (b[0] * b[0] + b[1] * b[1]) + (b[2] * b[2] + b[3] * b[3]); }
                ss += __shfl_xor(ss, 16); ss += __shfl_xor(ss, 32);
                if (fq == 0) rss[(size_t)row * 16 + u.pn * 4 + wc] = ss; }
    }
};
struct EpiFfn {
    static constexpr bool PERM = true, AFTER_DRAIN = false;
    bf16_t* H; const float* rss;
    __device__ __forceinline__ void operator()(const pg8::f32x4 (&acc)[2][2][4][2], const pg8::Unit& u, int wr, int wc, int fr, int fq) const {
        const int row0 = u.pm * 256 + wr * 64 + fr, col0 = u.pn * 128 + wc * 32 + 8 * fq;
#pragma unroll
        for (int ai = 0; ai < 2; ++ai)
#pragma unroll
            for (int m = 0; m < 4; ++m) { const int row = row0 + ai * 128 + m * 16; const float rs = row_rstd(rss, row);
                float hv[8];
#pragma unroll
                for (int n = 0; n < 2; ++n)
#pragma unroll
                    for (int e = 0; e < 4; ++e) { const float g = acc[ai][0][m][n][e] * rs, uu = acc[ai][1][m][n][e] * rs; hv[n * 4 + e] = siluf_(g) * uu; }
                u32x4 w; w.x = pg8::cvt_pk_bf16(hv[0], hv[1]); w.y = pg8::cvt_pk_bf16(hv[2], hv[3]); w.z = pg8::cvt_pk_bf16(hv[4], hv[5]); w.w = pg8::cvt_pk_bf16(hv[6], hv[7]);
                *(u32x4*)(H + (size_t)row * DFF + col0) = w; }
    }
};

struct Args { const float* in[18]; float* out; unsigned char* ws; int ph_lo, ph_hi; };
struct Frame {
    LAS unsigned char* lds; unsigned char* ldsg;
    int tid, lane, wave, G, bid;
};


typedef const __attribute__((address_space(4))) unsigned char* kargp_t;
__device__ __forceinline__ kargp_t karg_base() { kargp_t p = (kargp_t)__builtin_amdgcn_kernarg_segment_ptr(); asm volatile("" : "+s"(p)); return p; }
__device__ __forceinline__ const float* karg_in(kargp_t p, int i) { return *(const float* const __attribute__((address_space(4)))*)(p + 8 * i); }
__device__ __forceinline__ float* karg_out(kargp_t p) { return *(float* const __attribute__((address_space(4)))*)(p + 8 * 18); }
__device__ __forceinline__ unsigned char* karg_ws(kargp_t p) { return *(unsigned char* const __attribute__((address_space(4)))*)(p + 8 * 19); }

__device__ __forceinline__ int map_row(int kind, int n) {
    if (kind == 0) return n;
    if (kind == 2) return (n >> 7) * 256 + (n & 127);
    if (kind == 3) return (n >> 7) * 256 + 128 + (n & 127);
    if (n < 256) return C_GQ + n; if (n < 512) return C_GK + n - 256; if (n < 1024) return C_GV + n - 512; if (n < 1536) return C_GR + n - 1024;
    if (n < 1552) return 3072 + (n - 1536);
    if (n < 1808) return C_MQ + n - 1552; if (n < 2064) return C_MK + n - 1808; if (n < 2576) return C_MV + n - 2064; if (n < 3088) return C_MO + n - 2576;
    return 3072 + 16 + (n - 3088);
}
__device__ __forceinline__ void cvt_item(const float* W, int K, int N, const float* gain, bf16_t* WT, int kind, LAS float* scr, int item, int lane) {
    const int nblk = (N + 63) / 64, kb = item / nblk, nb = item % nblk, k0 = 64 * kb, n0 = 64 * nb;
    const int nq = n0 + 4 * (lane & 15), kr = lane >> 4;
    f32x4 v[16];
#pragma unroll
    for (int i = 0; i < 16; ++i) { v[i] = (f32x4){0.f, 0.f, 0.f, 0.f}; if (nq < N) v[i] = *(const f32x4*)(W + (size_t)(k0 + 4 * i + kr) * N + nq); }
#pragma unroll
    for (int i = 0; i < 16; ++i) { const int kk = 4 * i + kr; const float g = gain ? gain[k0 + kk] : 1.f; LAS float* d = scr + kk * 65 + 4 * (lane & 15);
        d[0] = v[i][0] * g; d[1] = v[i][1] * g; d[2] = v[i][2] * g; d[3] = v[i][3] * g; }
    asm volatile("s_waitcnt lgkmcnt(0)" ::: "memory");
    if (n0 + lane < N) {
        bf16_t* dst = WT + (size_t)map_row(kind, n0 + lane) * K + k0;
#pragma unroll
        for (int c = 0; c < 8; ++c) { const LAS float* sp = scr + (8 * c) * 65 + lane;
            u32x4 o; o.x = pk2(sp[0 * 65], sp[1 * 65]); o.y = pk2(sp[2 * 65], sp[3 * 65]); o.z = pk2(sp[4 * 65], sp[5 * 65]); o.w = pk2(sp[6 * 65], sp[7 * 65]);
            *(u32x4*)(dst + 8 * c) = o; }
    }
    asm volatile("s_waitcnt lgkmcnt(0)" ::: "memory");
}
__device__ __forceinline__ void cvt_matrix(Frame& F, const float* W, int K, int N, const float* gain, bf16_t* WT, int kind) {
    LAS float* scr = (LAS float*)(F.lds + F.wave * 16640);
    const int gw = F.bid * NWAVES + F.wave, NGW = F.G * NWAVES, lane = opaque_i(F.lane);
    const int nitems = (K / 64) * ((N + 63) / 64);
    for (int it = gw; it < nitems; it += NGW) cvt_item(W, K, N, gain, WT, kind, scr, it, lane);
}
__device__ __forceinline__ void phase_prologue(Frame& F) {
    kargp_t kp = karg_base();
    unsigned char* wsw = karg_ws(kp) + WS_W;
    for (int j = 0; j < 2; ++j) {
        unsigned char* wj = wsw + j * W_MIXSZ;
        cvt_matrix(F, karg_in(kp, 3) + (size_t)j * DM * HYB_IN, DM, HYB_IN, karg_in(kp, 1) + (2 * j) * DM, (bf16_t*)(wj + W_IN), 1);
        cvt_matrix(F, karg_in(kp, 10) + (size_t)j * DM * DM, DM, DM, nullptr, (bf16_t*)(wj + W_OUT), 0);
        cvt_matrix(F, karg_in(kp, 11) + (size_t)j * DM * 3 * DM, DM, 3 * DM, karg_in(kp, 1) + (2 * j + 1) * DM, (bf16_t*)(wj + W_QKV), 0);
        cvt_matrix(F, karg_in(kp, 14) + (size_t)j * DM * DM, DM, DM, nullptr, (bf16_t*)(wj + W_O), 0);
        u32x4* z = (u32x4*)(wj + W_IN + (size_t)(3072 + 24) * DM * 2);
        const int nz = (HYB_PAD - 3096) * DM * 2 / 16;
        for (int i = F.bid * NTHR + F.tid; i < nz; i += F.G * NTHR) z[i] = (u32x4){0u, 0u, 0u, 0u};
    }
    for (int l = 0; l < 4; ++l) {
        unsigned char* wl = wsw + W_FFN0 + l * W_FFNSZ;
        cvt_matrix(F, karg_in(kp, 15) + (size_t)l * DM * DFF, DM, DFF, karg_in(kp, 2) + l * DM, (bf16_t*)(wl + W_GU), 2);
        cvt_matrix(F, karg_in(kp, 16) + (size_t)l * DM * DFF, DM, DFF, karg_in(kp, 2) + l * DM, (bf16_t*)(wl + W_GU), 3);
        cvt_matrix(F, karg_in(kp, 17) + (size_t)l * DFF * DM, DFF, DM, nullptr, (bf16_t*)(wl + W_D), 0);
    }
    const float* x = karg_in(kp, 0); bf16_t* xb = (bf16_t*)(karg_ws(kp) + WS_XB); float* rss = (float*)(karg_ws(kp) + WS_RSS);
    const int gw = F.bid * NWAVES + F.wave, NGW = F.G * NWAVES;
    for (int row = gw; row < M; row += NGW) {
        const float* xr = x + (size_t)row * DM; float s = 0.f;
#pragma unroll
        for (int j = 0; j < 4; ++j) { const f32x4 v = *(const f32x4*)(xr + j * 256 + F.lane * 4);
            s += (v.x * v.x + v.y * v.y) + (v.z * v.z + v.w * v.w);
            unsigned long long o = (unsigned long long)pk2(v.x, v.y) | ((unsigned long long)pk2(v.z, v.w) << 32);
            *(unsigned long long*)(xb + (size_t)row * DM + j * 256 + F.lane * 4) = o; }
        s = wave_sum(s);
        if (F.lane < 16) rss[(size_t)row * 16 + F.lane] = F.lane == 0 ? s : 0.f;
    }
}

struct ScanArgs {
    bf16_t* P; const float* small;
    const float* w2; const float* bgate; const float* gla_gain; const float* convw; const float* bif; const float* ml_gain;
    bf16_t* ST; float* dec; float* NS;
};
__device__ __forceinline__ size_t st_off(int grp, int bh, int c) { return ((size_t)((grp * 16 + bh) * NCH + c)) * 8192; }

template <bool NEED_A>
__device__ __forceinline__ void gate_stage(const ScanArgs& a, int b, int c, int hh, float* At, float* Bm, float* blk, float* lastv) {
    int tid_ = threadIdx.x; asm volatile("" : "+v"(tid_));
    const int tid = tid_, tb = tid >> 6, k = tid & 63;
    const int grp = hh >> 2, h = hh & 3;
    const int row0 = b * SEQ + c * CH;
    float la[8];
    if (grp == 0) {
        float w2r[16];
#pragma unroll
        for (int r = 0; r < 16; ++r) w2r[r] = a.w2[r * 256 + h * 64 + k];
        const float bg = a.bgate[h * 64 + k];
#pragma unroll
        for (int i = 0; i < 8; ++i) {
            const float* g = a.small + (size_t)(row0 + tb * 8 + i) * SMALLP;
            float z = bg;
#pragma unroll
            for (int r = 0; r < 16; ++r) z += g[r] * w2r[r];
            la[i] = logsigmoidf_(z) * (1.f / 16.f);
            asm volatile("" ::: "memory");
        }
    } else {
#pragma unroll
        for (int i = 0; i < 8; ++i) {
            const float* g = a.small + (size_t)(row0 + tb * 8 + i) * SMALLP;
            la[i] = logsigmoidf_(g[20 + h] + a.bif[4 + h]);
        }
    }
    float cs[8]; float run = 0.f;
#pragma unroll
    for (int i = 0; i < 8; ++i) { run += la[i]; cs[i] = run; }
    blk[tb * 64 + k] = run;
    __syncthreads();
    float pre = 0.f, tot = 0.f;
#pragma unroll
    for (int j = 0; j < 8; ++j) { const float v = blk[j * 64 + k]; tot += v; if (j < tb) pre += v; }
    if (tb == 0) lastv[k] = tot;
#pragma unroll
    for (int i = 0; i < 8; ++i) {
        const int t = tb * 8 + i; const int row = row0 + t; const float bc = pre + cs[i];
        const bf16_t* pr = a.P + (size_t)row * PP;
        if (grp == 0) {
            const float kv = bf2f(pr[C_GK + h * 64 + k]);
            Bm[t * 65 + k] = kv * __expf(-bc);
            if (NEED_A) { const float qv = bf2f(pr[C_GQ + h * 64 + k]); At[t * 65 + k] = qv * 0.125f * __expf(bc); }
        } else {
            const float ip = a.small[(size_t)row * SMALLP + 16 + h] + a.bif[h];
            const int tt = c * CH + t;
            float ck = 0.f, cq = 0.f;
#pragma unroll
            for (int j = 0; j < 4; ++j) {
                const int ts = tt - 3 + j;
                if (ts >= 0) {
                    const bf16_t* ps = a.P + (size_t)(b * SEQ + ts) * PP;
                    ck += a.convw[j * 512 + 256 + h * 64 + k] * bf2f(ps[C_MK + h * 64 + k]);
                    if (NEED_A) cq += a.convw[j * 512 + h * 64 + k] * bf2f(ps[C_MQ + h * 64 + k]);
                }
            }
            Bm[t * 65 + k] = siluf_(ck) * 0.125f * __expf(ip - bc);
            if (NEED_A) At[t * 65 + k] = siluf_(cq) * __expf(bc);
        }
    }
}

__device__ __forceinline__ void phase_scan1(Frame& F, const ScanArgs& a) {
    float* sm = (float*)F.ldsg;
    float* Bm = sm; float* Vs = sm + 64 * 65; float* blk = Vs + 64 * 128; float* lastv = blk + 512;
    int tid_ = threadIdx.x; asm volatile("" : "+v"(tid_));
    const int tid = tid_, lane = tid & 63, kg = tid >> 6;
    for (int unit = F.bid; unit < BATCH * NCH; unit += F.G) {
        const int b = unit / NCH, c = unit % NCH;
        const int row0 = b * SEQ + c * CH;
        for (int hh = 0; hh < 8; ++hh) {
            const int grp = hh >> 2, h = hh & 3, bh = b * 4 + h;
            gate_stage<false>(a, b, c, hh, nullptr, Bm, blk, lastv);
            const int voff = (grp == 0 ? C_GV : C_MV) + h * 128;
#pragma unroll 4
            for (int i = tid; i < 64 * 128; i += 512) { const int s = i >> 7, v = i & 127; Vs[i] = bf2f(a.P[(size_t)(row0 + s) * PP + voff + v]); }
            __syncthreads();
            if (tid < 64) a.dec[((size_t)(grp * 16 + bh) * NCH + c) * 64 + tid] = __expf(lastv[tid]);
            if (grp == 1 && tid < 64) { float s = 0.f; for (int t = 0; t < 64; ++t) s += Bm[t * 65 + tid]; a.NS[((size_t)bh * NCH + c) * 64 + tid] = s; }
            float acc[8][2];
#pragma unroll
            for (int i = 0; i < 8; ++i) { acc[i][0] = 0.f; acc[i][1] = 0.f; }
#pragma unroll 2
            for (int s = 0; s < 64; ++s) {
                const float v0 = Vs[s * 128 + lane], v1 = Vs[s * 128 + 64 + lane];
#pragma unroll
                for (int i = 0; i < 8; ++i) { const float bv = Bm[s * 65 + kg * 8 + i]; acc[i][0] += bv * v0; acc[i][1] += bv * v1; }
            }
            bf16_t* st = a.ST + st_off(grp, bh, c);
            u32x4 w0, w1;
            w0.x = pk2(acc[0][0], acc[1][0]); w0.y = pk2(acc[2][0], acc[3][0]); w0.z = pk2(acc[4][0], acc[5][0]); w0.w = pk2(acc[6][0], acc[7][0]);
            w1.x = pk2(acc[0][1], acc[1][1]); w1.y = pk2(acc[2][1], acc[3][1]); w1.z = pk2(acc[4][1], acc[5][1]); w1.w = pk2(acc[6][1], acc[7][1]);
            *(u32x4*)(st + (size_t)lane * 64 + kg * 8) = w0; *(u32x4*)(st + (size_t)(lane + 64) * 64 + kg * 8) = w1;
            __syncthreads();
        }
    }
}
__device__ __forceinline__ void phase_scan2(Frame& F, const ScanArgs& a) {
    for (int gid = F.bid * NTHR + opaque_i(F.tid); gid < 131072; gid += F.G * NTHR) {
        const int grp = gid >> 16, rem = gid & 65535, bh = rem >> 12, r2 = rem & 4095, v = r2 >> 5, k = (r2 & 31) * 2;
        float s0 = 0.f, s1 = 0.f;
#pragma unroll 4
        for (int c = 0; c < NCH; ++c) {
            unsigned* p = (unsigned*)(a.ST + st_off(grp, bh, c) + v * 64 + k);
            const unsigned w = *p;
            const float l0 = __uint_as_float(w << 16), l1 = __uint_as_float(w & 0xffff0000u);
            *p = pk2(s0, s1);
            const float* d = a.dec + ((size_t)(grp * 16 + bh) * NCH + c) * 64 + k;
            s0 = d[0] * (s0 + l0); s1 = d[1] * (s1 + l1);
        }
        if (gid < 1024) {
            const int bh2 = gid >> 6, k2 = gid & 63; float ns = 0.f;
            for (int c = 0; c < NCH; ++c) {
                float* p = a.NS + ((size_t)bh2 * NCH + c) * 64 + k2; const float l = *p; *p = ns;
                ns = a.dec[((size_t)(16 + bh2) * NCH + c) * 64 + k2] * (ns + l);
            }
        }
    }
}
__device__ __forceinline__ void phase_scan3(Frame& F, const ScanArgs& a) {
    float* sm = (float*)F.ldsg;
    float* At = sm; float* Bm = At + 64 * 65; float* Pm = Bm + 64 * 65; float* Vs = Pm + 64 * 65; float* Ss = Vs + 64 * 128;
    float* blk = Ss + 64 * 128; float* lastv = blk + 512; float* nsv = lastv + 64;
    int tid_ = threadIdx.x; asm volatile("" : "+v"(tid_));
    const int tid = tid_, lane = tid & 63, tg = tid >> 6;
    for (int unit = F.bid; unit < BATCH * NCH; unit += F.G) {
        const int b = unit / NCH, c = unit % NCH;
        const int row0 = b * SEQ + c * CH;
        for (int hh = 0; hh < 8; ++hh) {
            const int grp = hh >> 2, h = hh & 3, bh = b * 4 + h;
            gate_stage<true>(a, b, c, hh, At, Bm, blk, lastv);
            const int voff = (grp == 0 ? C_GV : C_MV) + h * 128;
#pragma unroll 4
            for (int i = tid; i < 64 * 128; i += 512) { const int s = i >> 7, v = i & 127; Vs[i] = bf2f(a.P[(size_t)(row0 + s) * PP + voff + v]); }
            const bf16_t* st = a.ST + st_off(grp, bh, c);
#pragma unroll 4
            for (int i = tid; i < 64 * 128; i += 512) { const int v = i >> 6, k = i & 63; Ss[k * 128 + v] = bf2f(st[i]); }
            if (tid < 64) nsv[tid] = grp == 1 ? a.NS[((size_t)bh * NCH + c) * 64 + tid] : 0.f;
            __syncthreads();
            {
                const int t = tid >> 3, sg = tid & 7;
                float p[8];
#pragma unroll
                for (int i = 0; i < 8; ++i) p[i] = 0.f;
#pragma unroll 2
                for (int k = 0; k < 64; ++k) {
                    const float av = At[t * 65 + k];
#pragma unroll
                    for (int i = 0; i < 8; ++i) p[i] += av * Bm[(sg * 8 + i) * 65 + k];
                }
#pragma unroll
                for (int i = 0; i < 8; ++i) { const int s = sg * 8 + i; Pm[t * 65 + s] = s <= t ? p[i] : 0.f; }
            }
            __syncthreads();
            float acc[8][2], den[8];
#pragma unroll
            for (int i = 0; i < 8; ++i) { acc[i][0] = 0.f; acc[i][1] = 0.f; den[i] = 0.f; }
#pragma unroll 2
            for (int s = 0; s < 64; ++s) {
                const float v0 = Vs[s * 128 + lane], v1 = Vs[s * 128 + 64 + lane];
#pragma unroll
                for (int i = 0; i < 8; ++i) { const float pv = Pm[(tg * 8 + i) * 65 + s]; acc[i][0] += pv * v0; acc[i][1] += pv * v1; den[i] += pv; }
            }
#pragma unroll 2
            for (int k = 0; k < 64; ++k) {
                const float s0 = Ss[k * 128 + lane], s1 = Ss[k * 128 + 64 + lane], nk = nsv[k];
#pragma unroll
                for (int i = 0; i < 8; ++i) { const float av = At[(tg * 8 + i) * 65 + k]; acc[i][0] += av * s0; acc[i][1] += av * s1; den[i] += av * nk; }
            }
#pragma unroll
            for (int i = 0; i < 8; ++i) {
                asm volatile("" ::: "memory");
                const int row = row0 + tg * 8 + i;
                bf16_t* pr = a.P + (size_t)row * PP;
                float o0 = acc[i][0], o1 = acc[i][1];
                if (grp == 0) {
                    const float ss = wave_sum(o0 * o0 + o1 * o1);
                    const float rstd = rsqrtf(ss * (1.f / 128.f) + EPS);
                    const float g0 = bf2f(pr[C_GR + h * 128 + lane]), g1 = bf2f(pr[C_GR + h * 128 + 64 + lane]);
                    pr[C_GR + h * 128 + lane] = (bf16_t)f2bf(o0 * rstd * a.gla_gain[h * 128 + lane] * siluf_(g0));
                    pr[C_GR + h * 128 + 64 + lane] = (bf16_t)f2bf(o1 * rstd * a.gla_gain[h * 128 + 64 + lane] * siluf_(g1));
                } else {
                    const float dd = 1.f / fmaxf(fabsf(den[i]), 1.f);
                    const float g0 = bf2f(pr[C_MO + h * 128 + lane]), g1 = bf2f(pr[C_MO + h * 128 + 64 + lane]);
                    o0 = o0 * dd * sigmoidf_(g0); o1 = o1 * dd * sigmoidf_(g1);
                    const float ss = wave_sum(o0 * o0 + o1 * o1);
                    const float rstd = rsqrtf(ss * (1.f / 128.f) + EPS);
                    pr[C_MO + h * 128 + lane] = (bf16_t)f2bf(o0 * rstd * a.ml_gain[h * 128 + lane]);
                    pr[C_MO + h * 128 + 64 + lane] = (bf16_t)f2bf(o1 * rstd * a.ml_gain[h * 128 + 64 + lane]);
                }
            }
            __syncthreads();
        }
    }
}

__device__ __forceinline__ void phase_qkn(Frame& F, bf16_t* P, const float* qg, const float* kg, float* kmean) {
    const int gw = F.bid * NWAVES + F.wave, NGW = F.G * NWAVES, lane = opaque_i(F.lane);
    for (int u = gw; u < BATCH * 16 * 16; u += NGW) {
        const int hd = u & 15, blk = (u >> 4) & 15, b = u >> 8;
        const float* g = hd < 8 ? qg : kg;
        const float g0 = g[lane * 2], g1 = g[lane * 2 + 1];
        const float sc = hd < 8 ? 0.08838834764831845f : 1.f;
        float m0 = 0.f, m1 = 0.f;
        for (int r = 0; r < 256; ++r) {
            unsigned* p = (unsigned*)(P + (size_t)(b * SEQ + blk * 256 + r) * PP + hd * 128 + lane * 2);
            const unsigned w = *p;
            const float x0 = __uint_as_float(w << 16), x1 = __uint_as_float(w & 0xffff0000u);
            const float ss = wave_sum(x0 * x0 + x1 * x1);
            const float rr = rsqrtf(ss * (1.f / 128.f) + EPS) * sc;
            const float y0 = x0 * rr * g0, y1 = x1 * rr * g1;
            m0 += y0; m1 += y1;
            *p = pk2(y0, y1);
        }
        if (hd >= 8) { float* km = kmean + ((size_t)((b * 8 + (hd - 8)) * 16 + blk)) * 128 + lane * 2; km[0] = m0 * (1.f / 256.f); km[1] = m1 * (1.f / 256.f); }
    }
}
__device__ __forceinline__ void phase_attn_simple(Frame& F, bf16_t* P, const float* kmean) {
    float* qs = (float*)F.ldsg + F.wave * 1152; float* sc = qs + 128;
    const int gw = F.bid * NWAVES + F.wave, NGW = F.G * NWAVES, lane = opaque_i(F.lane);
    for (int item = gw; item < BATCH * 8 * SEQ; item += NGW) {
        const int t = item & (SEQ - 1), h = (item >> 12) & 7, b = item >> 15;
        const size_t row = (size_t)b * SEQ + t;
        {
            const unsigned w = *(const unsigned*)(P + row * PP + h * 128 + lane * 2);
            qs[lane * 2] = __uint_as_float(w << 16); qs[lane * 2 + 1] = __uint_as_float(w & 0xffff0000u);
        }
        const int qblk = t >> 8;
        float g = -INFINITY;
        if (lane < qblk) { const float* km = kmean + ((size_t)((b * 8 + h) * 16 + lane)) * 256; float s = 0.f; for (int d = 0; d < 128; ++d) s += qs[d] * (km[d] + km[128 + d]); g = s; }
        int sel0 = 0, sel1 = 0, sel2 = 0; const int nsel = qblk < 3 ? qblk : 3;
        {
            float gv[16];
#pragma unroll
            for (int n = 0; n < 16; ++n) gv[n] = __shfl(g, n);
            unsigned taken = 0u;
#pragma unroll
            for (int r = 0; r < 3; ++r) {
                int best = 0; float bv = -INFINITY; bool found = false;
#pragma unroll
                for (int n = 0; n < 16; ++n) { const bool ok = !((taken >> n) & 1u) && n < qblk; if (ok && (!found || gv[n] > bv)) { bv = gv[n]; best = n; found = true; } }
                if (r == 0) sel0 = best; else if (r == 1) sel1 = best; else sel2 = best;
                if (found) taken |= 1u << best;
            }
        }
        const float slope = exp2f(-(float)(h + 1));
        float mx = -1e30f;
        for (int r = 0; r <= nsel; ++r) {
            const int blk = r < nsel ? (r == 0 ? sel0 : (r == 1 ? sel1 : sel2)) : qblk;
            for (int sub = 0; sub < 4; ++sub) {
                const int key = blk * 256 + sub * 64 + lane; const int dist = t - key;
                const bf16_t* kr = P + ((size_t)b * SEQ + key) * PP + 1024 + h * 128;
                float s = 0.f;
                for (int d8 = 0; d8 < 16; ++d8) {
                    const u32x4 w = *(const u32x4*)(kr + d8 * 8);
#pragma unroll
                    for (int e = 0; e < 4; ++e) { s += qs[d8 * 8 + 2 * e] * __uint_as_float(w[e] << 16); s += qs[d8 * 8 + 2 * e + 1] * __uint_as_float(w[e] & 0xffff0000u); }
                }
                s = dist >= 0 ? s - slope * (float)dist : -1e30f;
                sc[r * 256 + sub * 64 + lane] = s; mx = fmaxf(mx, s);
            }
        }
        mx = wave_max(mx);
        float sum = 0.f;
        for (int i = lane; i < (nsel + 1) * 256; i += 64) { const float p = __expf(sc[i] - mx); sc[i] = p; sum += p; }
        sum = wave_sum(sum);
        float a0 = 0.f, a1 = 0.f;
        for (int r = 0; r <= nsel; ++r) {
            const int blk = r < nsel ? (r == 0 ? sel0 : (r == 1 ? sel1 : sel2)) : qblk;
            const bf16_t* vr = P + ((size_t)b * SEQ + blk * 256) * PP + 2048 + h * 128 + lane * 2;
#pragma unroll 4
            for (int j = 0; j < 256; ++j) {
                const float p = sc[r * 256 + j];
                const unsigned w = *(const unsigned*)(vr + (size_t)j * PP);
                a0 += p * __uint_as_float(w << 16); a1 += p * __uint_as_float(w & 0xffff0000u);
            }
        }
        const float inv = 1.f / sum;
        *(unsigned*)(P + row * PP + h * 128 + lane * 2) = pk2(a0 * inv, a1 * inv);
    }
}


__device__ __forceinline__ void phase_qkn2(Frame& F, bf16_t* P, const float* qg, const float* kg, float* kmean) {
    const int gw = F.bid * NWAVES + F.wave, NGW = F.G * NWAVES, lane = opaque_i(F.lane), sub = lane >> 4, cl = lane & 15;
    for (int u = gw; u < BATCH * 16 * 16 * 2; u += NGW) {
        const int half = u & 1, hd = (u >> 1) & 15, blk = (u >> 5) & 15, b = u >> 9;
        const float* g = (hd < 8 ? qg : kg) + cl * 8;
        const f32x4 ga = *(const f32x4*)g, gb = *(const f32x4*)(g + 4);
        const float sc = hd < 8 ? 0.08838834764831845f : 1.f;
        float m[8];
#pragma unroll
        for (int e = 0; e < 8; ++e) m[e] = 0.f;
        bf16_t* base = P + (size_t)(b * SEQ + blk * 256 + half * 128 + sub) * PP + hd * 128 + cl * 8;
#pragma unroll 8
        for (int it = 0; it < 32; ++it) {
            u32x4* p = (u32x4*)(base + (size_t)it * 4 * PP);
            const u32x4 w = *p;
            float x[8];
#pragma unroll
            for (int e = 0; e < 4; ++e) { x[2 * e] = __uint_as_float(w[e] << 16); x[2 * e + 1] = __uint_as_float(w[e] & 0xffff0000u); }
            float ss = (x[0] * x[0] + x[1] * x[1]) + (x[2] * x[2] + x[3] * x[3]) + (x[4] * x[4] + x[5] * x[5]) + (x[6] * x[6] + x[7] * x[7]);
            ss += __shfl_xor(ss, 1); ss += __shfl_xor(ss, 2); ss += __shfl_xor(ss, 4); ss += __shfl_xor(ss, 8);
            const float rr = rsqrtf(ss * (1.f / 128.f) + EPS) * sc;
            float y[8];
            y[0] = x[0] * rr * ga[0]; y[1] = x[1] * rr * ga[1]; y[2] = x[2] * rr * ga[2]; y[3] = x[3] * rr * ga[3];
            y[4] = x[4] * rr * gb[0]; y[5] = x[5] * rr * gb[1]; y[6] = x[6] * rr * gb[2]; y[7] = x[7] * rr * gb[3];
#pragma unroll
            for (int e = 0; e < 8; ++e) m[e] += y[e];
            u32x4 o; o.x = pk2(y[0], y[1]); o.y = pk2(y[2], y[3]); o.z = pk2(y[4], y[5]); o.w = pk2(y[6], y[7]);
            *p = o;
        }
        if (hd >= 8) {
#pragma unroll
            for (int e = 0; e < 8; ++e) { m[e] += __shfl_xor(m[e], 16); m[e] += __shfl_xor(m[e], 32); }
            if (sub == 0) { float* km = kmean + ((size_t)(((b * 8 + (hd - 8)) * 16 + blk) * 2 + half)) * 128 + cl * 8;
                *(f32x4*)km = (f32x4){m[0], m[1], m[2], m[3]} * (1.f / 256.f); *(f32x4*)(km + 4) = (f32x4){m[4], m[5], m[6], m[7]} * (1.f / 256.f); }
        }
    }
}

namespace att {
typedef short bf16x8 __attribute__((ext_vector_type(8)));
typedef short s16x4 __attribute__((ext_vector_type(4)));
typedef float f32x16 __attribute__((ext_vector_type(16)));
constexpr int SHM_V = 16384, SHM_K = 16384, OFF_V = 0, OFF_K = 2 * SHM_V, OFF_WS = 2 * SHM_V + 2 * SHM_K;
constexpr float THR = 8.f;
#define KSWZ(row, colB) ((row) * 256 + ((colB) ^ (((row) & 7) << 4)))
#define SBAR() __builtin_amdgcn_sched_barrier(0)
typedef LAS char* lptr;
__device__ __forceinline__ int crow(int r, int hi) { return (r & 3) + 8 * (r >> 2) + 4 * hi; }
__device__ __forceinline__ unsigned cvtpk(float lo, float hi) { unsigned r; asm volatile("v_cvt_pk_bf16_f32 %0, %1, %2" : "=v"(r) : "v"(lo), "v"(hi)); return r; }
__device__ __forceinline__ void partialSM(f32x16& p0, f32x16& p1, float& m_reg, float& mn, float& alpha, float slope, float base, bool ok, bool diag, int dq) {
    constexpr float C = 1.4426950408889634f;
#pragma unroll
    for (int r = 0; r < 16; ++r) { const int c = (r & 3) + 8 * (r >> 2); if (c) p0[r] = fmaf(slope, (float)c, p0[r]); p1[r] = fmaf(slope, (float)(c + 32), p1[r]); }
    if (diag) {
#pragma unroll
        for (int r = 0; r < 16; ++r) { const int c = (r & 3) + 8 * (r >> 2); if (c > dq) p0[r] = -INFINITY; if (c + 32 > dq) p1[r] = -INFINITY; }
    }
    float pmax = p0[0];
#pragma unroll
    for (int r = 1; r < 16; ++r) pmax = fmaxf(pmax, p0[r]);
#pragma unroll
    for (int r = 0; r < 16; ++r) pmax = fmaxf(pmax, p1[r]);
    const float bm = ok ? base : -INFINITY;
    pmax += bm;
    { auto rr = __builtin_amdgcn_permlane32_swap(__float_as_uint(pmax), __float_as_uint(pmax), false, false);
      pmax = fmaxf(__uint_as_float(rr[0]), __uint_as_float(rr[1])); }
    if (__builtin_expect(__all(pmax - m_reg <= THR), 1)) { mn = m_reg; alpha = 1.f; }
    else { mn = fmaxf(m_reg, pmax); alpha = __builtin_amdgcn_exp2f((m_reg - mn) * C); m_reg = mn; }
    const float add = (bm - mn) * C;
#pragma unroll
    for (int r = 0; r < 16; ++r) p0[r] = fmaf(p0[r], C, add);
#pragma unroll
    for (int r = 0; r < 16; ++r) p1[r] = fmaf(p1[r], C, add);
#pragma unroll
    for (int r = 0; r < 16; ++r) p0[r] = __builtin_amdgcn_exp2f(p0[r]);
}
__device__ __forceinline__ void finishSM(f32x16& p0, f32x16& p1, float alpha, float& l_reg, bf16x8& pa0, bf16x8& pa1, bf16x8& pa2, bf16x8& pa3) {
#pragma unroll
    for (int r = 0; r < 16; ++r) p1[r] = __builtin_amdgcn_exp2f(p1[r]);
    float ps = 0;
#pragma unroll
    for (int r = 0; r < 16; ++r) ps += p0[r];
#pragma unroll
    for (int r = 0; r < 16; ++r) ps += p1[r];
    { auto rr = __builtin_amdgcn_permlane32_swap(__float_as_uint(ps), __float_as_uint(ps), false, false);
      ps = __uint_as_float(rr[0]) + __uint_as_float(rr[1]); }
    l_reg = l_reg * alpha + ps;
#define PK4(P, BASE, OUT) do { unsigned a0 = cvtpk(P[BASE + 0], P[BASE + 1]), a1 = cvtpk(P[BASE + 2], P[BASE + 3]);   \
    unsigned b0 = cvtpk(P[BASE + 4], P[BASE + 5]), b1 = cvtpk(P[BASE + 6], P[BASE + 7]);                              \
    auto r0 = __builtin_amdgcn_permlane32_swap(a0, b0, false, false); auto r1 = __builtin_amdgcn_permlane32_swap(a1, b1, false, false); \
    u32x4 w = {r0[0], r1[0], r0[1], r1[1]}; OUT = *reinterpret_cast<bf16x8*>(&w); } while (0)
    PK4(p0, 0, pa0); PK4(p0, 8, pa1); PK4(p1, 0, pa2); PK4(p1, 8, pa3);
#undef PK4
}
__device__ __forceinline__ void qkt(f32x16& p0, f32x16& p1, lptr Ks, const bf16x8* qr, int r32, int hi) {
    p0 = f32x16{}; p1 = f32x16{};
#pragma unroll
    for (int d0 = 0; d0 < 8; ++d0) { const int cb = (d0 * 16 + hi * 8) * 2;
        const bf16x8 b0 = *(const LAS bf16x8*)(Ks + KSWZ(r32, cb));
        const bf16x8 b1 = *(const LAS bf16x8*)(Ks + KSWZ(32 + r32, cb));
        p0 = __builtin_amdgcn_mfma_f32_32x32x16_bf16(b0, qr[d0], p0, 0, 0, 0);
        p1 = __builtin_amdgcn_mfma_f32_32x32x16_bf16(b1, qr[d0], p1, 0, 0, 0); }
}
__device__ __forceinline__ int v_st(int k, int c) { const int kk = (k & ~0xC) | ((k & 4) << 1) | ((k & 8) >> 1); return ((kk >> 3) * 4 + (c >> 5)) * 512 + ((kk & 7) * 32 + (c & 31)) * 2; }
__device__ __forceinline__ int v_rd_base(int lane) { return ((lane & 3) << 3) | (((lane >> 2) & 3) << 6) | (((lane >> 4) & 1) << 5) | (((lane >> 5) & 1) << 8); }
constexpr int v_rd_off(int d0, int ks, int half) { return d0 * 512 + ks * 4096 + half * 2048; }
template <int OFF> __device__ __forceinline__ s16x4 tr_read(int vb) {
    s16x4 r; asm volatile("ds_read_b64_tr_b16 %0, %1 offset:%2" : "=&v"(r) : "v"(vb), "i"(OFF) : "memory"); return r;
}
template <int D0> __device__ __forceinline__ void pv_one(f32x16& od, int vb, bf16x8 pa0, bf16x8 pa1, bf16x8 pa2, bf16x8 pa3) {
    const s16x4 l0 = tr_read<v_rd_off(D0, 0, 0)>(vb), h0 = tr_read<v_rd_off(D0, 0, 1)>(vb), l1 = tr_read<v_rd_off(D0, 1, 0)>(vb), h1 = tr_read<v_rd_off(D0, 1, 1)>(vb);
    const s16x4 l2 = tr_read<v_rd_off(D0, 2, 0)>(vb), h2 = tr_read<v_rd_off(D0, 2, 1)>(vb), l3 = tr_read<v_rd_off(D0, 3, 0)>(vb), h3 = tr_read<v_rd_off(D0, 3, 1)>(vb);
    asm volatile("s_waitcnt lgkmcnt(0)" ::: "memory"); SBAR();
#define PK(L, H) (bf16x8){L[0], L[1], L[2], L[3], H[0], H[1], H[2], H[3]}
    od = __builtin_amdgcn_mfma_f32_32x32x16_bf16(pa0, PK(l0, h0), od, 0, 0, 0);
    od = __builtin_amdgcn_mfma_f32_32x32x16_bf16(pa1, PK(l1, h1), od, 0, 0, 0);
    od = __builtin_amdgcn_mfma_f32_32x32x16_bf16(pa2, PK(l2, h2), od, 0, 0, 0);
    od = __builtin_amdgcn_mfma_f32_32x32x16_bf16(pa3, PK(l3, h3), od, 0, 0, 0);
#undef PK
}
__device__ __forceinline__ void pv_d0(f32x16* o, int vb, bf16x8 pa0, bf16x8 pa1, bf16x8 pa2, bf16x8 pa3) {
    pv_one<0>(o[0], vb, pa0, pa1, pa2, pa3); pv_one<1>(o[1], vb, pa0, pa1, pa2, pa3); pv_one<2>(o[2], vb, pa0, pa1, pa2, pa3); pv_one<3>(o[3], vb, pa0, pa1, pa2, pa3);
}

__device__ __forceinline__ void unit(bf16_t* P, const float* kmean, int b, int h, int qb, lptr lds, unsigned ldsaddr) {
    int tid_ = threadIdx.x; asm volatile("" : "+v"(tid_));
    const int tid = tid_, wid = __builtin_amdgcn_readfirstlane(tid >> 6), lane = tid & 63, r32 = lane & 31, hi = lane >> 5;
    lptr V_lds = lds + OFF_V; lptr K_lds = lds + OFF_K;
    LAS float* wsl = (LAS float*)(lds + OFF_WS) + wid * 64; LAS float* li_l = wsl; LAS float* al_l = wsl + 32;
    const int q0 = qb * 256, tpos = q0 + wid * 32 + r32;
    const bf16_t* Qw = P + (size_t)(b * SEQ + tpos) * PP + h * 128 + hi * 8;
    const bf16_t* Kh = P + (size_t)(b * SEQ) * PP + 1024 + h * 128;
    const bf16_t* Vh = P + (size_t)(b * SEQ) * PP + 2048 + h * 128;
    float m_reg = -1e30f, l_reg = 0; f32x16 o[4] = {}; bf16x8 qr[8];
#pragma unroll
    for (int d0 = 0; d0 < 8; ++d0) qr[d0] = *(const bf16x8*)(Qw + d0 * 16);
    const float slope = exp2f(-(float)(h + 1));
    unsigned selmask = 0u;
    {
        float v0 = -INFINITY, v1 = -INFINITY, v2 = -INFINITY; int i0 = -1, i1 = -1, i2 = -1;
        for (int n = 0; n < qb; ++n) {
            const float* km = kmean + ((size_t)((b * 8 + h) * 16 + n)) * 256 + hi * 8;
            float s = 0.f;
#pragma unroll
            for (int d0 = 0; d0 < 8; ++d0) { const f32x4 ka = *(const f32x4*)(km + d0 * 16) + *(const f32x4*)(km + 128 + d0 * 16), kb = *(const f32x4*)(km + d0 * 16 + 4) + *(const f32x4*)(km + 128 + d0 * 16 + 4);
                const bf16x8 q = qr[d0];
                s += bf2f((bf16_t)q[0]) * ka[0]; s += bf2f((bf16_t)q[1]) * ka[1]; s += bf2f((bf16_t)q[2]) * ka[2]; s += bf2f((bf16_t)q[3]) * ka[3];
                s += bf2f((bf16_t)q[4]) * kb[0]; s += bf2f((bf16_t)q[5]) * kb[1]; s += bf2f((bf16_t)q[6]) * kb[2]; s += bf2f((bf16_t)q[7]) * kb[3]; }
            s += __shfl_xor(s, 32);
            if (s > v0) { v2 = v1; i2 = i1; v1 = v0; i1 = i0; v0 = s; i0 = n; }
            else if (s > v1) { v2 = v1; i2 = i1; v1 = s; i1 = n; }
            else if (s > v2) { v2 = s; i2 = n; }
        }
        if (i0 >= 0) selmask |= 1u << i0; if (i1 >= 0) selmask |= 1u << i1; if (i2 >= 0) selmask |= 1u << i2;
    }
    const int sr = tid >> 4, sc = (tid & 15) * 8, vst0 = v_st(sr, sc), vst1 = v_st(32 + sr, sc);
    const int vb0 = (int)ldsaddr + OFF_V + v_rd_base(lane);
    struct { bf16x8 vs0, vs1, ks0, ks1; } sr_[2];
#define SLOAD(i, k0) do { sr_[i].vs0 = *(const bf16x8*)(&Vh[(size_t)((k0) + sr) * PP + sc]); sr_[i].vs1 = *(const bf16x8*)(&Vh[(size_t)((k0) + 32 + sr) * PP + sc]); \
    sr_[i].ks0 = *(const bf16x8*)(&Kh[(size_t)((k0) + sr) * PP + sc]); sr_[i].ks1 = *(const bf16x8*)(&Kh[(size_t)((k0) + 32 + sr) * PP + sc]); } while (0)
#define SWRITE(bb, i) do { *(LAS bf16x8*)(V_lds + (bb) * SHM_V + vst0) = sr_[i].vs0;          \
    *(LAS bf16x8*)(V_lds + (bb) * SHM_V + vst1) = sr_[i].vs1; const int kc = sc * 2;               \
    *(LAS bf16x8*)(K_lds + (bb) * SHM_K + KSWZ(sr, kc)) = sr_[i].ks0;                       \
    *(LAS bf16x8*)(K_lds + (bb) * SHM_K + KSWZ(32 + sr, kc)) = sr_[i].ks1; } while (0)
#define SWAIT() asm volatile("s_waitcnt vmcnt(4)" ::: "memory")
#define RESC(a) do { if (__any((a) < 1.f)) { if (hi == 0) al_l[r32] = (a); asm volatile("s_waitcnt lgkmcnt(0)" ::: "memory"); \
    _Pragma("unroll") for (int d = 0; d < 4; ++d) _Pragma("unroll") for (int r = 0; r < 16; ++r) o[d][r] *= al_l[crow(r, hi)]; } } while (0)
#define PSM(P0, P1, MN, AL, jj) do { const int j_ = (jj), n_ = j_ >> 2, k0_ = j_ * 64; const bool isd_ = n_ == qb; \
    const bool ok_ = isd_ || ((selmask >> n_) & 1u); const float base_ = slope * (float)(k0_ + 4 * hi - tpos); \
    const bool nm_ = isd_ && (k0_ + 63 > q0 + wid * 32); \
    partialSM(P0, P1, m_reg, MN, AL, slope, base_, ok_, nm_, tpos - k0_ - 4 * hi); } while (0)
    f32x16 pA0, pA1, pB0, pB1; float mnA, mnB, alA, alB; bf16x8 pa0, pa1, pa2, pa3; const int NT = 4 * (qb + 1);
    constexpr int SE = 0, SO = 1;
    SLOAD(SE, 0); asm volatile("s_waitcnt vmcnt(0)" ::: "memory"); SWRITE(0, SE); __syncthreads();
    qkt(pA0, pA1, K_lds, qr, r32, hi); PSM(pA0, pA1, mnA, alA, 0);
    SLOAD(SO, 64); if (2 < NT) SLOAD(SE, 128);
    SWAIT(); SWRITE(1, SO); __syncthreads();
    for (int j = 1; j + 1 < NT; j += 2) {
        SBAR(); qkt(pB0, pB1, K_lds + SHM_K, qr, r32, hi);
        finishSM(pA0, pA1, alA, l_reg, pa0, pa1, pa2, pa3); SBAR();
        SLOAD(SO, (j + 2) * 64); SBAR();
        pv_d0(o, vb0, pa0, pa1, pa2, pa3); PSM(pB0, pB1, mnB, alB, j);
        __syncthreads(); SWAIT(); SWRITE(0, SE);
        RESC(alB); __syncthreads();
        SBAR(); qkt(pA0, pA1, K_lds, qr, r32, hi);
        finishSM(pB0, pB1, alB, l_reg, pa0, pa1, pa2, pa3); SBAR();
        if (j + 3 < NT) SLOAD(SE, (j + 3) * 64); SBAR();
        pv_d0(o, vb0 + SHM_V, pa0, pa1, pa2, pa3); PSM(pA0, pA1, mnA, alA, j + 1);
        __syncthreads(); SWAIT(); SWRITE(1, SO);
        RESC(alA); __syncthreads();
    }
    SBAR(); qkt(pB0, pB1, K_lds + SHM_K, qr, r32, hi);
    finishSM(pA0, pA1, alA, l_reg, pa0, pa1, pa2, pa3); SBAR();
    pv_d0(o, vb0, pa0, pa1, pa2, pa3); PSM(pB0, pB1, mnB, alB, NT - 1);
    __syncthreads(); RESC(alB);
    finishSM(pB0, pB1, alB, l_reg, pa0, pa1, pa2, pa3); SBAR();
    pv_d0(o, vb0 + SHM_V, pa0, pa1, pa2, pa3);
    if (hi == 0) li_l[r32] = l_reg; asm volatile("s_waitcnt lgkmcnt(0)" ::: "memory");
    float rli[16];
#pragma unroll
    for (int r = 0; r < 16; ++r) rli[r] = __builtin_amdgcn_rcpf(li_l[crow(r, hi)]);
    bf16_t* Ow = P + (size_t)(b * SEQ + q0 + wid * 32) * PP + h * 128;
#pragma unroll
    for (int r = 0; r < 16; ++r) { const int orow = crow(r, hi);
#pragma unroll
        for (int d0 = 0; d0 < 4; ++d0) Ow[(size_t)orow * PP + d0 * 32 + r32] = (bf16_t)f2bf(o[d0][r] * rli[r]); }
    __syncthreads();
#undef SLOAD
#undef SWRITE
#undef SWAIT
#undef RESC
#undef PSM
}
}
__device__ __forceinline__ void phase_attn(Frame& F, bf16_t* P, const float* kmean) {
    for (int pi = F.bid; pi < 256; pi += F.G) {
        const int xcd = pi & 7, slot = pi >> 3, bh = xcd * 4 + (slot >> 3), p = slot & 7;
        att::unit(P, kmean, bh >> 3, bh & 7, 15 - p, (att::lptr)F.lds, (unsigned)(uintptr_t)F.ldsg);
        att::unit(P, kmean, bh >> 3, bh & 7, p, (att::lptr)F.lds, (unsigned)(uintptr_t)F.ldsg);
    }
}


namespace scn {
using att::bf16x8; using att::f32x16; using att::lptr; using att::s16x4;
constexpr int HSLOT = 32768, O_VI = 0, O_BK = 16384, O_AQ = 24576;
constexpr int X_WS = RING_BYTES + 1024, X_SMALL = RING_BYTES + 4096;
__device__ __forceinline__ int swz(int row, int chunk) { return row * 128 + ((chunk ^ ((row >> 1) & 7)) << 4); }

__device__ __forceinline__ void stage_small(const ScanArgs& a, int row0, lptr lds, int tid) {
    *(LAS f32x4*)(lds + X_SMALL + tid * 16) = *(const f32x4*)(a.small + (size_t)row0 * SMALLP + tid * 4);
}
__device__ __forceinline__ void stage_v(const ScanArgs& a, int row0, int grp, int h, lptr slot, int ht) {
    const bf16_t* Vg = a.P + (size_t)row0 * PP + (grp == 0 ? C_GV : C_MV) + h * 128;
    bf16x8 v[8];
#pragma unroll
    for (int i = 0; i < 8; ++i) { const int idx = ht + 128 * i, srow = idx >> 4, sc = (idx & 15) * 8; v[i] = *(const bf16x8*)(Vg + (size_t)srow * PP + sc); }
#pragma unroll
    for (int i = 0; i < 8; ++i) { const int idx = ht + 128 * i, srow = idx >> 4, sc = (idx & 15) * 8; *(LAS bf16x8*)(slot + O_VI + att::v_st(srow, sc)) = v[i]; }
}
template <int MODE>
__device__ __forceinline__ void gate_step(const ScanArgs& a, int b, int c, int grp, int h, int half, lptr lds, lptr slot, int lane, float& bc_end, float& nsum) {
    const int k = lane, row0 = b * SEQ + c * CH, t0 = 32 * half;
    LAS const float* sml = (LAS const float*)(lds + X_SMALL);
    float bc = 0.f; nsum = 0.f;
    unsigned rq[32], rk[32];
    if (grp == 0) {
        float w2r[16];
#pragma unroll
        for (int r = 0; r < 16; ++r) w2r[r] = a.w2[r * 256 + h * 64 + k];
        const float bg = a.bgate[h * 64 + k];
#pragma unroll
        for (int i = 0; i < 32; ++i) { const bf16_t* pr = a.P + (size_t)(row0 + t0 + i) * PP; rk[i] = pr[C_GK + h * 64 + k]; if (MODE == 3) rq[i] = pr[C_GQ + h * 64 + k]; }
        if (half == 1) {
#pragma unroll 4
            for (int t = 0; t < 32; ++t) { float z = bg;
#pragma unroll
                for (int r4 = 0; r4 < 4; ++r4) { const f32x4 g = *(LAS const f32x4*)(sml + t * 32 + r4 * 4); z += g[0] * w2r[r4 * 4] + g[1] * w2r[r4 * 4 + 1] + g[2] * w2r[r4 * 4 + 2] + g[3] * w2r[r4 * 4 + 3]; }
                bc += logsigmoidf_(z) * (1.f / 16.f); }
        }
#pragma unroll
        for (int i8 = 0; i8 < 4; ++i8) {
            unsigned pk[8];
#pragma unroll
            for (int e = 0; e < 8; ++e) { if ((e & 1) == 0) asm volatile("" ::: "memory"); const int i = i8 * 8 + e, t = t0 + i; float z = bg;
#pragma unroll
                for (int r4 = 0; r4 < 4; ++r4) { const f32x4 g = *(LAS const f32x4*)(sml + t * 32 + r4 * 4); z += g[0] * w2r[r4 * 4] + g[1] * w2r[r4 * 4 + 1] + g[2] * w2r[r4 * 4 + 2] + g[3] * w2r[r4 * 4 + 3]; }
                bc += logsigmoidf_(z) * (1.f / 16.f);
                const float bv = __uint_as_float(rk[i] << 16) * __expf(-bc); nsum += bv; pk[e] = f2bf(bv);
                if (MODE == 3) { const float av = __uint_as_float(rq[i] << 16) * 0.125f * __expf(bc);
                    *(LAS bf16_t*)(slot + O_BK + swz(t, k >> 3) + (k & 7) * 2) = (bf16_t)pk[e];
                    *(LAS bf16_t*)(slot + O_AQ + swz(t, k >> 3) + (k & 7) * 2) = (bf16_t)f2bf(av); } }
            if (MODE == 1) { u32x4 w; w.x = pk[0] | (pk[1] << 16); w.y = pk[2] | (pk[3] << 16); w.z = pk[4] | (pk[5] << 16); w.w = pk[6] | (pk[7] << 16);
                *(LAS u32x4*)(slot + O_BK + swz(k, (t0 >> 3) + i8)) = w; }
        }
    } else {
        const float bi = a.bif[h], bf = a.bif[4 + h];
        const float wk0 = a.convw[0 * 512 + 256 + h * 64 + k], wk1 = a.convw[1 * 512 + 256 + h * 64 + k], wk2 = a.convw[2 * 512 + 256 + h * 64 + k], wk3 = a.convw[3 * 512 + 256 + h * 64 + k];
        float wq0 = 0.f, wq1 = 0.f, wq2 = 0.f, wq3 = 0.f;
        if (MODE == 3) { wq0 = a.convw[0 * 512 + h * 64 + k]; wq1 = a.convw[1 * 512 + h * 64 + k]; wq2 = a.convw[2 * 512 + h * 64 + k]; wq3 = a.convw[3 * 512 + h * 64 + k]; }
#pragma unroll
        for (int i = 0; i < 32; ++i) { const bf16_t* pr = a.P + (size_t)(row0 + t0 + i) * PP; rk[i] = pr[C_MK + h * 64 + k]; if (MODE == 3) rq[i] = pr[C_MQ + h * 64 + k]; }
        float k1 = 0.f, k2 = 0.f, k3 = 0.f, q1 = 0.f, q2 = 0.f, q3 = 0.f;
        if (c * CH + t0 > 0) {
            const bf16_t* p1 = a.P + (size_t)(row0 + t0 - 1) * PP; const bf16_t* p2 = p1 - PP; const bf16_t* p3 = p2 - PP;
            k1 = bf2f(p1[C_MK + h * 64 + k]); k2 = bf2f(p2[C_MK + h * 64 + k]); k3 = bf2f(p3[C_MK + h * 64 + k]);
            if (MODE == 3) { q1 = bf2f(p1[C_MQ + h * 64 + k]); q2 = bf2f(p2[C_MQ + h * 64 + k]); q3 = bf2f(p3[C_MQ + h * 64 + k]); }
        }
        if (half == 1) {
#pragma unroll 4
            for (int t = 0; t < 32; ++t) bc += logsigmoidf_(sml[t * 32 + 20 + h] + bf);
        }
#pragma unroll
        for (int i8 = 0; i8 < 4; ++i8) {
            unsigned pk[8];
#pragma unroll
            for (int e = 0; e < 8; ++e) { if ((e & 3) == 0) asm volatile("" ::: "memory"); const int i = i8 * 8 + e, t = t0 + i;
                bc += logsigmoidf_(sml[t * 32 + 20 + h] + bf);
                const float ip = sml[t * 32 + 16 + h] + bi;
                const float kc = __uint_as_float(rk[i] << 16);
                const float ck = wk0 * k3 + wk1 * k2 + wk2 * k1 + wk3 * kc; k3 = k2; k2 = k1; k1 = kc;
                const float bv = siluf_(ck) * 0.125f * __expf(ip - bc); nsum += bv; pk[e] = f2bf(bv);
                if (MODE == 3) { const float qc = __uint_as_float(rq[i] << 16);
                    const float cq = wq0 * q3 + wq1 * q2 + wq2 * q1 + wq3 * qc; q3 = q2; q2 = q1; q1 = qc;
                    const float av = siluf_(cq) * __expf(bc);
                    *(LAS bf16_t*)(slot + O_BK + swz(t, k >> 3) + (k & 7) * 2) = (bf16_t)pk[e];
                    *(LAS bf16_t*)(slot + O_AQ + swz(t, k >> 3) + (k & 7) * 2) = (bf16_t)f2bf(av); } }
            if (MODE == 1) { u32x4 w; w.x = pk[0] | (pk[1] << 16); w.y = pk[2] | (pk[3] << 16); w.z = pk[4] | (pk[5] << 16); w.w = pk[6] | (pk[7] << 16);
                *(LAS u32x4*)(slot + O_BK + swz(k, (t0 >> 3) + i8)) = w; }
        }
    }
    bc_end = bc;
}
}

__device__ __forceinline__ void phase_scan1m(Frame& F, const ScanArgs& a) {
    using namespace scn;
    const int wid = __builtin_amdgcn_readfirstlane(threadIdx.x >> 6);
    const int hw = wid >> 1, half = wid & 1;
    lptr lds = (lptr)F.lds; lptr slot = lds + hw * HSLOT;
    LAS float* wsl = (LAS float*)(lds + X_WS) + wid * 64;
    const unsigned ldsaddr = (unsigned)(uintptr_t)F.ldsg;
    for (int unit = F.bid; unit < BATCH * NCH; unit += F.G) {
        const int b = unit / NCH, c = unit % NCH, row0 = b * SEQ + c * CH;
        stage_small(a, row0, lds, opaque_i(threadIdx.x));
        for (int grp = 0; grp < 2; ++grp) {
            const int tid = opaque_i(threadIdx.x), lane = tid & 63, r32 = lane & 31, hi = lane >> 5;
            const int h = hw, bh = b * 4 + h;
            stage_v(a, row0, grp, h, slot, tid & 127);
            __syncthreads();
            float bc_end, nsum;
            gate_step<1>(a, b, c, grp, h, half, lds, slot, lane, bc_end, nsum);
            if (half == 1) a.dec[((size_t)(grp * 16 + bh) * NCH + c) * 64 + lane] = __expf(bc_end);
            if (grp == 1) wsl[lane] = nsum;
            __syncthreads();
            if (grp == 1 && half == 0) { LAS float* other = (LAS float*)(lds + X_WS) + (wid + 1) * 64; a.NS[((size_t)bh * NCH + c) * 64 + lane] = wsl[lane] + other[lane]; }
            bf16x8 pa[4];
#pragma unroll
            for (int ks = 0; ks < 4; ++ks) pa[ks] = *(LAS bf16x8*)(slot + O_BK + swz(32 * half + r32, 2 * ks + hi));
            f32x16 o[4] = {};
            att::pv_d0(o, (int)ldsaddr + hw * HSLOT + O_VI + att::v_rd_base(lane), pa[0], pa[1], pa[2], pa[3]);
            bf16_t* st = a.ST + st_off(grp, bh, c);
#pragma unroll
            for (int d0 = 0; d0 < 4; ++d0)
#pragma unroll
                for (int g = 0; g < 4; ++g) {
                    const unsigned long long w = (unsigned long long)pk2(o[d0][4 * g], o[d0][4 * g + 1]) | ((unsigned long long)pk2(o[d0][4 * g + 2], o[d0][4 * g + 3]) << 32);
                    *(unsigned long long*)(st + (size_t)(32 * d0 + r32) * 64 + 32 * half + 8 * g + 4 * hi) = w; }
            __syncthreads();
        }
    }
}
__device__ __forceinline__ void phase_scan3m(Frame& F, const ScanArgs& a) {
    using namespace scn;
    const int wid = __builtin_amdgcn_readfirstlane(threadIdx.x >> 6);
    const int hw = wid >> 1, half = wid & 1;
    lptr lds = (lptr)F.lds; lptr slot = lds + hw * HSLOT;
    LAS float* wsl = (LAS float*)(lds + X_WS) + wid * 64;
    const unsigned ldsaddr = (unsigned)(uintptr_t)F.ldsg;
    for (int unit = F.bid; unit < BATCH * NCH; unit += F.G) {
        const int b = unit / NCH, c = unit % NCH, row0 = b * SEQ + c * CH;
        stage_small(a, row0, lds, opaque_i(threadIdx.x));
        for (int grp = 0; grp < 2; ++grp) {
            const int tid = opaque_i(threadIdx.x), lane = tid & 63, r32 = lane & 31, hi = lane >> 5;
            const int h = hw, bh = b * 4 + h;
            stage_v(a, row0, grp, h, slot, tid & 127);
            __syncthreads();
            float bc_end, nsum;
            gate_step<3>(a, b, c, grp, h, half, lds, slot, lane, bc_end, nsum);
            __syncthreads();
            bf16x8 qr[4];
#pragma unroll
            for (int d0 = 0; d0 < 4; ++d0) qr[d0] = *(LAS bf16x8*)(slot + O_AQ + swz(32 * half + r32, 2 * d0 + hi));
            f32x16 p0 = {}, p1 = {};
#pragma unroll
            for (int d0 = 0; d0 < 4; ++d0) {
                const bf16x8 b0 = *(LAS bf16x8*)(slot + O_BK + swz(r32, 2 * d0 + hi));
                const bf16x8 b1 = *(LAS bf16x8*)(slot + O_BK + swz(32 + r32, 2 * d0 + hi));
                p0 = __builtin_amdgcn_mfma_f32_32x32x16_bf16(b0, qr[d0], p0, 0, 0, 0);
                p1 = __builtin_amdgcn_mfma_f32_32x32x16_bf16(b1, qr[d0], p1, 0, 0, 0); }
            const int dq = 32 * half + r32 - 4 * hi;
            float ps = 0.f;
#pragma unroll
            for (int r = 0; r < 16; ++r) { const int cc = (r & 3) + 8 * (r >> 2); if (cc > dq) p0[r] = 0.f; if (cc + 32 > dq) p1[r] = 0.f; ps += p0[r] + p1[r]; }
            bf16x8 pa0, pa1, pa2, pa3;
#define PK4(P, BASE, OUT) do { unsigned a0 = att::cvtpk(P[BASE + 0], P[BASE + 1]), a1 = att::cvtpk(P[BASE + 2], P[BASE + 3]);   \
    unsigned b0_ = att::cvtpk(P[BASE + 4], P[BASE + 5]), b1_ = att::cvtpk(P[BASE + 6], P[BASE + 7]);                              \
    auto r0 = __builtin_amdgcn_permlane32_swap(a0, b0_, false, false); auto r1 = __builtin_amdgcn_permlane32_swap(a1, b1_, false, false); \
    u32x4 w = {r0[0], r1[0], r0[1], r1[1]}; OUT = *reinterpret_cast<bf16x8*>(&w); } while (0)
            PK4(p0, 0, pa0); PK4(p0, 8, pa1); PK4(p1, 0, pa2); PK4(p1, 8, pa3);
#undef PK4
            float den = 0.f;
            if (grp == 1) {
                const float* ns = a.NS + ((size_t)bh * NCH + c) * 64 + hi * 8;
#pragma unroll
                for (int d0 = 0; d0 < 4; ++d0) { const f32x4 na = *(const f32x4*)(ns + d0 * 16), nb = *(const f32x4*)(ns + d0 * 16 + 4); const bf16x8 q = qr[d0];
                    ps += bf2f((bf16_t)q[0]) * na[0] + bf2f((bf16_t)q[1]) * na[1] + bf2f((bf16_t)q[2]) * na[2] + bf2f((bf16_t)q[3]) * na[3]
                        + bf2f((bf16_t)q[4]) * nb[0] + bf2f((bf16_t)q[5]) * nb[1] + bf2f((bf16_t)q[6]) * nb[2] + bf2f((bf16_t)q[7]) * nb[3]; }
                den = ps + __shfl_xor(ps, 32);
            }
            f32x16 o[4] = {};
            att::pv_d0(o, (int)ldsaddr + hw * HSLOT + O_VI + att::v_rd_base(lane), pa0, pa1, pa2, pa3);
            const bf16_t* st = a.ST + st_off(grp, bh, c);
#pragma unroll
            for (int d0 = 0; d0 < 4; ++d0) {
                bf16x8 sv[4];
#pragma unroll
                for (int ks = 0; ks < 4; ++ks) sv[ks] = *(const bf16x8*)(st + (size_t)(32 * d0 + r32) * 64 + 16 * ks + 8 * hi);
#pragma unroll
                for (int ks = 0; ks < 4; ++ks) o[d0] = __builtin_amdgcn_mfma_f32_32x32x16_bf16(qr[ks], sv[ks], o[d0], 0, 0, 0);
            }
            if (grp == 1) { if (hi == 0) wsl[r32] = den; asm volatile("s_waitcnt lgkmcnt(0)" ::: "memory"); }
            const int gcol = (grp == 0 ? C_GR : C_MO) + h * 128;
            const float* gain = (grp == 0 ? a.gla_gain : a.ml_gain) + h * 128;
            float gn[4];
#pragma unroll
            for (int d0 = 0; d0 < 4; ++d0) gn[d0] = gain[32 * d0 + r32];
#pragma unroll
            for (int r = 0; r < 16; ++r) {
                const int t = 32 * half + att::crow(r, hi);
                bf16_t* pr = a.P + (size_t)(row0 + t) * PP + gcol + r32;
                float ov[4], gv[4];
#pragma unroll
                for (int d0 = 0; d0 < 4; ++d0) { ov[d0] = o[d0][r]; gv[d0] = bf2f(pr[32 * d0]); }
                if (grp == 1) { const float dd = 1.f / fmaxf(fabsf(wsl[att::crow(r, hi)]), 1.f);
#pragma unroll
                    for (int d0 = 0; d0 < 4; ++d0) ov[d0] = ov[d0] * dd * sigmoidf_(gv[d0]); }
                float ss = (ov[0] * ov[0] + ov[1] * ov[1]) + (ov[2] * ov[2] + ov[3] * ov[3]);
                ss += __shfl_xor(ss, 1); ss += __shfl_xor(ss, 2); ss += __shfl_xor(ss, 4); ss += __shfl_xor(ss, 8); ss += __shfl_xor(ss, 16);
                const float rstd = rsqrtf(ss * (1.f / 128.f) + EPS);
#pragma unroll
                for (int d0 = 0; d0 < 4; ++d0) { float y = ov[d0] * rstd * gn[d0]; if (grp == 0) y *= siluf_(gv[d0]); pr[32 * d0] = (bf16_t)f2bf(y); }
            }
            __syncthreads();
        }
    }
}

__global__ void __launch_bounds__(NTHR, 2) mk_fwd(Args args) {
    extern __shared__ __attribute__((aligned(16))) unsigned char lds[];
    Frame F;
    F.lds = (LAS unsigned char*)lds; F.ldsg = lds;
    F.tid = threadIdx.x; F.lane = F.tid & 63; F.wave = __builtin_amdgcn_readfirstlane(F.tid >> 6);
    F.G = gridDim.x; F.bid = blockIdx.x;
    volatile LAS unsigned* MISC = (volatile LAS unsigned*)(F.lds + MISC_OFF);
    for (int u = F.tid; u < (LDS_BYTES - RING_BYTES) / 4; u += NTHR) ((LAS unsigned*)(F.lds + RING_BYTES))[u] = 0u;
    __syncthreads();
    kargp_t kp0 = karg_base();
    unsigned char* ws = karg_ws(kp0);
    XcdBarrier bar; bar.bar = (unsigned*)(ws + WS_CTL) + 4096; bar.x = 0; bar.st = nullptr;
    if (!MK_MULTI) bar = xcd_barrier_post((unsigned*)(ws + WS_CTL) + 4096, MISC + 8);
    const int lo = args.ph_lo, hi = args.ph_hi;
#define IN(k) (lo <= (k) && (k) < hi)
#define SEAM(k) do { if (!MK_MULTI && (k) + 1 < hi) xcd_barrier(bar); } while (0)

    float* rss = (float*)(ws + WS_RSS); float* small = (float*)(ws + WS_SMALL); float* kmean = (float*)(ws + WS_KMEAN);
    bf16_t* xb = (bf16_t*)(ws + WS_XB); bf16_t* P = (bf16_t*)(ws + WS_P);
    float* out = karg_out(kp0);

    if (IN(0)) { if (PH_MASK & 1) phase_prologue(F); SEAM(0); }

    for (int l = 0; l < DEPTH; ++l) {
        const int j = l >> 1, base = 1 + l * 8;
        unsigned char* wj = ws + WS_W + j * W_MIXSZ;
        unsigned char* wl = ws + WS_W + W_FFN0 + l * W_FFNSZ;
        kargp_t kp = karg_base();
        const float* xin = l == 0 ? karg_in(kp, 0) : out;
        if ((l & 1) == 0) {
            ScanArgs sa{P, small, karg_in(kp, 4) + (size_t)j * 16 * 256, karg_in(kp, 5) + j * 256, karg_in(kp, 6) + j * 512, karg_in(kp, 7) + (size_t)j * 4 * 512, karg_in(kp, 8) + j * 8, karg_in(kp, 9) + j * 512,
                        (bf16_t*)(ws + WS_XB), (float*)(ws + WS_DEC), (float*)(ws + WS_NS)};
            if (IN(base + 0)) {
                pg8::Gemm g{xb, (const bf16_t*)(wj + W_IN), M, HYB_PAD, DM, DM}; pg8::StaticOrder S; S.init(M, HYB_PAD, F.G, F.bid);
                EpiRowBf16 E{P, PP, rss, small, 12};
                if (PH_MASK & 64) pg8::gemm_phase<EpiRowBf16, pg8::StaticOrder, true, true>(F.lds, g, S, E);
                SEAM(base + 0);
            }
            if (IN(base + 1)) { if (PH_MASK & 2) { if (SCAN_SIMPLE) phase_scan1(F, sa); else phase_scan1m(F, sa); } SEAM(base + 1); }
            if (IN(base + 2)) { if (PH_MASK & 4) phase_scan2(F, sa); SEAM(base + 2); }
            if (IN(base + 3)) { if (PH_MASK & 8) { if (SCAN_SIMPLE) phase_scan3(F, sa); else phase_scan3m(F, sa); } SEAM(base + 3); }
            if (IN(base + 4)) {
                pg8::Gemm g{P + C_GR, (const bf16_t*)(wj + W_OUT), M, DM, DM, PP}; pg8::StaticOrder S; S.init(M, DM, F.G, F.bid);
                EpiRes E{xin, out, xb, rss};
                if (PH_MASK & 128) pg8::gemm_phase<EpiRes, pg8::StaticOrder, true, true>(F.lds, g, S, E);
                SEAM(base + 4);
            }
        } else {
            if (IN(base + 0)) {
                pg8::Gemm g{xb, (const bf16_t*)(wj + W_QKV), M, 3 * DM, DM, DM}; pg8::StaticOrder S; S.init(M, 3 * DM, F.G, F.bid);
                EpiRowBf16 E{P, PP, rss, small, -1};
                if (PH_MASK & 256) pg8::gemm_phase<EpiRowBf16, pg8::StaticOrder, true, true>(F.lds, g, S, E);
                SEAM(base + 0);
            }
            if (IN(base + 1)) { if (PH_MASK & 16) phase_qkn2(F, P, karg_in(kp, 12) + j * 128, karg_in(kp, 13) + j * 128, kmean); SEAM(base + 1); }
            if (IN(base + 2)) { if (PH_MASK & 32) { if (ATTN_SIMPLE) phase_attn_simple(F, P, kmean); else phase_attn(F, P, kmean); } SEAM(base + 2); }
            if (IN(base + 3)) {
                pg8::Gemm g{P, (const bf16_t*)(wj + W_O), M, DM, DM, PP}; pg8::StaticOrder S; S.init(M, DM, F.G, F.bid);
                EpiRes E{xin, out, xb, rss};
                if (PH_MASK & 512) pg8::gemm_phase<EpiRes, pg8::StaticOrder, true, true>(F.lds, g, S, E);
                SEAM(base + 3);
            }
        }
        if (IN(base + 5)) {
            pg8::Gemm g{xb, (const bf16_t*)(wl + W_GU), M, 2 * DFF, DM, DM}; pg8::StaticOrder S; S.init(M, 2 * DFF, F.G, F.bid);
            EpiFfn E{P, rss};
            if (PH_MASK & 1024) pg8::gemm_phase<EpiFfn, pg8::StaticOrder, true, true>(F.lds, g, S, E);
            SEAM(base + 5);
        }
        if (IN(base + 6)) {
            pg8::Gemm g{P, (const bf16_t*)(wl + W_D), M, DM, DFF, DFF}; pg8::StaticOrder S; S.init(M, DM, F.G, F.bid);
            EpiRes E{out, out, xb, rss};
            if (PH_MASK & 2048) pg8::gemm_phase<EpiRes, pg8::StaticOrder, true, true>(F.lds, g, S, E);
            SEAM(base + 6);
        }
    }
#undef IN
#undef SEAM
}

extern "C" void kernel_launch(void* const* d_in, const int* in_sizes, int n_in, void* d_out, int out_size, void* d_ws, size_t ws_size, hipStream_t stream) {
    static int grid = 0;
    if (grid == 0) {
        int dev = 0, cus = 0;
        if (n_in != 18 || ws_size < WS_END) { fprintf(stderr, "kernel_launch: unexpected inputs (%d) or workspace (%zu < %zu)\n", n_in, ws_size, (size_t)WS_END); grid = -1; return; }
        if (hipGetDevice(&dev) != hipSuccess || hipDeviceGetAttribute(&cus, hipDeviceAttributeMultiprocessorCount, dev) != hipSuccess) { grid = -1; return; }
        if (hipFuncSetAttribute((const void*)mk_fwd, hipFuncAttributeMaxDynamicSharedMemorySize, LDS_BYTES) != hipSuccess) { grid = -1; return; }
        int per_cu = 0;
        if (hipOccupancyMaxActiveBlocksPerMultiprocessor(&per_cu, (const void*)mk_fwd, NTHR, LDS_BYTES) != hipSuccess || per_cu < 1) { fprintf(stderr, "kernel_launch: occupancy query says %d\n", per_cu); }
        (void)hipGetLastError();
        grid = cus;
    }
    if (grid < 0) return;
    (void)hipMemsetAsync((char*)d_ws + WS_CTL, 0, CTL_ZERO_BYTES, stream);
    Args a{};
    for (int i = 0; i < 18; ++i) a.in[i] = (const float*)d_in[i];
    a.out = (float*)d_out; a.ws = (unsigned char*)d_ws;
#if MK_MULTI
    for (int ph = 0; ph < 1 + DEPTH * 8; ++ph) {
        if (ph > 0) { const int l = (ph - 1) >> 3, s = (ph - 1) & 7; if (s == 7) continue; if ((l & 1) == 0 && s == 7) continue; if ((l & 1) == 1 && s == 4) continue; }
        a.ph_lo = ph; a.ph_hi = ph + 1;
        hipLaunchKernelGGL(mk_fwd, dim3(grid), dim3(NTHR), LDS_BYTES, stream, a);
    }
#else
    a.ph_lo = 0; a.ph_hi = DEPTH * 8;
    hipLaunchKernelGGL(mk_fwd, dim3(grid), dim3(NTHR), LDS_BYTES, stream, a);
#endif
}
```

```cpp
#include <hip/hip_runtime.h>
#include <cstdio>
#include <cstdint>

namespace pg8 {
#define PG8_LAS __attribute__((address_space(3)))
typedef unsigned short bf16_t;
typedef short bf16x8 __attribute__((ext_vector_type(8)));
typedef float f32x4 __attribute__((ext_vector_type(4)));
typedef unsigned u32x4 __attribute__((ext_vector_type(4)));
constexpr int BM = 256, BK = 64, HALF = 128, HTB = HALF * BK * 2  , STAGE_BYTES = 8 * HTB, NXCD = 8, WGM = 8;

__host__ __device__ __forceinline__ int lds_byte(int r, int c) { const int st = (r >> 4) * 2 + (c >> 5), rr = r & 15, cc = c & 31, ob = rr * 64 + cc * 2; return st * 1024 + (ob ^ (((ob >> 9) & 1) << 5)); }
__host__ __device__ __forceinline__ void stage_rc(int b, int& R, int& C) { const int st = b / 1024, sb = b % 1024, swz = sb ^ (((sb >> 9) & 1) << 5); R = (st >> 1) * 16 + swz / 64; C = (st & 1) * 32 + (swz % 64) / 2; }
__host__ __device__ __forceinline__ int perm32(int rho) { const int n = rho >> 4, i = rho & 15; return 8 * (i >> 2) + 4 * n + (i & 3); }

struct Unit { int pm, pn; };
struct Gemm { const bf16_t* A; const bf16_t* Bt; int M, N, K, lda; };

struct StaticOrder {
    int nM, nN, nwg, G, c;
    __host__ __device__ void init(int M, int N, int G_, int c_) { nM = M / BM; nN = N / BM; nwg = nM * nN; G = G_; c = c_; }
    __host__ __device__ bool next(int i, Unit& u) const {
        const long L = (long)i * G + c; if (L >= nwg) return false;
        int wgid = (int)L; { const int q = nwg / NXCD, r = nwg % NXCD, xcd = wgid % NXCD, off = wgid / NXCD; wgid = (xcd < r ? xcd * (q + 1) : r * (q + 1) + (xcd - r) * q) + off; }
        const int nig = WGM * nN, gid = wgid / nig, fm = gid * WGM, gsz = (nM - fm) < WGM ? (nM - fm) : WGM;
        u.pm = fm + ((wgid % nig) % gsz); u.pn = (wgid % nig) / gsz; return true;
    }
    __device__ __forceinline__ void a_ready(const Unit&) const {}
    __device__ __forceinline__ void done(const Unit&) const {}
};
__device__ __forceinline__ unsigned cvt_pk_bf16(float lo, float hi) { unsigned r; asm volatile("v_cvt_pk_bf16_f32 %0, %1, %2" : "=v"(r) : "v"(lo), "v"(hi)); return r; }
template <class Epi, class Sched, bool ALIGN_EPI = false, bool SP2 = false>
__device__ __forceinline__ void gemm_phase(PG8_LAS unsigned char* lds, const Gemm g, const Sched& S, const Epi& E) {
    int tid_ = threadIdx.x; asm volatile("" : "+v"(tid_));
    const int tid = tid_, wid = __builtin_amdgcn_readfirstlane(tid >> 6), lane = tid & 63, wr = wid >> 2, wc = wid & 3, fr = lane & 15, fq = lane >> 4;
    const int K = g.K, nt = K / BK;
    unsigned voffA[2], voffB[2];
#pragma unroll
    for (int i = 0; i < 2; ++i) { int R, C; stage_rc(tid * 16 + i * 8192, R, C); const int Rb = Epi::PERM ? ((R & ~31) + perm32(R & 31)) : R;
        voffA[i] = (unsigned)(R * g.lda + C) * 2u; voffB[i] = (unsigned)(Rb * K + C) * 2u; }
    const size_t kstep = (size_t)(BK * 2);
    const size_t hstepB = (size_t)HALF * K * 2, hstepA = (size_t)HALF * g.lda * 2;
    const size_t tstepA = 2 * hstepA, tstepB = 2 * hstepB;
    const unsigned ldsw = (unsigned)wid * 1024u;
    const int aoff = lds_byte(wr * 64 + fr, fq * 8), boff = lds_byte(wc * 32 + fr, fq * 8);
#define PG8_SA(b, h) (((b) * 2 + (h)) * HTB)
#define PG8_SB(b, h) ((4 + (b) * 2 + (h)) * HTB)
#define PG8_STAGE(bufoff, gbase, voff) do { _Pragma("unroll") for (int _i = 0; _i < 2; ++_i) \
        __builtin_amdgcn_global_load_lds((const unsigned*)((const char*)(gbase) + (voff)[_i]), (PG8_LAS unsigned*)(lds + (bufoff) + ldsw + _i * 8192), 16, 0, 0); } while (0)
#define PG8_LDA(dst, b, h) do { _Pragma("unroll") for (int m = 0; m < 4; ++m) _Pragma("unroll") for (int k = 0; k < 2; ++k) dst[m][k] = *(const PG8_LAS bf16x8*)(lds + PG8_SA(b, h) + aoff + m * 2048 + k * 1024); } while (0)
#define PG8_LDB(dst, b, h) do { _Pragma("unroll") for (int n = 0; n < 2; ++n) _Pragma("unroll") for (int k = 0; k < 2; ++k) dst[n][k] = *(const PG8_LAS bf16x8*)(lds + PG8_SB(b, h) + boff + n * 2048 + k * 1024); } while (0)
#define PG8_MMA(ai, bj, At, Bt) do { __builtin_amdgcn_s_setprio(1); _Pragma("unroll") for (int m = 0; m < 4; ++m) _Pragma("unroll") for (int n = 0; n < 2; ++n) _Pragma("unroll") for (int k = 0; k < 2; ++k) \
        acc[ai][bj][m][n] = __builtin_amdgcn_mfma_f32_16x16x32_bf16(Bt[n][k], At[m][k], acc[ai][bj][m][n], 0, 0, 0); __builtin_amdgcn_s_setprio(0); } while (0)
#define PG8_WAIT_V(n) asm volatile("s_waitcnt vmcnt(" #n ")" ::: "memory")
#define PG8_WAIT_L(n) asm volatile("s_waitcnt lgkmcnt(" #n ")" ::: "memory")
#define PG8_BAR __builtin_amdgcn_s_barrier()
#define PG8_SCHED __builtin_amdgcn_sched_barrier(0)
    Unit cur, nxt; int ui = 0;
    if (!S.next(0, cur)) return;
    f32x4 acc[2][2][4][2];
#pragma unroll
    for (int a = 0; a < 2; ++a)
#pragma unroll
        for (int b = 0; b < 2; ++b)
#pragma unroll
            for (int m = 0; m < 4; ++m)
#pragma unroll
                for (int n = 0; n < 2; ++n) acc[a][b][m][n] = (f32x4){0.f, 0.f, 0.f, 0.f};
    bf16x8 At[4][2], B0[2][2], B1[2][2];
    const char* cA = (const char*)g.A + (size_t)cur.pm * tstepA; const char* cB = (const char*)g.Bt + (size_t)cur.pn * tstepB;
    S.a_ready(cur);
    if constexpr (SP2) {
        PG8_STAGE(PG8_SB(0, 0), cB, voffB); PG8_STAGE(PG8_SB(0, 1), cB + hstepB, voffB); PG8_STAGE(PG8_SA(0, 0), cA, voffA); PG8_STAGE(PG8_SA(0, 1), cA + hstepA, voffA);
        if (wr == 1) PG8_BAR;
        PG8_WAIT_V(2); PG8_BAR;
        PG8_STAGE(PG8_SB(1, 0), cB + kstep, voffB); PG8_STAGE(PG8_SA(1, 0), cA + kstep, voffA); PG8_STAGE(PG8_SB(1, 1), cB + hstepB + kstep, voffB);
        PG8_WAIT_V(6); PG8_BAR;
    } else {
        PG8_STAGE(PG8_SB(0, 0), cB, voffB); PG8_STAGE(PG8_SA(0, 0), cA, voffA); PG8_STAGE(PG8_SB(0, 1), cB + hstepB, voffB); PG8_STAGE(PG8_SA(0, 1), cA + hstepA, voffA);
        if (wr == 1) PG8_BAR;
        PG8_WAIT_V(4); PG8_BAR;
        PG8_STAGE(PG8_SB(1, 0), cB + kstep, voffB); PG8_STAGE(PG8_SA(1, 0), cA + kstep, voffA); PG8_STAGE(PG8_SB(1, 1), cB + hstepB + kstep, voffB);
        PG8_WAIT_V(6); PG8_BAR;
    }
    for (;;) {
        const bool has_next = S.next(ui + 1, nxt);
        const char* nA = has_next ? (const char*)g.A + (size_t)nxt.pm * tstepA : cA; const char* nB = has_next ? (const char*)g.Bt + (size_t)nxt.pn * tstepB : cB;
        for (int t = 0; t < nt; t += 2) {
            const bool last = (t == nt - 2);
            const char* a1 = cA + (size_t)(t + 1) * kstep;
            const char* a2 = last ? nA : cA + (size_t)(t + 2) * kstep; const char* b2 = last ? nB : cB + (size_t)(t + 2) * kstep;
            const char* a3 = a2 + kstep; const char* b3 = b2 + kstep;
            if (last && has_next) S.a_ready(nxt);
            if constexpr (SP2) {
            PG8_LDB(B0, 0, 0); PG8_LDB(B1, 0, 1); PG8_SCHED; PG8_LDA(At, 0, 0); PG8_STAGE(PG8_SA(1, 1), a1 + hstepA, voffA);
            PG8_WAIT_V(8); PG8_WAIT_L(0); PG8_BAR; PG8_MMA(0, 0, At, B0); PG8_MMA(0, 1, At, B1); PG8_BAR; PG8_SCHED;
            PG8_LDA(At, 0, 1); PG8_STAGE(PG8_SB(0, 0), b2, voffB); PG8_STAGE(PG8_SB(0, 1), b2 + hstepB, voffB); PG8_STAGE(PG8_SA(0, 0), a2, voffA);
            PG8_WAIT_V(8); PG8_WAIT_L(0); PG8_BAR; PG8_MMA(1, 0, At, B0); PG8_MMA(1, 1, At, B1); PG8_BAR; PG8_SCHED;
            PG8_LDB(B0, 1, 0); PG8_LDB(B1, 1, 1); PG8_SCHED; PG8_LDA(At, 1, 0); PG8_STAGE(PG8_SA(0, 1), a2 + hstepA, voffA);
            PG8_WAIT_V(8); PG8_WAIT_L(0); PG8_BAR; PG8_MMA(0, 0, At, B0); PG8_MMA(0, 1, At, B1); PG8_BAR; PG8_SCHED;
            PG8_LDA(At, 1, 1); PG8_STAGE(PG8_SB(1, 0), b3, voffB); PG8_STAGE(PG8_SB(1, 1), b3 + hstepB, voffB); PG8_STAGE(PG8_SA(1, 0), a3, voffA);
            PG8_WAIT_V(8); PG8_WAIT_L(0); PG8_BAR; PG8_MMA(1, 0, At, B0); PG8_MMA(1, 1, At, B1); PG8_BAR; PG8_SCHED;
            } else {
            PG8_LDB(B0, 0, 0); PG8_SCHED; PG8_LDA(At, 0, 0); PG8_STAGE(PG8_SA(1, 1), a1 + hstepA, voffA);
            PG8_WAIT_L(8); PG8_BAR; PG8_WAIT_L(0); PG8_MMA(0, 0, At, B0); PG8_BAR; PG8_SCHED;
            PG8_LDB(B1, 0, 1); PG8_STAGE(PG8_SB(0, 0), b2, voffB);
            PG8_BAR; PG8_WAIT_L(0); PG8_MMA(0, 1, At, B1); PG8_BAR;
            PG8_LDA(At, 0, 1); PG8_STAGE(PG8_SA(0, 0), a2, voffA);
            PG8_BAR; PG8_WAIT_L(0); PG8_MMA(1, 0, At, B0); PG8_BAR; PG8_SCHED;
            PG8_STAGE(PG8_SB(0, 1), b2 + hstepB, voffB);
            PG8_WAIT_V(6); PG8_BAR; PG8_MMA(1, 1, At, B1); PG8_BAR;
            PG8_LDB(B0, 1, 0); PG8_SCHED; PG8_LDA(At, 1, 0); PG8_STAGE(PG8_SA(0, 1), a2 + hstepA, voffA);
            PG8_WAIT_L(8); PG8_BAR; PG8_WAIT_L(0); PG8_MMA(0, 0, At, B0); PG8_BAR; PG8_SCHED;
            PG8_LDB(B1, 1, 1); PG8_STAGE(PG8_SB(1, 0), b3, voffB);
            PG8_BAR; PG8_WAIT_L(0); PG8_MMA(0, 1, At, B1); PG8_BAR;
            PG8_LDA(At, 1, 1); PG8_STAGE(PG8_SA(1, 0), a3, voffA);
            PG8_BAR; PG8_WAIT_L(0); PG8_MMA(1, 0, At, B0); PG8_BAR; PG8_SCHED;
            PG8_STAGE(PG8_SB(1, 1), b3 + hstepB, voffB);
            PG8_WAIT_V(6); PG8_BAR; PG8_MMA(1, 1, At, B1); PG8_BAR;
            }
        }
        if constexpr (ALIGN_EPI) { if (wr == 0) PG8_BAR; }
        if constexpr (!Epi::AFTER_DRAIN) { E(acc, cur, wr, wc, fr, fq); S.done(cur); }
        if (!has_next) break;
#pragma unroll
        for (int a = 0; a < 2; ++a)
#pragma unroll
            for (int b = 0; b < 2; ++b)
#pragma unroll
                for (int m = 0; m < 4; ++m)
#pragma unroll
                    for (int n = 0; n < 2; ++n) acc[a][b][m][n] = (f32x4){0.f, 0.f, 0.f, 0.f};
        cur = nxt; cA = nA; cB = nB; ++ui;
        if constexpr (ALIGN_EPI) { if (wr == 1) PG8_BAR; }
    }
    PG8_WAIT_V(0);
    if constexpr (!ALIGN_EPI) { if (wr == 0) PG8_BAR; }
    PG8_BAR;
    if constexpr (Epi::AFTER_DRAIN) { E.fused(acc, cur, wr, wc, fr, fq, lds, wid, lane); S.done(cur); }
#undef PG8_SA
#undef PG8_SB
#undef PG8_STAGE
#undef PG8_LDA
#undef PG8_LDB
#undef PG8_MMA
#undef PG8_WAIT_V
#undef PG8_WAIT_L
#undef PG8_BAR
#undef PG8_SCHED
}
}


typedef unsigned short bf16_t;
typedef float f32x4 __attribute__((ext_vector_type(4)));
typedef unsigned u32x4 __attribute__((ext_vector_type(4)));
#define LAS __attribute__((address_space(3)))
#define GAS __attribute__((address_space(1)))

#ifndef PH_MASK
#define PH_MASK 0xffff
#endif
#ifndef ATTN_SIMPLE
#define ATTN_SIMPLE 0
#endif
#ifndef SCAN_SIMPLE
#define SCAN_SIMPLE 0
#endif
#ifndef RPT
#define RPT 0
#endif
#ifndef MK_MULTI
#define MK_MULTI 0
#endif

constexpr int BATCH = 4, SEQ = 4096, DM = 1024, M = BATCH * SEQ, DEPTH = 4;
constexpr int DFF = 2816;
constexpr int HYB_IN = 3096, HYB_PAD = 3328;
constexpr int NCH = 64, CH = 64;
constexpr float EPS = 1e-6f;
constexpr int PP = 3072;
constexpr int C_GQ = 0, C_GK = 256, C_GV = 512, C_MQ = 1024, C_MK = 1280, C_MV = 1536, C_GR = 2048, C_MO = 2560;
constexpr int SMALLP = 32;

constexpr size_t MiB = 1u << 20;
constexpr size_t WS_CTL = 0, CTL_ZERO_BYTES = 65536, WS_RSS = 1 * MiB, WS_SMALL = 2 * MiB, WS_KMEAN = 4 * MiB, WS_DEC = 5 * MiB, WS_NS = 6 * MiB;
constexpr size_t WS_XB = 8 * MiB, WS_P = 40 * MiB, WS_W = 136 * MiB;
constexpr size_t W_IN = 0, W_OUT = W_IN + (size_t)HYB_PAD * DM * 2, W_QKV = W_OUT + (size_t)DM * DM * 2, W_O = W_QKV + (size_t)3 * DM * DM * 2, W_MIXSZ = W_O + (size_t)DM * DM * 2;
constexpr size_t W_FFN0 = 2 * W_MIXSZ, W_GU = 0, W_D = (size_t)2 * DFF * DM * 2, W_FFNSZ = W_D + (size_t)DM * DFF * 2;
constexpr size_t WS_END = WS_W + W_FFN0 + 4 * W_FFNSZ;
static_assert(WS_END <= 256 * MiB, "workspace map");

constexpr int RING_BYTES = 131072, LDS_BYTES = 147456, MISC_OFF = LDS_BYTES - 256;
constexpr int NWAVES = 8, NTHR = 512;

__device__ __forceinline__ float bf2f(bf16_t v) { return __uint_as_float((unsigned)v << 16); }
__device__ __forceinline__ unsigned f2bf(float f) { unsigned u = __float_as_uint(f); return (u + 0x7fffu + ((u >> 16) & 1u)) >> 16; }
__device__ __forceinline__ unsigned pk2(float lo, float hi) { return f2bf(lo) | (f2bf(hi) << 16); }
__device__ __forceinline__ float sigmoidf_(float x) { return __builtin_amdgcn_rcpf(1.f + __builtin_amdgcn_exp2f(-1.4426950408889634f * x)); }
__device__ __forceinline__ float siluf_(float x) { return x * __builtin_amdgcn_rcpf(1.f + __builtin_amdgcn_exp2f(-1.4426950408889634f * x)); }
__device__ __forceinline__ float logsigmoidf_(float x) { return fminf(x, 0.f) - 0.6931471805599453f * __builtin_amdgcn_logf(1.f + __builtin_amdgcn_exp2f(-1.4426950408889634f * fabsf(x))); }
__device__ __forceinline__ float wave_sum(float v) {
#pragma unroll
    for (int o = 1; o < 64; o <<= 1) v += __shfl_xor(v, o);
    return v;
}
__device__ __forceinline__ float wave_max(float v) {
#pragma unroll
    for (int o = 1; o < 64; o <<= 1) v = fmaxf(v, __shfl_xor(v, o));
    return v;
}
__device__ __forceinline__ int opaque_i(int v) { asm volatile("" : "+v"(v)); return v; }
__device__ __forceinline__ float row_rstd(const float* rss, int row) {
    const f32x4* p = (const f32x4*)(rss + (size_t)row * 16);
    const f32x4 a = p[0], b = p[1], c = p[2], d = p[3];
    const float s = ((a.x + a.y) + (a.z + a.w)) + ((b.x + b.y) + (b.z + b.w)) + ((c.x + c.y) + (c.z + c.w)) + ((d.x + d.y) + (d.z + d.w));
    return rsqrtf(s * (1.f / DM) + EPS);
}

#define XB_TMO      128
#define XB_XCNT(j)  (256  + 64 * (j))
#define XB_XSUB(j)  (1280 + 64 * (j))
#define XB_XGEN(j)  (2304 + 64 * (j))
#define XB_TOP      3328
#define XB_TOPGEN   3392
#define XCD_BAR_WORDS 3456
#define XB_SPIN_CAP (1u << 18)
__device__ __forceinline__ unsigned xb_ld(unsigned* p)              { return __hip_atomic_load(p, __ATOMIC_RELAXED, __HIP_MEMORY_SCOPE_AGENT); }
__device__ __forceinline__ unsigned xb_add(unsigned* p, unsigned v) { return __hip_atomic_fetch_add(p, v, __ATOMIC_RELAXED, __HIP_MEMORY_SCOPE_AGENT); }
__device__ __forceinline__ unsigned xb_xcc_id() { return (unsigned)__builtin_amdgcn_s_getreg((3 << 11) | 20) & 0xFu; }
#define XB_SPIN(cond, bar) do { unsigned _sp = 0; while (cond) { __builtin_amdgcn_s_sleep(1); \
    if ((++_sp & 255u) == 0u) { if (xb_ld(&(bar)[XB_TMO])) break; if (_sp > XB_SPIN_CAP) { atomicAdd(&(bar)[XB_TMO], 1u); break; } } } } while (0)
struct XcdBarrier { unsigned* bar; unsigned x; volatile LAS unsigned* st; };
__device__ __forceinline__ XcdBarrier xcd_barrier_post(unsigned* bar, volatile LAS unsigned* st) {
    XcdBarrier b; b.bar = bar; b.x = xb_xcc_id(); b.st = st;
    if (threadIdx.x == 0) (void)xb_add(&bar[XB_XCNT(b.x)], 1u);
    return b;
}
__device__ __forceinline__ void xcd_barrier_complete(unsigned* bar, unsigned x, unsigned& nloc, unsigned& nx) {
    const unsigned G = gridDim.x * gridDim.y * gridDim.z;
    unsigned sum, cnt, mine, sp = 0u;
    for (;;) {
        sum = 0u; cnt = 0u; mine = 0u;
#pragma unroll
        for (unsigned j = 0; j < 16; ++j) { const unsigned c = xb_ld(&bar[XB_XCNT(j)]); sum += c; cnt += (c > 0u) ? 1u : 0u; mine = (j == x) ? c : mine; }
        if (sum == G) break;
        __builtin_amdgcn_s_sleep(1);
        if ((++sp & 255u) == 0u) { if (xb_ld(&bar[XB_TMO])) break; if (sp > XB_SPIN_CAP) { atomicAdd(&bar[XB_TMO], 1u); break; } }
    }
    nloc = mine > 0u ? mine : 1u; nx = cnt > 0u ? cnt : 1u;
}
__device__ __forceinline__ void xcd_barrier(const XcdBarrier& b) {
    asm volatile("s_waitcnt vmcnt(0)" ::: "memory");
    __syncthreads();
    if (threadIdx.x == 0) {
        unsigned* bar = b.bar;
        __builtin_amdgcn_s_waitcnt(0);
        unsigned nloc = b.st[0], nx = b.st[1];
        if (nloc == 0u) { xcd_barrier_complete(bar, b.x, nloc, nx); b.st[0] = nloc; b.st[1] = nx; }
        const unsigned old = xb_add(&bar[XB_XSUB(b.x)], 1u);
        const unsigned gen = old / nloc;
        if (old + 1u == (gen + 1u) * nloc) {
            __builtin_amdgcn_fence(__ATOMIC_RELEASE, "agent");
            asm volatile("s_waitcnt vmcnt(0)" ::: "memory");
            const unsigned og = xb_add(&bar[XB_TOP], 1u);
            const unsigned tg = og / nx;
            if (og + 1u == (tg + 1u) * nx) xb_add(&bar[XB_TOPGEN], 1u);
            else XB_SPIN(xb_ld(&bar[XB_TOPGEN]) == tg, bar);
            __builtin_amdgcn_fence(__ATOMIC_ACQUIRE, "agent");
            xb_add(&bar[XB_XGEN(b.x)], 1u);
            asm volatile("s_waitcnt vmcnt(0)" ::: "memory");
        } else {
            XB_SPIN(xb_ld(&bar[XB_XGEN(b.x)]) == gen, bar);
            __builtin_amdgcn_fence(__ATOMIC_ACQUIRE, "agent");
            asm volatile("s_waitcnt vmcnt(0)" ::: "memory");
        }
    }
    __syncthreads();
}

struct EpiRowBf16 {
    static constexpr bool PERM = true, AFTER_DRAIN = false;
    bf16_t* O; int ldc; const float* rss; float* small; int small_pn;
    __device__ __forceinline__ void operator()(const pg8::f32x4 (&acc)[2][2][4][2], const pg8::Unit& u, int wr, int wc, int fr, int fq) const {
        const int row0 = u.pm * 256 + wr * 64 + fr;
        if (u.pn == small_pn) {
            if (wc == 0) {
#pragma unroll
                for (int ai = 0; ai < 2; ++ai)
#pragma unroll
                    for (int m = 0; m < 4; ++m) { const int row = row0 + ai * 128 + m * 16; const float rs = row_rstd(rss, row);
#pragma unroll
                        for (int n = 0; n < 2; ++n) *(f32x4*)(small + (size_t)row * SMALLP + 8 * fq + 4 * n) = acc[ai][0][m][n] * rs; }
            }
            return;
        }
        const int col0 = u.pn * 256 + wc * 32 + 8 * fq;
#pragma unroll
        for (int ai = 0; ai < 2; ++ai)
#pragma unroll
            for (int m = 0; m < 4; ++m) { const int row = row0 + ai * 128 + m * 16; const float rs = row_rstd(rss, row);
                bf16_t* rowp = O + (size_t)row * ldc + col0;
#pragma unroll
                for (int bj = 0; bj < 2; ++bj) { const f32x4 v0 = acc[ai][bj][m][0] * rs, v1 = acc[ai][bj][m][1] * rs;
                    u32x4 w; w.x = pg8::cvt_pk_bf16(v0[0], v0[1]); w.y = pg8::cvt_pk_bf16(v0[2], v0[3]); w.z = pg8::cvt_pk_bf16(v1[0], v1[1]); w.w = pg8::cvt_pk_bf16(v1[2], v1[3]);
                    *(u32x4*)(rowp + bj * 128) = w; } }
    }
};
struct EpiRes {
    static constexpr bool PERM = true, AFTER_DRAIN = false;
    const float* xin; float* xout; bf16_t* xb; float* rss; int dry;
    __device__ __forceinline__ void operator()(const pg8::f32x4 (&acc)[2][2][4][2], const pg8::Unit& u, int wr, int wc, int fr, int fq) const {
        if (RPT && dry) { if (acc[0][0][0][0][0] == 1.2345e-33f) xout[0] = 0.f; return; }
        const int row0 = u.pm * 256 + wr * 64 + fr, col0 = u.pn * 256 + wc * 32 + 8 * fq;
#pragma unroll
        for (int ai = 0; ai < 2; ++ai)
#pragma unroll
            for (int m = 0; m < 4; ++m) { const int row = row0 + ai * 128 + m * 16; float ss = 0.f;
#pragma unroll
                for (int bj = 0; bj < 2; ++bj) { const size_t off = (size_t)row * DM + col0 + bj * 128;
                    f32x4 a = *(const f32x4*)(xin + off), b = *(const f32x4*)(xin + off + 4);
                    a = a + acc[ai][bj][m][0]; b = b + acc[ai][bj][m][1];
                    *(f32x4*)(xout + off) = a; *(f32x4*)(xout + off + 4) = b;
                    u32x4 w; w.x = pg8::cvt_pk_bf16(a[0], a[1]); w.y = pg8::cvt_pk_bf16(a[2], a[3]); w.z = pg8::cvt_pk_bf16(b[0], b[1]); w.w = pg8::cvt_pk_bf16(b[2], b[3]);
                    *(u32x4*)(xb + off) = w;
                    ss += (a[0] * a[0] + a[1] * a[1]) + (a[2] * a[2] + a[3] * a[3]) + (b[0] * b[0] + b[1] * b[1]) + (b[2] * b[2] + b[3] * b[3]); }
                ss += __shfl_xor(ss, 16); ss += __shfl_xor(ss, 32);
                if (fq == 0) rss[(size_t)row * 16 + u.pn * 4 + wc] = ss; }
    }
};
struct EpiFfn {
    static constexpr bool PERM = true, AFTER_DRAIN = false;
    bf16_t* H; const float* rss;
    __device__ __forceinline__ void operator()(const pg8::f32x4 (&acc)[2][2][4][2], const pg8::Unit& u, int wr, int wc, int fr, int fq) const {
        const int row0 = u.pm * 256 + wr * 64 + fr, col0 = u.pn * 128 + wc * 32 + 8 * fq;
#pragma unroll
        for (int ai = 0; ai < 2; ++ai)
#pragma unroll
            for (int m = 0; m < 4; ++m) { const int row = row0 + ai * 128 + m * 16; const float rs = row_rstd(rss, row);
                float hv[8];
#pragma unroll
                for (int n = 0; n < 2; ++n)
#pragma unroll
                    for (int e = 0; e < 4; ++e) { const float g = acc[ai][0][m][n][e] * rs, uu = acc[ai][1][m][n][e] * rs; hv[n * 4 + e] = siluf_(g) * uu; }
                u32x4 w; w.x = pg8::cvt_pk_bf16(hv[0], hv[1]); w.y = pg8::cvt_pk_bf16(hv[2], hv[3]); w.z = pg8::cvt_pk_bf16(hv[4], hv[5]); w.w = pg8::cvt_pk_bf16(hv[6], hv[7]);
                *(u32x4*)(H + (size_t)row * DFF + col0) = w; }
    }
};

struct Args { const float* in[18]; float* out; unsigned char* ws; int ph_lo, ph_hi; };
struct Frame {
    LAS unsigned char* lds; unsigned char* ldsg;
    int tid, lane, wave, G, bid;
};


typedef const __attribute__((address_space(4))) unsigned char* kargp_t;
__device__ __forceinline__ kargp_t karg_base() { kargp_t p = (kargp_t)__builtin_amdgcn_kernarg_segment_ptr(); asm volatile("" : "+s"(p)); return p; }
__device__ __forceinline__ const float* karg_in(kargp_t p, int i) { return *(const float* const __attribute__((address_space(4)))*)(p + 8 * i); }
__device__ __forceinline__ float* karg_out(kargp_t p) { return *(float* const __attribute__((address_space(4)))*)(p + 8 * 18); }
__device__ __forceinline__ unsigned char* karg_ws(kargp_t p) { return *(unsigned char* const __attribute__((address_space(4)))*)(p + 8 * 19); }

__device__ __forceinline__ int map_row(int kind, int n) {
    if (kind == 0) return n;
    if (kind == 2) return (n >> 7) * 256 + (n & 127);
    if (kind == 3) return (n >> 7) * 256 + 128 + (n & 127);
    if (n < 256) return C_GQ + n; if (n < 512) return C_GK + n - 256; if (n < 1024) return C_GV + n - 512; if (n < 1536) return C_GR + n - 1024;
    if (n < 1552) return 3072 + (n - 1536);
    if (n < 1808) return C_MQ + n - 1552; if (n < 2064) return C_MK + n - 1808; if (n < 2576) return C_MV + n - 2064; if (n < 3088) return C_MO + n - 2576;
    return 3072 + 16 + (n - 3088);
}
__device__ __forceinline__ void cvt_item(const float* W, int K, int N, const float* gain, bf16_t* WT, int kind, LAS float* scr, int item, int lane) {
    const int nblk = (N + 63) / 64, kb = item / nblk, nb = item % nblk, k0 = 64 * kb, n0 = 64 * nb;
    const int nq = n0 + 4 * (lane & 15), kr = lane >> 4;
    f32x4 v[16];
#pragma unroll
    for (int i = 0; i < 16; ++i) { v[i] = (f32x4){0.f, 0.f, 0.f, 0.f}; if (nq < N) v[i] = *(const f32x4*)(W + (size_t)(k0 + 4 * i + kr) * N + nq); }
#pragma unroll
    for (int i = 0; i < 16; ++i) { const int kk = 4 * i + kr; const float g = gain ? gain[k0 + kk] : 1.f; LAS float* d = scr + kk * 65 + 4 * (lane & 15);
        d[0] = v[i][0] * g; d[1] = v[i][1] * g; d[2] = v[i][2] * g; d[3] = v[i][3] * g; }
    asm volatile("s_waitcnt lgkmcnt(0)" ::: "memory");
    if (n0 + lane < N) {
        bf16_t* dst = WT + (size_t)map_row(kind, n0 + lane) * K + k0;
#pragma unroll
        for (int c = 0; c < 8; ++c) { const LAS float* sp = scr + (8 * c) * 65 + lane;
            u32x4 o; o.x = pk2(sp[0 * 65], sp[1 * 65]); o.y = pk2(sp[2 * 65], sp[3 * 65]); o.z = pk2(sp[4 * 65], sp[5 * 65]); o.w = pk2(sp[6 * 65], sp[7 * 65]);
            *(u32x4*)(dst + 8 * c) = o; }
    }
    asm volatile("s_waitcnt lgkmcnt(0)" ::: "memory");
}
__device__ __forceinline__ void phase_prologue(Frame& F) {
    kargp_t kp = karg_base();
    unsigned char* wsw = karg_ws(kp) + WS_W;
    LAS float* scr = (LAS float*)(F.lds + F.wave * 16640);
    const int gw = F.bid * NWAVES + F.wave, NGW = F.G * NWAVES, lane = opaque_i(F.lane);
    constexpr int I_IN = 16 * 49, I_OUT = 256, I_QKV = 16 * 48, I_O = 256, I_MIX = I_IN + I_OUT + I_QKV + I_O, I_F = 704, I_FFN = 3 * I_F, I_ALL = 2 * I_MIX + 4 * I_FFN;
    for (int it = gw; it < I_ALL; it += NGW) {
        if (it < 2 * I_MIX) {
            const int j = it / I_MIX; int r = it % I_MIX; unsigned char* wj = wsw + j * W_MIXSZ;
            if (r < I_IN) cvt_item(karg_in(kp, 3) + (size_t)j * DM * HYB_IN, DM, HYB_IN, karg_in(kp, 1) + (2 * j) * DM, (bf16_t*)(wj + W_IN), 1, scr, r, lane);
            else if ((r -= I_IN) < I_OUT) cvt_item(karg_in(kp, 10) + (size_t)j * DM * DM, DM, DM, nullptr, (bf16_t*)(wj + W_OUT), 0, scr, r, lane);
            else if ((r -= I_OUT) < I_QKV) cvt_item(karg_in(kp, 11) + (size_t)j * DM * 3 * DM, DM, 3 * DM, karg_in(kp, 1) + (2 * j + 1) * DM, (bf16_t*)(wj + W_QKV), 0, scr, r, lane);
            else { r -= I_QKV; cvt_item(karg_in(kp, 14) + (size_t)j * DM * DM, DM, DM, nullptr, (bf16_t*)(wj + W_O), 0, scr, r, lane); }
        } else {
            const int q = it - 2 * I_MIX, l = q / I_FFN; int r = q % I_FFN; unsigned char* wl = wsw + W_FFN0 + l * W_FFNSZ;
            if (r < I_F) cvt_item(karg_in(kp, 15) + (size_t)l * DM * DFF, DM, DFF, karg_in(kp, 2) + l * DM, (bf16_t*)(wl + W_GU), 2, scr, r, lane);
            else if ((r -= I_F) < I_F) cvt_item(karg_in(kp, 16) + (size_t)l * DM * DFF, DM, DFF, karg_in(kp, 2) + l * DM, (bf16_t*)(wl + W_GU), 3, scr, r, lane);
            else { r -= I_F; cvt_item(karg_in(kp, 17) + (size_t)l * DFF * DM, DFF, DM, nullptr, (bf16_t*)(wl + W_D), 0, scr, r, lane); }
        }
    }
    for (int j = 0; j < 2; ++j) {
        u32x4* z = (u32x4*)(wsw + j * W_MIXSZ + W_IN + (size_t)(3072 + 24) * DM * 2);
        const int nz = (HYB_PAD - 3096) * DM * 2 / 16;
        for (int i = F.bid * NTHR + F.tid; i < nz; i += F.G * NTHR) z[i] = (u32x4){0u, 0u, 0u, 0u};
    }
    const float* x = karg_in(kp, 0); bf16_t* xb = (bf16_t*)(karg_ws(kp) + WS_XB); float* rss = (float*)(karg_ws(kp) + WS_RSS);
    for (int row = gw; row < M; row += NGW) {
        const float* xr = x + (size_t)row * DM; float s = 0.f;
#pragma unroll
        for (int j = 0; j < 4; ++j) { const f32x4 v = *(const f32x4*)(xr + j * 256 + F.lane * 4);
            s += (v.x * v.x + v.y * v.y) + (v.z * v.z + v.w * v.w);
            unsigned long long o = (unsigned long long)pk2(v.x, v.y) | ((unsigned long long)pk2(v.z, v.w) << 32);
            *(unsigned long long*)(xb + (size_t)row * DM + j * 256 + F.lane * 4) = o; }
        s = wave_sum(s);
        if (F.lane < 16) rss[(size_t)row * 16 + F.lane] = F.lane == 0 ? s : 0.f;
    }
}

struct ScanArgs {
    bf16_t* P; const float* small;
    const float* w2; const float* bgate; const float* gla_gain; const float* convw; const float* bif; const float* ml_gain;
    bf16_t* ST; float* dec; float* NS;
};
__device__ __forceinline__ size_t st_off(int grp, int bh, int c) { return ((size_t)((grp * 16 + bh) * NCH + c)) * 8192; }

template <bool NEED_A>
__device__ __forceinline__ void gate_stage(const ScanArgs& a, int b, int c, int hh, float* At, float* Bm, float* blk, float* lastv) {
    int tid_ = threadIdx.x; asm volatile("" : "+v"(tid_));
    const int tid = tid_, tb = tid >> 6, k = tid & 63;
    const int grp = hh >> 2, h = hh & 3;
    const int row0 = b * SEQ + c * CH;
    float la[8];
    if (grp == 0) {
        float w2r[16];
#pragma unroll
        for (int r = 0; r < 16; ++r) w2r[r] = a.w2[r * 256 + h * 64 + k];
        const float bg = a.bgate[h * 64 + k];
#pragma unroll
        for (int i = 0; i < 8; ++i) {
            const float* g = a.small + (size_t)(row0 + tb * 8 + i) * SMALLP;
            float z = bg;
#pragma unroll
            for (int r = 0; r < 16; ++r) z += g[r] * w2r[r];
            la[i] = logsigmoidf_(z) * (1.f / 16.f);
            asm volatile("" ::: "memory");
        }
    } else {
#pragma unroll
        for (int i = 0; i < 8; ++i) {
            const float* g = a.small + (size_t)(row0 + tb * 8 + i) * SMALLP;
            la[i] = logsigmoidf_(g[20 + h] + a.bif[4 + h]);
        }
    }
    float cs[8]; float run = 0.f;
#pragma unroll
    for (int i = 0; i < 8; ++i) { run += la[i]; cs[i] = run; }
    blk[tb * 64 + k] = run;
    __syncthreads();
    float pre = 0.f, tot = 0.f;
#pragma unroll
    for (int j = 0; j < 8; ++j) { const float v = blk[j * 64 + k]; tot += v; if (j < tb) pre += v; }
    if (tb == 0) lastv[k] = tot;
#pragma unroll
    for (int i = 0; i < 8; ++i) {
        const int t = tb * 8 + i; const int row = row0 + t; const float bc = pre + cs[i];
        const bf16_t* pr = a.P + (size_t)row * PP;
        if (grp == 0) {
            const float kv = bf2f(pr[C_GK + h * 64 + k]);
            Bm[t * 65 + k] = kv * __expf(-bc);
            if (NEED_A) { const float qv = bf2f(pr[C_GQ + h * 64 + k]); At[t * 65 + k] = qv * 0.125f * __expf(bc); }
        } else {
            const float ip = a.small[(size_t)row * SMALLP + 16 + h] + a.bif[h];
            const int tt = c * CH + t;
            float ck = 0.f, cq = 0.f;
#pragma unroll
            for (int j = 0; j < 4; ++j) {
                const int ts = tt - 3 + j;
                if (ts >= 0) {
                    const bf16_t* ps = a.P + (size_t)(b * SEQ + ts) * PP;
                    ck += a.convw[j * 512 + 256 + h * 64 + k] * bf2f(ps[C_MK + h * 64 + k]);
                    if (NEED_A) cq += a.convw[j * 512 + h * 64 + k] * bf2f(ps[C_MQ + h * 64 + k]);
                }
            }
            Bm[t * 65 + k] = siluf_(ck) * 0.125f * __expf(ip - bc);
            if (NEED_A) At[t * 65 + k] = siluf_(cq) * __expf(bc);
        }
    }
}

__device__ __forceinline__ void phase_scan1(Frame& F, const ScanArgs& a) {
    float* sm = (float*)F.ldsg;
    float* Bm = sm; float* Vs = sm + 64 * 65; float* blk = Vs + 64 * 128; float* lastv = blk + 512;
    int tid_ = threadIdx.x; asm volatile("" : "+v"(tid_));
    const int tid = tid_, lane = tid & 63, kg = tid >> 6;
    for (int unit = F.bid; unit < BATCH * NCH; unit += F.G) {
        const int b = unit / NCH, c = unit % NCH;
        const int row0 = b * SEQ + c * CH;
        for (int hh = 0; hh < 8; ++hh) {
            const int grp = hh >> 2, h = hh & 3, bh = b * 4 + h;
            gate_stage<false>(a, b, c, hh, nullptr, Bm, blk, lastv);
            const int voff = (grp == 0 ? C_GV : C_MV) + h * 128;
#pragma unroll 4
            for (int i = tid; i < 64 * 128; i += 512) { const int s = i >> 7, v = i & 127; Vs[i] = bf2f(a.P[(size_t)(row0 + s) * PP + voff + v]); }
            __syncthreads();
            if (tid < 64) a.dec[((size_t)(grp * 16 + bh) * NCH + c) * 64 + tid] = __expf(lastv[tid]);
            if (grp == 1 && tid < 64) { float s = 0.f; for (int t = 0; t < 64; ++t) s += Bm[t * 65 + tid]; a.NS[((size_t)bh * NCH + c) * 64 + tid] = s; }
            float acc[8][2];
#pragma unroll
            for (int i = 0; i < 8; ++i) { acc[i][0] = 0.f; acc[i][1] = 0.f; }
#pragma unroll 2
            for (int s = 0; s < 64; ++s) {
                const float v0 = Vs[s * 128 + lane], v1 = Vs[s * 128 + 64 + lane];
#pragma unroll
                for (int i = 0; i < 8; ++i) { const float bv = Bm[s * 65 + kg * 8 + i]; acc[i][0] += bv * v0; acc[i][1] += bv * v1; }
            }
            bf16_t* st = a.ST + st_off(grp, bh, c);
            u32x4 w0, w1;
            w0.x = pk2(acc[0][0], acc[1][0]); w0.y = pk2(acc[2][0], acc[3][0]); w0.z = pk2(acc[4][0], acc[5][0]); w0.w = pk2(acc[6][0], acc[7][0]);
            w1.x = pk2(acc[0][1], acc[1][1]); w1.y = pk2(acc[2][1], acc[3][1]); w1.z = pk2(acc[4][1], acc[5][1]); w1.w = pk2(acc[6][1], acc[7][1]);
            *(u32x4*)(st + (size_t)lane * 64 + kg * 8) = w0; *(u32x4*)(st + (size_t)(lane + 64) * 64 + kg * 8) = w1;
            __syncthreads();
        }
    }
}
__device__ __forceinline__ void phase_scan2(Frame& F, const ScanArgs& a, bool dry = false) {
    for (int gid = F.bid * NTHR + opaque_i(F.tid); gid < 131072; gid += F.G * NTHR) {
        const int grp = gid >> 16, rem = gid & 65535, bh = rem >> 12, r2 = rem & 4095, v = r2 >> 5, k = (r2 & 31) * 2;
        float s0 = 0.f, s1 = 0.f;
        unsigned* p0 = (unsigned*)(a.ST + st_off(grp, bh, 0) + v * 64 + k);
        const float* d0 = a.dec + ((size_t)(grp * 16 + bh) * NCH) * 64 + k;
        for (int cb = 0; cb < NCH; cb += 16) {
            unsigned w[16]; float da[16], db[16];
#pragma unroll
            for (int i = 0; i < 16; ++i) { w[i] = p0[(size_t)(cb + i) * 4096]; da[i] = d0[(cb + i) * 64]; db[i] = d0[(cb + i) * 64 + 1]; }
#pragma unroll
            for (int i = 0; i < 16; ++i) {
                const float l0 = __uint_as_float(w[i] << 16), l1 = __uint_as_float(w[i] & 0xffff0000u);
                if (!dry) p0[(size_t)(cb + i) * 4096] = pk2(s0, s1);
                s0 = da[i] * (s0 + l0); s1 = db[i] * (s1 + l1);
            }
        }
        if (gid < 1024) {
            const int bh2 = gid >> 6, k2 = gid & 63; float ns = 0.f;
            float* p = a.NS + ((size_t)bh2 * NCH) * 64 + k2; const float* dd = a.dec + ((size_t)(16 + bh2) * NCH) * 64 + k2;
            for (int cb = 0; cb < NCH; cb += 16) {
                float lv[16], dv[16];
#pragma unroll
                for (int i = 0; i < 16; ++i) { lv[i] = p[(cb + i) * 64]; dv[i] = dd[(cb + i) * 64]; }
#pragma unroll
                for (int i = 0; i < 16; ++i) { if (!dry) p[(cb + i) * 64] = ns; ns = dv[i] * (ns + lv[i]); }
            }
        }
    }
}
__device__ __forceinline__ void phase_scan3(Frame& F, const ScanArgs& a) {
    float* sm = (float*)F.ldsg;
    float* At = sm; float* Bm = At + 64 * 65; float* Pm = Bm + 64 * 65; float* Vs = Pm + 64 * 65; float* Ss = Vs + 64 * 128;
    float* blk = Ss + 64 * 128; float* lastv = blk + 512; float* nsv = lastv + 64;
    int tid_ = threadIdx.x; asm volatile("" : "+v"(tid_));
    const int tid = tid_, lane = tid & 63, tg = tid >> 6;
    for (int unit = F.bid; unit < BATCH * NCH; unit += F.G) {
        const int b = unit / NCH, c = unit % NCH;
        const int row0 = b * SEQ + c * CH;
        for (int hh = 0; hh < 8; ++hh) {
            const int grp = hh >> 2, h = hh & 3, bh = b * 4 + h;
            gate_stage<true>(a, b, c, hh, At, Bm, blk, lastv);
            const int voff = (grp == 0 ? C_GV : C_MV) + h * 128;
#pragma unroll 4
            for (int i = tid; i < 64 * 128; i += 512) { const int s = i >> 7, v = i & 127; Vs[i] = bf2f(a.P[(size_t)(row0 + s) * PP + voff + v]); }
            const bf16_t* st = a.ST + st_off(grp, bh, c);
#pragma unroll 4
            for (int i = tid; i < 64 * 128; i += 512) { const int v = i >> 6, k = i & 63; Ss[k * 128 + v] = bf2f(st[i]); }
            if (tid < 64) nsv[tid] = grp == 1 ? a.NS[((size_t)bh * NCH + c) * 64 + tid] : 0.f;
            __syncthreads();
            {
                const int t = tid >> 3, sg = tid & 7;
                float p[8];
#pragma unroll
                for (int i = 0; i < 8; ++i) p[i] = 0.f;
#pragma unroll 2
                for (int k = 0; k < 64; ++k) {
                    const float av = At[t * 65 + k];
#pragma unroll
                    for (int i = 0; i < 8; ++i) p[i] += av * Bm[(sg * 8 + i) * 65 + k];
                }
#pragma unroll
                for (int i = 0; i < 8; ++i) { const int s = sg * 8 + i; Pm[t * 65 + s] = s <= t ? p[i] : 0.f; }
            }
            __syncthreads();
            float acc[8][2], den[8];
#pragma unroll
            for (int i = 0; i < 8; ++i) { acc[i][0] = 0.f; acc[i][1] = 0.f; den[i] = 0.f; }
#pragma unroll 2
            for (int s = 0; s < 64; ++s) {
                const float v0 = Vs[s * 128 + lane], v1 = Vs[s * 128 + 64 + lane];
#pragma unroll
                for (int i = 0; i < 8; ++i) { const float pv = Pm[(tg * 8 + i) * 65 + s]; acc[i][0] += pv * v0; acc[i][1] += pv * v1; den[i] += pv; }
            }
#pragma unroll 2
            for (int k = 0; k < 64; ++k) {
                const float s0 = Ss[k * 128 + lane], s1 = Ss[k * 128 + 64 + lane], nk = nsv[k];
#pragma unroll
                for (int i = 0; i < 8; ++i) { const float av = At[(tg * 8 + i) * 65 + k]; acc[i][0] += av * s0; acc[i][1] += av * s1; den[i] += av * nk; }
            }
#pragma unroll
            for (int i = 0; i < 8; ++i) {
                asm volatile("" ::: "memory");
                const int row = row0 + tg * 8 + i;
                bf16_t* pr = a.P + (size_t)row * PP;
                float o0 = acc[i][0], o1 = acc[i][1];
                if (grp == 0) {
                    const float ss = wave_sum(o0 * o0 + o1 * o1);
                    const float rstd = rsqrtf(ss * (1.f / 128.f) + EPS);
                    const float g0 = bf2f(pr[C_GR + h * 128 + lane]), g1 = bf2f(pr[C_GR + h * 128 + 64 + lane]);
                    pr[C_GR + h * 128 + lane] = (bf16_t)f2bf(o0 * rstd * a.gla_gain[h * 128 + lane] * siluf_(g0));
                    pr[C_GR + h * 128 + 64 + lane] = (bf16_t)f2bf(o1 * rstd * a.gla_gain[h * 128 + 64 + lane] * siluf_(g1));
                } else {
                    const float dd = 1.f / fmaxf(fabsf(den[i]), 1.f);
                    const float g0 = bf2f(pr[C_MO + h * 128 + lane]), g1 = bf2f(pr[C_MO + h * 128 + 64 + lane]);
                    o0 = o0 * dd * sigmoidf_(g0); o1 = o1 * dd * sigmoidf_(g1);
                    const float ss = wave_sum(o0 * o0 + o1 * o1);
                    const float rstd = rsqrtf(ss * (1.f / 128.f) + EPS);
                    pr[C_MO + h * 128 + lane] = (bf16_t)f2bf(o0 * rstd * a.ml_gain[h * 128 + lane]);
                    pr[C_MO + h * 128 + 64 + lane] = (bf16_t)f2bf(o1 * rstd * a.ml_gain[h * 128 + 64 + lane]);
                }
            }
            __syncthreads();
        }
    }
}

__device__ __forceinline__ void phase_qkn(Frame& F, bf16_t* P, const float* qg, const float* kg, float* kmean) {
    const int gw = F.bid * NWAVES + F.wave, NGW = F.G * NWAVES, lane = opaque_i(F.lane);
    for (int u = gw; u < BATCH * 16 * 16; u += NGW) {
        const int hd = u & 15, blk = (u >> 4) & 15, b = u >> 8;
        const float* g = hd < 8 ? qg : kg;
        const float g0 = g[lane * 2], g1 = g[lane * 2 + 1];
        const float sc = hd < 8 ? 0.08838834764831845f : 1.f;
        float m0 = 0.f, m1 = 0.f;
        for (int r = 0; r < 256; ++r) {
            unsigned* p = (unsigned*)(P + (size_t)(b * SEQ + blk * 256 + r) * PP + hd * 128 + lane * 2);
            const unsigned w = *p;
            const float x0 = __uint_as_float(w << 16), x1 = __uint_as_float(w & 0xffff0000u);
            const float ss = wave_sum(x0 * x0 + x1 * x1);
            const float rr = rsqrtf(ss * (1.f / 128.f) + EPS) * sc;
            const float y0 = x0 * rr * g0, y1 = x1 * rr * g1;
            m0 += y0; m1 += y1;
            *p = pk2(y0, y1);
        }
        if (hd >= 8) { float* km = kmean + ((size_t)((b * 8 + (hd - 8)) * 16 + blk)) * 128 + lane * 2; km[0] = m0 * (1.f / 256.f); km[1] = m1 * (1.f / 256.f); }
    }
}
__device__ __forceinline__ void phase_attn_simple(Frame& F, bf16_t* P, const float* kmean) {
    float* qs = (float*)F.ldsg + F.wave * 1152; float* sc = qs + 128;
    const int gw = F.bid * NWAVES + F.wave, NGW = F.G * NWAVES, lane = opaque_i(F.lane);
    for (int item = gw; item < BATCH * 8 * SEQ; item += NGW) {
        const int t = item & (SEQ - 1), h = (item >> 12) & 7, b = item >> 15;
        const size_t row = (size_t)b * SEQ + t;
        {
            const unsigned w = *(const unsigned*)(P + row * PP + h * 128 + lane * 2);
            qs[lane * 2] = __uint_as_float(w << 16); qs[lane * 2 + 1] = __uint_as_float(w & 0xffff0000u);
        }
        const int qblk = t >> 8;
        float g = -INFINITY;
        if (lane < qblk) { const float* km = kmean + ((size_t)((b * 8 + h) * 16 + lane)) * 256; float s = 0.f; for (int d = 0; d < 128; ++d) s += qs[d] * (km[d] + km[128 + d]); g = s; }
        int sel0 = 0, sel1 = 0, sel2 = 0; const int nsel = qblk < 3 ? qblk : 3;
        {
            float gv[16];
#pragma unroll
            for (int n = 0; n < 16; ++n) gv[n] = __shfl(g, n);
            unsigned taken = 0u;
#pragma unroll
            for (int r = 0; r < 3; ++r) {
                int best = 0; float bv = -INFINITY; bool found = false;
#pragma unroll
                for (int n = 0; n < 16; ++n) { const bool ok = !((taken >> n) & 1u) && n < qblk; if (ok && (!found || gv[n] > bv)) { bv = gv[n]; best = n; found = true; } }
                if (r == 0) sel0 = best; else if (r == 1) sel1 = best; else sel2 = best;
                if (found) taken |= 1u << best;
            }
        }
        const float slope = exp2f(-(float)(h + 1));
        float mx = -1e30f;
        for (int r = 0; r <= nsel; ++r) {
            const int blk = r < nsel ? (r == 0 ? sel0 : (r == 1 ? sel1 : sel2)) : qblk;
            for (int sub = 0; sub < 4; ++sub) {
                const int key = blk * 256 + sub * 64 + lane; const int dist = t - key;
                const bf16_t* kr = P + ((size_t)b * SEQ + key) * PP + 1024 + h * 128;
                float s = 0.f;
                for (int d8 = 0; d8 < 16; ++d8) {
                    const u32x4 w = *(const u32x4*)(kr + d8 * 8);
#pragma unroll
                    for (int e = 0; e < 4; ++e) { s += qs[d8 * 8 + 2 * e] * __uint_as_float(w[e] << 16); s += qs[d8 * 8 + 2 * e + 1] * __uint_as_float(w[e] & 0xffff0000u); }
                }
                s = dist >= 0 ? s - slope * (float)dist : -1e30f;
                sc[r * 256 + sub * 64 + lane] = s; mx = fmaxf(mx, s);
            }
        }
        mx = wave_max(mx);
        float sum = 0.f;
        for (int i = lane; i < (nsel + 1) * 256; i += 64) { const float p = __expf(sc[i] - mx); sc[i] = p; sum += p; }
        sum = wave_sum(sum);
        float a0 = 0.f, a1 = 0.f;
        for (int r = 0; r <= nsel; ++r) {
            const int blk = r < nsel ? (r == 0 ? sel0 : (r == 1 ? sel1 : sel2)) : qblk;
            const bf16_t* vr = P + ((size_t)b * SEQ + blk * 256) * PP + 2048 + h * 128 + lane * 2;
#pragma unroll 4
            for (int j = 0; j < 256; ++j) {
                const float p = sc[r * 256 + j];
                const unsigned w = *(const unsigned*)(vr + (size_t)j * PP);
                a0 += p * __uint_as_float(w << 16); a1 += p * __uint_as_float(w & 0xffff0000u);
            }
        }
        const float inv = 1.f / sum;
        *(unsigned*)(P + row * PP + h * 128 + lane * 2) = pk2(a0 * inv, a1 * inv);
    }
}


__device__ __forceinline__ void phase_qkn2(Frame& F, bf16_t* P, const float* qg, const float* kg, float* kmean, bool dry = false) {
    const int gw = F.bid * NWAVES + F.wave, NGW = F.G * NWAVES, lane = opaque_i(F.lane), sub = lane >> 4, cl = lane & 15;
    for (int u = gw; u < BATCH * 16 * 16 * 2; u += NGW) {
        const int half = u & 1, hd = (u >> 1) & 15, blk = (u >> 5) & 15, b = u >> 9;
        const float* g = (hd < 8 ? qg : kg) + cl * 8;
        const f32x4 ga = *(const f32x4*)g, gb = *(const f32x4*)(g + 4);
        const float sc = hd < 8 ? 0.08838834764831845f : 1.f;
        float m[8];
#pragma unroll
        for (int e = 0; e < 8; ++e) m[e] = 0.f;
        bf16_t* base = P + (size_t)(b * SEQ + blk * 256 + half * 128 + sub) * PP + hd * 128 + cl * 8;
#pragma unroll 8
        for (int it = 0; it < 32; ++it) {
            u32x4* p = (u32x4*)(base + (size_t)it * 4 * PP);
            const u32x4 w = *p;
            float x[8];
#pragma unroll
            for (int e = 0; e < 4; ++e) { x[2 * e] = __uint_as_float(w[e] << 16); x[2 * e + 1] = __uint_as_float(w[e] & 0xffff0000u); }
            float ss = (x[0] * x[0] + x[1] * x[1]) + (x[2] * x[2] + x[3] * x[3]) + (x[4] * x[4] + x[5] * x[5]) + (x[6] * x[6] + x[7] * x[7]);
            ss += __shfl_xor(ss, 1); ss += __shfl_xor(ss, 2); ss += __shfl_xor(ss, 4); ss += __shfl_xor(ss, 8);
            const float rr = rsqrtf(ss * (1.f / 128.f) + EPS) * sc;
            float y[8];
            y[0] = x[0] * rr * ga[0]; y[1] = x[1] * rr * ga[1]; y[2] = x[2] * rr * ga[2]; y[3] = x[3] * rr * ga[3];
            y[4] = x[4] * rr * gb[0]; y[5] = x[5] * rr * gb[1]; y[6] = x[6] * rr * gb[2]; y[7] = x[7] * rr * gb[3];
#pragma unroll
            for (int e = 0; e < 8; ++e) m[e] += y[e];
            u32x4 o; o.x = pk2(y[0], y[1]); o.y = pk2(y[2], y[3]); o.z = pk2(y[4], y[5]); o.w = pk2(y[6], y[7]);
            if (!dry) *p = o;
        }
        if (hd >= 8 && !dry) {
#pragma unroll
            for (int e = 0; e < 8; ++e) { m[e] += __shfl_xor(m[e], 16); m[e] += __shfl_xor(m[e], 32); }
            if (sub == 0) { float* km = kmean + ((size_t)(((b * 8 + (hd - 8)) * 16 + blk) * 2 + half)) * 128 + cl * 8;
                *(f32x4*)km = (f32x4){m[0], m[1], m[2], m[3]} * (1.f / 256.f); *(f32x4*)(km + 4) = (f32x4){m[4], m[5], m[6], m[7]} * (1.f / 256.f); }
        }
    }
}

namespace att {
typedef short bf16x8 __attribute__((ext_vector_type(8)));
typedef short s16x4 __attribute__((ext_vector_type(4)));
typedef float f32x16 __attribute__((ext_vector_type(16)));
constexpr int SHM_V = 16384, SHM_K = 16384, OFF_V = 0, OFF_K = 2 * SHM_V, OFF_WS = 2 * SHM_V + 2 * SHM_K;
constexpr float THR = 8.f;
#define KSWZ(row, colB) ((row) * 256 + ((colB) ^ (((row) & 7) << 4)))
#define SBAR() __builtin_amdgcn_sched_barrier(0)
typedef LAS char* lptr;
__device__ __forceinline__ int crow(int r, int hi) { return (r & 3) + 8 * (r >> 2) + 4 * hi; }
__device__ __forceinline__ unsigned cvtpk(float lo, float hi) { unsigned r; asm volatile("v_cvt_pk_bf16_f32 %0, %1, %2" : "=v"(r) : "v"(lo), "v"(hi)); return r; }
__device__ __forceinline__ void partialSM(f32x16& p0, f32x16& p1, float& m_reg, float& mn, float& alpha, float slope, float base, bool ok, bool diag, int dq) {
    constexpr float C = 1.4426950408889634f;
#pragma unroll
    for (int r = 0; r < 16; ++r) { const int c = (r & 3) + 8 * (r >> 2); if (c) p0[r] = fmaf(slope, (float)c, p0[r]); p1[r] = fmaf(slope, (float)(c + 32), p1[r]); }
    if (diag) {
#pragma unroll
        for (int r = 0; r < 16; ++r) { const int c = (r & 3) + 8 * (r >> 2); if (c > dq) p0[r] = -INFINITY; if (c + 32 > dq) p1[r] = -INFINITY; }
    }
    float pmax = p0[0];
#pragma unroll
    for (int r = 1; r < 16; ++r) pmax = fmaxf(pmax, p0[r]);
#pragma unroll
    for (int r = 0; r < 16; ++r) pmax = fmaxf(pmax, p1[r]);
    const float bm = ok ? base : -INFINITY;
    pmax += bm;
    { auto rr = __builtin_amdgcn_permlane32_swap(__float_as_uint(pmax), __float_as_uint(pmax), false, false);
      pmax = fmaxf(__uint_as_float(rr[0]), __uint_as_float(rr[1])); }
    if (__builtin_expect(__all(pmax - m_reg <= THR), 1)) { mn = m_reg; alpha = 1.f; }
    else { mn = fmaxf(m_reg, pmax); alpha = __builtin_amdgcn_exp2f((m_reg - mn) * C); m_reg = mn; }
    const float add = (bm - mn) * C;
#pragma unroll
    for (int r = 0; r < 16; ++r) p0[r] = fmaf(p0[r], C, add);
#pragma unroll
    for (int r = 0; r < 16; ++r) p1[r] = fmaf(p1[r], C, add);
#pragma unroll
    for (int r = 0; r < 16; ++r) p0[r] = __builtin_amdgcn_exp2f(p0[r]);
}
__device__ __forceinline__ void finishSM(f32x16& p0, f32x16& p1, float alpha, float& l_reg, bf16x8& pa0, bf16x8& pa1, bf16x8& pa2, bf16x8& pa3) {
#pragma unroll
    for (int r = 0; r < 16; ++r) p1[r] = __builtin_amdgcn_exp2f(p1[r]);
    float ps = 0;
#pragma unroll
    for (int r = 0; r < 16; ++r) ps += p0[r];
#pragma unroll
    for (int r = 0; r < 16; ++r) ps += p1[r];
    { auto rr = __builtin_amdgcn_permlane32_swap(__float_as_uint(ps), __float_as_uint(ps), false, false);
      ps = __uint_as_float(rr[0]) + __uint_as_float(rr[1]); }
    l_reg = l_reg * alpha + ps;
#define PK4(P, BASE, OUT) do { unsigned a0 = cvtpk(P[BASE + 0], P[BASE + 1]), a1 = cvtpk(P[BASE + 2], P[BASE + 3]);   \
    unsigned b0 = cvtpk(P[BASE + 4], P[BASE + 5]), b1 = cvtpk(P[BASE + 6], P[BASE + 7]);                              \
    auto r0 = __builtin_amdgcn_permlane32_swap(a0, b0, false, false); auto r1 = __builtin_amdgcn_permlane32_swap(a1, b1, false, false); \
    u32x4 w = {r0[0], r1[0], r0[1], r1[1]}; OUT = *reinterpret_cast<bf16x8*>(&w); } while (0)
    PK4(p0, 0, pa0); PK4(p0, 8, pa1); PK4(p1, 0, pa2); PK4(p1, 8, pa3);
#undef PK4
}
__device__ __forceinline__ void qkt(f32x16& p0, f32x16& p1, lptr Ks, const bf16x8* qr, int r32, int hi) {
    p0 = f32x16{}; p1 = f32x16{};
#pragma unroll
    for (int d0 = 0; d0 < 8; ++d0) { const int cb = (d0 * 16 + hi * 8) * 2;
        const bf16x8 b0 = *(const LAS bf16x8*)(Ks + KSWZ(r32, cb));
        const bf16x8 b1 = *(const LAS bf16x8*)(Ks + KSWZ(32 + r32, cb));
        p0 = __builtin_amdgcn_mfma_f32_32x32x16_bf16(b0, qr[d0], p0, 0, 0, 0);
        p1 = __builtin_amdgcn_mfma_f32_32x32x16_bf16(b1, qr[d0], p1, 0, 0, 0); }
}
__device__ __forceinline__ int v_st(int k, int c) { const int kk = (k & ~0xC) | ((k & 4) << 1) | ((k & 8) >> 1); return ((kk >> 3) * 4 + (c >> 5)) * 512 + ((kk & 7) * 32 + (c & 31)) * 2; }
__device__ __forceinline__ int v_rd_base(int lane) { return ((lane & 3) << 3) | (((lane >> 2) & 3) << 6) | (((lane >> 4) & 1) << 5) | (((lane >> 5) & 1) << 8); }
constexpr int v_rd_off(int d0, int ks, int half) { return d0 * 512 + ks * 4096 + half * 2048; }
template <int OFF> __device__ __forceinline__ s16x4 tr_read(int vb) {
    s16x4 r; asm volatile("ds_read_b64_tr_b16 %0, %1 offset:%2" : "=&v"(r) : "v"(vb), "i"(OFF) : "memory"); return r;
}
template <int D0> __device__ __forceinline__ void pv_one(f32x16& od, int vb, bf16x8 pa0, bf16x8 pa1, bf16x8 pa2, bf16x8 pa3) {
    const s16x4 l0 = tr_read<v_rd_off(D0, 0, 0)>(vb), h0 = tr_read<v_rd_off(D0, 0, 1)>(vb), l1 = tr_read<v_rd_off(D0, 1, 0)>(vb), h1 = tr_read<v_rd_off(D0, 1, 1)>(vb);
    const s16x4 l2 = tr_read<v_rd_off(D0, 2, 0)>(vb), h2 = tr_read<v_rd_off(D0, 2, 1)>(vb), l3 = tr_read<v_rd_off(D0, 3, 0)>(vb), h3 = tr_read<v_rd_off(D0, 3, 1)>(vb);
    asm volatile("s_waitcnt lgkmcnt(0)" ::: "memory"); SBAR();
#define PK(L, H) (bf16x8){L[0], L[1], L[2], L[3], H[0], H[1], H[2], H[3]}
    od = __builtin_amdgcn_mfma_f32_32x32x16_bf16(pa0, PK(l0, h0), od, 0, 0, 0);
    od = __builtin_amdgcn_mfma_f32_32x32x16_bf16(pa1, PK(l1, h1), od, 0, 0, 0);
    od = __builtin_amdgcn_mfma_f32_32x32x16_bf16(pa2, PK(l2, h2), od, 0, 0, 0);
    od = __builtin_amdgcn_mfma_f32_32x32x16_bf16(pa3, PK(l3, h3), od, 0, 0, 0);
#undef PK
}
__device__ __forceinline__ void pv_d0(f32x16* o, int vb, bf16x8 pa0, bf16x8 pa1, bf16x8 pa2, bf16x8 pa3) {
    pv_one<0>(o[0], vb, pa0, pa1, pa2, pa3); pv_one<1>(o[1], vb, pa0, pa1, pa2, pa3); pv_one<2>(o[2], vb, pa0, pa1, pa2, pa3); pv_one<3>(o[3], vb, pa0, pa1, pa2, pa3);
}

__device__ __forceinline__ void unit(bf16_t* P, const float* kmean, int b, int h, int qb, lptr lds, unsigned ldsaddr, bool dry) {
    int tid_ = threadIdx.x; asm volatile("" : "+v"(tid_));
    const int tid = tid_, wid = __builtin_amdgcn_readfirstlane(tid >> 6), lane = tid & 63, r32 = lane & 31, hi = lane >> 5;
    lptr V_lds = lds + OFF_V; lptr K_lds = lds + OFF_K;
    LAS float* wsl = (LAS float*)(lds + OFF_WS) + wid * 64; LAS float* li_l = wsl; LAS float* al_l = wsl + 32;
    const int q0 = qb * 256, tpos = q0 + wid * 32 + r32;
    const bf16_t* Qw = P + (size_t)(b * SEQ + tpos) * PP + h * 128 + hi * 8;
    const bf16_t* Kh = P + (size_t)(b * SEQ) * PP + 1024 + h * 128;
    const bf16_t* Vh = P + (size_t)(b * SEQ) * PP + 2048 + h * 128;
    float m_reg = -1e30f, l_reg = 0; f32x16 o[4] = {}; bf16x8 qr[8];
#pragma unroll
    for (int d0 = 0; d0 < 8; ++d0) qr[d0] = *(const bf16x8*)(Qw + d0 * 16);
    const float slope = exp2f(-(float)(h + 1));
    unsigned selmask = 0u;
    {
        float v0 = -INFINITY, v1 = -INFINITY, v2 = -INFINITY; int i0 = -1, i1 = -1, i2 = -1;
        { const int n_ = tid >> 5, d_ = (tid & 31) * 4; const float* km = kmean + ((size_t)((b * 8 + h) * 16 + n_)) * 256 + d_;
          *(LAS f32x4*)(lds + tid * 16) = *(const f32x4*)km + *(const f32x4*)(km + 128); }
        float qf[64];
#pragma unroll
        for (int d0 = 0; d0 < 8; ++d0)
#pragma unroll
            for (int e = 0; e < 8; ++e) qf[d0 * 8 + e] = bf2f((bf16_t)qr[d0][e]);
        __syncthreads();
        for (int n = 0; n < qb; ++n) {
            LAS const float* km = (LAS const float*)(lds + n * 512) + hi * 8;
            float s = 0.f;
#pragma unroll
            for (int d0 = 0; d0 < 8; ++d0) { const f32x4 ka = *(LAS const f32x4*)(km + d0 * 16), kb = *(LAS const f32x4*)(km + d0 * 16 + 4);
                s += qf[d0 * 8 + 0] * ka[0] + qf[d0 * 8 + 1] * ka[1] + qf[d0 * 8 + 2] * ka[2] + qf[d0 * 8 + 3] * ka[3]
                   + qf[d0 * 8 + 4] * kb[0] + qf[d0 * 8 + 5] * kb[1] + qf[d0 * 8 + 6] * kb[2] + qf[d0 * 8 + 7] * kb[3]; }
            s += __shfl_xor(s, 32);
            if (s > v0) { v2 = v1; i2 = i1; v1 = v0; i1 = i0; v0 = s; i0 = n; }
            else if (s > v1) { v2 = v1; i2 = i1; v1 = s; i1 = n; }
            else if (s > v2) { v2 = s; i2 = n; }
        }
        __syncthreads();
        if (i0 >= 0) selmask |= 1u << i0; if (i1 >= 0) selmask |= 1u << i1; if (i2 >= 0) selmask |= 1u << i2;
    }
    const int sr = tid >> 4, sc = (tid & 15) * 8, vst0 = v_st(sr, sc), vst1 = v_st(32 + sr, sc);
    const int vb0 = (int)ldsaddr + OFF_V + v_rd_base(lane);
    struct { bf16x8 vs0, vs1, ks0, ks1; } sr_[2];
#define SLOAD(i, k0) do { sr_[i].vs0 = *(const bf16x8*)(&Vh[(size_t)((k0) + sr) * PP + sc]); sr_[i].vs1 = *(const bf16x8*)(&Vh[(size_t)((k0) + 32 + sr) * PP + sc]); \
    sr_[i].ks0 = *(const bf16x8*)(&Kh[(size_t)((k0) + sr) * PP + sc]); sr_[i].ks1 = *(const bf16x8*)(&Kh[(size_t)((k0) + 32 + sr) * PP + sc]); } while (0)
#define SWRITE(bb, i) do { *(LAS bf16x8*)(V_lds + (bb) * SHM_V + vst0) = sr_[i].vs0;          \
    *(LAS bf16x8*)(V_lds + (bb) * SHM_V + vst1) = sr_[i].vs1; const int kc = sc * 2;               \
    *(LAS bf16x8*)(K_lds + (bb) * SHM_K + KSWZ(sr, kc)) = sr_[i].ks0;                       \
    *(LAS bf16x8*)(K_lds + (bb) * SHM_K + KSWZ(32 + sr, kc)) = sr_[i].ks1; } while (0)
#define SWAIT() asm volatile("s_waitcnt vmcnt(4)" ::: "memory")
#define RESC(a) do { if (__any((a) < 1.f)) { if (hi == 0) al_l[r32] = (a); asm volatile("s_waitcnt lgkmcnt(0)" ::: "memory"); \
    _Pragma("unroll") for (int d = 0; d < 4; ++d) _Pragma("unroll") for (int r = 0; r < 16; ++r) o[d][r] *= al_l[crow(r, hi)]; } } while (0)
#define PSM(P0, P1, MN, AL, jj) do { const int j_ = (jj), n_ = j_ >> 2, k0_ = j_ * 64; const bool isd_ = n_ == qb; \
    const bool ok_ = isd_ || ((selmask >> n_) & 1u); const float base_ = slope * (float)(k0_ + 4 * hi - tpos); \
    const bool nm_ = isd_ && (k0_ + 63 > q0 + wid * 32); \
    partialSM(P0, P1, m_reg, MN, AL, slope, base_, ok_, nm_, tpos - k0_ - 4 * hi); } while (0)
    f32x16 pA0, pA1, pB0, pB1; float mnA, mnB, alA, alB; bf16x8 pa0, pa1, pa2, pa3; const int NT = 4 * (qb + 1);
    constexpr int SE = 0, SO = 1;
    SLOAD(SE, 0); asm volatile("s_waitcnt vmcnt(0)" ::: "memory"); SWRITE(0, SE); __syncthreads();
    qkt(pA0, pA1, K_lds, qr, r32, hi); PSM(pA0, pA1, mnA, alA, 0);
    SLOAD(SO, 64); if (2 < NT) SLOAD(SE, 128);
    SWAIT(); SWRITE(1, SO); __syncthreads();
    for (int j = 1; j + 1 < NT; j += 2) {
        SBAR(); qkt(pB0, pB1, K_lds + SHM_K, qr, r32, hi);
        finishSM(pA0, pA1, alA, l_reg, pa0, pa1, pa2, pa3); SBAR();
        SLOAD(SO, (j + 2) * 64); SBAR();
        pv_d0(o, vb0, pa0, pa1, pa2, pa3); PSM(pB0, pB1, mnB, alB, j);
        __syncthreads(); SWAIT(); SWRITE(0, SE);
        RESC(alB); __syncthreads();
        SBAR(); qkt(pA0, pA1, K_lds, qr, r32, hi);
        finishSM(pB0, pB1, alB, l_reg, pa0, pa1, pa2, pa3); SBAR();
        if (j + 3 < NT) SLOAD(SE, (j + 3) * 64); SBAR();
        pv_d0(o, vb0 + SHM_V, pa0, pa1, pa2, pa3); PSM(pA0, pA1, mnA, alA, j + 1);
        __syncthreads(); SWAIT(); SWRITE(1, SO);
        RESC(alA); __syncthreads();
    }
    SBAR(); qkt(pB0, pB1, K_lds + SHM_K, qr, r32, hi);
    finishSM(pA0, pA1, alA, l_reg, pa0, pa1, pa2, pa3); SBAR();
    pv_d0(o, vb0, pa0, pa1, pa2, pa3); PSM(pB0, pB1, mnB, alB, NT - 1);
    __syncthreads(); RESC(alB);
    finishSM(pB0, pB1, alB, l_reg, pa0, pa1, pa2, pa3); SBAR();
    pv_d0(o, vb0 + SHM_V, pa0, pa1, pa2, pa3);
    if (hi == 0) li_l[r32] = l_reg; asm volatile("s_waitcnt lgkmcnt(0)" ::: "memory");
    float rli[16];
#pragma unroll
    for (int r = 0; r < 16; ++r) rli[r] = __builtin_amdgcn_rcpf(li_l[crow(r, hi)]);
    bf16_t* Ow = P + (size_t)(b * SEQ + q0 + wid * 32) * PP + h * 128;
#pragma unroll
    for (int r = 0; r < 16; ++r) { const int orow = crow(r, hi);
#pragma unroll
        for (int d0 = 0; d0 < 4; ++d0) if (!dry) Ow[(size_t)orow * PP + d0 * 32 + r32] = (bf16_t)f2bf(o[d0][r] * rli[r]); }
    __syncthreads();
#undef SLOAD
#undef SWRITE
#undef SWAIT
#undef RESC
#undef PSM
}
}
__device__ __forceinline__ void phase_attn(Frame& F, bf16_t* P, const float* kmean, bool dry = false) {
    for (int pi = F.bid; pi < 256; pi += F.G) {
        const int xcd = pi & 7, slot = pi >> 3, bh = xcd * 4 + (slot >> 3), p = slot & 7;
        att::unit(P, kmean, bh >> 3, bh & 7, 15 - p, (att::lptr)F.lds, (unsigned)(uintptr_t)F.ldsg, dry);
        att::unit(P, kmean, bh >> 3, bh & 7, p, (att::lptr)F.lds, (unsigned)(uintptr_t)F.ldsg, dry);
    }
}


namespace scn {
using att::bf16x8; using att::f32x16; using att::lptr; using att::s16x4;
constexpr int HSLOT = 32768, O_VI = 0, O_BK = 16384, O_AQ = 24576;
constexpr int X_WS = RING_BYTES + 1024, X_SMALL = RING_BYTES + 4096;
__device__ __forceinline__ int swz(int row, int chunk) { return row * 128 + ((chunk ^ ((row >> 1) & 7)) << 4); }

__device__ __forceinline__ void stage_small(const ScanArgs& a, int row0, lptr lds, int tid) {
    *(LAS f32x4*)(lds + X_SMALL + tid * 16) = *(const f32x4*)(a.small + (size_t)row0 * SMALLP + tid * 4);
}
__device__ __forceinline__ void stage_v(const ScanArgs& a, int row0, int grp, int h, lptr slot, int ht) {
    const bf16_t* Vg = a.P + (size_t)row0 * PP + (grp == 0 ? C_GV : C_MV) + h * 128;
    bf16x8 v[8];
#pragma unroll
    for (int i = 0; i < 8; ++i) { const int idx = ht + 128 * i, srow = idx >> 4, sc = (idx & 15) * 8; v[i] = *(const bf16x8*)(Vg + (size_t)srow * PP + sc); }
#pragma unroll
    for (int i = 0; i < 8; ++i) { const int idx = ht + 128 * i, srow = idx >> 4, sc = (idx & 15) * 8; *(LAS bf16x8*)(slot + O_VI + att::v_st(srow, sc)) = v[i]; }
}
template <int MODE>
__device__ __forceinline__ void gate_step(const ScanArgs& a, int b, int c, int grp, int h, int half, lptr lds, lptr slot, int lane, float& bc_end, float& nsum) {
    const int k = lane, row0 = b * SEQ + c * CH, t0 = 32 * half;
    LAS const float* sml = (LAS const float*)(lds + X_SMALL);
    float bc = 0.f; nsum = 0.f;
    unsigned rq[32], rk[32];
    if (grp == 0) {
        float w2r[16];
#pragma unroll
        for (int r = 0; r < 16; ++r) w2r[r] = a.w2[r * 256 + h * 64 + k];
        const float bg = a.bgate[h * 64 + k];
#pragma unroll
        for (int i = 0; i < 32; ++i) { const bf16_t* pr = a.P + (size_t)(row0 + t0 + i) * PP; rk[i] = pr[C_GK + h * 64 + k]; if (MODE == 3) rq[i] = pr[C_GQ + h * 64 + k]; }
        if (half == 1) {
#pragma unroll 4
            for (int t = 0; t < 32; ++t) { float z = bg;
#pragma unroll
                for (int r4 = 0; r4 < 4; ++r4) { const f32x4 g = *(LAS const f32x4*)(sml + t * 32 + r4 * 4); z += g[0] * w2r[r4 * 4] + g[1] * w2r[r4 * 4 + 1] + g[2] * w2r[r4 * 4 + 2] + g[3] * w2r[r4 * 4 + 3]; }
                bc += logsigmoidf_(z) * (1.f / 16.f); }
        }
#pragma unroll
        for (int i8 = 0; i8 < 4; ++i8) {
            unsigned pk[8];
#pragma unroll
            for (int e = 0; e < 8; ++e) { if ((e & 1) == 0) asm volatile("" ::: "memory"); const int i = i8 * 8 + e, t = t0 + i; float z = bg;
#pragma unroll
                for (int r4 = 0; r4 < 4; ++r4) { const f32x4 g = *(LAS const f32x4*)(sml + t * 32 + r4 * 4); z += g[0] * w2r[r4 * 4] + g[1] * w2r[r4 * 4 + 1] + g[2] * w2r[r4 * 4 + 2] + g[3] * w2r[r4 * 4 + 3]; }
                bc += logsigmoidf_(z) * (1.f / 16.f);
                const float bv = __uint_as_float(rk[i] << 16) * __expf(-bc); nsum += bv; pk[e] = f2bf(bv);
                if (MODE == 3) { const float av = __uint_as_float(rq[i] << 16) * 0.125f * __expf(bc);
                    *(LAS bf16_t*)(slot + O_BK + swz(t, k >> 3) + (k & 7) * 2) = (bf16_t)pk[e];
                    *(LAS bf16_t*)(slot + O_AQ + swz(t, k >> 3) + (k & 7) * 2) = (bf16_t)f2bf(av); } }
            if (MODE == 1) { u32x4 w; w.x = pk[0] | (pk[1] << 16); w.y = pk[2] | (pk[3] << 16); w.z = pk[4] | (pk[5] << 16); w.w = pk[6] | (pk[7] << 16);
                *(LAS u32x4*)(slot + O_BK + swz(k, (t0 >> 3) + i8)) = w; }
        }
    } else {
        const float bi = a.bif[h], bf = a.bif[4 + h];
        const float wk0 = a.convw[0 * 512 + 256 + h * 64 + k], wk1 = a.convw[1 * 512 + 256 + h * 64 + k], wk2 = a.convw[2 * 512 + 256 + h * 64 + k], wk3 = a.convw[3 * 512 + 256 + h * 64 + k];
        float wq0 = 0.f, wq1 = 0.f, wq2 = 0.f, wq3 = 0.f;
        if (MODE == 3) { wq0 = a.convw[0 * 512 + h * 64 + k]; wq1 = a.convw[1 * 512 + h * 64 + k]; wq2 = a.convw[2 * 512 + h * 64 + k]; wq3 = a.convw[3 * 512 + h * 64 + k]; }
#pragma unroll
        for (int i = 0; i < 32; ++i) { const bf16_t* pr = a.P + (size_t)(row0 + t0 + i) * PP; rk[i] = pr[C_MK + h * 64 + k]; if (MODE == 3) rq[i] = pr[C_MQ + h * 64 + k]; }
        float k1 = 0.f, k2 = 0.f, k3 = 0.f, q1 = 0.f, q2 = 0.f, q3 = 0.f;
        if (c * CH + t0 > 0) {
            const bf16_t* p1 = a.P + (size_t)(row0 + t0 - 1) * PP; const bf16_t* p2 = p1 - PP; const bf16_t* p3 = p2 - PP;
            k1 = bf2f(p1[C_MK + h * 64 + k]); k2 = bf2f(p2[C_MK + h * 64 + k]); k3 = bf2f(p3[C_MK + h * 64 + k]);
            if (MODE == 3) { q1 = bf2f(p1[C_MQ + h * 64 + k]); q2 = bf2f(p2[C_MQ + h * 64 + k]); q3 = bf2f(p3[C_MQ + h * 64 + k]); }
        }
        if (half == 1) {
#pragma unroll 4
            for (int t = 0; t < 32; ++t) bc += logsigmoidf_(sml[t * 32 + 20 + h] + bf);
        }
#pragma unroll
        for (int i8 = 0; i8 < 4; ++i8) {
            unsigned pk[8];
#pragma unroll
            for (int e = 0; e < 8; ++e) { if ((e & 3) == 0) asm volatile("" ::: "memory"); const int i = i8 * 8 + e, t = t0 + i;
                bc += logsigmoidf_(sml[t * 32 + 20 + h] + bf);
                const float ip = sml[t * 32 + 16 + h] + bi;
                const float kc = __uint_as_float(rk[i] << 16);
                const float ck = wk0 * k3 + wk1 * k2 + wk2 * k1 + wk3 * kc; k3 = k2; k2 = k1; k1 = kc;
                const float bv = siluf_(ck) * 0.125f * __expf(ip - bc); nsum += bv; pk[e] = f2bf(bv);
                if (MODE == 3) { const float qc = __uint_as_float(rq[i] << 16);
                    const float cq = wq0 * q3 + wq1 * q2 + wq2 * q1 + wq3 * qc; q3 = q2; q2 = q1; q1 = qc;
                    const float av = siluf_(cq) * __expf(bc);
                    *(LAS bf16_t*)(slot + O_BK + swz(t, k >> 3) + (k & 7) * 2) = (bf16_t)pk[e];
                    *(LAS bf16_t*)(slot + O_AQ + swz(t, k >> 3) + (k & 7) * 2) = (bf16_t)f2bf(av); } }
            if (MODE == 1) { u32x4 w; w.x = pk[0] | (pk[1] << 16); w.y = pk[2] | (pk[3] << 16); w.z = pk[4] | (pk[5] << 16); w.w = pk[6] | (pk[7] << 16);
                *(LAS u32x4*)(slot + O_BK + swz(k, (t0 >> 3) + i8)) = w; }
        }
    }
    bc_end = bc;
}
}

__device__ __forceinline__ void phase_scan1m(Frame& F, const ScanArgs& a) {
    using namespace scn;
    const int wid = __builtin_amdgcn_readfirstlane(threadIdx.x >> 6);
    const int hw = wid >> 1, half = wid & 1;
    lptr lds = (lptr)F.lds; lptr slot = lds + hw * HSLOT;
    LAS float* wsl = (LAS float*)(lds + X_WS) + wid * 64;
    const unsigned ldsaddr = (unsigned)(uintptr_t)F.ldsg;
    for (int unit = F.bid; unit < BATCH * NCH; unit += F.G) {
        const int b = unit / NCH, c = unit % NCH, row0 = b * SEQ + c * CH;
        stage_small(a, row0, lds, opaque_i(threadIdx.x));
        for (int grp = 0; grp < 2; ++grp) {
            const int tid = opaque_i(threadIdx.x), lane = tid & 63, r32 = lane & 31, hi = lane >> 5;
            const int h = hw, bh = b * 4 + h;
            stage_v(a, row0, grp, h, slot, tid & 127);
            __syncthreads();
            float bc_end, nsum;
            gate_step<1>(a, b, c, grp, h, half, lds, slot, lane, bc_end, nsum);
            if (half == 1) a.dec[((size_t)(grp * 16 + bh) * NCH + c) * 64 + lane] = __expf(bc_end);
            if (grp == 1) wsl[lane] = nsum;
            __syncthreads();
            if (grp == 1 && half == 0) { LAS float* other = (LAS float*)(lds + X_WS) + (wid + 1) * 64; a.NS[((size_t)bh * NCH + c) * 64 + lane] = wsl[lane] + other[lane]; }
            bf16x8 pa[4];
#pragma unroll
            for (int ks = 0; ks < 4; ++ks) pa[ks] = *(LAS bf16x8*)(slot + O_BK + swz(32 * half + r32, 2 * ks + hi));
            f32x16 o[4] = {};
            att::pv_d0(o, (int)ldsaddr + hw * HSLOT + O_VI + att::v_rd_base(lane), pa[0], pa[1], pa[2], pa[3]);
            bf16_t* st = a.ST + st_off(grp, bh, c);
#pragma unroll
            for (int d0 = 0; d0 < 4; ++d0)
#pragma unroll
                for (int g = 0; g < 4; ++g) {
                    const unsigned long long w = (unsigned long long)pk2(o[d0][4 * g], o[d0][4 * g + 1]) | ((unsigned long long)pk2(o[d0][4 * g + 2], o[d0][4 * g + 3]) << 32);
                    *(unsigned long long*)(st + (size_t)(32 * d0 + r32) * 64 + 32 * half + 8 * g + 4 * hi) = w; }
            __syncthreads();
        }
    }
}
__device__ __forceinline__ void phase_scan3m(Frame& F, const ScanArgs& a, bool dry = false) {
    using namespace scn;
    const int wid = __builtin_amdgcn_readfirstlane(threadIdx.x >> 6);
    const int hw = wid >> 1, half = wid & 1;
    lptr lds = (lptr)F.lds; lptr slot = lds + hw * HSLOT;
    LAS float* wsl = (LAS float*)(lds + X_WS) + wid * 64;
    const unsigned ldsaddr = (unsigned)(uintptr_t)F.ldsg;
    for (int unit = F.bid; unit < BATCH * NCH; unit += F.G) {
        const int b = unit / NCH, c = unit % NCH, row0 = b * SEQ + c * CH;
        stage_small(a, row0, lds, opaque_i(threadIdx.x));
        for (int grp = 0; grp < 2; ++grp) {
            const int tid = opaque_i(threadIdx.x), lane = tid & 63, r32 = lane & 31, hi = lane >> 5;
            const int h = hw, bh = b * 4 + h;
            stage_v(a, row0, grp, h, slot, tid & 127);
            __syncthreads();
            float bc_end, nsum;
            gate_step<3>(a, b, c, grp, h, half, lds, slot, lane, bc_end, nsum);
            __syncthreads();
            bf16x8 qr[4];
#pragma unroll
            for (int d0 = 0; d0 < 4; ++d0) qr[d0] = *(LAS bf16x8*)(slot + O_AQ + swz(32 * half + r32, 2 * d0 + hi));
            f32x16 p0 = {}, p1 = {};
#pragma unroll
            for (int d0 = 0; d0 < 4; ++d0) {
                const bf16x8 b0 = *(LAS bf16x8*)(slot + O_BK + swz(r32, 2 * d0 + hi));
                const bf16x8 b1 = *(LAS bf16x8*)(slot + O_BK + swz(32 + r32, 2 * d0 + hi));
                p0 = __builtin_amdgcn_mfma_f32_32x32x16_bf16(b0, qr[d0], p0, 0, 0, 0);
                p1 = __builtin_amdgcn_mfma_f32_32x32x16_bf16(b1, qr[d0], p1, 0, 0, 0); }
            const int dq = 32 * half + r32 - 4 * hi;
            float ps = 0.f;
#pragma unroll
            for (int r = 0; r < 16; ++r) { const int cc = (r & 3) + 8 * (r >> 2); if (cc > dq) p0[r] = 0.f; if (cc + 32 > dq) p1[r] = 0.f; ps += p0[r] + p1[r]; }
            bf16x8 pa0, pa1, pa2, pa3;
#define PK4(P, BASE, OUT) do { unsigned a0 = att::cvtpk(P[BASE + 0], P[BASE + 1]), a1 = att::cvtpk(P[BASE + 2], P[BASE + 3]);   \
    unsigned b0_ = att::cvtpk(P[BASE + 4], P[BASE + 5]), b1_ = att::cvtpk(P[BASE + 6], P[BASE + 7]);                              \
    auto r0 = __builtin_amdgcn_permlane32_swap(a0, b0_, false, false); auto r1 = __builtin_amdgcn_permlane32_swap(a1, b1_, false, false); \
    u32x4 w = {r0[0], r1[0], r0[1], r1[1]}; OUT = *reinterpret_cast<bf16x8*>(&w); } while (0)
            PK4(p0, 0, pa0); PK4(p0, 8, pa1); PK4(p1, 0, pa2); PK4(p1, 8, pa3);
#undef PK4
            float den = 0.f;
            if (grp == 1) {
                const float* ns = a.NS + ((size_t)bh * NCH + c) * 64 + hi * 8;
#pragma unroll
                for (int d0 = 0; d0 < 4; ++d0) { const f32x4 na = *(const f32x4*)(ns + d0 * 16), nb = *(const f32x4*)(ns + d0 * 16 + 4); const bf16x8 q = qr[d0];
                    ps += bf2f((bf16_t)q[0]) * na[0] + bf2f((bf16_t)q[1]) * na[1] + bf2f((bf16_t)q[2]) * na[2] + bf2f((bf16_t)q[3]) * na[3]
                        + bf2f((bf16_t)q[4]) * nb[0] + bf2f((bf16_t)q[5]) * nb[1] + bf2f((bf16_t)q[6]) * nb[2] + bf2f((bf16_t)q[7]) * nb[3]; }
                den = ps + __shfl_xor(ps, 32);
            }
            f32x16 o[4] = {};
            att::pv_d0(o, (int)ldsaddr + hw * HSLOT + O_VI + att::v_rd_base(lane), pa0, pa1, pa2, pa3);
            const bf16_t* st = a.ST + st_off(grp, bh, c);
#pragma unroll
            for (int d0 = 0; d0 < 4; ++d0) {
                bf16x8 sv[4];
#pragma unroll
                for (int ks = 0; ks < 4; ++ks) sv[ks] = *(const bf16x8*)(st + (size_t)(32 * d0 + r32) * 64 + 16 * ks + 8 * hi);
#pragma unroll
                for (int ks = 0; ks < 4; ++ks) o[d0] = __builtin_amdgcn_mfma_f32_32x32x16_bf16(qr[ks], sv[ks], o[d0], 0, 0, 0);
            }
            if (grp == 1) { if (hi == 0) wsl[r32] = den; asm volatile("s_waitcnt lgkmcnt(0)" ::: "memory"); }
            const int gcol = (grp == 0 ? C_GR : C_MO) + h * 128;
            const float* gain = (grp == 0 ? a.gla_gain : a.ml_gain) + h * 128;
            float gn[4];
#pragma unroll
            for (int d0 = 0; d0 < 4; ++d0) gn[d0] = gain[32 * d0 + r32];
#pragma unroll
            for (int r = 0; r < 16; ++r) {
                const int t = 32 * half + att::crow(r, hi);
                bf16_t* pr = a.P + (size_t)(row0 + t) * PP + gcol + r32;
                float ov[4], gv[4];
#pragma unroll
                for (int d0 = 0; d0 < 4; ++d0) { ov[d0] = o[d0][r]; gv[d0] = bf2f(pr[32 * d0]); }
                if (grp == 1) { const float dd = 1.f / fmaxf(fabsf(wsl[att::crow(r, hi)]), 1.f);
#pragma unroll
                    for (int d0 = 0; d0 < 4; ++d0) ov[d0] = ov[d0] * dd * sigmoidf_(gv[d0]); }
                float ss = (ov[0] * ov[0] + ov[1] * ov[1]) + (ov[2] * ov[2] + ov[3] * ov[3]);
                ss += __shfl_xor(ss, 1); ss += __shfl_xor(ss, 2); ss += __shfl_xor(ss, 4); ss += __shfl_xor(ss, 8); ss += __shfl_xor(ss, 16);
                const float rstd = rsqrtf(ss * (1.f / 128.f) + EPS);
#pragma unroll
                for (int d0 = 0; d0 < 4; ++d0) { float y = ov[d0] * rstd * gn[d0]; if (grp == 0) y *= siluf_(gv[d0]); if (!dry) pr[32 * d0] = (bf16_t)f2bf(y); }
            }
            __syncthreads();
        }
    }
}

__global__ void __launch_bounds__(NTHR, 2) mk_fwd(Args args) {
    extern __shared__ __attribute__((aligned(16))) unsigned char lds[];
    Frame F;
    F.lds = (LAS unsigned char*)lds; F.ldsg = lds;
    F.tid = threadIdx.x; F.lane = F.tid & 63; F.wave = __builtin_amdgcn_readfirstlane(F.tid >> 6);
    F.G = gridDim.x; F.bid = blockIdx.x;
    volatile LAS unsigned* MISC = (volatile LAS unsigned*)(F.lds + MISC_OFF);
    for (int u = F.tid; u < (LDS_BYTES - RING_BYTES) / 4; u += NTHR) ((LAS unsigned*)(F.lds + RING_BYTES))[u] = 0u;
    __syncthreads();
    kargp_t kp0 = karg_base();
    unsigned char* ws = karg_ws(kp0);
    XcdBarrier bar; bar.bar = (unsigned*)(ws + WS_CTL) + 4096; bar.x = 0; bar.st = nullptr;
    if (!MK_MULTI) bar = xcd_barrier_post((unsigned*)(ws + WS_CTL) + 4096, MISC + 8);
    const int lo = args.ph_lo, hi = args.ph_hi;
#define IN(k) (lo <= (k) && (k) < hi)
#define SEAM(k) do { if (!MK_MULTI && (k) + 1 < hi) { xcd_barrier(bar); if (RPT & 2048) xcd_barrier(bar); } } while (0)

    float* rss = (float*)(ws + WS_RSS); float* small = (float*)(ws + WS_SMALL); float* kmean = (float*)(ws + WS_KMEAN);
    bf16_t* xb = (bf16_t*)(ws + WS_XB); bf16_t* P = (bf16_t*)(ws + WS_P);
    float* out = karg_out(kp0);

    if (IN(0)) { if (PH_MASK & 1) { phase_prologue(F); if (RPT & 1) phase_prologue(F); } SEAM(0); }

    for (int l = 0; l < DEPTH; ++l) {
        const int j = l >> 1, base = 1 + l * 8;
        unsigned char* wj = ws + WS_W + j * W_MIXSZ;
        unsigned char* wl = ws + WS_W + W_FFN0 + l * W_FFNSZ;
        kargp_t kp = karg_base();
        const float* xin = l == 0 ? karg_in(kp, 0) : out;
        if ((l & 1) == 0) {
            ScanArgs sa{P, small, karg_in(kp, 4) + (size_t)j * 16 * 256, karg_in(kp, 5) + j * 256, karg_in(kp, 6) + j * 512, karg_in(kp, 7) + (size_t)j * 4 * 512, karg_in(kp, 8) + j * 8, karg_in(kp, 9) + j * 512,
                        (bf16_t*)(ws + WS_XB), (float*)(ws + WS_DEC), (float*)(ws + WS_NS)};
            if (IN(base + 0)) {
                pg8::Gemm g{xb, (const bf16_t*)(wj + W_IN), M, HYB_PAD, DM, DM}; pg8::StaticOrder S; S.init(M, HYB_PAD, F.G, F.bid);
                EpiRowBf16 E{P, PP, rss, small, 12};
                if (PH_MASK & 64) { const int nrep_ = (RPT & 2) ? 2 : 1; for (int rep_ = 0; rep_ < nrep_; ++rep_) { pg8::gemm_phase<EpiRowBf16, pg8::StaticOrder, true, true>(F.lds, g, S, E); } }
                SEAM(base + 0);
            }
            if (IN(base + 1)) { if (PH_MASK & 2) { if (SCAN_SIMPLE) phase_scan1(F, sa); else { phase_scan1m(F, sa); if (RPT & 4) phase_scan1m(F, sa); } } SEAM(base + 1); }
            if (IN(base + 2)) { if (PH_MASK & 4) { if (RPT & 8) phase_scan2(F, sa, RPT && opaque_i(1) != 0); phase_scan2(F, sa, RPT && opaque_i(0) != 0); } SEAM(base + 2); }
            if (IN(base + 3)) { if (PH_MASK & 8) { if (SCAN_SIMPLE) phase_scan3(F, sa); else { if (RPT & 16) phase_scan3m(F, sa, RPT && opaque_i(1) != 0); phase_scan3m(F, sa, RPT && opaque_i(0) != 0); } } SEAM(base + 3); }
            if (IN(base + 4)) {
                pg8::Gemm g{P + C_GR, (const bf16_t*)(wj + W_OUT), M, DM, DM, PP}; pg8::StaticOrder S; S.init(M, DM, F.G, F.bid);
                EpiRes E{xin, out, xb, rss, 0};
                if (PH_MASK & 128) { const int nrep_ = (RPT & 32) ? 2 : 1; for (int rep_ = 0; rep_ < nrep_; ++rep_) { E.dry = RPT ? opaque_i(rep_ + 1 < nrep_ ? 1 : 0) : 0; pg8::gemm_phase<EpiRes, pg8::StaticOrder, true, true>(F.lds, g, S, E); } }
                SEAM(base + 4);
            }
        } else {
            if (IN(base + 0)) {
                pg8::Gemm g{xb, (const bf16_t*)(wj + W_QKV), M, 3 * DM, DM, DM}; pg8::StaticOrder S; S.init(M, 3 * DM, F.G, F.bid);
                EpiRowBf16 E{P, PP, rss, small, -1};
                if (PH_MASK & 256) { const int nrep_ = (RPT & 64) ? 2 : 1; for (int rep_ = 0; rep_ < nrep_; ++rep_) { pg8::gemm_phase<EpiRowBf16, pg8::StaticOrder, true, true>(F.lds, g, S, E); } }
                SEAM(base + 0);
            }
            if (IN(base + 1)) { if (PH_MASK & 16) { if (RPT & 128) phase_qkn2(F, P, karg_in(kp, 12) + j * 128, karg_in(kp, 13) + j * 128, kmean, RPT && opaque_i(1) != 0); phase_qkn2(F, P, karg_in(kp, 12) + j * 128, karg_in(kp, 13) + j * 128, kmean, RPT && opaque_i(0) != 0); } SEAM(base + 1); }
            if (IN(base + 2)) { if (PH_MASK & 32) { if (ATTN_SIMPLE) phase_attn_simple(F, P, kmean); else { if (RPT & 256) phase_attn(F, P, kmean, RPT && opaque_i(1) != 0); phase_attn(F, P, kmean, RPT && opaque_i(0) != 0); } } SEAM(base + 2); }
            if (IN(base + 3)) {
                pg8::Gemm g{P, (const bf16_t*)(wj + W_O), M, DM, DM, PP}; pg8::StaticOrder S; S.init(M, DM, F.G, F.bid);
                EpiRes E{xin, out, xb, rss, 0};
                if (PH_MASK & 512) { const int nrep_ = (RPT & 32) ? 2 : 1; for (int rep_ = 0; rep_ < nrep_; ++rep_) { E.dry = RPT ? opaque_i(rep_ + 1 < nrep_ ? 1 : 0) : 0; pg8::gemm_phase<EpiRes, pg8::StaticOrder, true, true>(F.lds, g, S, E); } }
                SEAM(base + 3);
            }
        }
        if (IN(base + 5)) {
            pg8::Gemm g{xb, (const bf16_t*)(wl + W_GU), M, 2 * DFF, DM, DM}; pg8::StaticOrder S; S.init(M, 2 * DFF, F.G, F.bid);
            EpiFfn E{P, rss};
            if (PH_MASK & 1024) { const int nrep_ = (RPT & 512) ? 2 : 1; for (int rep_ = 0; rep_ < nrep_; ++rep_) { pg8::gemm_phase<EpiFfn, pg8::StaticOrder, true, true>(F.lds, g, S, E); } }
            SEAM(base + 5);
        }
        if (IN(base + 6)) {
            pg8::Gemm g{P, (const bf16_t*)(wl + W_D), M, DM, DFF, DFF}; pg8::StaticOrder S; S.init(M, DM, F.G, F.bid);
            EpiRes E{out, out, xb, rss, 0};
            if (PH_MASK & 2048) { const int nrep_ = (RPT & 1024) ? 2 : 1; for (int rep_ = 0; rep_ < nrep_; ++rep_) { E.dry = RPT ? opaque_i(rep_ + 1 < nrep_ ? 1 : 0) : 0; pg8::gemm_phase<EpiRes, pg8::StaticOrder, true, true>(F.lds, g, S, E); } }
            SEAM(base + 6);
        }
    }
#undef IN
#undef SEAM
}

extern "C" void kernel_launch(void* const* d_in, const int* in_sizes, int n_in, void* d_out, int out_size, void* d_ws, size_t ws_size, hipStream_t stream) {
    static int grid = 0;
    if (grid == 0) {
        int dev = 0, cus = 0;
        if (n_in != 18 || ws_size < WS_END) { fprintf(stderr, "kernel_launch: unexpected inputs (%d) or workspace (%zu < %zu)\n", n_in, ws_size, (size_t)WS_END); grid = -1; return; }
        if (hipGetDevice(&dev) != hipSuccess || hipDeviceGetAttribute(&cus, hipDeviceAttributeMultiprocessorCount, dev) != hipSuccess) { grid = -1; return; }
        if (hipFuncSetAttribute((const void*)mk_fwd, hipFuncAttributeMaxDynamicSharedMemorySize, LDS_BYTES) != hipSuccess) { grid = -1; return; }
        int per_cu = 0;
        if (hipOccupancyMaxActiveBlocksPerMultiprocessor(&per_cu, (const void*)mk_fwd, NTHR, LDS_BYTES) != hipSuccess || per_cu < 1) { fprintf(stderr, "kernel_launch: occupancy query says %d\n", per_cu); }
        (void)hipGetLastError();
        grid = cus;
    }
    if (grid < 0) return;
    (void)hipMemsetAsync((char*)d_ws + WS_CTL, 0, CTL_ZERO_BYTES, stream);
    Args a{};
    for (int i = 0; i < 18; ++i) a.in[i] = (const float*)d_in[i];
    a.out = (float*)d_out; a.ws = (unsigned char*)d_ws;
#if MK_MULTI
    for (int ph = 0; ph < 1 + DEPTH * 8; ++ph) {
        if (ph > 0) { const int l = (ph - 1) >> 3, s = (ph - 1) & 7; if (s == 7) continue; if ((l & 1) == 0 && s == 7) continue; if ((l & 1) == 1 && s == 4) continue; }
        a.ph_lo = ph; a.ph_hi = ph + 1;
        hipLaunchKernelGGL(mk_fwd, dim3(grid), dim3(NTHR), LDS_BYTES, stream, a);
    }
#else
    a.ph_lo = 0; a.ph_hi = DEPTH * 8;
    hipLaunchKernelGGL(mk_fwd, dim3(grid), dim3(NTHR), LDS_BYTES, stream, a);
#endif
}
```

```cpp
#include <hip/hip_runtime.h>
#include <cstdio>
#include <cstdint>

namespace pg8 {
#define PG8_LAS __attribute__((address_space(3)))
typedef unsigned short bf16_t;
typedef short bf16x8 __attribute__((ext_vector_type(8)));
typedef float f32x4 __attribute__((ext_vector_type(4)));
typedef unsigned u32x4 __attribute__((ext_vector_type(4)));
constexpr int BM = 256, BK = 64, HALF = 128, HTB = HALF * BK * 2  , STAGE_BYTES = 8 * HTB, NXCD = 8, WGM = 8;

__host__ __device__ __forceinline__ int lds_byte(int r, int c) { const int st = (r >> 4) * 2 + (c >> 5), rr = r & 15, cc = c & 31, ob = rr * 64 + cc * 2; return st * 1024 + (ob ^ (((ob >> 9) & 1) << 5)); }
__host__ __device__ __forceinline__ void stage_rc(int b, int& R, int& C) { const int st = b / 1024, sb = b % 1024, swz = sb ^ (((sb >> 9) & 1) << 5); R = (st >> 1) * 16 + swz / 64; C = (st & 1) * 32 + (swz % 64) / 2; }
__host__ __device__ __forceinline__ int perm32(int rho) { const int n = rho >> 4, i = rho & 15; return 8 * (i >> 2) + 4 * n + (i & 3); }

struct Unit { int pm, pn; };
struct Gemm { const bf16_t* A; const bf16_t* Bt; int M, N, K, lda; };

struct StaticOrder {
    int nM, nN, nwg, G, c;
    __host__ __device__ void init(int M, int N, int G_, int c_) { nM = M / BM; nN = N / BM; nwg = nM * nN; G = G_; c = c_; }
    __host__ __device__ bool next(int i, Unit& u) const {
        const long L = (long)i * G + c; if (L >= nwg) return false;
        int wgid = (int)L; { const int q = nwg / NXCD, r = nwg % NXCD, xcd = wgid % NXCD, off = wgid / NXCD; wgid = (xcd < r ? xcd * (q + 1) : r * (q + 1) + (xcd - r) * q) + off; }
        const int nig = WGM * nN, gid = wgid / nig, fm = gid * WGM, gsz = (nM - fm) < WGM ? (nM - fm) : WGM;
        u.pm = fm + ((wgid % nig) % gsz); u.pn = (wgid % nig) / gsz; return true;
    }
    __device__ __forceinline__ void a_ready(const Unit&) const {}
    __device__ __forceinline__ void done(const Unit&) const {}
};
__device__ __forceinline__ unsigned cvt_pk_bf16(float lo, float hi) { unsigned r; asm volatile("v_cvt_pk_bf16_f32 %0, %1, %2" : "=v"(r) : "v"(lo), "v"(hi)); return r; }
template <class Epi, class Sched, bool ALIGN_EPI = false, bool SP2 = false>
__device__ __forceinline__ void gemm_phase(PG8_LAS unsigned char* lds, const Gemm g, const Sched& S, const Epi& E) {
    int tid_ = threadIdx.x; asm volatile("" : "+v"(tid_));
    const int tid = tid_, wid = __builtin_amdgcn_readfirstlane(tid >> 6), lane = tid & 63, wr = wid >> 2, wc = wid & 3, fr = lane & 15, fq = lane >> 4;
    const int K = g.K, nt = K / BK;
    unsigned voffA[2], voffB[2];
#pragma unroll
    for (int i = 0; i < 2; ++i) { int R, C; stage_rc(tid * 16 + i * 8192, R, C); const int Rb = Epi::PERM ? ((R & ~31) + perm32(R & 31)) : R;
        voffA[i] = (unsigned)(R * g.lda + C) * 2u; voffB[i] = (unsigned)(Rb * K + C) * 2u; }
    const size_t kstep = (size_t)(BK * 2);
    const size_t hstepB = (size_t)HALF * K * 2, hstepA = (size_t)HALF * g.lda * 2;
    const size_t tstepA = 2 * hstepA, tstepB = 2 * hstepB;
    const unsigned ldsw = (unsigned)wid * 1024u;
    const int aoff = lds_byte(wr * 64 + fr, fq * 8), boff = lds_byte(wc * 32 + fr, fq * 8);
#define PG8_SA(b, h) (((b) * 2 + (h)) * HTB)
#define PG8_SB(b, h) ((4 + (b) * 2 + (h)) * HTB)
#define PG8_STAGE(bufoff, gbase, voff) do { _Pragma("unroll") for (int _i = 0; _i < 2; ++_i) \
        __builtin_amdgcn_global_load_lds((const unsigned*)((const char*)(gbase) + (voff)[_i]), (PG8_LAS unsigned*)(lds + (bufoff) + ldsw + _i * 8192), 16, 0, 0); } while (0)
#define PG8_LDA(dst, b, h) do { _Pragma("unroll") for (int m = 0; m < 4; ++m) _Pragma("unroll") for (int k = 0; k < 2; ++k) dst[m][k] = *(const PG8_LAS bf16x8*)(lds + PG8_SA(b, h) + aoff + m * 2048 + k * 1024); } while (0)
#define PG8_LDB(dst, b, h) do { _Pragma("unroll") for (int n = 0; n < 2; ++n) _Pragma("unroll") for (int k = 0; k < 2; ++k) dst[n][k] = *(const PG8_LAS bf16x8*)(lds + PG8_SB(b, h) + boff + n * 2048 + k * 1024); } while (0)
#define PG8_MMA(ai, bj, At, Bt) do { __builtin_amdgcn_s_setprio(1); _Pragma("unroll") for (int m = 0; m < 4; ++m) _Pragma("unroll") for (int n = 0; n < 2; ++n) _Pragma("unroll") for (int k = 0; k < 2; ++k) \
        acc[ai][bj][m][n] = __builtin_amdgcn_mfma_f32_16x16x32_bf16(Bt[n][k], At[m][k], acc[ai][bj][m][n], 0, 0, 0); __builtin_amdgcn_s_setprio(0); } while (0)
#define PG8_WAIT_V(n) asm volatile("s_waitcnt vmcnt(" #n ")" ::: "memory")
#define PG8_WAIT_L(n) asm volatile("s_waitcnt lgkmcnt(" #n ")" ::: "memory")
#define PG8_BAR __builtin_amdgcn_s_barrier()
#define PG8_SCHED __builtin_amdgcn_sched_barrier(0)
    Unit cur, nxt; int ui = 0;
    if (!S.next(0, cur)) return;
    f32x4 acc[2][2][4][2];
#pragma unroll
    for (int a = 0; a < 2; ++a)
#pragma unroll
        for (int b = 0; b < 2; ++b)
#pragma unroll
            for (int m = 0; m < 4; ++m)
#pragma unroll
                for (int n = 0; n < 2; ++n) acc[a][b][m][n] = (f32x4){0.f, 0.f, 0.f, 0.f};
    bf16x8 At[4][2], B0[2][2], B1[2][2];
    const char* cA = (const char*)g.A + (size_t)cur.pm * tstepA; const char* cB = (const char*)g.Bt + (size_t)cur.pn * tstepB;
    S.a_ready(cur);
    if constexpr (SP2) {
        PG8_STAGE(PG8_SB(0, 0), cB, voffB); PG8_STAGE(PG8_SB(0, 1), cB + hstepB, voffB); PG8_STAGE(PG8_SA(0, 0), cA, voffA); PG8_STAGE(PG8_SA(0, 1), cA + hstepA, voffA);
        if (wr == 1) PG8_BAR;
        PG8_WAIT_V(2); PG8_BAR;
        PG8_STAGE(PG8_SB(1, 0), cB + kstep, voffB); PG8_STAGE(PG8_SA(1, 0), cA + kstep, voffA); PG8_STAGE(PG8_SB(1, 1), cB + hstepB + kstep, voffB);
        PG8_WAIT_V(6); PG8_BAR;
    } else {
        PG8_STAGE(PG8_SB(0, 0), cB, voffB); PG8_STAGE(PG8_SA(0, 0), cA, voffA); PG8_STAGE(PG8_SB(0, 1), cB + hstepB, voffB); PG8_STAGE(PG8_SA(0, 1), cA + hstepA, voffA);
        if (wr == 1) PG8_BAR;
        PG8_WAIT_V(4); PG8_BAR;
        PG8_STAGE(PG8_SB(1, 0), cB + kstep, voffB); PG8_STAGE(PG8_SA(1, 0), cA + kstep, voffA); PG8_STAGE(PG8_SB(1, 1), cB + hstepB + kstep, voffB);
        PG8_WAIT_V(6); PG8_BAR;
    }
    for (;;) {
        const bool has_next = S.next(ui + 1, nxt);
        const char* nA = has_next ? (const char*)g.A + (size_t)nxt.pm * tstepA : cA; const char* nB = has_next ? (const char*)g.Bt + (size_t)nxt.pn * tstepB : cB;
        for (int t = 0; t < nt; t += 2) {
            const bool last = (t == nt - 2);
            const char* a1 = cA + (size_t)(t + 1) * kstep;
            const char* a2 = last ? nA : cA + (size_t)(t + 2) * kstep; const char* b2 = last ? nB : cB + (size_t)(t + 2) * kstep;
            const char* a3 = a2 + kstep; const char* b3 = b2 + kstep;
            if (last && has_next) S.a_ready(nxt);
            if constexpr (SP2) {
            PG8_LDB(B0, 0, 0); PG8_LDB(B1, 0, 1); PG8_SCHED; PG8_LDA(At, 0, 0); PG8_STAGE(PG8_SA(1, 1), a1 + hstepA, voffA);
            PG8_WAIT_V(8); PG8_WAIT_L(0); PG8_BAR; PG8_MMA(0, 0, At, B0); PG8_MMA(0, 1, At, B1); PG8_BAR; PG8_SCHED;
            PG8_LDA(At, 0, 1); PG8_STAGE(PG8_SB(0, 0), b2, voffB); PG8_STAGE(PG8_SB(0, 1), b2 + hstepB, voffB); PG8_STAGE(PG8_SA(0, 0), a2, voffA);
            PG8_WAIT_V(8); PG8_WAIT_L(0); PG8_BAR; PG8_MMA(1, 0, At, B0); PG8_MMA(1, 1, At, B1); PG8_BAR; PG8_SCHED;
            PG8_LDB(B0, 1, 0); PG8_LDB(B1, 1, 1); PG8_SCHED; PG8_LDA(At, 1, 0); PG8_STAGE(PG8_SA(0, 1), a2 + hstepA, voffA);
            PG8_WAIT_V(8); PG8_WAIT_L(0); PG8_BAR; PG8_MMA(0, 0, At, B0); PG8_MMA(0, 1, At, B1); PG8_BAR; PG8_SCHED;
            PG8_LDA(At, 1, 1); PG8_STAGE(PG8_SB(1, 0), b3, voffB); PG8_STAGE(PG8_SB(1, 1), b3 + hstepB, voffB); PG8_STAGE(PG8_SA(1, 0), a3, voffA);
            PG8_WAIT_V(8); PG8_WAIT_L(0); PG8_BAR; PG8_MMA(1, 0, At, B0); PG8_MMA(1, 1, At, B1); PG8_BAR; PG8_SCHED;
            } else {
            PG8_LDB(B0, 0, 0); PG8_SCHED; PG8_LDA(At, 0, 0); PG8_STAGE(PG8_SA(1, 1), a1 + hstepA, voffA);
            PG8_WAIT_L(8); PG8_BAR; PG8_WAIT_L(0); PG8_MMA(0, 0, At, B0); PG8_BAR; PG8_SCHED;
            PG8_LDB(B1, 0, 1); PG8_STAGE(PG8_SB(0, 0), b2, voffB);
            PG8_BAR; PG8_WAIT_L(0); PG8_MMA(0, 1, At, B1); PG8_BAR;
            PG8_LDA(At, 0, 1); PG8_STAGE(PG8_SA(0, 0), a2, voffA);
            PG8_BAR; PG8_WAIT_L(0); PG8_MMA(1, 0, At, B0); PG8_BAR; PG8_SCHED;
            PG8_STAGE(PG8_SB(0, 1), b2 + hstepB, voffB);
            PG8_WAIT_V(6); PG8_BAR; PG8_MMA(1, 1, At, B1); PG8_BAR;
            PG8_LDB(B0, 1, 0); PG8_SCHED; PG8_LDA(At, 1, 0); PG8_STAGE(PG8_SA(0, 1), a2 + hstepA, voffA);
            PG8_WAIT_L(8); PG8_BAR; PG8_WAIT_L(0); PG8_MMA(0, 0, At, B0); PG8_BAR; PG8_SCHED;
            PG8_LDB(B1, 1, 1); PG8_STAGE(PG8_SB(1, 0), b3, voffB);
            PG8_BAR; PG8_WAIT_L(0); PG8_MMA(0, 1, At, B1); PG8_BAR;
            PG8_LDA(At, 1, 1); PG8_STAGE(PG8_SA(1, 0), a3, voffA);
            PG8_BAR; PG8_WAIT_L(0); PG8_MMA(1, 0, At, B0); PG8_BAR; PG8_SCHED;
            PG8_STAGE(PG8_SB(1, 1), b3 + hstepB, voffB);
            PG8_WAIT_V(6); PG8_BAR; PG8_MMA(1, 1, At, B1); PG8_BAR;
            }
        }
        if constexpr (ALIGN_EPI) { if (wr == 0) PG8_BAR; }
        if constexpr (!Epi::AFTER_DRAIN) { E(acc, cur, wr, wc, fr, fq); S.done(cur); }
        if (!has_next) break;
#pragma unroll
        for (int a = 0; a < 2; ++a)
#pragma unroll
            for (int b = 0; b < 2; ++b)
#pragma unroll
                for (int m = 0; m < 4; ++m)
#pragma unroll
                    for (int n = 0; n < 2; ++n) acc[a][b][m][n] = (f32x4){0.f, 0.f, 0.f, 0.f};
        cur = nxt; cA = nA; cB = nB; ++ui;
        if constexpr (ALIGN_EPI) { if (wr == 1) PG8_BAR; }
    }
    PG8_WAIT_V(0);
    if constexpr (!ALIGN_EPI) { if (wr == 0) PG8_BAR; }
    PG8_BAR;
    if constexpr (Epi::AFTER_DRAIN) { E.fused(acc, cur, wr, wc, fr, fq, lds, wid, lane); S.done(cur); }
#undef PG8_SA
#undef PG8_SB
#undef PG8_STAGE
#undef PG8_LDA
#undef PG8_LDB
#undef PG8_MMA
#undef PG8_WAIT_V
#undef PG8_WAIT_L
#undef PG8_BAR
#undef PG8_SCHED
}
}


typedef unsigned short bf16_t;
typedef float f32x4 __attribute__((ext_vector_type(4)));
typedef unsigned u32x4 __attribute__((ext_vector_type(4)));
#define LAS __attribute__((address_space(3)))
#define GAS __attribute__((address_space(1)))

#ifndef PH_MASK
#define PH_MASK 0xffff
#endif
#ifndef ATTN_SIMPLE
#define ATTN_SIMPLE 0
#endif
#ifndef SCAN_SIMPLE
#define SCAN_SIMPLE 0
#endif
#ifndef RPT
#define RPT 0
#endif
#ifndef VARX
#define VARX 0
#endif
#ifndef MK_MULTI
#define MK_MULTI 0
#endif

constexpr int BATCH = 4, SEQ = 4096, DM = 1024, M = BATCH * SEQ, DEPTH = 4;
constexpr int DFF = 2816;
constexpr int HYB_IN = 3096, HYB_PAD = 3584;
constexpr int NCH = 64, CH = 64;
constexpr float EPS = 1e-6f;
constexpr int PP = 3072;
constexpr int C_GQ = 0, C_GK = 256, C_GV = 512, C_MQ = 1024, C_MK = 1280, C_MV = 1536, C_GR = 2048, C_MO = 2560;
constexpr int SMALLP = 32;

constexpr size_t MiB = 1u << 20;
constexpr size_t WS_CTL = 0, CTL_ZERO_BYTES = 65536, WS_RSS = 1 * MiB, WS_SMALL = 2 * MiB, WS_KMEAN = 4 * MiB, WS_DEC = 5 * MiB, WS_NS = 6 * MiB, WS_SIDE = 7 * MiB, WS_Z = 240 * MiB;
constexpr size_t WS_XB = 8 * MiB, WS_P = 40 * MiB, WS_W = 136 * MiB;
constexpr size_t W_IN = 0, W_OUT = W_IN + (size_t)HYB_PAD * DM * 2, W_QKV = W_OUT + (size_t)DM * DM * 2, W_O = W_QKV + (size_t)3 * DM * DM * 2, W_MIXSZ = W_O + (size_t)DM * DM * 2;
constexpr size_t W_FFN0 = 2 * W_MIXSZ, W_GU = 0, W_D = (size_t)2 * DFF * DM * 2, W_FFNSZ = W_D + (size_t)DM * DFF * 2;
constexpr size_t WS_END = WS_W + W_FFN0 + 4 * W_FFNSZ;
static_assert(WS_END <= WS_Z && WS_Z + (size_t)M * 256 * 2 <= 256 * MiB, "workspace map");

constexpr int RING_BYTES = 131072, LDS_BYTES = 147456, MISC_OFF = LDS_BYTES - 256;
constexpr int NWAVES = 8, NTHR = 512;

__device__ __forceinline__ float bf2f(bf16_t v) { return __uint_as_float((unsigned)v << 16); }
__device__ __forceinline__ unsigned f2bf(float f) { unsigned u = __float_as_uint(f); return (u + 0x7fffu + ((u >> 16) & 1u)) >> 16; }
__device__ __forceinline__ unsigned pk2(float lo, float hi) { return f2bf(lo) | (f2bf(hi) << 16); }
__device__ __forceinline__ float sigmoidf_(float x) { return __builtin_amdgcn_rcpf(1.f + __builtin_amdgcn_exp2f(-1.4426950408889634f * x)); }
__device__ __forceinline__ float siluf_(float x) { return x * __builtin_amdgcn_rcpf(1.f + __builtin_amdgcn_exp2f(-1.4426950408889634f * x)); }
__device__ __forceinline__ float logsigmoidf_(float x) { return fminf(x, 0.f) - 0.6931471805599453f * __builtin_amdgcn_logf(1.f + __builtin_amdgcn_exp2f(-1.4426950408889634f * fabsf(x))); }
__device__ __forceinline__ float wave_sum(float v) {
#pragma unroll
    for (int o = 1; o < 64; o <<= 1) v += __shfl_xor(v, o);
    return v;
}
__device__ __forceinline__ float wave_max(float v) {
#pragma unroll
    for (int o = 1; o < 64; o <<= 1) v = fmaxf(v, __shfl_xor(v, o));
    return v;
}
__device__ __forceinline__ int opaque_i(int v) { asm volatile("" : "+v"(v)); return v; }
__device__ __forceinline__ float row16_sum(float v) {
    v += __builtin_bit_cast(float, __builtin_amdgcn_update_dpp(0, __builtin_bit_cast(int, v), 0xB1, 0xF, 0xF, true));
    v += __builtin_bit_cast(float, __builtin_amdgcn_update_dpp(0, __builtin_bit_cast(int, v), 0x4E, 0xF, 0xF, true));
    v += __builtin_bit_cast(float, __builtin_amdgcn_update_dpp(0, __builtin_bit_cast(int, v), 0x141, 0xF, 0xF, true));
    v += __builtin_bit_cast(float, __builtin_amdgcn_update_dpp(0, __builtin_bit_cast(int, v), 0x140, 0xF, 0xF, true));
    return v;
}
__device__ __forceinline__ float row_rstd(const float* rss, int row) {
    const f32x4* p = (const f32x4*)(rss + (size_t)row * 16);
    const f32x4 a = p[0], b = p[1], c = p[2], d = p[3];
    const float s = ((a.x + a.y) + (a.z + a.w)) + ((b.x + b.y) + (b.z + b.w)) + ((c.x + c.y) + (c.z + c.w)) + ((d.x + d.y) + (d.z + d.w));
    return __builtin_amdgcn_rsqf(s * (1.f / DM) + EPS);
}

#define XB_TMO      128
#define XB_XCNT(j)  (256  + 64 * (j))
#define XB_XSUB(j)  (1280 + 64 * (j))
#define XB_XGEN(j)  (2304 + 64 * (j))
#define XB_TOP      3328
#define XB_TOPGEN   3392
#define XCD_BAR_WORDS 3456
#define XB_SPIN_CAP (1u << 18)
__device__ __forceinline__ unsigned xb_ld(unsigned* p)              { return __hip_atomic_load(p, __ATOMIC_RELAXED, __HIP_MEMORY_SCOPE_AGENT); }
__device__ __forceinline__ unsigned xb_add(unsigned* p, unsigned v) { return __hip_atomic_fetch_add(p, v, __ATOMIC_RELAXED, __HIP_MEMORY_SCOPE_AGENT); }
__device__ __forceinline__ unsigned xb_xcc_id() { return (unsigned)__builtin_amdgcn_s_getreg((3 << 11) | 20) & 0xFu; }
#define XB_SPIN(cond, bar) do { unsigned _sp = 0; while (cond) { __builtin_amdgcn_s_sleep(1); \
    if ((++_sp & 255u) == 0u) { if (xb_ld(&(bar)[XB_TMO])) break; if (_sp > XB_SPIN_CAP) { atomicAdd(&(bar)[XB_TMO], 1u); break; } } } } while (0)
struct XcdBarrier { unsigned* bar; unsigned x; volatile LAS unsigned* st; };
__device__ __forceinline__ XcdBarrier xcd_barrier_post(unsigned* bar, volatile LAS unsigned* st) {
    XcdBarrier b; b.bar = bar; b.x = xb_xcc_id(); b.st = st;
    if (threadIdx.x == 0) (void)xb_add(&bar[XB_XCNT(b.x)], 1u);
    return b;
}
__device__ __forceinline__ void xcd_barrier_complete(unsigned* bar, unsigned x, unsigned& nloc, unsigned& nx) {
    const unsigned G = gridDim.x * gridDim.y * gridDim.z;
    unsigned sum, cnt, mine, sp = 0u;
    for (;;) {
        sum = 0u; cnt = 0u; mine = 0u;
#pragma unroll
        for (unsigned j = 0; j < 16; ++j) { const unsigned c = xb_ld(&bar[XB_XCNT(j)]); sum += c; cnt += (c > 0u) ? 1u : 0u; mine = (j == x) ? c : mine; }
        if (sum == G) break;
        __builtin_amdgcn_s_sleep(1);
        if ((++sp & 255u) == 0u) { if (xb_ld(&bar[XB_TMO])) break; if (sp > XB_SPIN_CAP) { atomicAdd(&bar[XB_TMO], 1u); break; } }
    }
    nloc = mine > 0u ? mine : 1u; nx = cnt > 0u ? cnt : 1u;
}
__device__ __forceinline__ void xcd_barrier(const XcdBarrier& b) {
    asm volatile("s_waitcnt vmcnt(0)" ::: "memory");
    __syncthreads();
    if (threadIdx.x == 0) {
        unsigned* bar = b.bar;
        __builtin_amdgcn_s_waitcnt(0);
        unsigned nloc = b.st[0], nx = b.st[1];
        if (nloc == 0u) { xcd_barrier_complete(bar, b.x, nloc, nx); b.st[0] = nloc; b.st[1] = nx; }
        const unsigned old = xb_add(&bar[XB_XSUB(b.x)], 1u);
        const unsigned gen = old / nloc;
        if (old + 1u == (gen + 1u) * nloc) {
            __builtin_amdgcn_fence(__ATOMIC_RELEASE, "agent");
            asm volatile("s_waitcnt vmcnt(0)" ::: "memory");
            const unsigned og = xb_add(&bar[XB_TOP], 1u);
            const unsigned tg = og / nx;
            if (og + 1u == (tg + 1u) * nx) xb_add(&bar[XB_TOPGEN], 1u);
            else XB_SPIN(xb_ld(&bar[XB_TOPGEN]) == tg, bar);
            __builtin_amdgcn_fence(__ATOMIC_ACQUIRE, "agent");
            xb_add(&bar[XB_XGEN(b.x)], 1u);
            asm volatile("s_waitcnt vmcnt(0)" ::: "memory");
        } else {
            XB_SPIN(xb_ld(&bar[XB_XGEN(b.x)]) == gen, bar);
            __builtin_amdgcn_fence(__ATOMIC_ACQUIRE, "agent");
            asm volatile("s_waitcnt vmcnt(0)" ::: "memory");
        }
    }
    __syncthreads();
}

struct EpiRowBf16 {
    static constexpr bool PERM = true, AFTER_DRAIN = false;
    bf16_t* O; int ldc; const float* rss; float* small; int small_pn; bf16_t* Z; int z_pn;
    __device__ __forceinline__ void operator()(const pg8::f32x4 (&acc)[2][2][4][2], const pg8::Unit& u, int wr, int wc, int fr, int fq) const {
        const int row0 = u.pm * 256 + wr * 64 + fr;
        if (u.pn == small_pn) {
            if (wc == 0) {
#pragma unroll
                for (int ai = 0; ai < 2; ++ai)
#pragma unroll
                    for (int m = 0; m < 4; ++m) { const int row = row0 + ai * 128 + m * 16; const float rs = row_rstd(rss, row);
#pragma unroll
                        for (int n = 0; n < 2; ++n) *(f32x4*)(small + (size_t)row * SMALLP + 8 * fq + 4 * n) = acc[ai][0][m][n] * rs; }
            }
            return;
        }
        const bool isz = u.pn == z_pn;
        bf16_t* Ob = isz ? Z : O; const int ldo = isz ? 256 : ldc;
        const int col0 = (isz ? 0 : u.pn * 256) + wc * 32 + 8 * fq;
        float rs[8];
#pragma unroll
        for (int i = 0; i < 8; ++i) rs[i] = row_rstd(rss, row0 + (i >> 2) * 128 + (i & 3) * 16);
#pragma unroll
        for (int ai = 0; ai < 2; ++ai)
#pragma unroll
            for (int m = 0; m < 4; ++m) { const int row = row0 + ai * 128 + m * 16; const float r = rs[ai * 4 + m];
                bf16_t* rowp = Ob + (size_t)row * ldo + col0;
#pragma unroll
                for (int bj = 0; bj < 2; ++bj) { const f32x4 v0 = acc[ai][bj][m][0] * r, v1 = acc[ai][bj][m][1] * r;
                    u32x4 w; w.x = pg8::cvt_pk_bf16(v0[0], v0[1]); w.y = pg8::cvt_pk_bf16(v0[2], v0[3]); w.z = pg8::cvt_pk_bf16(v1[0], v1[1]); w.w = pg8::cvt_pk_bf16(v1[2], v1[3]);
                    *(u32x4*)(rowp + bj * 128) = w; } }
    }
};
struct EpiRes {
    static constexpr bool PERM = true, AFTER_DRAIN = false;
    const float* xin; float* xout; bf16_t* xb; float* rss; int dry;
    __device__ __forceinline__ void operator()(const pg8::f32x4 (&acc)[2][2][4][2], const pg8::Unit& u, int wr, int wc, int fr, int fq) const {
        if (RPT && dry) { if (acc[0][0][0][0][0] == 1.2345e-33f) xout[0] = 0.f; return; }
        const int row0 = u.pm * 256 + wr * 64 + fr, col0 = u.pn * 256 + wc * 32 + 8 * fq;
#pragma unroll
        for (int ai = 0; ai < 2; ++ai) {
            f32x4 xo[4][2][2];
#pragma unroll
            for (int m = 0; m < 4; ++m)
#pragma unroll
                for (int bj = 0; bj < 2; ++bj) { const size_t off = (size_t)(row0 + ai * 128 + m * 16) * DM + col0 + bj * 128;
                    xo[m][bj][0] = *(const f32x4*)(xin + off); xo[m][bj][1] = *(const f32x4*)(xin + off + 4); }
#pragma unroll
            for (int m = 0; m < 4; ++m) { const int row = row0 + ai * 128 + m * 16; float ss = 0.f;
#pragma unroll
                for (int bj = 0; bj < 2; ++bj) { const size_t off = (size_t)row * DM + col0 + bj * 128;
                    const f32x4 a = xo[m][bj][0] + acc[ai][bj][m][0], b = xo[m][bj][1] + acc[ai][bj][m][1];
                    *(f32x4*)(xout + off) = a; *(f32x4*)(xout + off + 4) = b;
                    u32x4 w; w.x = pg8::cvt_pk_bf16(a[0], a[1]); w.y = pg8::cvt_pk_bf16(a[2], a[3]); w.z = pg8::cvt_pk_bf16(b[0], b[1]); w.w = pg8::cvt_pk_bf16(b[2], b[3]);
                    *(u32x4*)(xb + off) = w;
                    ss += (a[0] * a[0] + a[1] * a[1]) + (a[2] * a[2] + a[3] * a[3]) + (b[0] * b[0] + b[1] * b[1]) + (b[2] * b[2] + b[3] * b[3]); }
                ss += __shfl_xor(ss, 16); ss += __shfl_xor(ss, 32);
                if (fq == 0) rss[(size_t)row * 16 + u.pn * 4 + wc] = ss; }
        }
    }
};
struct EpiFfn {
    static constexpr bool PERM = true, AFTER_DRAIN = false;
    bf16_t* H; const float* rss;
    __device__ __forceinline__ void operator()(const pg8::f32x4 (&acc)[2][2][4][2], const pg8::Unit& u, int wr, int wc, int fr, int fq) const {
        const int row0 = u.pm * 256 + wr * 64 + fr, col0 = u.pn * 128 + wc * 32 + 8 * fq;
        float rs[8];
#pragma unroll
        for (int i = 0; i < 8; ++i) rs[i] = row_rstd(rss, row0 + (i >> 2) * 128 + (i & 3) * 16);
#pragma unroll
        for (int ai = 0; ai < 2; ++ai)
#pragma unroll
            for (int m = 0; m < 4; ++m) { const int row = row0 + ai * 128 + m * 16; const float r = rs[ai * 4 + m];
                float hv[8];
#pragma unroll
                for (int n = 0; n < 2; ++n)
#pragma unroll
                    for (int e = 0; e < 4; ++e) { const float g = acc[ai][0][m][n][e] * r, uu = acc[ai][1][m][n][e] * r; hv[n * 4 + e] = siluf_(g) * uu; }
                u32x4 w; w.x = pg8::cvt_pk_bf16(hv[0], hv[1]); w.y = pg8::cvt_pk_bf16(hv[2], hv[3]); w.z = pg8::cvt_pk_bf16(hv[4], hv[5]); w.w = pg8::cvt_pk_bf16(hv[6], hv[7]);
                *(u32x4*)(H + (size_t)row * DFF + col0) = w; }
    }
};


struct EpiQkv {
    static constexpr bool PERM = true, AFTER_DRAIN = false;
    bf16_t* O; const float* rss; const float* qg; const float* kg; float* kmean; LAS float* xch; LAS float* xch2;
    __device__ __forceinline__ void operator()(const pg8::f32x4 (&acc)[2][2][4][2], const pg8::Unit& u, int wr, int wc, int fr, int fq) const {
        fr = opaque_i(fr); fq = opaque_i(fq);
        const unsigned vo_o = (unsigned)(((wr * 64 + fr) * PP + wc * 32 + 8 * fq) * 2);
        const unsigned vo_r = (unsigned)((wr * 64 + fr) * 64);
        const char* rbase = (const char*)rss + (size_t)u.pm * 256 * 64;
        char* obase = (char*)O + ((size_t)u.pm * 256 * PP + (size_t)u.pn * 256) * 2;
        float rs[8];
#pragma unroll
        for (int i = 0; i < 8; ++i) { const f32x4* p = (const f32x4*)(rbase + ((i >> 2) * 128 + (i & 3) * 16) * 64 + vo_r);
            const f32x4 a = p[0], b = p[1], c = p[2], d = p[3];
            rs[i] = __builtin_amdgcn_rsqf((((a.x + a.y) + (a.z + a.w)) + ((b.x + b.y) + (b.z + b.w)) + ((c.x + c.y) + (c.z + c.w)) + ((d.x + d.y) + (d.z + d.w))) * (1.f / DM) + EPS);
            if (i & 1) asm volatile("" ::: "memory"); }
        if (u.pn >= 8) {
#pragma unroll
            for (int ai = 0; ai < 2; ++ai)
#pragma unroll
                for (int m = 0; m < 4; ++m) { const float r = rs[ai * 4 + m];
#pragma unroll
                    for (int bj = 0; bj < 2; ++bj) { const f32x4 v0 = acc[ai][bj][m][0] * r, v1 = acc[ai][bj][m][1] * r;
                        u32x4 w; w.x = pg8::cvt_pk_bf16(v0[0], v0[1]); w.y = pg8::cvt_pk_bf16(v0[2], v0[3]); w.z = pg8::cvt_pk_bf16(v1[0], v1[1]); w.w = pg8::cvt_pk_bf16(v1[2], v1[3]);
                        *(u32x4*)(obase + ((ai * 128 + m * 16) * PP + bj * 128) * 2 + vo_o) = w; } }
            return;
        }
        const bool isq = u.pn < 4;
        LAS float* xw = xch + (wr * 64 + fr) * 8 + wc;
#pragma unroll
        for (int ai = 0; ai < 2; ++ai)
#pragma unroll
            for (int m = 0; m < 4; ++m) { const float r = rs[ai * 4 + m];
#pragma unroll
                for (int bj = 0; bj < 2; ++bj) { const f32x4 v0 = acc[ai][bj][m][0] * r, v1 = acc[ai][bj][m][1] * r;
                    float ss = (v0[0] * v0[0] + v0[1] * v0[1]) + (v0[2] * v0[2] + v0[3] * v0[3]) + (v1[0] * v1[0] + v1[1] * v1[1]) + (v1[2] * v1[2] + v1[3] * v1[3]);
                    ss += __shfl_xor(ss, 16); ss += __shfl_xor(ss, 32);
                    if (fq == 0) xw[(ai * 128 + m * 16) * 8 + bj * 4] = ss; }
                if (fq == 0 && wc == 0) xch2[wr * 64 + fr + ai * 128 + m * 16] = r; }
        asm volatile("s_waitcnt lgkmcnt(0)" ::: "memory"); __builtin_amdgcn_s_barrier(); asm volatile("" ::: "memory");
        const float* g = (isq ? qg : kg) + wc * 32 + 8 * fq;
        const f32x4 ga = *(const f32x4*)g, gb = *(const f32x4*)(g + 4);
        const float sc = isq ? 0.08838834764831845f : 1.f;
        LAS const float* xr = xch + (wr * 64 + fr) * 8;
#pragma unroll
        for (int bj = 0; bj < 2; ++bj) {
#pragma unroll
            for (int ai = 0; ai < 2; ++ai)
#pragma unroll
                for (int m = 0; m < 4; ++m) { asm volatile("" ::: "memory"); __builtin_amdgcn_sched_barrier(0); const float r = xch2[wr * 64 + fr + ai * 128 + m * 16];
                    const f32x4 p4 = *(LAS const f32x4*)(xr + (ai * 128 + m * 16) * 8 + bj * 4);
                    const float rr = __builtin_amdgcn_rsqf(((p4[0] + p4[1]) + (p4[2] + p4[3])) * (1.f / 128.f) + EPS) * sc * r;
                    const f32x4 v0 = acc[ai][bj][m][0] * rr * ga, v1 = acc[ai][bj][m][1] * rr * gb;
                    u32x4 w; w.x = pg8::cvt_pk_bf16(v0[0], v0[1]); w.y = pg8::cvt_pk_bf16(v0[2], v0[3]); w.z = pg8::cvt_pk_bf16(v1[0], v1[1]); w.w = pg8::cvt_pk_bf16(v1[2], v1[3]);
                    *(u32x4*)(obase + ((ai * 128 + m * 16) * PP + bj * 128) * 2 + vo_o) = w; }
        }
    }
};

struct Args { const float* in[18]; float* out; unsigned char* ws; int ph_lo, ph_hi; };
struct Frame {
    LAS unsigned char* lds; unsigned char* ldsg;
    int tid, lane, wave, G, bid;
};


typedef const __attribute__((address_space(4))) unsigned char* kargp_t;
__device__ __forceinline__ kargp_t karg_base() { kargp_t p = (kargp_t)__builtin_amdgcn_kernarg_segment_ptr(); asm volatile("" : "+s"(p)); return p; }
__device__ __forceinline__ const float* karg_in(kargp_t p, int i) { return *(const float* const __attribute__((address_space(4)))*)(p + 8 * i); }
__device__ __forceinline__ float* karg_out(kargp_t p) { return *(float* const __attribute__((address_space(4)))*)(p + 8 * 18); }
__device__ __forceinline__ unsigned char* karg_ws(kargp_t p) { return *(unsigned char* const __attribute__((address_space(4)))*)(p + 8 * 19); }

__device__ __forceinline__ int map_row(int kind, int n) {
    if (kind == 0) return n;
    if (kind == 2) return (n >> 7) * 256 + (n & 127);
    if (kind == 3) return (n >> 7) * 256 + 128 + (n & 127);
    if (n < 256) return C_GQ + n; if (n < 512) return C_GK + n - 256; if (n < 1024) return C_GV + n - 512; if (n < 1536) return C_GR + n - 1024;
    if (n < 1552) return -1;
    if (n < 1808) return C_MQ + n - 1552; if (n < 2064) return C_MK + n - 1808; if (n < 2576) return C_MV + n - 2064; if (n < 3088) return C_MO + n - 2576;
    return 3328 + 16 + (n - 3088);
}
__device__ __forceinline__ void cvt_item(const float* W, int K, int N, const float* gain, bf16_t* WT, int kind, LAS float* scr, int item, int lane) {
    const int nblk = (N + 63) / 64, kb = item / nblk, nb = item % nblk, k0 = 64 * kb, n0 = 64 * nb;
    const int nq = n0 + 4 * (lane & 15), kr = lane >> 4;
    f32x4 v[16];
#pragma unroll
    for (int i = 0; i < 16; ++i) { v[i] = (f32x4){0.f, 0.f, 0.f, 0.f}; if (nq < N) v[i] = *(const f32x4*)(W + (size_t)(k0 + 4 * i + kr) * N + nq); }
#pragma unroll
    for (int i = 0; i < 16; ++i) { const int kk = 4 * i + kr; const float g = gain ? gain[k0 + kk] : 1.f; LAS float* d = scr + kk * 65 + 4 * (lane & 15);
        d[0] = v[i][0] * g; d[1] = v[i][1] * g; d[2] = v[i][2] * g; d[3] = v[i][3] * g; }
    asm volatile("s_waitcnt lgkmcnt(0)" ::: "memory");
    if (n0 + lane < N && map_row(kind, n0 + lane) >= 0) {
        bf16_t* dst = WT + (size_t)map_row(kind, n0 + lane) * K + k0;
#pragma unroll
        for (int c = 0; c < 8; ++c) { const LAS float* sp = scr + (8 * c) * 65 + lane;
            u32x4 o; o.x = pk2(sp[0 * 65], sp[1 * 65]); o.y = pk2(sp[2 * 65], sp[3 * 65]); o.z = pk2(sp[4 * 65], sp[5 * 65]); o.w = pk2(sp[6 * 65], sp[7 * 65]);
            *(u32x4*)(dst + 8 * c) = o; }
    }
    asm volatile("s_waitcnt lgkmcnt(0)" ::: "memory");
}
__device__ __forceinline__ void cvt_wz_item(const float* Win, const float* w2, const float* gain, bf16_t* WT, int item, int lane) {
    const int kb = item >> 2, nb = item & 3, k0 = 64 * kb, n = nb * 64 + lane;
    float w2r[16];
#pragma unroll
    for (int r = 0; r < 16; ++r) w2r[r] = w2[r * 256 + n];
    bf16_t* dst = WT + (size_t)(3072 + n) * DM + k0;
    for (int c = 0; c < 8; ++c) {
        float v[8];
#pragma unroll
        for (int e = 0; e < 8; ++e) { const int k = k0 + 8 * c + e; const float* gl = Win + (size_t)k * HYB_IN + 1536; float z = 0.f;
#pragma unroll
            for (int r = 0; r < 16; ++r) z += gl[r] * w2r[r];
            v[e] = z * gain[k]; }
        u32x4 o; o.x = pk2(v[0], v[1]); o.y = pk2(v[2], v[3]); o.z = pk2(v[4], v[5]); o.w = pk2(v[6], v[7]);
        *(u32x4*)(dst + 8 * c) = o;
    }
}
__device__ __forceinline__ void phase_prologue(Frame& F) {
    kargp_t kp = karg_base();
    unsigned char* wsw = karg_ws(kp) + WS_W;
    LAS float* scr = (LAS float*)(F.lds + F.wave * 16640);
    const int gw = F.bid * NWAVES + F.wave, NGW = F.G * NWAVES, lane = opaque_i(F.lane);
    constexpr int I_IN = 16 * 49, I_WZ = 64, I_OUT = 256, I_QKV = 16 * 48, I_O = 256, I_MIX = I_IN + I_WZ + I_OUT + I_QKV + I_O, I_F = 704, I_FFN = 3 * I_F, I_ALL = 2 * I_MIX + 4 * I_FFN;
    for (int it = gw; it < I_ALL; it += NGW) {
        if (it < 2 * I_MIX) {
            const int j = it / I_MIX; int r = it % I_MIX; unsigned char* wj = wsw + j * W_MIXSZ;
            if (r < I_IN) cvt_item(karg_in(kp, 3) + (size_t)j * DM * HYB_IN, DM, HYB_IN, karg_in(kp, 1) + (2 * j) * DM, (bf16_t*)(wj + W_IN), 1, scr, r, lane);
            else if ((r -= I_IN) < I_WZ) cvt_wz_item(karg_in(kp, 3) + (size_t)j * DM * HYB_IN, karg_in(kp, 4) + (size_t)j * 16 * 256, karg_in(kp, 1) + (2 * j) * DM, (bf16_t*)(wj + W_IN), r, lane);
            else if ((r -= I_WZ) < I_OUT) cvt_item(karg_in(kp, 10) + (size_t)j * DM * DM, DM, DM, nullptr, (bf16_t*)(wj + W_OUT), 0, scr, r, lane);
            else if ((r -= I_OUT) < I_QKV) cvt_item(karg_in(kp, 11) + (size_t)j * DM * 3 * DM, DM, 3 * DM, karg_in(kp, 1) + (2 * j + 1) * DM, (bf16_t*)(wj + W_QKV), 0, scr, r, lane);
            else { r -= I_QKV; cvt_item(karg_in(kp, 14) + (size_t)j * DM * DM, DM, DM, nullptr, (bf16_t*)(wj + W_O), 0, scr, r, lane); }
        } else {
            const int q = it - 2 * I_MIX, l = q / I_FFN; int r = q % I_FFN; unsigned char* wl = wsw + W_FFN0 + l * W_FFNSZ;
            if (r < I_F) cvt_item(karg_in(kp, 15) + (size_t)l * DM * DFF, DM, DFF, karg_in(kp, 2) + l * DM, (bf16_t*)(wl + W_GU), 2, scr, r, lane);
            else if ((r -= I_F) < I_F) cvt_item(karg_in(kp, 16) + (size_t)l * DM * DFF, DM, DFF, karg_in(kp, 2) + l * DM, (bf16_t*)(wl + W_GU), 3, scr, r, lane);
            else { r -= I_F; cvt_item(karg_in(kp, 17) + (size_t)l * DFF * DM, DFF, DM, nullptr, (bf16_t*)(wl + W_D), 0, scr, r, lane); }
        }
    }
    for (int j = 0; j < 2; ++j) {
        u32x4* z0 = (u32x4*)(wsw + j * W_MIXSZ + W_IN + (size_t)3328 * DM * 2);
        u32x4* z1 = (u32x4*)(wsw + j * W_MIXSZ + W_IN + (size_t)3352 * DM * 2);
        const int n0 = 16 * DM * 2 / 16, n1 = (3584 - 3352) * DM * 2 / 16;
        for (int i = F.bid * NTHR + F.tid; i < n0 + n1; i += F.G * NTHR) { if (i < n0) z0[i] = (u32x4){0u, 0u, 0u, 0u}; else z1[i - n0] = (u32x4){0u, 0u, 0u, 0u}; }
    }
    const float* x = karg_in(kp, 0); bf16_t* xb = (bf16_t*)(karg_ws(kp) + WS_XB); float* rss = (float*)(karg_ws(kp) + WS_RSS);
    for (int row = gw; row < M; row += NGW) {
        const float* xr = x + (size_t)row * DM; float s = 0.f;
#pragma unroll
        for (int j = 0; j < 4; ++j) { const f32x4 v = *(const f32x4*)(xr + j * 256 + F.lane * 4);
            s += (v.x * v.x + v.y * v.y) + (v.z * v.z + v.w * v.w);
            unsigned long long o = (unsigned long long)pk2(v.x, v.y) | ((unsigned long long)pk2(v.z, v.w) << 32);
            *(unsigned long long*)(xb + (size_t)row * DM + j * 256 + F.lane * 4) = o; }
        s = wave_sum(s);
        if (F.lane < 16) rss[(size_t)row * 16 + F.lane] = F.lane == 0 ? s : 0.f;
    }
}

struct ScanArgs {
    const bf16_t* Z; bf16_t* side;
    bf16_t* P; const float* small;
    const float* w2; const float* bgate; const float* gla_gain; const float* convw; const float* bif; const float* ml_gain;
    bf16_t* ST; float* dec; float* NS;
};
__device__ __forceinline__ size_t st_off(int grp, int bh, int c) { return ((size_t)((grp * 16 + bh) * NCH + c)) * 8192; }

template <bool NEED_A>
__device__ __forceinline__ void gate_stage(const ScanArgs& a, int b, int c, int hh, float* At, float* Bm, float* blk, float* lastv) {
    int tid_ = threadIdx.x; asm volatile("" : "+v"(tid_));
    const int tid = tid_, tb = tid >> 6, k = tid & 63;
    const int grp = hh >> 2, h = hh & 3;
    const int row0 = b * SEQ + c * CH;
    float la[8];
    if (grp == 0) {
        float w2r[16];
#pragma unroll
        for (int r = 0; r < 16; ++r) w2r[r] = a.w2[r * 256 + h * 64 + k];
        const float bg = a.bgate[h * 64 + k];
#pragma unroll
        for (int i = 0; i < 8; ++i) {
            const float* g = a.small + (size_t)(row0 + tb * 8 + i) * SMALLP;
            float z = bg;
#pragma unroll
            for (int r = 0; r < 16; ++r) z += g[r] * w2r[r];
            la[i] = logsigmoidf_(z) * (1.f / 16.f);
            asm volatile("" ::: "memory");
        }
    } else {
#pragma unroll
        for (int i = 0; i < 8; ++i) {
            const float* g = a.small + (size_t)(row0 + tb * 8 + i) * SMALLP;
            la[i] = logsigmoidf_(g[20 + h] + a.bif[4 + h]);
        }
    }
    float cs[8]; float run = 0.f;
#pragma unroll
    for (int i = 0; i < 8; ++i) { run += la[i]; cs[i] = run; }
    blk[tb * 64 + k] = run;
    __syncthreads();
    float pre = 0.f, tot = 0.f;
#pragma unroll
    for (int j = 0; j < 8; ++j) { const float v = blk[j * 64 + k]; tot += v; if (j < tb) pre += v; }
    if (tb == 0) lastv[k] = tot;
#pragma unroll
    for (int i = 0; i < 8; ++i) {
        const int t = tb * 8 + i; const int row = row0 + t; const float bc = pre + cs[i];
        const bf16_t* pr = a.P + (size_t)row * PP;
        if (grp == 0) {
            const float kv = bf2f(pr[C_GK + h * 64 + k]);
            Bm[t * 65 + k] = kv * __expf(-bc);
            if (NEED_A) { const float qv = bf2f(pr[C_GQ + h * 64 + k]); At[t * 65 + k] = qv * 0.125f * __expf(bc); }
        } else {
            const float ip = a.small[(size_t)row * SMALLP + 16 + h] + a.bif[h];
            const int tt = c * CH + t;
            float ck = 0.f, cq = 0.f;
#pragma unroll
            for (int j = 0; j < 4; ++j) {
                const int ts = tt - 3 + j;
                if (ts >= 0) {
                    const bf16_t* ps = a.P + (size_t)(b * SEQ + ts) * PP;
                    ck += a.convw[j * 512 + 256 + h * 64 + k] * bf2f(ps[C_MK + h * 64 + k]);
                    if (NEED_A) cq += a.convw[j * 512 + h * 64 + k] * bf2f(ps[C_MQ + h * 64 + k]);
                }
            }
            Bm[t * 65 + k] = siluf_(ck) * 0.125f * __expf(ip - bc);
            if (NEED_A) At[t * 65 + k] = siluf_(cq) * __expf(bc);
        }
    }
}

__device__ __forceinline__ void phase_scan1(Frame& F, const ScanArgs& a) {
    float* sm = (float*)F.ldsg;
    float* Bm = sm; float* Vs = sm + 64 * 65; float* blk = Vs + 64 * 128; float* lastv = blk + 512;
    int tid_ = threadIdx.x; asm volatile("" : "+v"(tid_));
    const int tid = tid_, lane = tid & 63, kg = tid >> 6;
    for (int unit = F.bid; unit < BATCH * NCH; unit += F.G) {
        const int b = unit / NCH, c = unit % NCH;
        const int row0 = b * SEQ + c * CH;
        for (int hh = 0; hh < 8; ++hh) {
            const int grp = hh >> 2, h = hh & 3, bh = b * 4 + h;
            gate_stage<false>(a, b, c, hh, nullptr, Bm, blk, lastv);
            const int voff = (grp == 0 ? C_GV : C_MV) + h * 128;
#pragma unroll 4
            for (int i = tid; i < 64 * 128; i += 512) { const int s = i >> 7, v = i & 127; Vs[i] = bf2f(a.P[(size_t)(row0 + s) * PP + voff + v]); }
            __syncthreads();
            if (tid < 64) a.dec[((size_t)(grp * 16 + bh) * NCH + c) * 64 + tid] = __expf(lastv[tid]);
            if (grp == 1 && tid < 64) { float s = 0.f; for (int t = 0; t < 64; ++t) s += Bm[t * 65 + tid]; a.NS[((size_t)bh * NCH + c) * 64 + tid] = s; }
            float acc[8][2];
#pragma unroll
            for (int i = 0; i < 8; ++i) { acc[i][0] = 0.f; acc[i][1] = 0.f; }
#pragma unroll 2
            for (int s = 0; s < 64; ++s) {
                const float v0 = Vs[s * 128 + lane], v1 = Vs[s * 128 + 64 + lane];
#pragma unroll
                for (int i = 0; i < 8; ++i) { const float bv = Bm[s * 65 + kg * 8 + i]; acc[i][0] += bv * v0; acc[i][1] += bv * v1; }
            }
            bf16_t* st = a.ST + st_off(grp, bh, c);
            u32x4 w0, w1;
            w0.x = pk2(acc[0][0], acc[1][0]); w0.y = pk2(acc[2][0], acc[3][0]); w0.z = pk2(acc[4][0], acc[5][0]); w0.w = pk2(acc[6][0], acc[7][0]);
            w1.x = pk2(acc[0][1], acc[1][1]); w1.y = pk2(acc[2][1], acc[3][1]); w1.z = pk2(acc[4][1], acc[5][1]); w1.w = pk2(acc[6][1], acc[7][1]);
            *(u32x4*)(st + (size_t)lane * 64 + kg * 8) = w0; *(u32x4*)(st + (size_t)(lane + 64) * 64 + kg * 8) = w1;
            __syncthreads();
        }
    }
}
__device__ __forceinline__ void phase_scan2(Frame& F, const ScanArgs& a, bool dry = false) {
    for (int gid = F.bid * NTHR + opaque_i(F.tid); gid < 131072; gid += F.G * NTHR) {
        const int grp = gid >> 16, rem = gid & 65535, bh = rem >> 12, r2 = rem & 4095, v = r2 >> 5, k = (r2 & 31) * 2;
        float s0 = 0.f, s1 = 0.f;
        unsigned* p0 = (unsigned*)(a.ST + st_off(grp, bh, 0) + v * 64 + k);
        const float* d0 = a.dec + ((size_t)(grp * 16 + bh) * NCH) * 64 + k;
        for (int cb = 0; cb < NCH; cb += 16) {
            unsigned w[16]; float da[16], db[16];
#pragma unroll
            for (int i = 0; i < 16; ++i) { w[i] = p0[(size_t)(cb + i) * 4096]; da[i] = d0[(cb + i) * 64]; db[i] = d0[(cb + i) * 64 + 1]; }
#pragma unroll
            for (int i = 0; i < 16; ++i) {
                const float l0 = __uint_as_float(w[i] << 16), l1 = __uint_as_float(w[i] & 0xffff0000u);
                if (!dry) p0[(size_t)(cb + i) * 4096] = pk2(s0, s1);
                s0 = da[i] * (s0 + l0); s1 = db[i] * (s1 + l1);
            }
        }
        if (gid < 1024) {
            const int bh2 = gid >> 6, k2 = gid & 63; float ns = 0.f;
            float* p = a.NS + ((size_t)bh2 * NCH) * 64 + k2; const float* dd = a.dec + ((size_t)(16 + bh2) * NCH) * 64 + k2;
            for (int cb = 0; cb < NCH; cb += 16) {
                float lv[16], dv[16];
#pragma unroll
                for (int i = 0; i < 16; ++i) { lv[i] = p[(cb + i) * 64]; dv[i] = dd[(cb + i) * 64]; }
#pragma unroll
                for (int i = 0; i < 16; ++i) { if (!dry) p[(cb + i) * 64] = ns; ns = dv[i] * (ns + lv[i]); }
            }
        }
    }
}
__device__ __forceinline__ void phase_scan3(Frame& F, const ScanArgs& a) {
    float* sm = (float*)F.ldsg;
    float* At = sm; float* Bm = At + 64 * 65; float* Pm = Bm + 64 * 65; float* Vs = Pm + 64 * 65; float* Ss = Vs + 64 * 128;
    float* blk = Ss + 64 * 128; float* lastv = blk + 512; float* nsv = lastv + 64;
    int tid_ = threadIdx.x; asm volatile("" : "+v"(tid_));
    const int tid = tid_, lane = tid & 63, tg = tid >> 6;
    for (int unit = F.bid; unit < BATCH * NCH; unit += F.G) {
        const int b = unit / NCH, c = unit % NCH;
        const int row0 = b * SEQ + c * CH;
        for (int hh = 0; hh < 8; ++hh) {
            const int grp = hh >> 2, h = hh & 3, bh = b * 4 + h;
            gate_stage<true>(a, b, c, hh, At, Bm, blk, lastv);
            const int voff = (grp == 0 ? C_GV : C_MV) + h * 128;
#pragma unroll 4
            for (int i = tid; i < 64 * 128; i += 512) { const int s = i >> 7, v = i & 127; Vs[i] = bf2f(a.P[(size_t)(row0 + s) * PP + voff + v]); }
            const bf16_t* st = a.ST + st_off(grp, bh, c);
#pragma unroll 4
            for (int i = tid; i < 64 * 128; i += 512) { const int v = i >> 6, k = i & 63; Ss[k * 128 + v] = bf2f(st[i]); }
            if (tid < 64) nsv[tid] = grp == 1 ? a.NS[((size_t)bh * NCH + c) * 64 + tid] : 0.f;
            __syncthreads();
            {
                const int t = tid >> 3, sg = tid & 7;
                float p[8];
#pragma unroll
                for (int i = 0; i < 8; ++i) p[i] = 0.f;
#pragma unroll 2
                for (int k = 0; k < 64; ++k) {
                    const float av = At[t * 65 + k];
#pragma unroll
                    for (int i = 0; i < 8; ++i) p[i] += av * Bm[(sg * 8 + i) * 65 + k];
                }
#pragma unroll
                for (int i = 0; i < 8; ++i) { const int s = sg * 8 + i; Pm[t * 65 + s] = s <= t ? p[i] : 0.f; }
            }
            __syncthreads();
            float acc[8][2], den[8];
#pragma unroll
            for (int i = 0; i < 8; ++i) { acc[i][0] = 0.f; acc[i][1] = 0.f; den[i] = 0.f; }
#pragma unroll 2
            for (int s = 0; s < 64; ++s) {
                const float v0 = Vs[s * 128 + lane], v1 = Vs[s * 128 + 64 + lane];
#pragma unroll
                for (int i = 0; i < 8; ++i) { const float pv = Pm[(tg * 8 + i) * 65 + s]; acc[i][0] += pv * v0; acc[i][1] += pv * v1; den[i] += pv; }
            }
#pragma unroll 2
            for (int k = 0; k < 64; ++k) {
                const float s0 = Ss[k * 128 + lane], s1 = Ss[k * 128 + 64 + lane], nk = nsv[k];
#pragma unroll
                for (int i = 0; i < 8; ++i) { const float av = At[(tg * 8 + i) * 65 + k]; acc[i][0] += av * s0; acc[i][1] += av * s1; den[i] += av * nk; }
            }
#pragma unroll
            for (int i = 0; i < 8; ++i) {
                asm volatile("" ::: "memory");
                const int row = row0 + tg * 8 + i;
                bf16_t* pr = a.P + (size_t)row * PP;
                float o0 = acc[i][0], o1 = acc[i][1];
                if (grp == 0) {
                    const float ss = wave_sum(o0 * o0 + o1 * o1);
                    const float rstd = rsqrtf(ss * (1.f / 128.f) + EPS);
                    const float g0 = bf2f(pr[C_GR + h * 128 + lane]), g1 = bf2f(pr[C_GR + h * 128 + 64 + lane]);
                    pr[C_GR + h * 128 + lane] = (bf16_t)f2bf(o0 * rstd * a.gla_gain[h * 128 + lane] * siluf_(g0));
                    pr[C_GR + h * 128 + 64 + lane] = (bf16_t)f2bf(o1 * rstd * a.gla_gain[h * 128 + 64 + lane] * siluf_(g1));
                } else {
                    const float dd = 1.f / fmaxf(fabsf(den[i]), 1.f);
                    const float g0 = bf2f(pr[C_MO + h * 128 + lane]), g1 = bf2f(pr[C_MO + h * 128 + 64 + lane]);
                    o0 = o0 * dd * sigmoidf_(g0); o1 = o1 * dd * sigmoidf_(g1);
                    const float ss = wave_sum(o0 * o0 + o1 * o1);
                    const float rstd = rsqrtf(ss * (1.f / 128.f) + EPS);
                    pr[C_MO + h * 128 + lane] = (bf16_t)f2bf(o0 * rstd * a.ml_gain[h * 128 + lane]);
                    pr[C_MO + h * 128 + 64 + lane] = (bf16_t)f2bf(o1 * rstd * a.ml_gain[h * 128 + 64 + lane]);
                }
            }
            __syncthreads();
        }
    }
}

__device__ __forceinline__ void phase_qkn(Frame& F, bf16_t* P, const float* qg, const float* kg, float* kmean) {
    const int gw = F.bid * NWAVES + F.wave, NGW = F.G * NWAVES, lane = opaque_i(F.lane);
    for (int u = gw; u < BATCH * 16 * 16; u += NGW) {
        const int hd = u & 15, blk = (u >> 4) & 15, b = u >> 8;
        const float* g = hd < 8 ? qg : kg;
        const float g0 = g[lane * 2], g1 = g[lane * 2 + 1];
        const float sc = hd < 8 ? 0.08838834764831845f : 1.f;
        float m0 = 0.f, m1 = 0.f;
        for (int r = 0; r < 256; ++r) {
            unsigned* p = (unsigned*)(P + (size_t)(b * SEQ + blk * 256 + r) * PP + hd * 128 + lane * 2);
            const unsigned w = *p;
            const float x0 = __uint_as_float(w << 16), x1 = __uint_as_float(w & 0xffff0000u);
            const float ss = wave_sum(x0 * x0 + x1 * x1);
            const float rr = rsqrtf(ss * (1.f / 128.f) + EPS) * sc;
            const float y0 = x0 * rr * g0, y1 = x1 * rr * g1;
            m0 += y0; m1 += y1;
            *p = pk2(y0, y1);
        }
        if (hd >= 8) { float* km = kmean + ((size_t)((b * 8 + (hd - 8)) * 16 + blk)) * 128 + lane * 2; km[0] = m0 * (1.f / 256.f); km[1] = m1 * (1.f / 256.f); }
    }
}
__device__ __forceinline__ void phase_attn_simple(Frame& F, bf16_t* P, const float* kmean) {
    float* qs = (float*)F.ldsg + F.wave * 1152; float* sc = qs + 128;
    const int gw = F.bid * NWAVES + F.wave, NGW = F.G * NWAVES, lane = opaque_i(F.lane);
    for (int item = gw; item < BATCH * 8 * SEQ; item += NGW) {
        const int t = item & (SEQ - 1), h = (item >> 12) & 7, b = item >> 15;
        const size_t row = (size_t)b * SEQ + t;
        {
            const unsigned w = *(const unsigned*)(P + row * PP + h * 128 + lane * 2);
            qs[lane * 2] = __uint_as_float(w << 16); qs[lane * 2 + 1] = __uint_as_float(w & 0xffff0000u);
        }
        const int qblk = t >> 8;
        float g = -INFINITY;
        if (lane < qblk) { const float* km = kmean + ((size_t)((b * 8 + h) * 16 + lane)) * 256; float s = 0.f; for (int d = 0; d < 128; ++d) s += qs[d] * (km[d] + km[128 + d]); g = s; }
        int sel0 = 0, sel1 = 0, sel2 = 0; const int nsel = qblk < 3 ? qblk : 3;
        {
            float gv[16];
#pragma unroll
            for (int n = 0; n < 16; ++n) gv[n] = __shfl(g, n);
            unsigned taken = 0u;
#pragma unroll
            for (int r = 0; r < 3; ++r) {
                int best = 0; float bv = -INFINITY; bool found = false;
#pragma unroll
                for (int n = 0; n < 16; ++n) { const bool ok = !((taken >> n) & 1u) && n < qblk; if (ok && (!found || gv[n] > bv)) { bv = gv[n]; best = n; found = true; } }
                if (r == 0) sel0 = best; else if (r == 1) sel1 = best; else sel2 = best;
                if (found) taken |= 1u << best;
            }
        }
        const float slope = exp2f(-(float)(h + 1));
        float mx = -1e30f;
        for (int r = 0; r <= nsel; ++r) {
            const int blk = r < nsel ? (r == 0 ? sel0 : (r == 1 ? sel1 : sel2)) : qblk;
            for (int sub = 0; sub < 4; ++sub) {
                const int key = blk * 256 + sub * 64 + lane; const int dist = t - key;
                const bf16_t* kr = P + ((size_t)b * SEQ + key) * PP + 1024 + h * 128;
                float s = 0.f;
                for (int d8 = 0; d8 < 16; ++d8) {
                    const u32x4 w = *(const u32x4*)(kr + d8 * 8);
#pragma unroll
                    for (int e = 0; e < 4; ++e) { s += qs[d8 * 8 + 2 * e] * __uint_as_float(w[e] << 16); s += qs[d8 * 8 + 2 * e + 1] * __uint_as_float(w[e] & 0xffff0000u); }
                }
                s = dist >= 0 ? s - slope * (float)dist : -1e30f;
                sc[r * 256 + sub * 64 + lane] = s; mx = fmaxf(mx, s);
            }
        }
        mx = wave_max(mx);
        float sum = 0.f;
        for (int i = lane; i < (nsel + 1) * 256; i += 64) { const float p = __expf(sc[i] - mx); sc[i] = p; sum += p; }
        sum = wave_sum(sum);
        float a0 = 0.f, a1 = 0.f;
        for (int r = 0; r <= nsel; ++r) {
            const int blk = r < nsel ? (r == 0 ? sel0 : (r == 1 ? sel1 : sel2)) : qblk;
            const bf16_t* vr = P + ((size_t)b * SEQ + blk * 256) * PP + 2048 + h * 128 + lane * 2;
#pragma unroll 4
            for (int j = 0; j < 256; ++j) {
                const float p = sc[r * 256 + j];
                const unsigned w = *(const unsigned*)(vr + (size_t)j * PP);
                a0 += p * __uint_as_float(w << 16); a1 += p * __uint_as_float(w & 0xffff0000u);
            }
        }
        const float inv = 1.f / sum;
        *(unsigned*)(P + row * PP + h * 128 + lane * 2) = pk2(a0 * inv, a1 * inv);
    }
}


__device__ __forceinline__ void phase_qkn2(Frame& F, bf16_t* P, const float* qg, const float* kg, float* kmean, bool dry = false) {
    const int gw = F.bid * NWAVES + F.wave, NGW = F.G * NWAVES, lane = opaque_i(F.lane), sub = lane >> 4, cl = lane & 15;
    for (int u = gw; u < BATCH * 16 * 16 * 2; u += NGW) {
        const int half = u & 1, hd = (u >> 1) & 15, blk = (u >> 5) & 15, b = u >> 9;
        const float* g = (hd < 8 ? qg : kg) + cl * 8;
        const f32x4 ga = *(const f32x4*)g, gb = *(const f32x4*)(g + 4);
        const float sc = hd < 8 ? 0.08838834764831845f : 1.f;
        float m[8];
#pragma unroll
        for (int e = 0; e < 8; ++e) m[e] = 0.f;
        bf16_t* base = P + (size_t)(b * SEQ + blk * 256 + half * 128 + sub) * PP + hd * 128 + cl * 8;
#pragma unroll 8
        for (int it = 0; it < 32; ++it) {
            u32x4* p = (u32x4*)(base + (size_t)it * 4 * PP);
            const u32x4 w = *p;
            float x[8];
#pragma unroll
            for (int e = 0; e < 4; ++e) { x[2 * e] = __uint_as_float(w[e] << 16); x[2 * e + 1] = __uint_as_float(w[e] & 0xffff0000u); }
            float ss = (x[0] * x[0] + x[1] * x[1]) + (x[2] * x[2] + x[3] * x[3]) + (x[4] * x[4] + x[5] * x[5]) + (x[6] * x[6] + x[7] * x[7]);
            ss += __shfl_xor(ss, 1); ss += __shfl_xor(ss, 2); ss += __shfl_xor(ss, 4); ss += __shfl_xor(ss, 8);
            const float rr = rsqrtf(ss * (1.f / 128.f) + EPS) * sc;
            float y[8];
            y[0] = x[0] * rr * ga[0]; y[1] = x[1] * rr * ga[1]; y[2] = x[2] * rr * ga[2]; y[3] = x[3] * rr * ga[3];
            y[4] = x[4] * rr * gb[0]; y[5] = x[5] * rr * gb[1]; y[6] = x[6] * rr * gb[2]; y[7] = x[7] * rr * gb[3];
#pragma unroll
            for (int e = 0; e < 8; ++e) m[e] += y[e];
            u32x4 o; o.x = pk2(y[0], y[1]); o.y = pk2(y[2], y[3]); o.z = pk2(y[4], y[5]); o.w = pk2(y[6], y[7]);
            if (!dry) *p = o;
        }
        if (hd >= 8 && !dry) {
#pragma unroll
            for (int e = 0; e < 8; ++e) { m[e] += __shfl_xor(m[e], 16); m[e] += __shfl_xor(m[e], 32); }
            if (sub == 0) { float* km = kmean + ((size_t)(((b * 8 + (hd - 8)) * 16 + blk) * 2 + half)) * 128 + cl * 8;
                *(f32x4*)km = (f32x4){m[0], m[1], m[2], m[3]} * (1.f / 256.f); *(f32x4*)(km + 4) = (f32x4){m[4], m[5], m[6], m[7]} * (1.f / 256.f); }
        }
    }
}


__device__ __forceinline__ void phase_kmean(Frame& F, const bf16_t* P, float* kmean) {
    const int lane = opaque_i(F.lane), sub = lane >> 4, cl = lane & 15, tid = F.wave * 64 + lane;
    LAS float* part = (LAS float*)F.lds;
    for (int u = F.bid; u < BATCH * 8 * 16; u += F.G) {
        const int blk = u & 15, h = (u >> 4) & 7, b = u >> 7;
        const bf16_t* base = P + (size_t)(b * SEQ + blk * 256 + F.wave * 32 + sub) * PP + 1024 + h * 128 + cl * 8;
        float m[8];
#pragma unroll
        for (int e = 0; e < 8; ++e) m[e] = 0.f;
        u32x4 w[8];
#pragma unroll
        for (int it = 0; it < 8; ++it) w[it] = *(const u32x4*)(base + (size_t)it * 4 * PP);
#pragma unroll
        for (int it = 0; it < 8; ++it)
#pragma unroll
            for (int e = 0; e < 4; ++e) { m[2 * e] += __uint_as_float(w[it][e] << 16); m[2 * e + 1] += __uint_as_float(w[it][e] & 0xffff0000u); }
#pragma unroll
        for (int e = 0; e < 8; ++e) { m[e] += __shfl_xor(m[e], 16); m[e] += __shfl_xor(m[e], 32); }
        if (sub == 0) { *(LAS f32x4*)(part + F.wave * 128 + cl * 8) = (f32x4){m[0], m[1], m[2], m[3]}; *(LAS f32x4*)(part + F.wave * 128 + cl * 8 + 4) = (f32x4){m[4], m[5], m[6], m[7]}; }
        __syncthreads();
        if (tid < 128) { float sacc = 0.f;
#pragma unroll
            for (int wv = 0; wv < 8; ++wv) sacc += part[wv * 128 + tid];
            float* km = kmean + (size_t)u * 256; km[tid] = sacc * (1.f / 256.f); km[128 + tid] = 0.f; }
        __syncthreads();
    }
}

namespace att {
typedef short bf16x8 __attribute__((ext_vector_type(8)));
typedef short s16x4 __attribute__((ext_vector_type(4)));
typedef float f32x16 __attribute__((ext_vector_type(16)));
constexpr int SHM_V = 16384, SHM_K = 16384, OFF_V = 0, OFF_K = 2 * SHM_V, OFF_WS = 2 * SHM_V + 2 * SHM_K;
constexpr float THR = 8.f;
#define KSWZ(row, colB) ((row) * 256 + ((colB) ^ (((row) & 7) << 4)))
#define SBAR() __builtin_amdgcn_sched_barrier(0)
typedef LAS char* lptr;
__device__ __forceinline__ int crow(int r, int hi) { return (r & 3) + 8 * (r >> 2) + 4 * hi; }
__device__ __forceinline__ unsigned cvtpk(float lo, float hi) { unsigned r; asm volatile("v_cvt_pk_bf16_f32 %0, %1, %2" : "=v"(r) : "v"(lo), "v"(hi)); return r; }
__device__ __forceinline__ void partialSM(f32x16& p0, f32x16& p1, float& m_reg, float& mn, float& alpha, float slope, float base, bool ok, bool diag, int dq) {
    constexpr float C = 1.4426950408889634f;
#pragma unroll
    for (int r = 0; r < 16; ++r) { const int c = (r & 3) + 8 * (r >> 2); if (c) p0[r] = fmaf(slope, (float)c, p0[r]); p1[r] = fmaf(slope, (float)(c + 32), p1[r]); }
    if (diag) {
#pragma unroll
        for (int r = 0; r < 16; ++r) { const int c = (r & 3) + 8 * (r >> 2); if (c > dq) p0[r] = -INFINITY; if (c + 32 > dq) p1[r] = -INFINITY; }
    }
    float pmax = p0[0];
#pragma unroll
    for (int r = 1; r < 16; ++r) pmax = fmaxf(pmax, p0[r]);
#pragma unroll
    for (int r = 0; r < 16; ++r) pmax = fmaxf(pmax, p1[r]);
    const float bm = ok ? base : -INFINITY;
    pmax += bm;
    { auto rr = __builtin_amdgcn_permlane32_swap(__float_as_uint(pmax), __float_as_uint(pmax), false, false);
      pmax = fmaxf(__uint_as_float(rr[0]), __uint_as_float(rr[1])); }
    if (__builtin_expect(__all(pmax - m_reg <= THR), 1)) { mn = m_reg; alpha = 1.f; }
    else { mn = fmaxf(m_reg, pmax); alpha = __builtin_amdgcn_exp2f((m_reg - mn) * C); m_reg = mn; }
    const float add = (bm - mn) * C;
#pragma unroll
    for (int r = 0; r < 16; ++r) p0[r] = fmaf(p0[r], C, add);
#pragma unroll
    for (int r = 0; r < 16; ++r) p1[r] = fmaf(p1[r], C, add);
#pragma unroll
    for (int r = 0; r < 16; ++r) p0[r] = __builtin_amdgcn_exp2f(p0[r]);
}
__device__ __forceinline__ void finishSM(f32x16& p0, f32x16& p1, float alpha, float& l_reg, bf16x8& pa0, bf16x8& pa1, bf16x8& pa2, bf16x8& pa3) {
#pragma unroll
    for (int r = 0; r < 16; ++r) p1[r] = __builtin_amdgcn_exp2f(p1[r]);
    float ps = 0;
#pragma unroll
    for (int r = 0; r < 16; ++r) ps += p0[r];
#pragma unroll
    for (int r = 0; r < 16; ++r) ps += p1[r];
    { auto rr = __builtin_amdgcn_permlane32_swap(__float_as_uint(ps), __float_as_uint(ps), false, false);
      ps = __uint_as_float(rr[0]) + __uint_as_float(rr[1]); }
    l_reg = l_reg * alpha + ps;
#define PK4(P, BASE, OUT) do { unsigned a0 = cvtpk(P[BASE + 0], P[BASE + 1]), a1 = cvtpk(P[BASE + 2], P[BASE + 3]);   \
    unsigned b0 = cvtpk(P[BASE + 4], P[BASE + 5]), b1 = cvtpk(P[BASE + 6], P[BASE + 7]);                              \
    auto r0 = __builtin_amdgcn_permlane32_swap(a0, b0, false, false); auto r1 = __builtin_amdgcn_permlane32_swap(a1, b1, false, false); \
    u32x4 w = {r0[0], r1[0], r0[1], r1[1]}; OUT = *reinterpret_cast<bf16x8*>(&w); } while (0)
    PK4(p0, 0, pa0); PK4(p0, 8, pa1); PK4(p1, 0, pa2); PK4(p1, 8, pa3);
#undef PK4
}
__device__ __forceinline__ void qkt(f32x16& p0, f32x16& p1, lptr Ks, const bf16x8* qr, int r32, int hi) {
    p0 = f32x16{}; p1 = f32x16{};
#pragma unroll
    for (int d0 = 0; d0 < 8; ++d0) { const int cb = (d0 * 16 + hi * 8) * 2;
        const bf16x8 b0 = *(const LAS bf16x8*)(Ks + KSWZ(r32, cb));
        const bf16x8 b1 = *(const LAS bf16x8*)(Ks + KSWZ(32 + r32, cb));
        p0 = __builtin_amdgcn_mfma_f32_32x32x16_bf16(b0, qr[d0], p0, 0, 0, 0);
        p1 = __builtin_amdgcn_mfma_f32_32x32x16_bf16(b1, qr[d0], p1, 0, 0, 0); }
}
__device__ __forceinline__ int v_st(int k, int c) { const int kk = (k & ~0xC) | ((k & 4) << 1) | ((k & 8) >> 1); return ((kk >> 3) * 4 + (c >> 5)) * 512 + ((kk & 7) * 32 + (c & 31)) * 2; }
__device__ __forceinline__ int v_rd_base(int lane) { return ((lane & 3) << 3) | (((lane >> 2) & 3) << 6) | (((lane >> 4) & 1) << 5) | (((lane >> 5) & 1) << 8); }
constexpr int v_rd_off(int d0, int ks, int half) { return d0 * 512 + ks * 4096 + half * 2048; }
template <int OFF> __device__ __forceinline__ s16x4 tr_read(int vb) {
    s16x4 r; asm volatile("ds_read_b64_tr_b16 %0, %1 offset:%2" : "=&v"(r) : "v"(vb), "i"(OFF) : "memory"); return r;
}
template <int D0> __device__ __forceinline__ void pv_one(f32x16& od, int vb, bf16x8 pa0, bf16x8 pa1, bf16x8 pa2, bf16x8 pa3) {
    const s16x4 l0 = tr_read<v_rd_off(D0, 0, 0)>(vb), h0 = tr_read<v_rd_off(D0, 0, 1)>(vb), l1 = tr_read<v_rd_off(D0, 1, 0)>(vb), h1 = tr_read<v_rd_off(D0, 1, 1)>(vb);
    const s16x4 l2 = tr_read<v_rd_off(D0, 2, 0)>(vb), h2 = tr_read<v_rd_off(D0, 2, 1)>(vb), l3 = tr_read<v_rd_off(D0, 3, 0)>(vb), h3 = tr_read<v_rd_off(D0, 3, 1)>(vb);
    asm volatile("s_waitcnt lgkmcnt(0)" ::: "memory"); SBAR();
#define PK(L, H) (bf16x8){L[0], L[1], L[2], L[3], H[0], H[1], H[2], H[3]}
    od = __builtin_amdgcn_mfma_f32_32x32x16_bf16(pa0, PK(l0, h0), od, 0, 0, 0);
    od = __builtin_amdgcn_mfma_f32_32x32x16_bf16(pa1, PK(l1, h1), od, 0, 0, 0);
    od = __builtin_amdgcn_mfma_f32_32x32x16_bf16(pa2, PK(l2, h2), od, 0, 0, 0);
    od = __builtin_amdgcn_mfma_f32_32x32x16_bf16(pa3, PK(l3, h3), od, 0, 0, 0);
#undef PK
}
__device__ __forceinline__ void pv_d0(f32x16* o, int vb, bf16x8 pa0, bf16x8 pa1, bf16x8 pa2, bf16x8 pa3) {
    pv_one<0>(o[0], vb, pa0, pa1, pa2, pa3); pv_one<1>(o[1], vb, pa0, pa1, pa2, pa3); pv_one<2>(o[2], vb, pa0, pa1, pa2, pa3); pv_one<3>(o[3], vb, pa0, pa1, pa2, pa3);
}

__device__ __forceinline__ void unit(bf16_t* P, const float* kmean, int b, int h, int qb, lptr lds, unsigned ldsaddr, bool dry) {
    int tid_ = threadIdx.x; asm volatile("" : "+v"(tid_));
    const int tid = tid_, wid = __builtin_amdgcn_readfirstlane(tid >> 6), lane = tid & 63, r32 = lane & 31, hi = lane >> 5;
    lptr V_lds = lds + OFF_V; lptr K_lds = lds + OFF_K;
    LAS float* wsl = (LAS float*)(lds + OFF_WS) + wid * 64; LAS float* li_l = wsl; LAS float* al_l = wsl + 32;
    const int q0 = qb * 256, tpos = q0 + wid * 32 + r32;
    const bf16_t* Qw = P + (size_t)(b * SEQ + tpos) * PP + h * 128 + hi * 8;
    const bf16_t* Kh = P + (size_t)(b * SEQ) * PP + 1024 + h * 128;
    const bf16_t* Vh = P + (size_t)(b * SEQ) * PP + 2048 + h * 128;
    float m_reg = -1e30f, l_reg = 0; f32x16 o[4] = {}; bf16x8 qr[8];
#pragma unroll
    for (int d0 = 0; d0 < 8; ++d0) qr[d0] = *(const bf16x8*)(Qw + d0 * 16);
    const float slope = exp2f(-(float)(h + 1));
    unsigned selmask = 0u;
    {
        float v0 = -INFINITY, v1 = -INFINITY, v2 = -INFINITY; int i0 = -1, i1 = -1, i2 = -1;
        { const int n_ = tid >> 5, d_ = (tid & 31) * 4; const float* km = kmean + ((size_t)((b * 8 + h) * 16 + n_)) * 256 + d_;
          *(LAS f32x4*)(lds + tid * 16) = *(const f32x4*)km + *(const f32x4*)(km + 128); }
        float qf[64];
#pragma unroll
        for (int d0 = 0; d0 < 8; ++d0)
#pragma unroll
            for (int e = 0; e < 8; ++e) qf[d0 * 8 + e] = bf2f((bf16_t)qr[d0][e]);
        __syncthreads();
        for (int n = 0; n < qb; ++n) {
            LAS const float* km = (LAS const float*)(lds + n * 512) + hi * 8;
            float s = 0.f;
#pragma unroll
            for (int d0 = 0; d0 < 8; ++d0) { const f32x4 ka = *(LAS const f32x4*)(km + d0 * 16), kb = *(LAS const f32x4*)(km + d0 * 16 + 4);
                s += qf[d0 * 8 + 0] * ka[0] + qf[d0 * 8 + 1] * ka[1] + qf[d0 * 8 + 2] * ka[2] + qf[d0 * 8 + 3] * ka[3]
                   + qf[d0 * 8 + 4] * kb[0] + qf[d0 * 8 + 5] * kb[1] + qf[d0 * 8 + 6] * kb[2] + qf[d0 * 8 + 7] * kb[3]; }
            s += __shfl_xor(s, 32);
            if (s > v0) { v2 = v1; i2 = i1; v1 = v0; i1 = i0; v0 = s; i0 = n; }
            else if (s > v1) { v2 = v1; i2 = i1; v1 = s; i1 = n; }
            else if (s > v2) { v2 = s; i2 = n; }
        }
        __syncthreads();
        if (i0 >= 0) selmask |= 1u << i0; if (i1 >= 0) selmask |= 1u << i1; if (i2 >= 0) selmask |= 1u << i2;
    }
    const int sr = tid >> 4, sc = (tid & 15) * 8, vst0 = v_st(sr, sc), vst1 = v_st(32 + sr, sc);
    const int vb0 = (int)ldsaddr + OFF_V + v_rd_base(lane);
    struct { bf16x8 vs0, vs1, ks0, ks1; } sr_[2];
#define SLOAD(i, k0) do { sr_[i].vs0 = *(const bf16x8*)(&Vh[(size_t)((k0) + sr) * PP + sc]); sr_[i].vs1 = *(const bf16x8*)(&Vh[(size_t)((k0) + 32 + sr) * PP + sc]); \
    sr_[i].ks0 = *(const bf16x8*)(&Kh[(size_t)((k0) + sr) * PP + sc]); sr_[i].ks1 = *(const bf16x8*)(&Kh[(size_t)((k0) + 32 + sr) * PP + sc]); } while (0)
#define SWRITE(bb, i) do { *(LAS bf16x8*)(V_lds + (bb) * SHM_V + vst0) = sr_[i].vs0;          \
    *(LAS bf16x8*)(V_lds + (bb) * SHM_V + vst1) = sr_[i].vs1; const int kc = sc * 2;               \
    *(LAS bf16x8*)(K_lds + (bb) * SHM_K + KSWZ(sr, kc)) = sr_[i].ks0;                       \
    *(LAS bf16x8*)(K_lds + (bb) * SHM_K + KSWZ(32 + sr, kc)) = sr_[i].ks1; } while (0)
#define SWAIT() asm volatile("s_waitcnt vmcnt(4)" ::: "memory")
#define RESC(a) do { if (__any((a) < 1.f)) { if (hi == 0) al_l[r32] = (a); asm volatile("s_waitcnt lgkmcnt(0)" ::: "memory"); \
    _Pragma("unroll") for (int d = 0; d < 4; ++d) _Pragma("unroll") for (int r = 0; r < 16; ++r) o[d][r] *= al_l[crow(r, hi)]; } } while (0)
#define PSM(P0, P1, MN, AL, jj) do { const int j_ = (jj), n_ = j_ >> 2, k0_ = j_ * 64; const bool isd_ = n_ == qb; \
    const bool ok_ = isd_ || ((selmask >> n_) & 1u); const float base_ = slope * (float)(k0_ + 4 * hi - tpos); \
    const bool nm_ = isd_ && (k0_ + 63 > q0 + wid * 32); \
    partialSM(P0, P1, m_reg, MN, AL, slope, base_, ok_, nm_, tpos - k0_ - 4 * hi); } while (0)
    f32x16 pA0, pA1, pB0, pB1; float mnA, mnB, alA, alB; bf16x8 pa0, pa1, pa2, pa3; const int NT = 4 * (qb + 1);
    constexpr int SE = 0, SO = 1;
    SLOAD(SE, 0); asm volatile("s_waitcnt vmcnt(0)" ::: "memory"); SWRITE(0, SE); __syncthreads();
    qkt(pA0, pA1, K_lds, qr, r32, hi); PSM(pA0, pA1, mnA, alA, 0);
    SLOAD(SO, 64); if (2 < NT) SLOAD(SE, 128);
    SWAIT(); SWRITE(1, SO); __syncthreads();
    for (int j = 1; j + 1 < NT; j += 2) {
        SBAR(); qkt(pB0, pB1, K_lds + SHM_K, qr, r32, hi);
        finishSM(pA0, pA1, alA, l_reg, pa0, pa1, pa2, pa3); SBAR();
        SLOAD(SO, (j + 2) * 64); SBAR();
        pv_d0(o, vb0, pa0, pa1, pa2, pa3); PSM(pB0, pB1, mnB, alB, j);
        __syncthreads(); SWAIT(); SWRITE(0, SE);
        RESC(alB); __syncthreads();
        SBAR(); qkt(pA0, pA1, K_lds, qr, r32, hi);
        finishSM(pB0, pB1, alB, l_reg, pa0, pa1, pa2, pa3); SBAR();
        if (j + 3 < NT) SLOAD(SE, (j + 3) * 64); SBAR();
        pv_d0(o, vb0 + SHM_V, pa0, pa1, pa2, pa3); PSM(pA0, pA1, mnA, alA, j + 1);
        __syncthreads(); SWAIT(); SWRITE(1, SO);
        RESC(alA); __syncthreads();
    }
    SBAR(); qkt(pB0, pB1, K_lds + SHM_K, qr, r32, hi);
    finishSM(pA0, pA1, alA, l_reg, pa0, pa1, pa2, pa3); SBAR();
    pv_d0(o, vb0, pa0, pa1, pa2, pa3); PSM(pB0, pB1, mnB, alB, NT - 1);
    __syncthreads(); RESC(alB);
    finishSM(pB0, pB1, alB, l_reg, pa0, pa1, pa2, pa3); SBAR();
    pv_d0(o, vb0 + SHM_V, pa0, pa1, pa2, pa3);
    if (hi == 0) li_l[r32] = l_reg; asm volatile("s_waitcnt lgkmcnt(0)" ::: "memory");
    float rli[16];
#pragma unroll
    for (int r = 0; r < 16; ++r) rli[r] = __builtin_amdgcn_rcpf(li_l[crow(r, hi)]);
    bf16_t* Ow = P + (size_t)(b * SEQ + q0 + wid * 32) * PP + h * 128;
#pragma unroll
    for (int r = 0; r < 16; ++r) { const int orow = crow(r, hi);
#pragma unroll
        for (int d0 = 0; d0 < 4; ++d0) if (!dry) Ow[(size_t)orow * PP + d0 * 32 + r32] = (bf16_t)f2bf(o[d0][r] * rli[r]); }
    __syncthreads();
#undef SLOAD
#undef SWRITE
#undef SWAIT
#undef RESC
#undef PSM
}
}
__device__ __forceinline__ void phase_attn(Frame& F, bf16_t* P, const float* kmean, bool dry = false) {
    for (int pi = F.bid; pi < 256; pi += F.G) {
        const int xcd = pi & 7, slot = pi >> 3, bh = xcd * 4 + (slot >> 3), p = slot & 7;
        att::unit(P, kmean, bh >> 3, bh & 7, 15 - p, (att::lptr)F.lds, (unsigned)(uintptr_t)F.ldsg, dry);
        att::unit(P, kmean, bh >> 3, bh & 7, p, (att::lptr)F.lds, (unsigned)(uintptr_t)F.ldsg, dry);
    }
}


namespace scn {
using att::bf16x8; using att::f32x16; using att::lptr; using att::s16x4;
constexpr int HSLOT = 32768, O_VI = 0, O_BK = 16384, O_AQ = 24576;
constexpr int X_WS = RING_BYTES + 1024, X_SMALL = RING_BYTES + 6144;
__device__ __forceinline__ int swz(int row, int chunk) { return row * 128 + ((chunk ^ ((row >> 1) & 7)) << 4); }

__device__ __forceinline__ void stage_small(const ScanArgs& a, int row0, lptr lds, int tid) {
    *(LAS f32x4*)(lds + X_SMALL + tid * 16) = *(const f32x4*)(a.small + (size_t)row0 * SMALLP + tid * 4);
}
__device__ __forceinline__ void stage_v(const ScanArgs& a, int row0, int grp, int h, lptr slot, int ht) {
    const bf16_t* Vg = a.P + (size_t)row0 * PP + (grp == 0 ? C_GV : C_MV) + h * 128;
    bf16x8 v[8];
#pragma unroll
    for (int i = 0; i < 8; ++i) { const int idx = ht + 128 * i, srow = idx >> 4, sc = (idx & 15) * 8; v[i] = *(const bf16x8*)(Vg + (size_t)srow * PP + sc); }
#pragma unroll
    for (int i = 0; i < 8; ++i) { const int idx = ht + 128 * i, srow = idx >> 4, sc = (idx & 15) * 8; *(LAS bf16x8*)(slot + O_VI + att::v_st(srow, sc)) = v[i]; }
}
__device__ __forceinline__ size_t side_off(int b, int c, int t, int mat, int h) { return ((size_t)((b * NCH + c) * 3 + (t - 61))) * 512 + mat * 256 + h * 64; }

__device__ __forceinline__ void gate_full(const ScanArgs& a, int b, int c, int grp, int h, int half, lptr lds, lptr slot, int lane, LAS float* wsl, float& bc_end, float& nsum, bool dry) {
    const int k = lane, row0 = b * SEQ + c * CH, t0 = 32 * half;
    LAS const float* sml = (LAS const float*)(lds + X_SMALL);
    nsum = 0.f;
    unsigned rq[32], rk[32]; float cs[32];
    float wk0 = 0.f, wk1 = 0.f, wk2 = 0.f, wk3 = 0.f, wq0 = 0.f, wq1 = 0.f, wq2 = 0.f, wq3 = 0.f, bi = 0.f;
    float k1 = 0.f, k2 = 0.f, k3 = 0.f, q1 = 0.f, q2 = 0.f, q3 = 0.f;
    const int cq_ = (grp == 0 ? C_GQ : C_MQ) + h * 64 + k, ck_ = (grp == 0 ? C_GK : C_MK) + h * 64 + k;
    bf16_t* prow = a.P + (size_t)(row0 + t0) * PP;
#pragma unroll
    for (int i = 0; i < 32; ++i) { rk[i] = prow[(size_t)i * PP + ck_]; rq[i] = prow[(size_t)i * PP + cq_]; }
    if (grp == 0) {
        const float bg = a.bgate[h * 64 + k];
        const bf16_t* zr = a.Z + (size_t)(row0 + t0) * 256 + h * 64 + k;
        unsigned zv[32];
#pragma unroll
        for (int i = 0; i < 32; ++i) zv[i] = zr[i * 256];
        float run = 0.f;
#pragma unroll
        for (int i = 0; i < 32; ++i) { run += logsigmoidf_(__uint_as_float(zv[i] << 16) + bg) * (1.f / 16.f); cs[i] = run; }
    } else {
        bi = a.bif[h]; const float bf = a.bif[4 + h];
        wk0 = a.convw[0 * 512 + 256 + h * 64 + k]; wk1 = a.convw[1 * 512 + 256 + h * 64 + k]; wk2 = a.convw[2 * 512 + 256 + h * 64 + k]; wk3 = a.convw[3 * 512 + 256 + h * 64 + k];
        wq0 = a.convw[0 * 512 + h * 64 + k]; wq1 = a.convw[1 * 512 + h * 64 + k]; wq2 = a.convw[2 * 512 + h * 64 + k]; wq3 = a.convw[3 * 512 + h * 64 + k];
        if (c * CH + t0 > 0) {
            const bf16_t* p1 = prow - PP; const bf16_t* p2 = p1 - PP; const bf16_t* p3 = p2 - PP;
            k1 = bf2f(p1[ck_]); k2 = bf2f(p2[ck_]); k3 = bf2f(p3[ck_]); q1 = bf2f(p1[cq_]); q2 = bf2f(p2[cq_]); q3 = bf2f(p3[cq_]);
        }
        float run = 0.f;
#pragma unroll
        for (int i = 0; i < 32; ++i) { run += logsigmoidf_(sml[(t0 + i) * 32 + 20 + h] + bf); cs[i] = run; }
    }
    wsl[lane] = cs[31];
    asm volatile("s_waitcnt vmcnt(0)" ::: "memory");
    __syncthreads();
    const float off = half ? (wsl - 128)[lane] : 0.f;
    bc_end = off + cs[31];
#pragma unroll
    for (int i8 = 0; i8 < 4; ++i8) {
        unsigned pk[8];
#pragma unroll
        for (int e = 0; e < 8; ++e) { const int i = i8 * 8 + e, t = t0 + i; const float bc = off + cs[i];
            float bv, av;
            if (grp == 0) {
                const float ex = __expf(bc);
                bv = __uint_as_float(rk[i] << 16) * __builtin_amdgcn_rcpf(ex);
                av = __uint_as_float(rq[i] << 16) * 0.125f * ex;
            } else {
                const float ip = sml[t * 32 + 16 + h] + bi;
                const float kc = __uint_as_float(rk[i] << 16);
                const float ck = wk0 * k3 + wk1 * k2 + wk2 * k1 + wk3 * kc; k3 = k2; k2 = k1; k1 = kc;
                bv = siluf_(ck) * 0.125f * __expf(ip - bc);
                const float qc = __uint_as_float(rq[i] << 16);
                const float cq = wq0 * q3 + wq1 * q2 + wq2 * q1 + wq3 * qc; q3 = q2; q2 = q1; q1 = qc;
                av = siluf_(cq) * __expf(bc);
            }
            nsum += bv; pk[e] = f2bf(bv);
            const bf16_t ab = (bf16_t)f2bf(av), bb = (bf16_t)pk[e];
            if (RPT && dry) { asm volatile("" :: "v"((unsigned)ab), "v"((unsigned)bb)); }
            if (!dry) { if (grp == 1 && t >= 61) { bf16_t* sd = a.side + side_off(b, c, t, 0, h) + k; sd[0] = ab; sd[256] = bb; }
            else { prow[(size_t)i * PP + cq_] = ab; prow[(size_t)i * PP + ck_] = bb; if (VARX & 4) { asm volatile("" ::: "memory"); prow[(size_t)i * PP + cq_] = ab; prow[(size_t)i * PP + ck_] = bb; } } } }
        { u32x4 w; w.x = pk[0] | (pk[1] << 16); w.y = pk[2] | (pk[3] << 16); w.z = pk[4] | (pk[5] << 16); w.w = pk[6] | (pk[7] << 16);
          *(LAS u32x4*)(slot + O_BK + swz(k, (t0 >> 3) + i8)) = w; }
    }
}
__device__ __forceinline__ void stage_ab(const ScanArgs& a, int b, int c, int grp, int h, lptr slot, int ht) {
    const int row0 = b * SEQ + c * CH;
    bf16x8 v[8];
#pragma unroll
    for (int i = 0; i < 8; ++i) { const int idx = ht + 128 * i, mat = idx >> 9, r = (idx >> 3) & 63, ch = idx & 7;
        const bf16_t* src = a.P + (size_t)(row0 + r) * PP + (grp == 0 ? (mat ? C_GK : C_GQ) : (mat ? C_MK : C_MQ)) + h * 64 + ch * 8;
        if (grp == 1 && r >= 61) src = a.side + side_off(b, c, r, mat, h) + ch * 8;
        v[i] = *(const bf16x8*)src; }
#pragma unroll
    for (int i = 0; i < 8; ++i) { const int idx = ht + 128 * i, mat = idx >> 9, r = (idx >> 3) & 63, ch = idx & 7;
        *(LAS bf16x8*)(slot + (mat ? O_BK : O_AQ) + swz(r, ch)) = v[i]; }
}
}

__device__ __forceinline__ void phase_scan1m(Frame& F, const ScanArgs& a, bool dry = false) {
    using namespace scn;
    const int wid = __builtin_amdgcn_readfirstlane(threadIdx.x >> 6);
    const int hw = wid >> 1, half = wid & 1;
    lptr lds = (lptr)F.lds; lptr slot = lds + hw * HSLOT;
    LAS float* wsl = (LAS float*)(lds + X_WS) + wid * 128;
    const unsigned ldsaddr = (unsigned)(uintptr_t)F.ldsg;
    for (int unit = F.bid; unit < BATCH * NCH; unit += F.G) {
        const int b = unit / NCH, c = unit % NCH, row0 = b * SEQ + c * CH;
        stage_small(a, row0, lds, opaque_i(threadIdx.x));
        for (int grp = 0; grp < 2; ++grp) {
            const int tid = opaque_i(threadIdx.x), lane = tid & 63, r32 = lane & 31, hi = lane >> 5;
            const int h = hw, bh = b * 4 + h;
            stage_v(a, row0, grp, h, slot, tid & 127);
            __syncthreads();
            float bc_end, nsum;
            gate_full(a, b, c, grp, h, half, lds, slot, lane, wsl, bc_end, nsum, dry);
            if (half == 1 && !dry) a.dec[((size_t)(grp * 16 + bh) * NCH + c) * 64 + lane] = __expf(bc_end);
            if (grp == 1) wsl[64 + lane] = nsum;
            __syncthreads();
            if (grp == 1 && half == 0 && !dry) { LAS float* other = wsl + 128; a.NS[((size_t)bh * NCH + c) * 64 + lane] = wsl[64 + lane] + other[64 + lane]; }
            bf16x8 pa[4];
#pragma unroll
            for (int ks = 0; ks < 4; ++ks) pa[ks] = *(LAS bf16x8*)(slot + O_BK + swz(32 * half + r32, 2 * ks + hi));
            f32x16 o[4] = {};
            att::pv_d0(o, (int)ldsaddr + hw * HSLOT + O_VI + att::v_rd_base(lane), pa[0], pa[1], pa[2], pa[3]);
            bf16_t* st = a.ST + st_off(grp, bh, c);
#pragma unroll
            for (int d0 = 0; d0 < 4; ++d0)
#pragma unroll
                for (int g = 0; g < 4; ++g) {
                    const unsigned long long w = (unsigned long long)pk2(o[d0][4 * g], o[d0][4 * g + 1]) | ((unsigned long long)pk2(o[d0][4 * g + 2], o[d0][4 * g + 3]) << 32);
                    if (!dry) *(unsigned long long*)(st + (size_t)(32 * d0 + r32) * 64 + 32 * half + 8 * g + 4 * hi) = w; }
            __syncthreads();
        }
    }
}
__device__ __forceinline__ void phase_scan3m(Frame& F, const ScanArgs& a, bool dry = false) {
    using namespace scn;
    const int wid = __builtin_amdgcn_readfirstlane(threadIdx.x >> 6);
    const int hw = wid >> 1, half = wid & 1;
    lptr lds = (lptr)F.lds; lptr slot = lds + hw * HSLOT;
    LAS float* wsl = (LAS float*)(lds + X_WS) + wid * 128;
    const unsigned ldsaddr = (unsigned)(uintptr_t)F.ldsg;
    for (int unit = F.bid; unit < BATCH * NCH; unit += F.G) {
        const int b = unit / NCH, c = unit % NCH, row0 = b * SEQ + c * CH;
        for (int grp = 0; grp < 2; ++grp) {
            const int tid = opaque_i(threadIdx.x), lane = tid & 63, r32 = lane & 31, hi = lane >> 5;
            const int h = hw, bh = b * 4 + h;
            stage_v(a, row0, grp, h, slot, tid & 127);
            stage_ab(a, b, c, grp, h, slot, tid & 127);
            __syncthreads();
            bf16x8 qr[4];
#pragma unroll
            for (int d0 = 0; d0 < 4; ++d0) qr[d0] = *(LAS bf16x8*)(slot + O_AQ + swz(32 * half + r32, 2 * d0 + hi));
            f32x16 p0 = {}, p1 = {};
#pragma unroll
            for (int d0 = 0; d0 < 4; ++d0) {
                const bf16x8 b0 = *(LAS bf16x8*)(slot + O_BK + swz(r32, 2 * d0 + hi));
                const bf16x8 b1 = *(LAS bf16x8*)(slot + O_BK + swz(32 + r32, 2 * d0 + hi));
                p0 = __builtin_amdgcn_mfma_f32_32x32x16_bf16(b0, qr[d0], p0, 0, 0, 0);
                p1 = __builtin_amdgcn_mfma_f32_32x32x16_bf16(b1, qr[d0], p1, 0, 0, 0); }
            const int dq = 32 * half + r32 - 4 * hi;
            float ps = 0.f;
#pragma unroll
            for (int r = 0; r < 16; ++r) { const int cc = (r & 3) + 8 * (r >> 2); if (cc > dq) p0[r] = 0.f; if (cc + 32 > dq) p1[r] = 0.f; ps += p0[r] + p1[r]; }
            bf16x8 pa0, pa1, pa2, pa3;
#define PK4(P, BASE, OUT) do { unsigned a0 = att::cvtpk(P[BASE + 0], P[BASE + 1]), a1 = att::cvtpk(P[BASE + 2], P[BASE + 3]);   \
    unsigned b0_ = att::cvtpk(P[BASE + 4], P[BASE + 5]), b1_ = att::cvtpk(P[BASE + 6], P[BASE + 7]);                              \
    auto r0 = __builtin_amdgcn_permlane32_swap(a0, b0_, false, false); auto r1 = __builtin_amdgcn_permlane32_swap(a1, b1_, false, false); \
    u32x4 w = {r0[0], r1[0], r0[1], r1[1]}; OUT = *reinterpret_cast<bf16x8*>(&w); } while (0)
            PK4(p0, 0, pa0); PK4(p0, 8, pa1); PK4(p1, 0, pa2); PK4(p1, 8, pa3);
#undef PK4
            float den = 0.f;
            if (grp == 1) {
                const float* ns = a.NS + ((size_t)bh * NCH + c) * 64 + hi * 8;
#pragma unroll
                for (int d0 = 0; d0 < 4; ++d0) { const f32x4 na = *(const f32x4*)(ns + d0 * 16), nb = *(const f32x4*)(ns + d0 * 16 + 4); const bf16x8 q = qr[d0];
                    ps += bf2f((bf16_t)q[0]) * na[0] + bf2f((bf16_t)q[1]) * na[1] + bf2f((bf16_t)q[2]) * na[2] + bf2f((bf16_t)q[3]) * na[3]
                        + bf2f((bf16_t)q[4]) * nb[0] + bf2f((bf16_t)q[5]) * nb[1] + bf2f((bf16_t)q[6]) * nb[2] + bf2f((bf16_t)q[7]) * nb[3]; }
                den = ps + __shfl_xor(ps, 32);
            }
            f32x16 o[4] = {};
            att::pv_d0(o, (int)ldsaddr + hw * HSLOT + O_VI + att::v_rd_base(lane), pa0, pa1, pa2, pa3);
            const bf16_t* st = a.ST + st_off(grp, bh, c);
#pragma unroll
            for (int d0 = 0; d0 < 4; ++d0) {
                bf16x8 sv[4];
#pragma unroll
                for (int ks = 0; ks < 4; ++ks) sv[ks] = *(const bf16x8*)(st + (size_t)(32 * d0 + r32) * 64 + 16 * ks + 8 * hi);
#pragma unroll
                for (int ks = 0; ks < 4; ++ks) o[d0] = __builtin_amdgcn_mfma_f32_32x32x16_bf16(qr[ks], sv[ks], o[d0], 0, 0, 0);
            }
            if (grp == 1) { if (hi == 0) wsl[64 + r32] = den; asm volatile("s_waitcnt lgkmcnt(0)" ::: "memory"); }
            const int gcol = (grp == 0 ? C_GR : C_MO) + h * 128;
            const float* gain = (grp == 0 ? a.gla_gain : a.ml_gain) + h * 128;
            float gn[4];
#pragma unroll
            for (int d0 = 0; d0 < 4; ++d0) gn[d0] = gain[32 * d0 + r32];
#pragma unroll
            for (int r = 0; r < 16; ++r) {
                const int t = 32 * half + att::crow(r, hi);
                bf16_t* pr = a.P + (size_t)(row0 + t) * PP + gcol + r32;
                float ov[4], gv[4];
#pragma unroll
                for (int d0 = 0; d0 < 4; ++d0) { ov[d0] = o[d0][r]; gv[d0] = bf2f(pr[32 * d0]); }
                if (grp == 1) { const float dd = 1.f / fmaxf(fabsf(wsl[64 + att::crow(r, hi)]), 1.f);
#pragma unroll
                    for (int d0 = 0; d0 < 4; ++d0) ov[d0] = ov[d0] * dd * sigmoidf_(gv[d0]); }
                float ss = (ov[0] * ov[0] + ov[1] * ov[1]) + (ov[2] * ov[2] + ov[3] * ov[3]);
                ss += __shfl_xor(ss, 1); ss += __shfl_xor(ss, 2); ss += __shfl_xor(ss, 4); ss += __shfl_xor(ss, 8); ss += __shfl_xor(ss, 16);
                const float rstd = __builtin_amdgcn_rsqf(ss * (1.f / 128.f) + EPS);
#pragma unroll
                for (int d0 = 0; d0 < 4; ++d0) { float y = ov[d0] * rstd * gn[d0]; if (grp == 0) y *= siluf_(gv[d0]); if (!dry) pr[32 * d0] = (bf16_t)f2bf(y); }
            }
            __syncthreads();
        }
    }
}

__global__ void __launch_bounds__(NTHR, 2) mk_fwd(Args args) {
    extern __shared__ __attribute__((aligned(16))) unsigned char lds[];
    Frame F;
    F.lds = (LAS unsigned char*)lds; F.ldsg = lds;
    F.tid = threadIdx.x; F.lane = F.tid & 63; F.wave = __builtin_amdgcn_readfirstlane(F.tid >> 6);
    F.G = gridDim.x; F.bid = blockIdx.x;
    volatile LAS unsigned* MISC = (volatile LAS unsigned*)(F.lds + MISC_OFF);
    for (int u = F.tid; u < (LDS_BYTES - RING_BYTES) / 4; u += NTHR) ((LAS unsigned*)(F.lds + RING_BYTES))[u] = 0u;
    __syncthreads();
    kargp_t kp0 = karg_base();
    unsigned char* ws = karg_ws(kp0);
    XcdBarrier bar; bar.bar = (unsigned*)(ws + WS_CTL) + 4096; bar.x = 0; bar.st = nullptr;
    if (!MK_MULTI) bar = xcd_barrier_post((unsigned*)(ws + WS_CTL) + 4096, MISC + 8);
    const int lo = args.ph_lo, hi = args.ph_hi;
#define IN(k) (lo <= (k) && (k) < hi)
#define SEAM(k) do { if (!MK_MULTI && (k) + 1 < hi) { xcd_barrier(bar); if (RPT & 2048) xcd_barrier(bar); } } while (0)

    float* rss = (float*)(ws + WS_RSS); float* small = (float*)(ws + WS_SMALL); float* kmean = (float*)(ws + WS_KMEAN);
    bf16_t* xb = (bf16_t*)(ws + WS_XB); bf16_t* P = (bf16_t*)(ws + WS_P);
    float* out = karg_out(kp0);

    if (IN(0)) { if (PH_MASK & 1) { phase_prologue(F); if (RPT & 1) phase_prologue(F); } SEAM(0); }

    for (int l = 0; l < DEPTH; ++l) {
        const int j = l >> 1, base = 1 + l * 8;
        unsigned char* wj = ws + WS_W + j * W_MIXSZ;
        unsigned char* wl = ws + WS_W + W_FFN0 + l * W_FFNSZ;
        kargp_t kp = karg_base();
        const float* xin = l == 0 ? karg_in(kp, 0) : out;
        if ((l & 1) == 0) {
            ScanArgs sa{(const bf16_t*)(ws + WS_Z), (bf16_t*)(ws + WS_SIDE), P, small, karg_in(kp, 4) + (size_t)j * 16 * 256, karg_in(kp, 5) + j * 256, karg_in(kp, 6) + j * 512, karg_in(kp, 7) + (size_t)j * 4 * 512, karg_in(kp, 8) + j * 8, karg_in(kp, 9) + j * 512,
                        (bf16_t*)(ws + WS_XB), (float*)(ws + WS_DEC), (float*)(ws + WS_NS)};
            if (IN(base + 0)) {
                pg8::Gemm g{xb, (const bf16_t*)(wj + W_IN), M, HYB_PAD, DM, DM}; pg8::StaticOrder S; S.init(M, HYB_PAD, F.G, F.bid);
                EpiRowBf16 E{P, PP, rss, small, 13, (bf16_t*)(ws + WS_Z), 12};
                if (PH_MASK & 64) { const int nrep_ = (RPT & 2) ? 2 : 1; for (int rep_ = 0; rep_ < nrep_; ++rep_) { pg8::gemm_phase<EpiRowBf16, pg8::StaticOrder, true, true>(F.lds, g, S, E); } }
                SEAM(base + 0);
            }
            if (IN(base + 1)) { if (PH_MASK & 2) { if (SCAN_SIMPLE) phase_scan1(F, sa); else { if (RPT & 4) phase_scan1m(F, sa, RPT && opaque_i(1) != 0); phase_scan1m(F, sa, RPT && opaque_i(0) != 0); } } SEAM(base + 1); }
            if (IN(base + 2)) { if (PH_MASK & 4) { if (RPT & 8) phase_scan2(F, sa, RPT && opaque_i(1) != 0); phase_scan2(F, sa, RPT && opaque_i(0) != 0); } SEAM(base + 2); }
            if (IN(base + 3)) { if (PH_MASK & 8) { if (SCAN_SIMPLE) phase_scan3(F, sa); else { if (RPT & 16) phase_scan3m(F, sa, RPT && opaque_i(1) != 0); phase_scan3m(F, sa, RPT && opaque_i(0) != 0); } } SEAM(base + 3); }
            if (IN(base + 4)) {
                pg8::Gemm g{P + C_GR, (const bf16_t*)(wj + W_OUT), M, DM, DM, PP}; pg8::StaticOrder S; S.init(M, DM, F.G, F.bid);
                EpiRes E{xin, out, xb, rss, 0};
                if (PH_MASK & 128) { const int nrep_ = (RPT & 32) ? 2 : 1; for (int rep_ = 0; rep_ < nrep_; ++rep_) { E.dry = RPT ? opaque_i(rep_ + 1 < nrep_ ? 1 : 0) : 0; pg8::gemm_phase<EpiRes, pg8::StaticOrder, true, true>(F.lds, g, S, E); } }
                SEAM(base + 4);
            }
        } else {
            if (IN(base + 0)) {
                pg8::Gemm g{xb, (const bf16_t*)(wj + W_QKV), M, 3 * DM, DM, DM}; pg8::StaticOrder S; S.init(M, 3 * DM, F.G, F.bid);
                EpiQkv E{P, rss, karg_in(kp, 12) + j * 128, karg_in(kp, 13) + j * 128, kmean, (LAS float*)(F.lds + scn::X_SMALL), (LAS float*)(F.lds + scn::X_WS)};
                if (PH_MASK & 256) { const int nrep_ = (RPT & 64) ? 2 : 1; for (int rep_ = 0; rep_ < nrep_; ++rep_) { pg8::gemm_phase<EpiQkv, pg8::StaticOrder, true, true>(F.lds, g, S, E); } }
                SEAM(base + 0);
            }
            if (IN(base + 1)) { if (PH_MASK & 16) phase_kmean(F, P, kmean); SEAM(base + 1); }
            if (IN(base + 2)) { if (PH_MASK & 32) { if (ATTN_SIMPLE) phase_attn_simple(F, P, kmean); else { if (RPT & 256) phase_attn(F, P, kmean, RPT && opaque_i(1) != 0); phase_attn(F, P, kmean, RPT && opaque_i(0) != 0); } } SEAM(base + 2); }
            if (IN(base + 3)) {
                pg8::Gemm g{P, (const bf16_t*)(wj + W_O), M, DM, DM, PP}; pg8::StaticOrder S; S.init(M, DM, F.G, F.bid);
                EpiRes E{xin, out, xb, rss, 0};
                if (PH_MASK & 512) { const int nrep_ = (RPT & 32) ? 2 : 1; for (int rep_ = 0; rep_ < nrep_; ++rep_) { E.dry = RPT ? opaque_i(rep_ + 1 < nrep_ ? 1 : 0) : 0; pg8::gemm_phase<EpiRes, pg8::StaticOrder, true, true>(F.lds, g, S, E); } }
                SEAM(base + 3);
            }
        }
        if (IN(base + 5)) {
            pg8::Gemm g{xb, (const bf16_t*)(wl + W_GU), M, 2 * DFF, DM, DM}; pg8::StaticOrder S; S.init(M, 2 * DFF, F.G, F.bid);
            EpiFfn E{P, rss};
            if (PH_MASK & 1024) { const int nrep_ = (RPT & 512) ? 2 : 1; for (int rep_ = 0; rep_ < nrep_; ++rep_) { pg8::gemm_phase<EpiFfn, pg8::StaticOrder, true, true>(F.lds, g, S, E); } }
            SEAM(base + 5);
        }
        if (IN(base + 6)) {
            pg8::Gemm g{P, (const bf16_t*)(wl + W_D), M, DM, DFF, DFF}; pg8::StaticOrder S; S.init(M, DM, F.G, F.bid);
            EpiRes E{out, out, xb, rss, 0};
            if (PH_MASK & 2048) { const int nrep_ = (RPT & 1024) ? 2 : 1; for (int rep_ = 0; rep_ < nrep_; ++rep_) { E.dry = RPT ? opaque_i(rep_ + 1 < nrep_ ? 1 : 0) : 0; pg8::gemm_phase<EpiRes, pg8::StaticOrder, true, true>(F.lds, g, S, E); } }
            SEAM(base + 6);
        }
    }
#undef IN
#undef SEAM
}

extern "C" void kernel_launch(void* const* d_in, const int* in_sizes, int n_in, void* d_out, int out_size, void* d_ws, size_t ws_size, hipStream_t stream) {
    static int grid = 0;
    if (grid == 0) {
        int dev = 0, cus = 0;
        if (n_in != 18 || ws_size < 256 * MiB) { fprintf(stderr, "kernel_launch: unexpected inputs (%d) or workspace (%zu < %zu)\n", n_in, ws_size, (size_t)WS_END); grid = -1; return; }
        if (hipGetDevice(&dev) != hipSuccess || hipDeviceGetAttribute(&cus, hipDeviceAttributeMultiprocessorCount, dev) != hipSuccess) { grid = -1; return; }
        if (hipFuncSetAttribute((const void*)mk_fwd, hipFuncAttributeMaxDynamicSharedMemorySize, LDS_BYTES) != hipSuccess) { grid = -1; return; }
        int per_cu = 0;
        if (hipOccupancyMaxActiveBlocksPerMultiprocessor(&per_cu, (const void*)mk_fwd, NTHR, LDS_BYTES) != hipSuccess || per_cu < 1) { fprintf(stderr, "kernel_launch: occupancy query says %d\n", per_cu); }
        (void)hipGetLastError();
        grid = cus;
    }
    if (grid < 0) return;
    (void)hipMemsetAsync((char*)d_ws + WS_CTL, 0, CTL_ZERO_BYTES, stream);
    Args a{};
    for (int i = 0; i < 18; ++i) a.in[i] = (const float*)d_in[i];
    a.out = (float*)d_out; a.ws = (unsigned char*)d_ws;
#if MK_MULTI
    for (int ph = 0; ph < 1 + DEPTH * 8; ++ph) {
        if (ph > 0) { const int l = (ph - 1) >> 3, s = (ph - 1) & 7; if (s == 7) continue; if ((l & 1) == 0 && s == 7) continue; if ((l & 1) == 1 && s == 4) continue; }
        a.ph_lo = ph; a.ph_hi = ph + 1;
        hipLaunchKernelGGL(mk_fwd, dim3(grid), dim3(NTHR), LDS_BYTES, stream, a);
    }
#else
    a.ph_lo = 0; a.ph_hi = DEPTH * 8;
    hipLaunchKernelGGL(mk_fwd, dim3(grid), dim3(NTHR), LDS_BYTES, stream, a);
#endif
}
```

```cpp
#include <hip/hip_runtime.h>
#include <cstdio>
#include <cstdint>

namespace pg8 {
#define PG8_LAS __attribute__((address_space(3)))
typedef unsigned short bf16_t;
typedef short bf16x8 __attribute__((ext_vector_type(8)));
typedef float f32x4 __attribute__((ext_vector_type(4)));
typedef unsigned u32x4 __attribute__((ext_vector_type(4)));
constexpr int BM = 256, BK = 64, HALF = 128, HTB = HALF * BK * 2  , STAGE_BYTES = 8 * HTB, NXCD = 8, WGM = 8;

__host__ __device__ __forceinline__ int lds_byte(int r, int c) { const int st = (r >> 4) * 2 + (c >> 5), rr = r & 15, cc = c & 31, ob = rr * 64 + cc * 2; return st * 1024 + (ob ^ (((ob >> 9) & 1) << 5)); }
__host__ __device__ __forceinline__ void stage_rc(int b, int& R, int& C) { const int st = b / 1024, sb = b % 1024, swz = sb ^ (((sb >> 9) & 1) << 5); R = (st >> 1) * 16 + swz / 64; C = (st & 1) * 32 + (swz % 64) / 2; }
__host__ __device__ __forceinline__ int perm32(int rho) { const int n = rho >> 4, i = rho & 15; return 8 * (i >> 2) + 4 * n + (i & 3); }

struct Unit { int pm, pn, idx; };
struct Gemm { const bf16_t* A; const bf16_t* Bt; int M, N, K, lda; };

struct StaticOrder {
    int nM, nN, nwg, G, c;
    __host__ __device__ void init(int M, int N, int G_, int c_) { nM = M / BM; nN = N / BM; nwg = nM * nN; G = G_; c = c_; }
    __host__ __device__ bool next(int i, Unit& u) const {
        const long L = (long)i * G + c; if (L >= nwg) return false;
        int wgid = (int)L; { const int q = nwg / NXCD, r = nwg % NXCD, xcd = wgid % NXCD, off = wgid / NXCD; wgid = (xcd < r ? xcd * (q + 1) : r * (q + 1) + (xcd - r) * q) + off; }
        const int nig = WGM * nN, gid = wgid / nig, fm = gid * WGM, gsz = (nM - fm) < WGM ? (nM - fm) : WGM;
        u.pm = fm + ((wgid % nig) % gsz); u.pn = (wgid % nig) / gsz; u.idx = i; return true;
    }
    __device__ __forceinline__ void a_ready(const Unit&) const {}
    __device__ __forceinline__ void done(const Unit&) const {}
};
__device__ __forceinline__ unsigned cvt_pk_bf16(float lo, float hi) { unsigned r; asm volatile("v_cvt_pk_bf16_f32 %0, %1, %2" : "=v"(r) : "v"(lo), "v"(hi)); return r; }
template <class Epi, class Sched, bool ALIGN_EPI = false, bool SP2 = false>
__device__ __forceinline__ void gemm_phase(PG8_LAS unsigned char* lds, const Gemm g, const Sched& S, const Epi& E) {
    int tid_ = threadIdx.x; asm volatile("" : "+v"(tid_));
    const int tid = tid_, wid = __builtin_amdgcn_readfirstlane(tid >> 6), lane = tid & 63, wr = wid >> 2, wc = wid & 3, fr = lane & 15, fq = lane >> 4;
    const int K = g.K, nt = K / BK;
    unsigned voffA[2], voffB[2];
#pragma unroll
    for (int i = 0; i < 2; ++i) { int R, C; stage_rc(tid * 16 + i * 8192, R, C); const int Rb = Epi::PERM ? ((R & ~31) + perm32(R & 31)) : R;
        voffA[i] = (unsigned)(R * g.lda + C) * 2u; voffB[i] = (unsigned)(Rb * K + C) * 2u; }
    const size_t kstep = (size_t)(BK * 2);
    const size_t hstepB = (size_t)HALF * K * 2, hstepA = (size_t)HALF * g.lda * 2;
    const size_t tstepA = 2 * hstepA, tstepB = 2 * hstepB;
    const unsigned ldsw = (unsigned)wid * 1024u;
    const int aoff = lds_byte(wr * 64 + fr, fq * 8), boff = lds_byte(wc * 32 + fr, fq * 8);
#define PG8_SA(b, h) (((b) * 2 + (h)) * HTB)
#define PG8_SB(b, h) ((4 + (b) * 2 + (h)) * HTB)
#define PG8_STAGE(bufoff, gbase, voff) do { _Pragma("unroll") for (int _i = 0; _i < 2; ++_i) \
        __builtin_amdgcn_global_load_lds((const unsigned*)((const char*)(gbase) + (voff)[_i]), (PG8_LAS unsigned*)(lds + (bufoff) + ldsw + _i * 8192), 16, 0, 0); } while (0)
#define PG8_LDA(dst, b, h) do { _Pragma("unroll") for (int m = 0; m < 4; ++m) _Pragma("unroll") for (int k = 0; k < 2; ++k) dst[m][k] = *(const PG8_LAS bf16x8*)(lds + PG8_SA(b, h) + aoff + m * 2048 + k * 1024); } while (0)
#define PG8_LDB(dst, b, h) do { _Pragma("unroll") for (int n = 0; n < 2; ++n) _Pragma("unroll") for (int k = 0; k < 2; ++k) dst[n][k] = *(const PG8_LAS bf16x8*)(lds + PG8_SB(b, h) + boff + n * 2048 + k * 1024); } while (0)
#define PG8_MMA(ai, bj, At, Bt) do { __builtin_amdgcn_s_setprio(1); _Pragma("unroll") for (int m = 0; m < 4; ++m) _Pragma("unroll") for (int n = 0; n < 2; ++n) _Pragma("unroll") for (int k = 0; k < 2; ++k) \
        acc[ai][bj][m][n] = __builtin_amdgcn_mfma_f32_16x16x32_bf16(Bt[n][k], At[m][k], acc[ai][bj][m][n], 0, 0, 0); __builtin_amdgcn_s_setprio(0); } while (0)
#define PG8_WAIT_V(n) asm volatile("s_waitcnt vmcnt(" #n ")" ::: "memory")
#define PG8_WAIT_L(n) asm volatile("s_waitcnt lgkmcnt(" #n ")" ::: "memory")
#define PG8_BAR __builtin_amdgcn_s_barrier()
#define PG8_SCHED __builtin_amdgcn_sched_barrier(0)
    Unit cur, nxt; int ui = 0;
    if (!S.next(0, cur)) return;
    f32x4 acc[2][2][4][2];
#pragma unroll
    for (int a = 0; a < 2; ++a)
#pragma unroll
        for (int b = 0; b < 2; ++b)
#pragma unroll
            for (int m = 0; m < 4; ++m)
#pragma unroll
                for (int n = 0; n < 2; ++n) acc[a][b][m][n] = (f32x4){0.f, 0.f, 0.f, 0.f};
    bf16x8 At[4][2], B0[2][2], B1[2][2];
    const char* cA = (const char*)g.A + (size_t)cur.pm * tstepA; const char* cB = (const char*)g.Bt + (size_t)cur.pn * tstepB;
    S.a_ready(cur);
    if constexpr (SP2) {
        PG8_STAGE(PG8_SB(0, 0), cB, voffB); PG8_STAGE(PG8_SB(0, 1), cB + hstepB, voffB); PG8_STAGE(PG8_SA(0, 0), cA, voffA); PG8_STAGE(PG8_SA(0, 1), cA + hstepA, voffA);
        if (wr == 1) PG8_BAR;
        PG8_WAIT_V(2); PG8_BAR;
        PG8_STAGE(PG8_SB(1, 0), cB + kstep, voffB); PG8_STAGE(PG8_SA(1, 0), cA + kstep, voffA); PG8_STAGE(PG8_SB(1, 1), cB + hstepB + kstep, voffB);
        PG8_WAIT_V(6); PG8_BAR;
    } else {
        PG8_STAGE(PG8_SB(0, 0), cB, voffB); PG8_STAGE(PG8_SA(0, 0), cA, voffA); PG8_STAGE(PG8_SB(0, 1), cB + hstepB, voffB); PG8_STAGE(PG8_SA(0, 1), cA + hstepA, voffA);
        if (wr == 1) PG8_BAR;
        PG8_WAIT_V(4); PG8_BAR;
        PG8_STAGE(PG8_SB(1, 0), cB + kstep, voffB); PG8_STAGE(PG8_SA(1, 0), cA + kstep, voffA); PG8_STAGE(PG8_SB(1, 1), cB + hstepB + kstep, voffB);
        PG8_WAIT_V(6); PG8_BAR;
    }
    for (;;) {
        const bool has_next = S.next(ui + 1, nxt);
        const char* nA = has_next ? (const char*)g.A + (size_t)nxt.pm * tstepA : cA; const char* nB = has_next ? (const char*)g.Bt + (size_t)nxt.pn * tstepB : cB;
        for (int t = 0; t < nt; t += 2) {
            const bool last = (t == nt - 2);
            const char* a1 = cA + (size_t)(t + 1) * kstep;
            const char* a2 = last ? nA : cA + (size_t)(t + 2) * kstep; const char* b2 = last ? nB : cB + (size_t)(t + 2) * kstep;
            const char* a3 = a2 + kstep; const char* b3 = b2 + kstep;
            if (last && has_next) S.a_ready(nxt);
            if constexpr (SP2) {
            PG8_LDB(B0, 0, 0); PG8_LDB(B1, 0, 1); PG8_SCHED; PG8_LDA(At, 0, 0); PG8_STAGE(PG8_SA(1, 1), a1 + hstepA, voffA);
            PG8_WAIT_V(8); PG8_WAIT_L(0); PG8_BAR; PG8_MMA(0, 0, At, B0); PG8_MMA(0, 1, At, B1); PG8_BAR; PG8_SCHED;
            PG8_LDA(At, 0, 1); PG8_STAGE(PG8_SB(0, 0), b2, voffB); PG8_STAGE(PG8_SB(0, 1), b2 + hstepB, voffB); PG8_STAGE(PG8_SA(0, 0), a2, voffA);
            PG8_WAIT_V(8); PG8_WAIT_L(0); PG8_BAR; PG8_MMA(1, 0, At, B0); PG8_MMA(1, 1, At, B1); PG8_BAR; PG8_SCHED;
            PG8_LDB(B0, 1, 0); PG8_LDB(B1, 1, 1); PG8_SCHED; PG8_LDA(At, 1, 0); PG8_STAGE(PG8_SA(0, 1), a2 + hstepA, voffA);
            PG8_WAIT_V(8); PG8_WAIT_L(0); PG8_BAR; PG8_MMA(0, 0, At, B0); PG8_MMA(0, 1, At, B1); PG8_BAR; PG8_SCHED;
            PG8_LDA(At, 1, 1); PG8_STAGE(PG8_SB(1, 0), b3, voffB); PG8_STAGE(PG8_SB(1, 1), b3 + hstepB, voffB); PG8_STAGE(PG8_SA(1, 0), a3, voffA);
            PG8_WAIT_V(8); PG8_WAIT_L(0); PG8_BAR; PG8_MMA(1, 0, At, B0); PG8_MMA(1, 1, At, B1); PG8_BAR; PG8_SCHED;
            } else {
            PG8_LDB(B0, 0, 0); PG8_SCHED; PG8_LDA(At, 0, 0); PG8_STAGE(PG8_SA(1, 1), a1 + hstepA, voffA);
            PG8_WAIT_L(8); PG8_BAR; PG8_WAIT_L(0); PG8_MMA(0, 0, At, B0); PG8_BAR; PG8_SCHED;
            PG8_LDB(B1, 0, 1); PG8_STAGE(PG8_SB(0, 0), b2, voffB);
            PG8_BAR; PG8_WAIT_L(0); PG8_MMA(0, 1, At, B1); PG8_BAR;
            PG8_LDA(At, 0, 1); PG8_STAGE(PG8_SA(0, 0), a2, voffA);
            PG8_BAR; PG8_WAIT_L(0); PG8_MMA(1, 0, At, B0); PG8_BAR; PG8_SCHED;
            PG8_STAGE(PG8_SB(0, 1), b2 + hstepB, voffB);
            PG8_WAIT_V(6); PG8_BAR; PG8_MMA(1, 1, At, B1); PG8_BAR;
            PG8_LDB(B0, 1, 0); PG8_SCHED; PG8_LDA(At, 1, 0); PG8_STAGE(PG8_SA(0, 1), a2 + hstepA, voffA);
            PG8_WAIT_L(8); PG8_BAR; PG8_WAIT_L(0); PG8_MMA(0, 0, At, B0); PG8_BAR; PG8_SCHED;
            PG8_LDB(B1, 1, 1); PG8_STAGE(PG8_SB(1, 0), b3, voffB);
            PG8_BAR; PG8_WAIT_L(0); PG8_MMA(0, 1, At, B1); PG8_BAR;
            PG8_LDA(At, 1, 1); PG8_STAGE(PG8_SA(1, 0), a3, voffA);
            PG8_BAR; PG8_WAIT_L(0); PG8_MMA(1, 0, At, B0); PG8_BAR; PG8_SCHED;
            PG8_STAGE(PG8_SB(1, 1), b3 + hstepB, voffB);
            PG8_WAIT_V(6); PG8_BAR; PG8_MMA(1, 1, At, B1); PG8_BAR;
            }
        }
        if constexpr (ALIGN_EPI) { if (wr == 0) PG8_BAR; }
        if constexpr (!Epi::AFTER_DRAIN) { E(acc, cur, wr, wc, fr, fq); S.done(cur); }
        if (!has_next) break;
#pragma unroll
        for (int a = 0; a < 2; ++a)
#pragma unroll
            for (int b = 0; b < 2; ++b)
#pragma unroll
                for (int m = 0; m < 4; ++m)
#pragma unroll
                    for (int n = 0; n < 2; ++n) acc[a][b][m][n] = (f32x4){0.f, 0.f, 0.f, 0.f};
        cur = nxt; cA = nA; cB = nB; ++ui;
        if constexpr (ALIGN_EPI) { if (wr == 1) PG8_BAR; }
    }
    PG8_WAIT_V(0);
    if constexpr (!ALIGN_EPI) { if (wr == 0) PG8_BAR; }
    PG8_BAR;
    if constexpr (Epi::AFTER_DRAIN) { E.fused(acc, cur, wr, wc, fr, fq, lds, wid, lane); S.done(cur); }
#undef PG8_SA
#undef PG8_SB
#undef PG8_STAGE
#undef PG8_LDA
#undef PG8_LDB
#undef PG8_MMA
#undef PG8_WAIT_V
#undef PG8_WAIT_L
#undef PG8_BAR
#undef PG8_SCHED
}
}


typedef unsigned short bf16_t;
typedef float f32x4 __attribute__((ext_vector_type(4)));
typedef unsigned u32x4 __attribute__((ext_vector_type(4)));
#define LAS __attribute__((address_space(3)))
#define GAS __attribute__((address_space(1)))

#ifndef PH_MASK
#define PH_MASK 0xffff
#endif
#ifndef ATTN_SIMPLE
#define ATTN_SIMPLE 0
#endif
#ifndef SCAN_SIMPLE
#define SCAN_SIMPLE 0
#endif
#ifndef RPT
#define RPT 0
#endif
#ifndef VARX
#define VARX 0
#endif
#ifndef MK_MULTI
#define MK_MULTI 0
#endif

constexpr int BATCH = 4, SEQ = 4096, DM = 1024, M = BATCH * SEQ, DEPTH = 4;
constexpr int DFF = 2816;
constexpr int HYB_IN = 3096, HYB_PAD = 3584;
constexpr int NCH = 64, CH = 64;
constexpr float EPS = 1e-6f;
constexpr int PP = 3072;
constexpr int C_GQ = 0, C_GK = 256, C_GV = 512, C_MQ = 1024, C_MK = 1280, C_MV = 1536, C_GR = 2048, C_MO = 2560;
constexpr int SMALLP = 32;

constexpr size_t MiB = 1u << 20;
constexpr size_t WS_CTL = 0, CTL_ZERO_BYTES = 65536, WS_RSS = 1 * MiB, WS_SMALL = 2 * MiB, WS_KMEAN = 4 * MiB, WS_DEC = 5 * MiB, WS_NS = 6 * MiB, WS_SIDE = 7 * MiB, WS_Z = 240 * MiB;
constexpr size_t WS_XB = 8 * MiB, WS_P = 40 * MiB, WS_W = 136 * MiB;
constexpr size_t W_IN = 0, W_OUT = W_IN + (size_t)HYB_PAD * DM * 2, W_QKV = W_OUT + (size_t)DM * DM * 2, W_O = W_QKV + (size_t)3 * DM * DM * 2, W_MIXSZ = W_O + (size_t)DM * DM * 2;
constexpr size_t W_FFN0 = 2 * W_MIXSZ, W_GU = 0, W_D = (size_t)2 * DFF * DM * 2, W_FFNSZ = W_D + (size_t)DM * DFF * 2;
constexpr size_t WS_END = WS_W + W_FFN0 + 4 * W_FFNSZ;
static_assert(WS_END <= WS_Z && WS_Z + (size_t)M * 256 * 2 <= 256 * MiB, "workspace map");

constexpr int RING_BYTES = 131072, LDS_BYTES = 147456, MISC_OFF = LDS_BYTES - 256;
constexpr int NWAVES = 8, NTHR = 512;

__device__ __forceinline__ float bf2f(bf16_t v) { return __uint_as_float((unsigned)v << 16); }
__device__ __forceinline__ unsigned f2bf(float f) { unsigned u = __float_as_uint(f); return (u + 0x7fffu + ((u >> 16) & 1u)) >> 16; }
__device__ __forceinline__ unsigned pk2(float lo, float hi) { return f2bf(lo) | (f2bf(hi) << 16); }
__device__ __forceinline__ float sigmoidf_(float x) { return __builtin_amdgcn_rcpf(1.f + __builtin_amdgcn_exp2f(-1.4426950408889634f * x)); }
__device__ __forceinline__ float siluf_(float x) { return x * __builtin_amdgcn_rcpf(1.f + __builtin_amdgcn_exp2f(-1.4426950408889634f * x)); }
__device__ __forceinline__ float logsigmoidf_(float x) { return fminf(x, 0.f) - 0.6931471805599453f * __builtin_amdgcn_logf(1.f + __builtin_amdgcn_exp2f(-1.4426950408889634f * fabsf(x))); }
__device__ __forceinline__ float wave_sum(float v) {
#pragma unroll
    for (int o = 1; o < 64; o <<= 1) v += __shfl_xor(v, o);
    return v;
}
__device__ __forceinline__ float wave_max(float v) {
#pragma unroll
    for (int o = 1; o < 64; o <<= 1) v = fmaxf(v, __shfl_xor(v, o));
    return v;
}
__device__ __forceinline__ int opaque_i(int v) { asm volatile("" : "+v"(v)); return v; }
__device__ __forceinline__ float row16_sum(float v) {
    v += __builtin_bit_cast(float, __builtin_amdgcn_update_dpp(0, __builtin_bit_cast(int, v), 0xB1, 0xF, 0xF, true));
    v += __builtin_bit_cast(float, __builtin_amdgcn_update_dpp(0, __builtin_bit_cast(int, v), 0x4E, 0xF, 0xF, true));
    v += __builtin_bit_cast(float, __builtin_amdgcn_update_dpp(0, __builtin_bit_cast(int, v), 0x141, 0xF, 0xF, true));
    v += __builtin_bit_cast(float, __builtin_amdgcn_update_dpp(0, __builtin_bit_cast(int, v), 0x140, 0xF, 0xF, true));
    return v;
}
__device__ __forceinline__ float row_rstd(const float* rss, int row) {
    const f32x4* p = (const f32x4*)(rss + (size_t)row * 16);
    const f32x4 a = p[0], b = p[1], c = p[2], d = p[3];
    const float s = ((a.x + a.y) + (a.z + a.w)) + ((b.x + b.y) + (b.z + b.w)) + ((c.x + c.y) + (c.z + c.w)) + ((d.x + d.y) + (d.z + d.w));
    return __builtin_amdgcn_rsqf(s * (1.f / DM) + EPS);
}

#define XB_TMO      128
#define XB_XCNT(j)  (256  + 64 * (j))
#define XB_XSUB(j)  (1280 + 64 * (j))
#define XB_XGEN(j)  (2304 + 64 * (j))
#define XB_TOP      3328
#define XB_TOPGEN   3392
#define XCD_BAR_WORDS 3456
#define XB_SPIN_CAP (1u << 18)
__device__ __forceinline__ unsigned xb_ld(unsigned* p)              { return __hip_atomic_load(p, __ATOMIC_RELAXED, __HIP_MEMORY_SCOPE_AGENT); }
__device__ __forceinline__ unsigned xb_add(unsigned* p, unsigned v) { return __hip_atomic_fetch_add(p, v, __ATOMIC_RELAXED, __HIP_MEMORY_SCOPE_AGENT); }
__device__ __forceinline__ unsigned xb_xcc_id() { return (unsigned)__builtin_amdgcn_s_getreg((3 << 11) | 20) & 0xFu; }
#define XB_SPIN(cond, bar) do { unsigned _sp = 0; while (cond) { __builtin_amdgcn_s_sleep(1); \
    if ((++_sp & 255u) == 0u) { if (xb_ld(&(bar)[XB_TMO])) break; if (_sp > XB_SPIN_CAP) { atomicAdd(&(bar)[XB_TMO], 1u); break; } } } } while (0)
struct XcdBarrier { unsigned* bar; unsigned x; volatile LAS unsigned* st; };
__device__ __forceinline__ XcdBarrier xcd_barrier_post(unsigned* bar, volatile LAS unsigned* st) {
    XcdBarrier b; b.bar = bar; b.x = xb_xcc_id(); b.st = st;
    if (threadIdx.x == 0) (void)xb_add(&bar[XB_XCNT(b.x)], 1u);
    return b;
}
__device__ __forceinline__ void xcd_barrier_complete(unsigned* bar, unsigned x, unsigned& nloc, unsigned& nx) {
    const unsigned G = gridDim.x * gridDim.y * gridDim.z;
    unsigned sum, cnt, mine, sp = 0u;
    for (;;) {
        sum = 0u; cnt = 0u; mine = 0u;
#pragma unroll
        for (unsigned j = 0; j < 16; ++j) { const unsigned c = xb_ld(&bar[XB_XCNT(j)]); sum += c; cnt += (c > 0u) ? 1u : 0u; mine = (j == x) ? c : mine; }
        if (sum == G) break;
        __builtin_amdgcn_s_sleep(1);
        if ((++sp & 255u) == 0u) { if (xb_ld(&bar[XB_TMO])) break; if (sp > XB_SPIN_CAP) { atomicAdd(&bar[XB_TMO], 1u); break; } }
    }
    nloc = mine > 0u ? mine : 1u; nx = cnt > 0u ? cnt : 1u;
}
__device__ __forceinline__ void xcd_barrier(const XcdBarrier& b) {
    asm volatile("s_waitcnt vmcnt(0)" ::: "memory");
    __syncthreads();
    if (threadIdx.x == 0) {
        unsigned* bar = b.bar;
        __builtin_amdgcn_s_waitcnt(0);
        unsigned nloc = b.st[0], nx = b.st[1];
        if (nloc == 0u) { xcd_barrier_complete(bar, b.x, nloc, nx); b.st[0] = nloc; b.st[1] = nx; }
        const unsigned old = xb_add(&bar[XB_XSUB(b.x)], 1u);
        const unsigned gen = old / nloc;
        if (old + 1u == (gen + 1u) * nloc) {
            __builtin_amdgcn_fence(__ATOMIC_RELEASE, "agent");
            asm volatile("s_waitcnt vmcnt(0)" ::: "memory");
            const unsigned og = xb_add(&bar[XB_TOP], 1u);
            const unsigned tg = og / nx;
            if (og + 1u == (tg + 1u) * nx) xb_add(&bar[XB_TOPGEN], 1u);
            else XB_SPIN(xb_ld(&bar[XB_TOPGEN]) == tg, bar);
            __builtin_amdgcn_fence(__ATOMIC_ACQUIRE, "agent");
            xb_add(&bar[XB_XGEN(b.x)], 1u);
            asm volatile("s_waitcnt vmcnt(0)" ::: "memory");
        } else {
            XB_SPIN(xb_ld(&bar[XB_XGEN(b.x)]) == gen, bar);
            __builtin_amdgcn_fence(__ATOMIC_ACQUIRE, "agent");
            asm volatile("s_waitcnt vmcnt(0)" ::: "memory");
        }
    }
    __syncthreads();
}


__device__ __forceinline__ void stage_rstd(const pg8::StaticOrder& S, const float* rss, LAS float* lds_rs) {
    const int tid = opaque_i(threadIdx.x), half = tid >> 8, t = tid & 255;
    pg8::Unit u;
    for (int i = half; S.next(i, u); i += 2) lds_rs[i * 256 + t] = row_rstd(rss, u.pm * 256 + t);
    asm volatile("s_waitcnt lgkmcnt(0)" ::: "memory");
    __syncthreads();
}

struct EpiRowBf16 {
    static constexpr bool PERM = true, AFTER_DRAIN = false;
    bf16_t* O; int ldc; LAS const float* lrs; float* small; int small_pn; bf16_t* Z; int z_pn;
    __device__ __forceinline__ void operator()(const pg8::f32x4 (&acc)[2][2][4][2], const pg8::Unit& u, int wr, int wc, int fr, int fq) const {
        const int row0 = u.pm * 256 + wr * 64 + fr;
        if (u.pn == small_pn) {
            if (wc == 0) {
#pragma unroll
                for (int ai = 0; ai < 2; ++ai)
#pragma unroll
                    for (int m = 0; m < 4; ++m) { const int row = row0 + ai * 128 + m * 16; const float rs = lrs[u.idx * 256 + wr * 64 + fr + ai * 128 + m * 16];
#pragma unroll
                        for (int n = 0; n < 2; ++n) *(f32x4*)(small + (size_t)row * SMALLP + 8 * fq + 4 * n) = acc[ai][0][m][n] * rs; }
            }
            return;
        }
        const bool isz = u.pn == z_pn;
        bf16_t* Ob = isz ? Z : O; const int ldo = isz ? 256 : ldc;
        const int col0 = (isz ? 0 : u.pn * 256) + wc * 32 + 8 * fq;
        float rs[8];
#pragma unroll
        for (int i = 0; i < 8; ++i) rs[i] = lrs[u.idx * 256 + wr * 64 + fr + (i >> 2) * 128 + (i & 3) * 16];
#pragma unroll
        for (int ai = 0; ai < 2; ++ai)
#pragma unroll
            for (int m = 0; m < 4; ++m) { const int row = row0 + ai * 128 + m * 16; const float r = rs[ai * 4 + m];
                bf16_t* rowp = Ob + (size_t)row * ldo + col0;
#pragma unroll
                for (int bj = 0; bj < 2; ++bj) { const f32x4 v0 = acc[ai][bj][m][0] * r, v1 = acc[ai][bj][m][1] * r;
                    u32x4 w; w.x = pg8::cvt_pk_bf16(v0[0], v0[1]); w.y = pg8::cvt_pk_bf16(v0[2], v0[3]); w.z = pg8::cvt_pk_bf16(v1[0], v1[1]); w.w = pg8::cvt_pk_bf16(v1[2], v1[3]);
                    *(u32x4*)(rowp + bj * 128) = w; } }
    }
};
struct EpiRes {
    static constexpr bool PERM = true, AFTER_DRAIN = false;
    const float* xin; float* xout; bf16_t* xb; float* rss; int dry;
    __device__ __forceinline__ void operator()(const pg8::f32x4 (&acc)[2][2][4][2], const pg8::Unit& u, int wr, int wc, int fr, int fq) const {
        if (RPT && dry) { if (acc[0][0][0][0][0] == 1.2345e-33f) xout[0] = 0.f; return; }
        const int row0 = u.pm * 256 + wr * 64 + fr, col0 = u.pn * 256 + wc * 32 + 8 * fq;
#pragma unroll
        for (int ai = 0; ai < 2; ++ai) {
            f32x4 xo[4][2][2];
#pragma unroll
            for (int m = 0; m < 4; ++m)
#pragma unroll
                for (int bj = 0; bj < 2; ++bj) { const size_t off = (size_t)(row0 + ai * 128 + m * 16) * DM + col0 + bj * 128;
                    xo[m][bj][0] = *(const f32x4*)(xin + off); xo[m][bj][1] = *(const f32x4*)(xin + off + 4); }
#pragma unroll
            for (int m = 0; m < 4; ++m) { const int row = row0 + ai * 128 + m * 16; float ss = 0.f;
#pragma unroll
                for (int bj = 0; bj < 2; ++bj) { const size_t off = (size_t)row * DM + col0 + bj * 128;
                    const f32x4 a = xo[m][bj][0] + acc[ai][bj][m][0], b = xo[m][bj][1] + acc[ai][bj][m][1];
                    *(f32x4*)(xout + off) = a; *(f32x4*)(xout + off + 4) = b;
                    u32x4 w; w.x = pg8::cvt_pk_bf16(a[0], a[1]); w.y = pg8::cvt_pk_bf16(a[2], a[3]); w.z = pg8::cvt_pk_bf16(b[0], b[1]); w.w = pg8::cvt_pk_bf16(b[2], b[3]);
                    *(u32x4*)(xb + off) = w;
                    ss += (a[0] * a[0] + a[1] * a[1]) + (a[2] * a[2] + a[3] * a[3]) + (b[0] * b[0] + b[1] * b[1]) + (b[2] * b[2] + b[3] * b[3]); }
                ss += __shfl_xor(ss, 16); ss += __shfl_xor(ss, 32);
                if (fq == 0) rss[(size_t)row * 16 + u.pn * 4 + wc] = ss; }
        }
    }
};
struct EpiFfn {
    static constexpr bool PERM = true, AFTER_DRAIN = false;
    bf16_t* H; LAS const float* lrs;
    __device__ __forceinline__ void operator()(const pg8::f32x4 (&acc)[2][2][4][2], const pg8::Unit& u, int wr, int wc, int fr, int fq) const {
        const int row0 = u.pm * 256 + wr * 64 + fr, col0 = u.pn * 128 + wc * 32 + 8 * fq;
        float rs[8];
#pragma unroll
        for (int i = 0; i < 8; ++i) rs[i] = lrs[u.idx * 256 + wr * 64 + fr + (i >> 2) * 128 + (i & 3) * 16];
#pragma unroll
        for (int ai = 0; ai < 2; ++ai)
#pragma unroll
            for (int m = 0; m < 4; ++m) { const int row = row0 + ai * 128 + m * 16; const float r = rs[ai * 4 + m];
                float hv[8];
#pragma unroll
                for (int n = 0; n < 2; ++n)
#pragma unroll
                    for (int e = 0; e < 4; ++e) { const float g = acc[ai][0][m][n][e] * r, uu = acc[ai][1][m][n][e] * r; hv[n * 4 + e] = siluf_(g) * uu; }
                u32x4 w; w.x = pg8::cvt_pk_bf16(hv[0], hv[1]); w.y = pg8::cvt_pk_bf16(hv[2], hv[3]); w.z = pg8::cvt_pk_bf16(hv[4], hv[5]); w.w = pg8::cvt_pk_bf16(hv[6], hv[7]);
                *(u32x4*)(H + (size_t)row * DFF + col0) = w; }
    }
};


struct EpiQkv {
    static constexpr bool PERM = true, AFTER_DRAIN = false;
    bf16_t* O; LAS const float* lrs; const float* qg; const float* kg; float* kmean; LAS float* xch; LAS float* xch2;
    __device__ __forceinline__ void operator()(const pg8::f32x4 (&acc)[2][2][4][2], const pg8::Unit& u, int wr, int wc, int fr, int fq) const {
        fr = opaque_i(fr); fq = opaque_i(fq);
        const unsigned vo_o = (unsigned)(((wr * 64 + fr) * PP + wc * 32 + 8 * fq) * 2);
        char* obase = (char*)O + ((size_t)u.pm * 256 * PP + (size_t)u.pn * 256) * 2;
        float rs[8];
#pragma unroll
        for (int i = 0; i < 8; ++i) rs[i] = lrs[u.idx * 256 + wr * 64 + fr + (i >> 2) * 128 + (i & 3) * 16];
        if (u.pn >= 8) {
#pragma unroll
            for (int ai = 0; ai < 2; ++ai)
#pragma unroll
                for (int m = 0; m < 4; ++m) { const float r = rs[ai * 4 + m];
#pragma unroll
                    for (int bj = 0; bj < 2; ++bj) { const f32x4 v0 = acc[ai][bj][m][0] * r, v1 = acc[ai][bj][m][1] * r;
                        u32x4 w; w.x = pg8::cvt_pk_bf16(v0[0], v0[1]); w.y = pg8::cvt_pk_bf16(v0[2], v0[3]); w.z = pg8::cvt_pk_bf16(v1[0], v1[1]); w.w = pg8::cvt_pk_bf16(v1[2], v1[3]);
                        *(u32x4*)(obase + ((ai * 128 + m * 16) * PP + bj * 128) * 2 + vo_o) = w; } }
            return;
        }
        const bool isq = u.pn < 4;
        LAS float* xw = xch + (wr * 64 + fr) * 8 + wc;
#pragma unroll
        for (int ai = 0; ai < 2; ++ai)
#pragma unroll
            for (int m = 0; m < 4; ++m) { const float r = rs[ai * 4 + m];
#pragma unroll
                for (int bj = 0; bj < 2; ++bj) { const f32x4 v0 = acc[ai][bj][m][0] * r, v1 = acc[ai][bj][m][1] * r;
                    float ss = (v0[0] * v0[0] + v0[1] * v0[1]) + (v0[2] * v0[2] + v0[3] * v0[3]) + (v1[0] * v1[0] + v1[1] * v1[1]) + (v1[2] * v1[2] + v1[3] * v1[3]);
                    ss += __shfl_xor(ss, 16); ss += __shfl_xor(ss, 32);
                    if (fq == 0) xw[(ai * 128 + m * 16) * 8 + bj * 4] = ss; }
                if (fq == 0 && wc == 0) xch2[wr * 64 + fr + ai * 128 + m * 16] = r; }
        asm volatile("s_waitcnt lgkmcnt(0)" ::: "memory"); __builtin_amdgcn_s_barrier(); asm volatile("" ::: "memory");
        const float* g = (isq ? qg : kg) + wc * 32 + 8 * fq;
        const f32x4 ga = *(const f32x4*)g, gb = *(const f32x4*)(g + 4);
        const float sc = isq ? 0.08838834764831845f : 1.f;
        LAS const float* xr = xch + (wr * 64 + fr) * 8;
#pragma unroll
        for (int bj = 0; bj < 2; ++bj) {
#pragma unroll
            for (int ai = 0; ai < 2; ++ai)
#pragma unroll
                for (int m = 0; m < 4; ++m) { asm volatile("" ::: "memory"); __builtin_amdgcn_sched_barrier(0); const float r = xch2[wr * 64 + fr + ai * 128 + m * 16];
                    const f32x4 p4 = *(LAS const f32x4*)(xr + (ai * 128 + m * 16) * 8 + bj * 4);
                    const float rr = __builtin_amdgcn_rsqf(((p4[0] + p4[1]) + (p4[2] + p4[3])) * (1.f / 128.f) + EPS) * sc * r;
                    const f32x4 v0 = acc[ai][bj][m][0] * rr * ga, v1 = acc[ai][bj][m][1] * rr * gb;
                    u32x4 w; w.x = pg8::cvt_pk_bf16(v0[0], v0[1]); w.y = pg8::cvt_pk_bf16(v0[2], v0[3]); w.z = pg8::cvt_pk_bf16(v1[0], v1[1]); w.w = pg8::cvt_pk_bf16(v1[2], v1[3]);
                    *(u32x4*)(obase + ((ai * 128 + m * 16) * PP + bj * 128) * 2 + vo_o) = w; }
        }
    }
};

struct Args { const float* in[18]; float* out; unsigned char* ws; int ph_lo, ph_hi; };
struct Frame {
    LAS unsigned char* lds; unsigned char* ldsg;
    int tid, lane, wave, G, bid;
};


typedef const __attribute__((address_space(4))) unsigned char* kargp_t;
__device__ __forceinline__ kargp_t karg_base() { kargp_t p = (kargp_t)__builtin_amdgcn_kernarg_segment_ptr(); asm volatile("" : "+s"(p)); return p; }
__device__ __forceinline__ const float* karg_in(kargp_t p, int i) { return *(const float* const __attribute__((address_space(4)))*)(p + 8 * i); }
__device__ __forceinline__ float* karg_out(kargp_t p) { return *(float* const __attribute__((address_space(4)))*)(p + 8 * 18); }
__device__ __forceinline__ unsigned char* karg_ws(kargp_t p) { return *(unsigned char* const __attribute__((address_space(4)))*)(p + 8 * 19); }

__device__ __forceinline__ int map_row(int kind, int n) {
    if (kind == 0) return n;
    if (kind == 2) return (n >> 7) * 256 + (n & 127);
    if (kind == 3) return (n >> 7) * 256 + 128 + (n & 127);
    if (n < 256) return C_GQ + n; if (n < 512) return C_GK + n - 256; if (n < 1024) return C_GV + n - 512; if (n < 1536) return C_GR + n - 1024;
    if (n < 1552) return -1;
    if (n < 1808) return C_MQ + n - 1552; if (n < 2064) return C_MK + n - 1808; if (n < 2576) return C_MV + n - 2064; if (n < 3088) return C_MO + n - 2576;
    return 3328 + 16 + (n - 3088);
}
__device__ __forceinline__ void cvt_item(const float* W, int K, int N, const float* gain, bf16_t* WT, int kind, LAS float* scr, int item, int lane) {
    const int nblk = (N + 63) / 64, kb = item / nblk, nb = item % nblk, k0 = 64 * kb, n0 = 64 * nb;
    const int nq = n0 + 4 * (lane & 15), kr = lane >> 4;
    f32x4 v[16];
#pragma unroll
    for (int i = 0; i < 16; ++i) { v[i] = (f32x4){0.f, 0.f, 0.f, 0.f}; if (nq < N) v[i] = *(const f32x4*)(W + (size_t)(k0 + 4 * i + kr) * N + nq); }
#pragma unroll
    for (int i = 0; i < 16; ++i) { const int kk = 4 * i + kr; const float g = gain ? gain[k0 + kk] : 1.f; LAS float* d = scr + kk * 65 + 4 * (lane & 15);
        d[0] = v[i][0] * g; d[1] = v[i][1] * g; d[2] = v[i][2] * g; d[3] = v[i][3] * g; }
    asm volatile("s_waitcnt lgkmcnt(0)" ::: "memory");
    if (n0 + lane < N && map_row(kind, n0 + lane) >= 0) {
        bf16_t* dst = WT + (size_t)map_row(kind, n0 + lane) * K + k0;
#pragma unroll
        for (int c = 0; c < 8; ++c) { const LAS float* sp = scr + (8 * c) * 65 + lane;
            u32x4 o; o.x = pk2(sp[0 * 65], sp[1 * 65]); o.y = pk2(sp[2 * 65], sp[3 * 65]); o.z = pk2(sp[4 * 65], sp[5 * 65]); o.w = pk2(sp[6 * 65], sp[7 * 65]);
            *(u32x4*)(dst + 8 * c) = o; }
    }
    asm volatile("s_waitcnt lgkmcnt(0)" ::: "memory");
}
__device__ __forceinline__ void cvt_wz_item(const float* Win, const float* w2, const float* gain, bf16_t* WT, int item, int lane) {
    const int kb = item >> 2, nb = item & 3, k0 = 64 * kb, n = nb * 64 + lane;
    float w2r[16];
#pragma unroll
    for (int r = 0; r < 16; ++r) w2r[r] = w2[r * 256 + n];
    bf16_t* dst = WT + (size_t)(3072 + n) * DM + k0;
    for (int c = 0; c < 8; ++c) {
        float v[8];
#pragma unroll
        for (int e = 0; e < 8; ++e) { const int k = k0 + 8 * c + e; const float* gl = Win + (size_t)k * HYB_IN + 1536; float z = 0.f;
#pragma unroll
            for (int r = 0; r < 16; ++r) z += gl[r] * w2r[r];
            v[e] = z * gain[k]; }
        u32x4 o; o.x = pk2(v[0], v[1]); o.y = pk2(v[2], v[3]); o.z = pk2(v[4], v[5]); o.w = pk2(v[6], v[7]);
        *(u32x4*)(dst + 8 * c) = o;
    }
}
__device__ __forceinline__ void phase_prologue(Frame& F) {
    kargp_t kp = karg_base();
    unsigned char* wsw = karg_ws(kp) + WS_W;
    LAS float* scr = (LAS float*)(F.lds + F.wave * 16640);
    const int gw = F.bid * NWAVES + F.wave, NGW = F.G * NWAVES, lane = opaque_i(F.lane);
    constexpr int I_IN = 16 * 49, I_WZ = 64, I_OUT = 256, I_QKV = 16 * 48, I_O = 256, I_MIX = I_IN + I_WZ + I_OUT + I_QKV + I_O, I_F = 704, I_FFN = 3 * I_F, I_ALL = 2 * I_MIX + 4 * I_FFN;
    for (int it = gw; it < I_ALL; it += NGW) {
        if (it < 2 * I_MIX) {
            const int j = it / I_MIX; int r = it % I_MIX; unsigned char* wj = wsw + j * W_MIXSZ;
            if (r < I_IN) cvt_item(karg_in(kp, 3) + (size_t)j * DM * HYB_IN, DM, HYB_IN, karg_in(kp, 1) + (2 * j) * DM, (bf16_t*)(wj + W_IN), 1, scr, r, lane);
            else if ((r -= I_IN) < I_WZ) cvt_wz_item(karg_in(kp, 3) + (size_t)j * DM * HYB_IN, karg_in(kp, 4) + (size_t)j * 16 * 256, karg_in(kp, 1) + (2 * j) * DM, (bf16_t*)(wj + W_IN), r, lane);
            else if ((r -= I_WZ) < I_OUT) cvt_item(karg_in(kp, 10) + (size_t)j * DM * DM, DM, DM, nullptr, (bf16_t*)(wj + W_OUT), 0, scr, r, lane);
            else if ((r -= I_OUT) < I_QKV) cvt_item(karg_in(kp, 11) + (size_t)j * DM * 3 * DM, DM, 3 * DM, karg_in(kp, 1) + (2 * j + 1) * DM, (bf16_t*)(wj + W_QKV), 0, scr, r, lane);
            else { r -= I_QKV; cvt_item(karg_in(kp, 14) + (size_t)j * DM * DM, DM, DM, nullptr, (bf16_t*)(wj + W_O), 0, scr, r, lane); }
        } else {
            const int q = it - 2 * I_MIX, l = q / I_FFN; int r = q % I_FFN; unsigned char* wl = wsw + W_FFN0 + l * W_FFNSZ;
            if (r < I_F) cvt_item(karg_in(kp, 15) + (size_t)l * DM * DFF, DM, DFF, karg_in(kp, 2) + l * DM, (bf16_t*)(wl + W_GU), 2, scr, r, lane);
            else if ((r -= I_F) < I_F) cvt_item(karg_in(kp, 16) + (size_t)l * DM * DFF, DM, DFF, karg_in(kp, 2) + l * DM, (bf16_t*)(wl + W_GU), 3, scr, r, lane);
            else { r -= I_F; cvt_item(karg_in(kp, 17) + (size_t)l * DFF * DM, DFF, DM, nullptr, (bf16_t*)(wl + W_D), 0, scr, r, lane); }
        }
    }
    for (int j = 0; j < 2; ++j) {
        u32x4* z0 = (u32x4*)(wsw + j * W_MIXSZ + W_IN + (size_t)3328 * DM * 2);
        u32x4* z1 = (u32x4*)(wsw + j * W_MIXSZ + W_IN + (size_t)3352 * DM * 2);
        const int n0 = 16 * DM * 2 / 16, n1 = (3584 - 3352) * DM * 2 / 16;
        for (int i = F.bid * NTHR + F.tid; i < n0 + n1; i += F.G * NTHR) { if (i < n0) z0[i] = (u32x4){0u, 0u, 0u, 0u}; else z1[i - n0] = (u32x4){0u, 0u, 0u, 0u}; }
    }
    const float* x = karg_in(kp, 0); bf16_t* xb = (bf16_t*)(karg_ws(kp) + WS_XB); float* rss = (float*)(karg_ws(kp) + WS_RSS);
    for (int row = gw; row < M; row += NGW) {
        const float* xr = x + (size_t)row * DM; float s = 0.f;
#pragma unroll
        for (int j = 0; j < 4; ++j) { const f32x4 v = *(const f32x4*)(xr + j * 256 + F.lane * 4);
            s += (v.x * v.x + v.y * v.y) + (v.z * v.z + v.w * v.w);
            unsigned long long o = (unsigned long long)pk2(v.x, v.y) | ((unsigned long long)pk2(v.z, v.w) << 32);
            *(unsigned long long*)(xb + (size_t)row * DM + j * 256 + F.lane * 4) = o; }
        s = wave_sum(s);
        if (F.lane < 16) rss[(size_t)row * 16 + F.lane] = F.lane == 0 ? s : 0.f;
    }
}

struct ScanArgs {
    const bf16_t* Z; bf16_t* side;
    bf16_t* P; const float* small;
    const float* w2; const float* bgate; const float* gla_gain; const float* convw; const float* bif; const float* ml_gain;
    bf16_t* ST; float* dec; float* NS;
};
__device__ __forceinline__ size_t st_off(int grp, int bh, int c) { return ((size_t)((grp * 16 + bh) * NCH + c)) * 8192; }

template <bool NEED_A>
__device__ __forceinline__ void gate_stage(const ScanArgs& a, int b, int c, int hh, float* At, float* Bm, float* blk, float* lastv) {
    int tid_ = threadIdx.x; asm volatile("" : "+v"(tid_));
    const int tid = tid_, tb = tid >> 6, k = tid & 63;
    const int grp = hh >> 2, h = hh & 3;
    const int row0 = b * SEQ + c * CH;
    float la[8];
    if (grp == 0) {
        float w2r[16];
#pragma unroll
        for (int r = 0; r < 16; ++r) w2r[r] = a.w2[r * 256 + h * 64 + k];
        const float bg = a.bgate[h * 64 + k];
#pragma unroll
        for (int i = 0; i < 8; ++i) {
            const float* g = a.small + (size_t)(row0 + tb * 8 + i) * SMALLP;
            float z = bg;
#pragma unroll
            for (int r = 0; r < 16; ++r) z += g[r] * w2r[r];
            la[i] = logsigmoidf_(z) * (1.f / 16.f);
            asm volatile("" ::: "memory");
        }
    } else {
#pragma unroll
        for (int i = 0; i < 8; ++i) {
            const float* g = a.small + (size_t)(row0 + tb * 8 + i) * SMALLP;
            la[i] = logsigmoidf_(g[20 + h] + a.bif[4 + h]);
        }
    }
    float cs[8]; float run = 0.f;
#pragma unroll
    for (int i = 0; i < 8; ++i) { run += la[i]; cs[i] = run; }
    blk[tb * 64 + k] = run;
    __syncthreads();
    float pre = 0.f, tot = 0.f;
#pragma unroll
    for (int j = 0; j < 8; ++j) { const float v = blk[j * 64 + k]; tot += v; if (j < tb) pre += v; }
    if (tb == 0) lastv[k] = tot;
#pragma unroll
    for (int i = 0; i < 8; ++i) {
        const int t = tb * 8 + i; const int row = row0 + t; const float bc = pre + cs[i];
        const bf16_t* pr = a.P + (size_t)row * PP;
        if (grp == 0) {
            const float kv = bf2f(pr[C_GK + h * 64 + k]);
            Bm[t * 65 + k] = kv * __expf(-bc);
            if (NEED_A) { const float qv = bf2f(pr[C_GQ + h * 64 + k]); At[t * 65 + k] = qv * 0.125f * __expf(bc); }
        } else {
            const float ip = a.small[(size_t)row * SMALLP + 16 + h] + a.bif[h];
            const int tt = c * CH + t;
            float ck = 0.f, cq = 0.f;
#pragma unroll
            for (int j = 0; j < 4; ++j) {
                const int ts = tt - 3 + j;
                if (ts >= 0) {
                    const bf16_t* ps = a.P + (size_t)(b * SEQ + ts) * PP;
                    ck += a.convw[j * 512 + 256 + h * 64 + k] * bf2f(ps[C_MK + h * 64 + k]);
                    if (NEED_A) cq += a.convw[j * 512 + h * 64 + k] * bf2f(ps[C_MQ + h * 64 + k]);
                }
            }
            Bm[t * 65 + k] = siluf_(ck) * 0.125f * __expf(ip - bc);
            if (NEED_A) At[t * 65 + k] = siluf_(cq) * __expf(bc);
        }
    }
}

__device__ __forceinline__ void phase_scan1(Frame& F, const ScanArgs& a) {
    float* sm = (float*)F.ldsg;
    float* Bm = sm; float* Vs = sm + 64 * 65; float* blk = Vs + 64 * 128; float* lastv = blk + 512;
    int tid_ = threadIdx.x; asm volatile("" : "+v"(tid_));
    const int tid = tid_, lane = tid & 63, kg = tid >> 6;
    for (int unit = F.bid; unit < BATCH * NCH; unit += F.G) {
        const int b = unit / NCH, c = unit % NCH;
        const int row0 = b * SEQ + c * CH;
        for (int hh = 0; hh < 8; ++hh) {
            const int grp = hh >> 2, h = hh & 3, bh = b * 4 + h;
            gate_stage<false>(a, b, c, hh, nullptr, Bm, blk, lastv);
            const int voff = (grp == 0 ? C_GV : C_MV) + h * 128;
#pragma unroll 4
            for (int i = tid; i < 64 * 128; i += 512) { const int s = i >> 7, v = i & 127; Vs[i] = bf2f(a.P[(size_t)(row0 + s) * PP + voff + v]); }
            __syncthreads();
            if (tid < 64) a.dec[((size_t)(grp * 16 + bh) * NCH + c) * 64 + tid] = __expf(lastv[tid]);
            if (grp == 1 && tid < 64) { float s = 0.f; for (int t = 0; t < 64; ++t) s += Bm[t * 65 + tid]; a.NS[((size_t)bh * NCH + c) * 64 + tid] = s; }
            float acc[8][2];
#pragma unroll
            for (int i = 0; i < 8; ++i) { acc[i][0] = 0.f; acc[i][1] = 0.f; }
#pragma unroll 2
            for (int s = 0; s < 64; ++s) {
                const float v0 = Vs[s * 128 + lane], v1 = Vs[s * 128 + 64 + lane];
#pragma unroll
                for (int i = 0; i < 8; ++i) { const float bv = Bm[s * 65 + kg * 8 + i]; acc[i][0] += bv * v0; acc[i][1] += bv * v1; }
            }
            bf16_t* st = a.ST + st_off(grp, bh, c);
            u32x4 w0, w1;
            w0.x = pk2(acc[0][0], acc[1][0]); w0.y = pk2(acc[2][0], acc[3][0]); w0.z = pk2(acc[4][0], acc[5][0]); w0.w = pk2(acc[6][0], acc[7][0]);
            w1.x = pk2(acc[0][1], acc[1][1]); w1.y = pk2(acc[2][1], acc[3][1]); w1.z = pk2(acc[4][1], acc[5][1]); w1.w = pk2(acc[6][1], acc[7][1]);
            *(u32x4*)(st + (size_t)lane * 64 + kg * 8) = w0; *(u32x4*)(st + (size_t)(lane + 64) * 64 + kg * 8) = w1;
            __syncthreads();
        }
    }
}
__device__ __forceinline__ void phase_scan2(Frame& F, const ScanArgs& a, bool dry = false) {
    for (int gid = F.bid * NTHR + opaque_i(F.tid); gid < 131072; gid += F.G * NTHR) {
        const int grp = gid >> 16, rem = gid & 65535, bh = rem >> 12, r2 = rem & 4095, v = r2 >> 5, k = (r2 & 31) * 2;
        float s0 = 0.f, s1 = 0.f;
        unsigned* p0 = (unsigned*)(a.ST + st_off(grp, bh, 0) + v * 64 + k);
        const float* d0 = a.dec + ((size_t)(grp * 16 + bh) * NCH) * 64 + k;
        for (int cb = 0; cb < NCH; cb += 16) {
            unsigned w[16]; float da[16], db[16];
#pragma unroll
            for (int i = 0; i < 16; ++i) { w[i] = p0[(size_t)(cb + i) * 4096]; da[i] = d0[(cb + i) * 64]; db[i] = d0[(cb + i) * 64 + 1]; }
#pragma unroll
            for (int i = 0; i < 16; ++i) {
                const float l0 = __uint_as_float(w[i] << 16), l1 = __uint_as_float(w[i] & 0xffff0000u);
                if (!dry) p0[(size_t)(cb + i) * 4096] = pk2(s0, s1);
                s0 = da[i] * (s0 + l0); s1 = db[i] * (s1 + l1);
            }
        }
        if (gid < 1024) {
            const int bh2 = gid >> 6, k2 = gid & 63; float ns = 0.f;
            float* p = a.NS + ((size_t)bh2 * NCH) * 64 + k2; const float* dd = a.dec + ((size_t)(16 + bh2) * NCH) * 64 + k2;
            for (int cb = 0; cb < NCH; cb += 16) {
                float lv[16], dv[16];
#pragma unroll
                for (int i = 0; i < 16; ++i) { lv[i] = p[(cb + i) * 64]; dv[i] = dd[(cb + i) * 64]; }
#pragma unroll
                for (int i = 0; i < 16; ++i) { if (!dry) p[(cb + i) * 64] = ns; ns = dv[i] * (ns + lv[i]); }
            }
        }
    }
}
__device__ __forceinline__ void phase_scan3(Frame& F, const ScanArgs& a) {
    float* sm = (float*)F.ldsg;
    float* At = sm; float* Bm = At + 64 * 65; float* Pm = Bm + 64 * 65; float* Vs = Pm + 64 * 65; float* Ss = Vs + 64 * 128;
    float* blk = Ss + 64 * 128; float* lastv = blk + 512; float* nsv = lastv + 64;
    int tid_ = threadIdx.x; asm volatile("" : "+v"(tid_));
    const int tid = tid_, lane = tid & 63, tg = tid >> 6;
    for (int unit = F.bid; unit < BATCH * NCH; unit += F.G) {
        const int b = unit / NCH, c = unit % NCH;
        const int row0 = b * SEQ + c * CH;
        for (int hh = 0; hh < 8; ++hh) {
            const int grp = hh >> 2, h = hh & 3, bh = b * 4 + h;
            gate_stage<true>(a, b, c, hh, At, Bm, blk, lastv);
            const int voff = (grp == 0 ? C_GV : C_MV) + h * 128;
#pragma unroll 4
            for (int i = tid; i < 64 * 128; i += 512) { const int s = i >> 7, v = i & 127; Vs[i] = bf2f(a.P[(size_t)(row0 + s) * PP + voff + v]); }
            const bf16_t* st = a.ST + st_off(grp, bh, c);
#pragma unroll 4
            for (int i = tid; i < 64 * 128; i += 512) { const int v = i >> 6, k = i & 63; Ss[k * 128 + v] = bf2f(st[i]); }
            if (tid < 64) nsv[tid] = grp == 1 ? a.NS[((size_t)bh * NCH + c) * 64 + tid] : 0.f;
            __syncthreads();
            {
                const int t = tid >> 3, sg = tid & 7;
                float p[8];
#pragma unroll
                for (int i = 0; i < 8; ++i) p[i] = 0.f;
#pragma unroll 2
                for (int k = 0; k < 64; ++k) {
                    const float av = At[t * 65 + k];
#pragma unroll
                    for (int i = 0; i < 8; ++i) p[i] += av * Bm[(sg * 8 + i) * 65 + k];
                }
#pragma unroll
                for (int i = 0; i < 8; ++i) { const int s = sg * 8 + i; Pm[t * 65 + s] = s <= t ? p[i] : 0.f; }
            }
            __syncthreads();
            float acc[8][2], den[8];
#pragma unroll
            for (int i = 0; i < 8; ++i) { acc[i][0] = 0.f; acc[i][1] = 0.f; den[i] = 0.f; }
#pragma unroll 2
            for (int s = 0; s < 64; ++s) {
                const float v0 = Vs[s * 128 + lane], v1 = Vs[s * 128 + 64 + lane];
#pragma unroll
                for (int i = 0; i < 8; ++i) { const float pv = Pm[(tg * 8 + i) * 65 + s]; acc[i][0] += pv * v0; acc[i][1] += pv * v1; den[i] += pv; }
            }
#pragma unroll 2
            for (int k = 0; k < 64; ++k) {
                const float s0 = Ss[k * 128 + lane], s1 = Ss[k * 128 + 64 + lane], nk = nsv[k];
#pragma unroll
                for (int i = 0; i < 8; ++i) { const float av = At[(tg * 8 + i) * 65 + k]; acc[i][0] += av * s0; acc[i][1] += av * s1; den[i] += av * nk; }
            }
#pragma unroll
            for (int i = 0; i < 8; ++i) {
                asm volatile("" ::: "memory");
                const int row = row0 + tg * 8 + i;
                bf16_t* pr = a.P + (size_t)row * PP;
                float o0 = acc[i][0], o1 = acc[i][1];
                if (grp == 0) {
                    const float ss = wave_sum(o0 * o0 + o1 * o1);
                    const float rstd = rsqrtf(ss * (1.f / 128.f) + EPS);
                    const float g0 = bf2f(pr[C_GR + h * 128 + lane]), g1 = bf2f(pr[C_GR + h * 128 + 64 + lane]);
                    pr[C_GR + h * 128 + lane] = (bf16_t)f2bf(o0 * rstd * a.gla_gain[h * 128 + lane] * siluf_(g0));
                    pr[C_GR + h * 128 + 64 + lane] = (bf16_t)f2bf(o1 * rstd * a.gla_gain[h * 128 + 64 + lane] * siluf_(g1));
                } else {
                    const float dd = 1.f / fmaxf(fabsf(den[i]), 1.f);
                    const float g0 = bf2f(pr[C_MO + h * 128 + lane]), g1 = bf2f(pr[C_MO + h * 128 + 64 + lane]);
                    o0 = o0 * dd * sigmoidf_(g0); o1 = o1 * dd * sigmoidf_(g1);
                    const float ss = wave_sum(o0 * o0 + o1 * o1);
                    const float rstd = rsqrtf(ss * (1.f / 128.f) + EPS);
                    pr[C_MO + h * 128 + lane] = (bf16_t)f2bf(o0 * rstd * a.ml_gain[h * 128 + lane]);
                    pr[C_MO + h * 128 + 64 + lane] = (bf16_t)f2bf(o1 * rstd * a.ml_gain[h * 128 + 64 + lane]);
                }
            }
            __syncthreads();
        }
    }
}

__device__ __forceinline__ void phase_qkn(Frame& F, bf16_t* P, const float* qg, const float* kg, float* kmean) {
    const int gw = F.bid * NWAVES + F.wave, NGW = F.G * NWAVES, lane = opaque_i(F.lane);
    for (int u = gw; u < BATCH * 16 * 16; u += NGW) {
        const int hd = u & 15, blk = (u >> 4) & 15, b = u >> 8;
        const float* g = hd < 8 ? qg : kg;
        const float g0 = g[lane * 2], g1 = g[lane * 2 + 1];
        const float sc = hd < 8 ? 0.08838834764831845f : 1.f;
        float m0 = 0.f, m1 = 0.f;
        for (int r = 0; r < 256; ++r) {
            unsigned* p = (unsigned*)(P + (size_t)(b * SEQ + blk * 256 + r) * PP + hd * 128 + lane * 2);
            const unsigned w = *p;
            const float x0 = __uint_as_float(w << 16), x1 = __uint_as_float(w & 0xffff0000u);
            const float ss = wave_sum(x0 * x0 + x1 * x1);
            const float rr = rsqrtf(ss * (1.f / 128.f) + EPS) * sc;
            const float y0 = x0 * rr * g0, y1 = x1 * rr * g1;
            m0 += y0; m1 += y1;
            *p = pk2(y0, y1);
        }
        if (hd >= 8) { float* km = kmean + ((size_t)((b * 8 + (hd - 8)) * 16 + blk)) * 128 + lane * 2; km[0] = m0 * (1.f / 256.f); km[1] = m1 * (1.f / 256.f); }
    }
}
__device__ __forceinline__ void phase_attn_simple(Frame& F, bf16_t* P, const float* kmean) {
    float* qs = (float*)F.ldsg + F.wave * 1152; float* sc = qs + 128;
    const int gw = F.bid * NWAVES + F.wave, NGW = F.G * NWAVES, lane = opaque_i(F.lane);
    for (int item = gw; item < BATCH * 8 * SEQ; item += NGW) {
        const int t = item & (SEQ - 1), h = (item >> 12) & 7, b = item >> 15;
        const size_t row = (size_t)b * SEQ + t;
        {
            const unsigned w = *(const unsigned*)(P + row * PP + h * 128 + lane * 2);
            qs[lane * 2] = __uint_as_float(w << 16); qs[lane * 2 + 1] = __uint_as_float(w & 0xffff0000u);
        }
        const int qblk = t >> 8;
        float g = -INFINITY;
        if (lane < qblk) { const float* km = kmean + ((size_t)((b * 8 + h) * 16 + lane)) * 256; float s = 0.f; for (int d = 0; d < 128; ++d) s += qs[d] * (km[d] + km[128 + d]); g = s; }
        int sel0 = 0, sel1 = 0, sel2 = 0; const int nsel = qblk < 3 ? qblk : 3;
        {
            float gv[16];
#pragma unroll
            for (int n = 0; n < 16; ++n) gv[n] = __shfl(g, n);
            unsigned taken = 0u;
#pragma unroll
            for (int r = 0; r < 3; ++r) {
                int best = 0; float bv = -INFINITY; bool found = false;
#pragma unroll
                for (int n = 0; n < 16; ++n) { const bool ok = !((taken >> n) & 1u) && n < qblk; if (ok && (!found || gv[n] > bv)) { bv = gv[n]; best = n; found = true; } }
                if (r == 0) sel0 = best; else if (r == 1) sel1 = best; else sel2 = best;
                if (found) taken |= 1u << best;
            }
        }
        const float slope = exp2f(-(float)(h + 1));
        float mx = -1e30f;
        for (int r = 0; r <= nsel; ++r) {
            const int blk = r < nsel ? (r == 0 ? sel0 : (r == 1 ? sel1 : sel2)) : qblk;
            for (int sub = 0; sub < 4; ++sub) {
                const int key = blk * 256 + sub * 64 + lane; const int dist = t - key;
                const bf16_t* kr = P + ((size_t)b * SEQ + key) * PP + 1024 + h * 128;
                float s = 0.f;
                for (int d8 = 0; d8 < 16; ++d8) {
                    const u32x4 w = *(const u32x4*)(kr + d8 * 8);
#pragma unroll
                    for (int e = 0; e < 4; ++e) { s += qs[d8 * 8 + 2 * e] * __uint_as_float(w[e] << 16); s += qs[d8 * 8 + 2 * e + 1] * __uint_as_float(w[e] & 0xffff0000u); }
                }
                s = dist >= 0 ? s - slope * (float)dist : -1e30f;
                sc[r * 256 + sub * 64 + lane] = s; mx = fmaxf(mx, s);
            }
        }
        mx = wave_max(mx);
        float sum = 0.f;
        for (int i = lane; i < (nsel + 1) * 256; i += 64) { const float p = __expf(sc[i] - mx); sc[i] = p; sum += p; }
        sum = wave_sum(sum);
        float a0 = 0.f, a1 = 0.f;
        for (int r = 0; r <= nsel; ++r) {
            const int blk = r < nsel ? (r == 0 ? sel0 : (r == 1 ? sel1 : sel2)) : qblk;
            const bf16_t* vr = P + ((size_t)b * SEQ + blk * 256) * PP + 2048 + h * 128 + lane * 2;
#pragma unroll 4
            for (int j = 0; j < 256; ++j) {
                const float p = sc[r * 256 + j];
                const unsigned w = *(const unsigned*)(vr + (size_t)j * PP);
                a0 += p * __uint_as_float(w << 16); a1 += p * __uint_as_float(w & 0xffff0000u);
            }
        }
        const float inv = 1.f / sum;
        *(unsigned*)(P + row * PP + h * 128 + lane * 2) = pk2(a0 * inv, a1 * inv);
    }
}


__device__ __forceinline__ void phase_qkn2(Frame& F, bf16_t* P, const float* qg, const float* kg, float* kmean, bool dry = false) {
    const int gw = F.bid * NWAVES + F.wave, NGW = F.G * NWAVES, lane = opaque_i(F.lane), sub = lane >> 4, cl = lane & 15;
    for (int u = gw; u < BATCH * 16 * 16 * 2; u += NGW) {
        const int half = u & 1, hd = (u >> 1) & 15, blk = (u >> 5) & 15, b = u >> 9;
        const float* g = (hd < 8 ? qg : kg) + cl * 8;
        const f32x4 ga = *(const f32x4*)g, gb = *(const f32x4*)(g + 4);
        const float sc = hd < 8 ? 0.08838834764831845f : 1.f;
        float m[8];
#pragma unroll
        for (int e = 0; e < 8; ++e) m[e] = 0.f;
        bf16_t* base = P + (size_t)(b * SEQ + blk * 256 + half * 128 + sub) * PP + hd * 128 + cl * 8;
#pragma unroll 8
        for (int it = 0; it < 32; ++it) {
            u32x4* p = (u32x4*)(base + (size_t)it * 4 * PP);
            const u32x4 w = *p;
            float x[8];
#pragma unroll
            for (int e = 0; e < 4; ++e) { x[2 * e] = __uint_as_float(w[e] << 16); x[2 * e + 1] = __uint_as_float(w[e] & 0xffff0000u); }
            float ss = (x[0] * x[0] + x[1] * x[1]) + (x[2] * x[2] + x[3] * x[3]) + (x[4] * x[4] + x[5] * x[5]) + (x[6] * x[6] + x[7] * x[7]);
            ss += __shfl_xor(ss, 1); ss += __shfl_xor(ss, 2); ss += __shfl_xor(ss, 4); ss += __shfl_xor(ss, 8);
            const float rr = rsqrtf(ss * (1.f / 128.f) + EPS) * sc;
            float y[8];
            y[0] = x[0] * rr * ga[0]; y[1] = x[1] * rr * ga[1]; y[2] = x[2] * rr * ga[2]; y[3] = x[3] * rr * ga[3];
            y[4] = x[4] * rr * gb[0]; y[5] = x[5] * rr * gb[1]; y[6] = x[6] * rr * gb[2]; y[7] = x[7] * rr * gb[3];
#pragma unroll
            for (int e = 0; e < 8; ++e) m[e] += y[e];
            u32x4 o; o.x = pk2(y[0], y[1]); o.y = pk2(y[2], y[3]); o.z = pk2(y[4], y[5]); o.w = pk2(y[6], y[7]);
            if (!dry) *p = o;
        }
        if (hd >= 8 && !dry) {
#pragma unroll
            for (int e = 0; e < 8; ++e) { m[e] += __shfl_xor(m[e], 16); m[e] += __shfl_xor(m[e], 32); }
            if (sub == 0) { float* km = kmean + ((size_t)(((b * 8 + (hd - 8)) * 16 + blk) * 2 + half)) * 128 + cl * 8;
                *(f32x4*)km = (f32x4){m[0], m[1], m[2], m[3]} * (1.f / 256.f); *(f32x4*)(km + 4) = (f32x4){m[4], m[5], m[6], m[7]} * (1.f / 256.f); }
        }
    }
}


__device__ __forceinline__ void phase_kmean(Frame& F, const bf16_t* P, float* kmean) {
    const int lane = opaque_i(F.lane), sub = lane >> 4, cl = lane & 15, tid = F.wave * 64 + lane;
    LAS float* part = (LAS float*)F.lds;
    for (int u = F.bid; u < BATCH * 8 * 16; u += F.G) {
        const int blk = u & 15, h = (u >> 4) & 7, b = u >> 7;
        const bf16_t* base = P + (size_t)(b * SEQ + blk * 256 + F.wave * 32 + sub) * PP + 1024 + h * 128 + cl * 8;
        float m[8];
#pragma unroll
        for (int e = 0; e < 8; ++e) m[e] = 0.f;
        u32x4 w[8];
#pragma unroll
        for (int it = 0; it < 8; ++it) w[it] = *(const u32x4*)(base + (size_t)it * 4 * PP);
#pragma unroll
        for (int it = 0; it < 8; ++it)
#pragma unroll
            for (int e = 0; e < 4; ++e) { m[2 * e] += __uint_as_float(w[it][e] << 16); m[2 * e + 1] += __uint_as_float(w[it][e] & 0xffff0000u); }
#pragma unroll
        for (int e = 0; e < 8; ++e) { m[e] += __shfl_xor(m[e], 16); m[e] += __shfl_xor(m[e], 32); }
        if (sub == 0) { *(LAS f32x4*)(part + F.wave * 128 + cl * 8) = (f32x4){m[0], m[1], m[2], m[3]}; *(LAS f32x4*)(part + F.wave * 128 + cl * 8 + 4) = (f32x4){m[4], m[5], m[6], m[7]}; }
        __syncthreads();
        if (tid < 128) { float sacc = 0.f;
#pragma unroll
            for (int wv = 0; wv < 8; ++wv) sacc += part[wv * 128 + tid];
            float* km = kmean + (size_t)u * 256; km[tid] = sacc * (1.f / 256.f); km[128 + tid] = 0.f; }
        __syncthreads();
    }
}

namespace att {
typedef short bf16x8 __attribute__((ext_vector_type(8)));
typedef short s16x4 __attribute__((ext_vector_type(4)));
typedef float f32x16 __attribute__((ext_vector_type(16)));
constexpr int SHM_V = 16384, SHM_K = 16384, OFF_V = 0, OFF_K = 2 * SHM_V, OFF_WS = 2 * SHM_V + 2 * SHM_K;
constexpr float THR = 8.f;
#define KSWZ(row, colB) ((row) * 256 + ((colB) ^ (((row) & 7) << 4)))
#define SBAR() __builtin_amdgcn_sched_barrier(0)
typedef LAS char* lptr;
__device__ __forceinline__ int crow(int r, int hi) { return (r & 3) + 8 * (r >> 2) + 4 * hi; }
__device__ __forceinline__ unsigned cvtpk(float lo, float hi) { unsigned r; asm volatile("v_cvt_pk_bf16_f32 %0, %1, %2" : "=v"(r) : "v"(lo), "v"(hi)); return r; }
__device__ __forceinline__ void partialSM(f32x16& p0, f32x16& p1, float& m_reg, float& mn, float& alpha, float slope, float base, bool ok, bool diag, int dq) {
    constexpr float C = 1.4426950408889634f;
#pragma unroll
    for (int r = 0; r < 16; ++r) { const int c = (r & 3) + 8 * (r >> 2); if (c) p0[r] = fmaf(slope, (float)c, p0[r]); p1[r] = fmaf(slope, (float)(c + 32), p1[r]); }
    if (diag) {
#pragma unroll
        for (int r = 0; r < 16; ++r) { const int c = (r & 3) + 8 * (r >> 2); if (c > dq) p0[r] = -INFINITY; if (c + 32 > dq) p1[r] = -INFINITY; }
    }
    const float bm = ok ? base : -INFINITY;
    mn = m_reg; alpha = 1.f;
    const float add = (bm - mn) * C;
#pragma unroll
    for (int r = 0; r < 16; ++r) p0[r] = fmaf(p0[r], C, add);
#pragma unroll
    for (int r = 0; r < 16; ++r) p1[r] = fmaf(p1[r], C, add);
#pragma unroll
    for (int r = 0; r < 16; ++r) p0[r] = __builtin_amdgcn_exp2f(p0[r]);
}
__device__ __forceinline__ void finishSM(f32x16& p0, f32x16& p1, float alpha, float& l_reg, bf16x8& pa0, bf16x8& pa1, bf16x8& pa2, bf16x8& pa3) {
#pragma unroll
    for (int r = 0; r < 16; ++r) p1[r] = __builtin_amdgcn_exp2f(p1[r]);
    float ps = 0;
#pragma unroll
    for (int r = 0; r < 16; ++r) ps += p0[r];
#pragma unroll
    for (int r = 0; r < 16; ++r) ps += p1[r];
    { auto rr = __builtin_amdgcn_permlane32_swap(__float_as_uint(ps), __float_as_uint(ps), false, false);
      ps = __uint_as_float(rr[0]) + __uint_as_float(rr[1]); }
    l_reg = l_reg * alpha + ps;
#define PK4(P, BASE, OUT) do { unsigned a0 = cvtpk(P[BASE + 0], P[BASE + 1]), a1 = cvtpk(P[BASE + 2], P[BASE + 3]);   \
    unsigned b0 = cvtpk(P[BASE + 4], P[BASE + 5]), b1 = cvtpk(P[BASE + 6], P[BASE + 7]);                              \
    auto r0 = __builtin_amdgcn_permlane32_swap(a0, b0, false, false); auto r1 = __builtin_amdgcn_permlane32_swap(a1, b1, false, false); \
    u32x4 w = {r0[0], r1[0], r0[1], r1[1]}; OUT = *reinterpret_cast<bf16x8*>(&w); } while (0)
    PK4(p0, 0, pa0); PK4(p0, 8, pa1); PK4(p1, 0, pa2); PK4(p1, 8, pa3);
#undef PK4
}
__device__ __forceinline__ void qkt(f32x16& p0, f32x16& p1, lptr Ks, const bf16x8* qr, int r32, int hi) {
    p0 = f32x16{}; p1 = f32x16{};
#pragma unroll
    for (int d0 = 0; d0 < 8; ++d0) { const int cb = (d0 * 16 + hi * 8) * 2;
        const bf16x8 b0 = *(const LAS bf16x8*)(Ks + KSWZ(r32, cb));
        const bf16x8 b1 = *(const LAS bf16x8*)(Ks + KSWZ(32 + r32, cb));
        p0 = __builtin_amdgcn_mfma_f32_32x32x16_bf16(b0, qr[d0], p0, 0, 0, 0);
        p1 = __builtin_amdgcn_mfma_f32_32x32x16_bf16(b1, qr[d0], p1, 0, 0, 0); }
}
__device__ __forceinline__ int v_st(int k, int c) { const int kk = (k & ~0xC) | ((k & 4) << 1) | ((k & 8) >> 1); return ((kk >> 3) * 4 + (c >> 5)) * 512 + ((kk & 7) * 32 + (c & 31)) * 2; }
__device__ __forceinline__ int v_rd_base(int lane) { return ((lane & 3) << 3) | (((lane >> 2) & 3) << 6) | (((lane >> 4) & 1) << 5) | (((lane >> 5) & 1) << 8); }
constexpr int v_rd_off(int d0, int ks, int half) { return d0 * 512 + ks * 4096 + half * 2048; }
template <int OFF> __device__ __forceinline__ s16x4 tr_read(int vb) {
    s16x4 r; asm volatile("ds_read_b64_tr_b16 %0, %1 offset:%2" : "=&v"(r) : "v"(vb), "i"(OFF) : "memory"); return r;
}
template <int D0> __device__ __forceinline__ void pv_one(f32x16& od, int vb, bf16x8 pa0, bf16x8 pa1, bf16x8 pa2, bf16x8 pa3) {
    const s16x4 l0 = tr_read<v_rd_off(D0, 0, 0)>(vb), h0 = tr_read<v_rd_off(D0, 0, 1)>(vb), l1 = tr_read<v_rd_off(D0, 1, 0)>(vb), h1 = tr_read<v_rd_off(D0, 1, 1)>(vb);
    const s16x4 l2 = tr_read<v_rd_off(D0, 2, 0)>(vb), h2 = tr_read<v_rd_off(D0, 2, 1)>(vb), l3 = tr_read<v_rd_off(D0, 3, 0)>(vb), h3 = tr_read<v_rd_off(D0, 3, 1)>(vb);
    asm volatile("s_waitcnt lgkmcnt(0)" ::: "memory"); SBAR();
#define PK(L, H) (bf16x8){L[0], L[1], L[2], L[3], H[0], H[1], H[2], H[3]}
    od = __builtin_amdgcn_mfma_f32_32x32x16_bf16(pa0, PK(l0, h0), od, 0, 0, 0);
    od = __builtin_amdgcn_mfma_f32_32x32x16_bf16(pa1, PK(l1, h1), od, 0, 0, 0);
    od = __builtin_amdgcn_mfma_f32_32x32x16_bf16(pa2, PK(l2, h2), od, 0, 0, 0);
    od = __builtin_amdgcn_mfma_f32_32x32x16_bf16(pa3, PK(l3, h3), od, 0, 0, 0);
#undef PK
}
__device__ __forceinline__ void pv_d0(f32x16* o, int vb, bf16x8 pa0, bf16x8 pa1, bf16x8 pa2, bf16x8 pa3) {
    pv_one<0>(o[0], vb, pa0, pa1, pa2, pa3); pv_one<1>(o[1], vb, pa0, pa1, pa2, pa3); pv_one<2>(o[2], vb, pa0, pa1, pa2, pa3); pv_one<3>(o[3], vb, pa0, pa1, pa2, pa3);
}

__device__ __forceinline__ void unit(bf16_t* P, const float* kmean, int b, int h, int qb, lptr lds, unsigned ldsaddr, float mref, bool dry) {
    int tid_ = threadIdx.x; asm volatile("" : "+v"(tid_));
    const int tid = tid_, wid = __builtin_amdgcn_readfirstlane(tid >> 6), lane = tid & 63, r32 = lane & 31, hi = lane >> 5;
    lptr V_lds = lds + OFF_V; lptr K_lds = lds + OFF_K;
    LAS float* wsl = (LAS float*)(lds + OFF_WS) + wid * 64; LAS float* li_l = wsl; LAS float* al_l = wsl + 32;
    const int q0 = qb * 256, tpos = q0 + wid * 32 + r32;
    const bf16_t* Qw = P + (size_t)(b * SEQ + tpos) * PP + h * 128 + hi * 8;
    const bf16_t* Kh = P + (size_t)(b * SEQ) * PP + 1024 + h * 128;
    const bf16_t* Vh = P + (size_t)(b * SEQ) * PP + 2048 + h * 128;
    float m_reg = mref, l_reg = 0; f32x16 o[4] = {}; bf16x8 qr[8];
#pragma unroll
    for (int d0 = 0; d0 < 8; ++d0) qr[d0] = *(const bf16x8*)(Qw + d0 * 16);
    const float slope = exp2f(-(float)(h + 1));
    unsigned selmask = 0u;
    {
        float v0 = -INFINITY, v1 = -INFINITY, v2 = -INFINITY; int i0 = -1, i1 = -1, i2 = -1;
        { const int n_ = tid >> 5, d_ = (tid & 31) * 4; const float* km = kmean + ((size_t)((b * 8 + h) * 16 + n_)) * 256 + d_;
          *(LAS f32x4*)(lds + tid * 16) = *(const f32x4*)km + *(const f32x4*)(km + 128); }
        float qf[64];
#pragma unroll
        for (int d0 = 0; d0 < 8; ++d0)
#pragma unroll
            for (int e = 0; e < 8; ++e) qf[d0 * 8 + e] = bf2f((bf16_t)qr[d0][e]);
        __syncthreads();
        for (int n = 0; n < qb; ++n) {
            LAS const float* km = (LAS const float*)(lds + n * 512) + hi * 8;
            float s = 0.f;
#pragma unroll
            for (int d0 = 0; d0 < 8; ++d0) { const f32x4 ka = *(LAS const f32x4*)(km + d0 * 16), kb = *(LAS const f32x4*)(km + d0 * 16 + 4);
                s += qf[d0 * 8 + 0] * ka[0] + qf[d0 * 8 + 1] * ka[1] + qf[d0 * 8 + 2] * ka[2] + qf[d0 * 8 + 3] * ka[3]
                   + qf[d0 * 8 + 4] * kb[0] + qf[d0 * 8 + 5] * kb[1] + qf[d0 * 8 + 6] * kb[2] + qf[d0 * 8 + 7] * kb[3]; }
            s += __shfl_xor(s, 32);
            if (s > v0) { v2 = v1; i2 = i1; v1 = v0; i1 = i0; v0 = s; i0 = n; }
            else if (s > v1) { v2 = v1; i2 = i1; v1 = s; i1 = n; }
            else if (s > v2) { v2 = s; i2 = n; }
        }
        __syncthreads();
        if (i0 >= 0) selmask |= 1u << i0; if (i1 >= 0) selmask |= 1u << i1; if (i2 >= 0) selmask |= 1u << i2;
    }
    const int sr = tid >> 4, sc = (tid & 15) * 8, vst0 = v_st(sr, sc), vst1 = v_st(32 + sr, sc);
    const int vb0 = (int)ldsaddr + OFF_V + v_rd_base(lane);
    struct { bf16x8 vs0, vs1, ks0, ks1; } sr_[2];
#define SLOAD(i, k0) do { sr_[i].vs0 = *(const bf16x8*)(&Vh[(size_t)((k0) + sr) * PP + sc]); sr_[i].vs1 = *(const bf16x8*)(&Vh[(size_t)((k0) + 32 + sr) * PP + sc]); \
    sr_[i].ks0 = *(const bf16x8*)(&Kh[(size_t)((k0) + sr) * PP + sc]); sr_[i].ks1 = *(const bf16x8*)(&Kh[(size_t)((k0) + 32 + sr) * PP + sc]); } while (0)
#define SWRITE(bb, i) do { *(LAS bf16x8*)(V_lds + (bb) * SHM_V + vst0) = sr_[i].vs0;          \
    *(LAS bf16x8*)(V_lds + (bb) * SHM_V + vst1) = sr_[i].vs1; const int kc = sc * 2;               \
    *(LAS bf16x8*)(K_lds + (bb) * SHM_K + KSWZ(sr, kc)) = sr_[i].ks0;                       \
    *(LAS bf16x8*)(K_lds + (bb) * SHM_K + KSWZ(32 + sr, kc)) = sr_[i].ks1; } while (0)
#define SWAIT() asm volatile("s_waitcnt vmcnt(4)" ::: "memory")
#define RESC(a) do { if (__any((a) < 1.f)) { if (hi == 0) al_l[r32] = (a); asm volatile("s_waitcnt lgkmcnt(0)" ::: "memory"); \
    _Pragma("unroll") for (int d = 0; d < 4; ++d) _Pragma("unroll") for (int r = 0; r < 16; ++r) o[d][r] *= al_l[crow(r, hi)]; } } while (0)
#define PSM(P0, P1, MN, AL, jj) do { const int j_ = (jj), n_ = j_ >> 2, k0_ = j_ * 64; const bool isd_ = n_ == qb; \
    const bool ok_ = isd_ || ((selmask >> n_) & 1u); const float base_ = slope * (float)(k0_ + 4 * hi - tpos); \
    const bool nm_ = isd_ && (k0_ + 63 > q0 + wid * 32); \
    partialSM(P0, P1, m_reg, MN, AL, slope, base_, ok_, nm_, tpos - k0_ - 4 * hi); } while (0)
    f32x16 pA0, pA1, pB0, pB1; float mnA, mnB, alA, alB; bf16x8 pa0, pa1, pa2, pa3; const int NT = 4 * (qb + 1);
    constexpr int SE = 0, SO = 1;
    SLOAD(SE, 0); asm volatile("s_waitcnt vmcnt(0)" ::: "memory"); SWRITE(0, SE); __syncthreads();
    qkt(pA0, pA1, K_lds, qr, r32, hi); PSM(pA0, pA1, mnA, alA, 0);
    SLOAD(SO, 64); if (2 < NT) SLOAD(SE, 128);
    SWAIT(); SWRITE(1, SO); __syncthreads();
    for (int j = 1; j + 1 < NT; j += 2) {
        SBAR(); qkt(pB0, pB1, K_lds + SHM_K, qr, r32, hi);
        finishSM(pA0, pA1, alA, l_reg, pa0, pa1, pa2, pa3); SBAR();
        SLOAD(SO, (j + 2) * 64); SBAR();
        pv_d0(o, vb0, pa0, pa1, pa2, pa3); PSM(pB0, pB1, mnB, alB, j);
        __syncthreads(); SWAIT(); SWRITE(0, SE);
        __syncthreads();
        SBAR(); qkt(pA0, pA1, K_lds, qr, r32, hi);
        finishSM(pB0, pB1, alB, l_reg, pa0, pa1, pa2, pa3); SBAR();
        if (j + 3 < NT) SLOAD(SE, (j + 3) * 64); SBAR();
        pv_d0(o, vb0 + SHM_V, pa0, pa1, pa2, pa3); PSM(pA0, pA1, mnA, alA, j + 1);
        __syncthreads(); SWAIT(); SWRITE(1, SO);
        __syncthreads();
    }
    SBAR(); qkt(pB0, pB1, K_lds + SHM_K, qr, r32, hi);
    finishSM(pA0, pA1, alA, l_reg, pa0, pa1, pa2, pa3); SBAR();
    pv_d0(o, vb0, pa0, pa1, pa2, pa3); PSM(pB0, pB1, mnB, alB, NT - 1);
    __syncthreads();
    finishSM(pB0, pB1, alB, l_reg, pa0, pa1, pa2, pa3); SBAR();
    pv_d0(o, vb0 + SHM_V, pa0, pa1, pa2, pa3);
    if (hi == 0) li_l[r32] = l_reg; asm volatile("s_waitcnt lgkmcnt(0)" ::: "memory");
    float rli[16];
#pragma unroll
    for (int r = 0; r < 16; ++r) rli[r] = __builtin_amdgcn_rcpf(li_l[crow(r, hi)]);
    bf16_t* Ow = P + (size_t)(b * SEQ + q0 + wid * 32) * PP + h * 128;
#pragma unroll
    for (int r = 0; r < 16; ++r) { const int orow = crow(r, hi);
#pragma unroll
        for (int d0 = 0; d0 < 4; ++d0) if (!dry) Ow[(size_t)orow * PP + d0 * 32 + r32] = (bf16_t)f2bf(o[d0][r] * rli[r]); }
    __syncthreads();
#undef SLOAD
#undef SWRITE
#undef SWAIT
#undef RESC
#undef PSM
}
}
__device__ __forceinline__ void phase_attn(Frame& F, bf16_t* P, const float* kmean, const float* qg, const float* kg, bool dry = false) {
    const int ln_ = opaque_i(F.lane);
    float gq = fmaxf(fabsf(qg[ln_]), fabsf(qg[64 + ln_])), gk = fmaxf(fabsf(kg[ln_]), fabsf(kg[64 + ln_]));
    gq = wave_max(gq); gk = wave_max(gk);
    const float mref = __uint_as_float((unsigned)__builtin_amdgcn_readfirstlane((int)__float_as_uint(1.02f * 11.313708498984761f * gq * gk)));
    for (int pi = F.bid; pi < 256; pi += F.G) {
        const int xcd = pi & 7, slot = pi >> 3, bh = xcd * 4 + (slot >> 3), p = slot & 7;
        att::unit(P, kmean, bh >> 3, bh & 7, 15 - p, (att::lptr)F.lds, (unsigned)(uintptr_t)F.ldsg, mref, dry);
        att::unit(P, kmean, bh >> 3, bh & 7, p, (att::lptr)F.lds, (unsigned)(uintptr_t)F.ldsg, mref, dry);
    }
}

namespace scn {
using att::bf16x8; using att::f32x16; using att::lptr; using att::s16x4;
constexpr int HSLOT = 32768, O_VI = 0, O_BK = 16384, O_AQ = 24576;
constexpr int X_WS = RING_BYTES + 1024, X_SMALL = RING_BYTES + 6144;
__device__ __forceinline__ int swz(int row, int chunk) { return row * 128 + ((chunk ^ ((row >> 1) & 7)) << 4); }

__device__ __forceinline__ void stage_small(const ScanArgs& a, int row0, lptr lds, int tid) {
    *(LAS f32x4*)(lds + X_SMALL + tid * 16) = *(const f32x4*)(a.small + (size_t)row0 * SMALLP + tid * 4);
}
__device__ __forceinline__ void stage_v(const ScanArgs& a, int row0, int grp, int h, lptr slot, int ht) {
    const bf16_t* Vg = a.P + (size_t)row0 * PP + (grp == 0 ? C_GV : C_MV) + h * 128;
    bf16x8 v[8];
#pragma unroll
    for (int i = 0; i < 8; ++i) { const int idx = ht + 128 * i, srow = idx >> 4, sc = (idx & 15) * 8; v[i] = *(const bf16x8*)(Vg + (size_t)srow * PP + sc); }
#pragma unroll
    for (int i = 0; i < 8; ++i) { const int idx = ht + 128 * i, srow = idx >> 4, sc = (idx & 15) * 8; *(LAS bf16x8*)(slot + O_VI + att::v_st(srow, sc)) = v[i]; }
}
__device__ __forceinline__ size_t side_off(int b, int c, int t, int mat, int h) { return ((size_t)((b * NCH + c) * 3 + (t - 61))) * 512 + mat * 256 + h * 64; }

__device__ __forceinline__ void gate_full(const ScanArgs& a, int b, int c, int grp, int h, int half, lptr lds, lptr slot, int lane, LAS float* wsl, float& bc_end, float& nsum, bool dry) {
    const int k = lane, row0 = b * SEQ + c * CH, t0 = 32 * half;
    LAS const float* sml = (LAS const float*)(lds + X_SMALL);
    nsum = 0.f;
    unsigned rq[32], rk[32]; float cs[32];
    float wk0 = 0.f, wk1 = 0.f, wk2 = 0.f, wk3 = 0.f, wq0 = 0.f, wq1 = 0.f, wq2 = 0.f, wq3 = 0.f, bi = 0.f;
    float k1 = 0.f, k2 = 0.f, k3 = 0.f, q1 = 0.f, q2 = 0.f, q3 = 0.f;
    const int cq_ = (grp == 0 ? C_GQ : C_MQ) + h * 64 + k, ck_ = (grp == 0 ? C_GK : C_MK) + h * 64 + k;
    bf16_t* prow = a.P + (size_t)(row0 + t0) * PP;
#pragma unroll
    for (int i = 0; i < 32; ++i) { rk[i] = prow[(size_t)i * PP + ck_]; rq[i] = prow[(size_t)i * PP + cq_]; }
    if (grp == 0) {
        const float bg = a.bgate[h * 64 + k];
        const bf16_t* zr = a.Z + (size_t)(row0 + t0) * 256 + h * 64 + k;
        unsigned zv[32];
#pragma unroll
        for (int i = 0; i < 32; ++i) zv[i] = zr[i * 256];
        float run = 0.f;
#pragma unroll
        for (int i = 0; i < 32; ++i) { run += logsigmoidf_(__uint_as_float(zv[i] << 16) + bg) * (1.f / 16.f); cs[i] = run; }
    } else {
        bi = a.bif[h]; const float bf = a.bif[4 + h];
        wk0 = a.convw[0 * 512 + 256 + h * 64 + k]; wk1 = a.convw[1 * 512 + 256 + h * 64 + k]; wk2 = a.convw[2 * 512 + 256 + h * 64 + k]; wk3 = a.convw[3 * 512 + 256 + h * 64 + k];
        wq0 = a.convw[0 * 512 + h * 64 + k]; wq1 = a.convw[1 * 512 + h * 64 + k]; wq2 = a.convw[2 * 512 + h * 64 + k]; wq3 = a.convw[3 * 512 + h * 64 + k];
        if (c * CH + t0 > 0) {
            const bf16_t* p1 = prow - PP; const bf16_t* p2 = p1 - PP; const bf16_t* p3 = p2 - PP;
            k1 = bf2f(p1[ck_]); k2 = bf2f(p2[ck_]); k3 = bf2f(p3[ck_]); q1 = bf2f(p1[cq_]); q2 = bf2f(p2[cq_]); q3 = bf2f(p3[cq_]);
        }
        float run = 0.f;
#pragma unroll
        for (int i = 0; i < 32; ++i) { run += logsigmoidf_(sml[(t0 + i) * 32 + 20 + h] + bf); cs[i] = run; }
    }
    wsl[lane] = cs[31];
    asm volatile("s_waitcnt vmcnt(0)" ::: "memory");
    __syncthreads();
    const float off = half ? (wsl - 128)[lane] : 0.f;
    bc_end = off + cs[31];
#pragma unroll
    for (int i8 = 0; i8 < 4; ++i8) {
        unsigned pk[8];
#pragma unroll
        for (int e = 0; e < 8; ++e) { const int i = i8 * 8 + e, t = t0 + i; const float bc = off + cs[i];
            float bv, av;
            if (grp == 0) {
                const float ex = __expf(bc);
                bv = __uint_as_float(rk[i] << 16) * __builtin_amdgcn_rcpf(ex);
                av = __uint_as_float(rq[i] << 16) * 0.125f * ex;
            } else {
                const float ip = sml[t * 32 + 16 + h] + bi;
                const float kc = __uint_as_float(rk[i] << 16);
                const float ck = wk0 * k3 + wk1 * k2 + wk2 * k1 + wk3 * kc; k3 = k2; k2 = k1; k1 = kc;
                bv = siluf_(ck) * 0.125f * __expf(ip - bc);
                const float qc = __uint_as_float(rq[i] << 16);
                const float cq = wq0 * q3 + wq1 * q2 + wq2 * q1 + wq3 * qc; q3 = q2; q2 = q1; q1 = qc;
                av = siluf_(cq) * __expf(bc);
            }
            nsum += bv; pk[e] = f2bf(bv);
            const bf16_t ab = (bf16_t)f2bf(av), bb = (bf16_t)pk[e];
            if (RPT && dry) { asm volatile("" :: "v"((unsigned)ab), "v"((unsigned)bb)); }
            if (!dry) { if (grp == 1 && t >= 61) { bf16_t* sd = a.side + side_off(b, c, t, 0, h) + k; sd[0] = ab; sd[256] = bb; }
            else { prow[(size_t)i * PP + cq_] = ab; prow[(size_t)i * PP + ck_] = bb; if (VARX & 4) { asm volatile("" ::: "memory"); prow[(size_t)i * PP + cq_] = ab; prow[(size_t)i * PP + ck_] = bb; } } } }
        { u32x4 w; w.x = pk[0] | (pk[1] << 16); w.y = pk[2] | (pk[3] << 16); w.z = pk[4] | (pk[5] << 16); w.w = pk[6] | (pk[7] << 16);
          *(LAS u32x4*)(slot + O_BK + swz(k, (t0 >> 3) + i8)) = w; }
    }
}
__device__ __forceinline__ void stage_ab(const ScanArgs& a, int b, int c, int grp, int h, lptr slot, int ht) {
    const int row0 = b * SEQ + c * CH;
    bf16x8 v[8];
#pragma unroll
    for (int i = 0; i < 8; ++i) { const int idx = ht + 128 * i, mat = idx >> 9, r = (idx >> 3) & 63, ch = idx & 7;
        const bf16_t* src = a.P + (size_t)(row0 + r) * PP + (grp == 0 ? (mat ? C_GK : C_GQ) : (mat ? C_MK : C_MQ)) + h * 64 + ch * 8;
        if (grp == 1 && r >= 61) src = a.side + side_off(b, c, r, mat, h) + ch * 8;
        v[i] = *(const bf16x8*)src; }
#pragma unroll
    for (int i = 0; i < 8; ++i) { const int idx = ht + 128 * i, mat = idx >> 9, r = (idx >> 3) & 63, ch = idx & 7;
        *(LAS bf16x8*)(slot + (mat ? O_BK : O_AQ) + swz(r, ch)) = v[i]; }
}
}

__device__ __forceinline__ void phase_scan1m(Frame& F, const ScanArgs& a, bool dry = false) {
    using namespace scn;
    const int wid = __builtin_amdgcn_readfirstlane(threadIdx.x >> 6);
    const int hw = wid >> 1, half = wid & 1;
    lptr lds = (lptr)F.lds; lptr slot = lds + hw * HSLOT;
    LAS float* wsl = (LAS float*)(lds + X_WS) + wid * 128;
    const unsigned ldsaddr = (unsigned)(uintptr_t)F.ldsg;
    for (int unit = F.bid; unit < BATCH * NCH; unit += F.G) {
        const int b = unit / NCH, c = unit % NCH, row0 = b * SEQ + c * CH;
        stage_small(a, row0, lds, opaque_i(threadIdx.x));
        for (int grp = 0; grp < 2; ++grp) {
            const int tid = opaque_i(threadIdx.x), lane = tid & 63, r32 = lane & 31, hi = lane >> 5;
            const int h = hw, bh = b * 4 + h;
            stage_v(a, row0, grp, h, slot, tid & 127);
            __syncthreads();
            float bc_end, nsum;
            gate_full(a, b, c, grp, h, half, lds, slot, lane, wsl, bc_end, nsum, dry);
            if (half == 1 && !dry) a.dec[((size_t)(grp * 16 + bh) * NCH + c) * 64 + lane] = __expf(bc_end);
            if (grp == 1) wsl[64 + lane] = nsum;
            __syncthreads();
            if (grp == 1 && half == 0 && !dry) { LAS float* other = wsl + 128; a.NS[((size_t)bh * NCH + c) * 64 + lane] = wsl[64 + lane] + other[64 + lane]; }
            bf16x8 pa[4];
#pragma unroll
            for (int ks = 0; ks < 4; ++ks) pa[ks] = *(LAS bf16x8*)(slot + O_BK + swz(32 * half + r32, 2 * ks + hi));
            f32x16 o[4] = {};
            att::pv_d0(o, (int)ldsaddr + hw * HSLOT + O_VI + att::v_rd_base(lane), pa[0], pa[1], pa[2], pa[3]);
            bf16_t* st = a.ST + st_off(grp, bh, c);
#pragma unroll
            for (int d0 = 0; d0 < 4; ++d0)
#pragma unroll
                for (int g = 0; g < 4; ++g) {
                    const unsigned long long w = (unsigned long long)pk2(o[d0][4 * g], o[d0][4 * g + 1]) | ((unsigned long long)pk2(o[d0][4 * g + 2], o[d0][4 * g + 3]) << 32);
                    if (!dry) *(unsigned long long*)(st + (size_t)(32 * d0 + r32) * 64 + 32 * half + 8 * g + 4 * hi) = w; }
            __syncthreads();
        }
    }
}
__device__ __forceinline__ void phase_scan3m(Frame& F, const ScanArgs& a, bool dry = false) {
    using namespace scn;
    const int wid = __builtin_amdgcn_readfirstlane(threadIdx.x >> 6);
    const int hw = wid >> 1, half = wid & 1;
    lptr lds = (lptr)F.lds; lptr slot = lds + hw * HSLOT;
    LAS float* wsl = (LAS float*)(lds + X_WS) + wid * 128;
    const unsigned ldsaddr = (unsigned)(uintptr_t)F.ldsg;
    for (int unit = F.bid; unit < BATCH * NCH; unit += F.G) {
        const int b = unit / NCH, c = unit % NCH, row0 = b * SEQ + c * CH;
        for (int grp = 0; grp < 2; ++grp) {
            const int tid = opaque_i(threadIdx.x), lane = tid & 63, r32 = lane & 31, hi = lane >> 5;
            const int h = hw, bh = b * 4 + h;
            stage_v(a, row0, grp, h, slot, tid & 127);
            stage_ab(a, b, c, grp, h, slot, tid & 127);
            __syncthreads();
            bf16x8 qr[4];
#pragma unroll
            for (int d0 = 0; d0 < 4; ++d0) qr[d0] = *(LAS bf16x8*)(slot + O_AQ + swz(32 * half + r32, 2 * d0 + hi));
            f32x16 p0 = {}, p1 = {};
#pragma unroll
            for (int d0 = 0; d0 < 4; ++d0) {
                const bf16x8 b0 = *(LAS bf16x8*)(slot + O_BK + swz(r32, 2 * d0 + hi));
                const bf16x8 b1 = *(LAS bf16x8*)(slot + O_BK + swz(32 + r32, 2 * d0 + hi));
                p0 = __builtin_amdgcn_mfma_f32_32x32x16_bf16(b0, qr[d0], p0, 0, 0, 0);
                p1 = __builtin_amdgcn_mfma_f32_32x32x16_bf16(b1, qr[d0], p1, 0, 0, 0); }
            const int dq = 32 * half + r32 - 4 * hi;
            float ps = 0.f;
#pragma unroll
            for (int r = 0; r < 16; ++r) { const int cc = (r & 3) + 8 * (r >> 2); if (cc > dq) p0[r] = 0.f; if (cc + 32 > dq) p1[r] = 0.f; ps += p0[r] + p1[r]; }
            bf16x8 pa0, pa1, pa2, pa3;
#define PK4(P, BASE, OUT) do { unsigned a0 = att::cvtpk(P[BASE + 0], P[BASE + 1]), a1 = att::cvtpk(P[BASE + 2], P[BASE + 3]);   \
    unsigned b0_ = att::cvtpk(P[BASE + 4], P[BASE + 5]), b1_ = att::cvtpk(P[BASE + 6], P[BASE + 7]);                              \
    auto r0 = __builtin_amdgcn_permlane32_swap(a0, b0_, false, false); auto r1 = __builtin_amdgcn_permlane32_swap(a1, b1_, false, false); \
    u32x4 w = {r0[0], r1[0], r0[1], r1[1]}; OUT = *reinterpret_cast<bf16x8*>(&w); } while (0)
            PK4(p0, 0, pa0); PK4(p0, 8, pa1); PK4(p1, 0, pa2); PK4(p1, 8, pa3);
#undef PK4
            float den = 0.f;
            if (grp == 1) {
                const float* ns = a.NS + ((size_t)bh * NCH + c) * 64 + hi * 8;
#pragma unroll
                for (int d0 = 0; d0 < 4; ++d0) { const f32x4 na = *(const f32x4*)(ns + d0 * 16), nb = *(const f32x4*)(ns + d0 * 16 + 4); const bf16x8 q = qr[d0];
                    ps += bf2f((bf16_t)q[0]) * na[0] + bf2f((bf16_t)q[1]) * na[1] + bf2f((bf16_t)q[2]) * na[2] + bf2f((bf16_t)q[3]) * na[3]
                        + bf2f((bf16_t)q[4]) * nb[0] + bf2f((bf16_t)q[5]) * nb[1] + bf2f((bf16_t)q[6]) * nb[2] + bf2f((bf16_t)q[7]) * nb[3]; }
                den = ps + __shfl_xor(ps, 32);
            }
            f32x16 o[4] = {};
            att::pv_d0(o, (int)ldsaddr + hw * HSLOT + O_VI + att::v_rd_base(lane), pa0, pa1, pa2, pa3);
            const bf16_t* st = a.ST + st_off(grp, bh, c);
#pragma unroll
            for (int d0 = 0; d0 < 4; ++d0) {
                bf16x8 sv[4];
#pragma unroll
                for (int ks = 0; ks < 4; ++ks) sv[ks] = *(const bf16x8*)(st + (size_t)(32 * d0 + r32) * 64 + 16 * ks + 8 * hi);
#pragma unroll
                for (int ks = 0; ks < 4; ++ks) o[d0] = __builtin_amdgcn_mfma_f32_32x32x16_bf16(qr[ks], sv[ks], o[d0], 0, 0, 0);
            }
            if (grp == 1) { if (hi == 0) wsl[64 + r32] = den; asm volatile("s_waitcnt lgkmcnt(0)" ::: "memory"); }
            const int gcol = (grp == 0 ? C_GR : C_MO) + h * 128;
            const float* gain = (grp == 0 ? a.gla_gain : a.ml_gain) + h * 128;
            float gn[4];
#pragma unroll
            for (int d0 = 0; d0 < 4; ++d0) gn[d0] = gain[32 * d0 + r32];
#pragma unroll
            for (int r = 0; r < 16; ++r) {
                const int t = 32 * half + att::crow(r, hi);
                bf16_t* pr = a.P + (size_t)(row0 + t) * PP + gcol + r32;
                float ov[4], gv[4];
#pragma unroll
                for (int d0 = 0; d0 < 4; ++d0) { ov[d0] = o[d0][r]; gv[d0] = bf2f(pr[32 * d0]); }
                if (grp == 1) { const float dd = 1.f / fmaxf(fabsf(wsl[64 + att::crow(r, hi)]), 1.f);
#pragma unroll
                    for (int d0 = 0; d0 < 4; ++d0) ov[d0] = ov[d0] * dd * sigmoidf_(gv[d0]); }
                float ss = (ov[0] * ov[0] + ov[1] * ov[1]) + (ov[2] * ov[2] + ov[3] * ov[3]);
                ss += __shfl_xor(ss, 1); ss += __shfl_xor(ss, 2); ss += __shfl_xor(ss, 4); ss += __shfl_xor(ss, 8); ss += __shfl_xor(ss, 16);
                const float rstd = __builtin_amdgcn_rsqf(ss * (1.f / 128.f) + EPS);
#pragma unroll
                for (int d0 = 0; d0 < 4; ++d0) { float y = ov[d0] * rstd * gn[d0]; if (grp == 0) y *= siluf_(gv[d0]); if (!dry) pr[32 * d0] = (bf16_t)f2bf(y); }
            }
            __syncthreads();
        }
    }
}

__global__ void __launch_bounds__(NTHR, 2) mk_fwd(Args args) {
    extern __shared__ __attribute__((aligned(16))) unsigned char lds[];
    Frame F;
    F.lds = (LAS unsigned char*)lds; F.ldsg = lds;
    F.tid = threadIdx.x; F.lane = F.tid & 63; F.wave = __builtin_amdgcn_readfirstlane(F.tid >> 6);
    F.G = gridDim.x; F.bid = blockIdx.x;
    volatile LAS unsigned* MISC = (volatile LAS unsigned*)(F.lds + MISC_OFF);
    for (int u = F.tid; u < (LDS_BYTES - RING_BYTES) / 4; u += NTHR) ((LAS unsigned*)(F.lds + RING_BYTES))[u] = 0u;
    __syncthreads();
    XcdBarrier bar; bar.bar = (unsigned*)(karg_ws(karg_base()) + WS_CTL) + 4096; bar.x = 0; bar.st = nullptr;
    if (!MK_MULTI) bar = xcd_barrier_post((unsigned*)(karg_ws(karg_base()) + WS_CTL) + 4096, MISC + 8);
    const int lo = args.ph_lo, hi = args.ph_hi;
#define IN(k) (lo <= (k) && (k) < hi)
#define SEAM(k) do { if (!MK_MULTI && (k) + 1 < hi) { xcd_barrier(bar); if (RPT & 2048) xcd_barrier(bar); } } while (0)
#define KP()     karg_base()
#define WSP()    karg_ws(KP())
#define OUTP()   karg_out(KP())
#define RSSP()   ((float*)(WSP() + WS_RSS))
#define SMALLP_() ((float*)(WSP() + WS_SMALL))
#define KMEANP() ((float*)(WSP() + WS_KMEAN))
#define XBP()    ((bf16_t*)(WSP() + WS_XB))
#define PP_()    ((bf16_t*)(WSP() + WS_P))
#define WJ()     (WSP() + WS_W + (size_t)(l >> 1) * W_MIXSZ)
#define WL()     (WSP() + WS_W + W_FFN0 + (size_t)l * W_FFNSZ)
#define XIN()    (l == 0 ? karg_in(KP(), 0) : (const float*)OUTP())
#define MKSA()   const int j = l >> 1; kargp_t kp = KP(); unsigned char* ws = karg_ws(kp); \
    ScanArgs sa{(const bf16_t*)(ws + WS_Z), (bf16_t*)(ws + WS_SIDE), (bf16_t*)(ws + WS_P), (float*)(ws + WS_SMALL), karg_in(kp, 4) + (size_t)j * 16 * 256, karg_in(kp, 5) + j * 256, karg_in(kp, 6) + j * 512, \
                karg_in(kp, 7) + (size_t)j * 4 * 512, karg_in(kp, 8) + j * 8, karg_in(kp, 9) + j * 512, (bf16_t*)(ws + WS_XB), (float*)(ws + WS_DEC), (float*)(ws + WS_NS)}

    if (IN(0)) { if (PH_MASK & 1) { phase_prologue(F); if (RPT & 1) phase_prologue(F); } SEAM(0); }

    for (int l = 0; l < DEPTH; ++l) {
        const int base = 1 + l * 8;
        if ((l & 1) == 0) {
            if (IN(base + 0)) {
                pg8::Gemm g{XBP(), (const bf16_t*)(WJ() + W_IN), M, HYB_PAD, DM, DM}; pg8::StaticOrder S; S.init(M, HYB_PAD, F.G, F.bid);
                LAS float* lrs = (LAS float*)(F.lds + scn::X_SMALL); stage_rstd(S, RSSP(), lrs);
                EpiRowBf16 E{PP_(), PP, lrs, SMALLP_(), 13, (bf16_t*)(WSP() + WS_Z), 12};
                if (PH_MASK & 64) { const int nrep_ = (RPT & 2) ? 2 : 1; for (int rep_ = 0; rep_ < nrep_; ++rep_) { pg8::gemm_phase<EpiRowBf16, pg8::StaticOrder, true, true>(F.lds, g, S, E); } }
                SEAM(base + 0);
            }
            if (IN(base + 1)) { if (PH_MASK & 2) { MKSA(); if (RPT & 4) phase_scan1m(F, sa, RPT && opaque_i(1) != 0); phase_scan1m(F, sa, RPT && opaque_i(0) != 0); } SEAM(base + 1); }
            if (IN(base + 2)) { if (PH_MASK & 4) { MKSA(); if (RPT & 8) phase_scan2(F, sa, RPT && opaque_i(1) != 0); phase_scan2(F, sa, RPT && opaque_i(0) != 0); } SEAM(base + 2); }
            if (IN(base + 3)) { if (PH_MASK & 8) { MKSA(); if (RPT & 16) phase_scan3m(F, sa, RPT && opaque_i(1) != 0); phase_scan3m(F, sa, RPT && opaque_i(0) != 0); } SEAM(base + 3); }
            if (IN(base + 4)) {
                pg8::Gemm g{PP_() + C_GR, (const bf16_t*)(WJ() + W_OUT), M, DM, DM, PP}; pg8::StaticOrder S; S.init(M, DM, F.G, F.bid);
                EpiRes E{XIN(), OUTP(), XBP(), RSSP(), 0};
                if (PH_MASK & 128) { const int nrep_ = (RPT & 32) ? 2 : 1; for (int rep_ = 0; rep_ < nrep_; ++rep_) { E.dry = RPT ? opaque_i(rep_ + 1 < nrep_ ? 1 : 0) : 0; pg8::gemm_phase<EpiRes, pg8::StaticOrder, true, true>(F.lds, g, S, E); } }
                SEAM(base + 4);
            }
        } else {
            if (IN(base + 0)) {
                const int j = l >> 1;
                pg8::Gemm g{XBP(), (const bf16_t*)(WJ() + W_QKV), M, 3 * DM, DM, DM}; pg8::StaticOrder S; S.init(M, 3 * DM, F.G, F.bid);
                LAS float* lrs = (LAS float*)(F.lds + RING_BYTES + 2048); stage_rstd(S, RSSP(), lrs);
                EpiQkv E{PP_(), lrs, karg_in(KP(), 12) + j * 128, karg_in(KP(), 13) + j * 128, KMEANP(), (LAS float*)(F.lds + scn::X_SMALL), (LAS float*)(F.lds + scn::X_WS)};
                if (PH_MASK & 256) { const int nrep_ = (RPT & 64) ? 2 : 1; for (int rep_ = 0; rep_ < nrep_; ++rep_) { pg8::gemm_phase<EpiQkv, pg8::StaticOrder, true, true>(F.lds, g, S, E); } }
                SEAM(base + 0);
            }
            if (IN(base + 1)) { if (PH_MASK & 16) phase_kmean(F, PP_(), KMEANP()); SEAM(base + 1); }
            if (IN(base + 2)) { if (PH_MASK & 32) { const int j = l >> 1;
                if (RPT & 256) phase_attn(F, PP_(), KMEANP(), karg_in(KP(), 12) + j * 128, karg_in(KP(), 13) + j * 128, RPT && opaque_i(1) != 0);
                phase_attn(F, PP_(), KMEANP(), karg_in(KP(), 12) + j * 128, karg_in(KP(), 13) + j * 128, RPT && opaque_i(0) != 0); } SEAM(base + 2); }
            if (IN(base + 3)) {
                pg8::Gemm g{PP_(), (const bf16_t*)(WJ() + W_O), M, DM, DM, PP}; pg8::StaticOrder S; S.init(M, DM, F.G, F.bid);
                EpiRes E{XIN(), OUTP(), XBP(), RSSP(), 0};
                if (PH_MASK & 512) { const int nrep_ = (RPT & 32) ? 2 : 1; for (int rep_ = 0; rep_ < nrep_; ++rep_) { E.dry = RPT ? opaque_i(rep_ + 1 < nrep_ ? 1 : 0) : 0; pg8::gemm_phase<EpiRes, pg8::StaticOrder, true, true>(F.lds, g, S, E); } }
                SEAM(base + 3);
            }
        }
        if (IN(base + 5)) {
            pg8::Gemm g{XBP(), (const bf16_t*)(WL() + W_GU), M, 2 * DFF, DM, DM}; pg8::StaticOrder S; S.init(M, 2 * DFF, F.G, F.bid);
            LAS float* lrs = (LAS float*)(F.lds + scn::X_SMALL); stage_rstd(S, RSSP(), lrs);
            EpiFfn E{PP_(), lrs};
            if (PH_MASK & 1024) { const int nrep_ = (RPT & 512) ? 2 : 1; for (int rep_ = 0; rep_ < nrep_; ++rep_) { pg8::gemm_phase<EpiFfn, pg8::StaticOrder, true, true>(F.lds, g, S, E); } }
            SEAM(base + 5);
        }
        if (IN(base + 6)) {
            pg8::Gemm g{PP_(), (const bf16_t*)(WL() + W_D), M, DM, DFF, DFF}; pg8::StaticOrder S; S.init(M, DM, F.G, F.bid);
            EpiRes E{OUTP(), OUTP(), XBP(), RSSP(), 0};
            if (PH_MASK & 2048) { const int nrep_ = (RPT & 1024) ? 2 : 1; for (int rep_ = 0; rep_ < nrep_; ++rep_) { E.dry = RPT ? opaque_i(rep_ + 1 < nrep_ ? 1 : 0) : 0; pg8::gemm_phase<EpiRes, pg8::StaticOrder, true, true>(F.lds, g, S, E); } }
            SEAM(base + 6);
        }
    }
#undef IN
#undef SEAM
}

extern "C" void kernel_launch(void* const* d_in, const int* in_sizes, int n_in, void* d_out, int out_size, void* d_ws, size_t ws_size, hipStream_t stream) {
    static int grid = 0;
    if (grid == 0) {
        int dev = 0, cus = 0;
        if (n_in != 18 || ws_size < 256 * MiB) { fprintf(stderr, "kernel_launch: unexpected inputs (%d) or workspace (%zu < %zu)\n", n_in, ws_size, (size_t)WS_END); grid = -1; return; }
        if (hipGetDevice(&dev) != hipSuccess || hipDeviceGetAttribute(&cus, hipDeviceAttributeMultiprocessorCount, dev) != hipSuccess) { grid = -1; return; }
        if (hipFuncSetAttribute((const void*)mk_fwd, hipFuncAttributeMaxDynamicSharedMemorySize, LDS_BYTES) != hipSuccess) { grid = -1; return; }
        int per_cu = 0;
        if (hipOccupancyMaxActiveBlocksPerMultiprocessor(&per_cu, (const void*)mk_fwd, NTHR, LDS_BYTES) != hipSuccess || per_cu < 1) { fprintf(stderr, "kernel_launch: occupancy query says %d\n", per_cu); }
        (void)hipGetLastError();
        grid = cus;
    }
    if (grid < 0) return;
    (void)hipMemsetAsync((char*)d_ws + WS_CTL, 0, CTL_ZERO_BYTES, stream);
    Args a{};
    for (int i = 0; i < 18; ++i) a.in[i] = (const float*)d_in[i];
    a.out = (float*)d_out; a.ws = (unsigned char*)d_ws;
#if MK_MULTI
    for (int ph = 0; ph < 1 + DEPTH * 8; ++ph) {
        if (ph > 0) { const int l = (ph - 1) >> 3, s = (ph - 1) & 7; if (s == 7) continue; if ((l & 1) == 0 && s == 7) continue; if ((l & 1) == 1 && s == 4) continue; }
        a.ph_lo = ph; a.ph_hi = ph + 1;
        hipLaunchKernelGGL(mk_fwd, dim3(grid), dim3(NTHR), LDS_BYTES, stream, a);
    }
#else
    a.ph_lo = 0; a.ph_hi = DEPTH * 8;
    hipLaunchKernelGGL(mk_fwd, dim3(grid), dim3(NTHR), LDS_BYTES, stream, a);
#endif
}
```

```cpp
#include <hip/hip_runtime.h>
#include <cstdio>
#include <cstdint>

namespace pg8 {
#define PG8_LAS __attribute__((address_space(3)))
typedef unsigned short bf16_t;
typedef short bf16x8 __attribute__((ext_vector_type(8)));
typedef float f32x4 __attribute__((ext_vector_type(4)));
typedef unsigned u32x4 __attribute__((ext_vector_type(4)));
constexpr int BM = 256, BK = 64, HALF = 128, HTB = HALF * BK * 2  , STAGE_BYTES = 8 * HTB, NXCD = 8, WGM = 8;

__host__ __device__ __forceinline__ int lds_byte(int r, int c) { const int st = (r >> 4) * 2 + (c >> 5), rr = r & 15, cc = c & 31, ob = rr * 64 + cc * 2; return st * 1024 + (ob ^ (((ob >> 9) & 1) << 5)); }
__host__ __device__ __forceinline__ void stage_rc(int b, int& R, int& C) { const int st = b / 1024, sb = b % 1024, swz = sb ^ (((sb >> 9) & 1) << 5); R = (st >> 1) * 16 + swz / 64; C = (st & 1) * 32 + (swz % 64) / 2; }
__host__ __device__ __forceinline__ int perm32(int rho) { const int n = rho >> 4, i = rho & 15; return 8 * (i >> 2) + 4 * n + (i & 3); }

struct Unit { int pm, pn, idx; };
struct Gemm { const bf16_t* A; const bf16_t* Bt; int M, N, K, lda; };

struct StaticOrder {
    int nM, nN, nwg, G, c;
    __host__ __device__ void init(int M, int N, int G_, int c_) { nM = M / BM; nN = N / BM; nwg = nM * nN; G = G_; c = c_; }
    __host__ __device__ bool next(int i, Unit& u) const {
        const long L = (long)i * G + c; if (L >= nwg) return false;
        int wgid = (int)L; { const int q = nwg / NXCD, r = nwg % NXCD, xcd = wgid % NXCD, off = wgid / NXCD; wgid = (xcd < r ? xcd * (q + 1) : r * (q + 1) + (xcd - r) * q) + off; }
        const int nig = WGM * nN, gid = wgid / nig, fm = gid * WGM, gsz = (nM - fm) < WGM ? (nM - fm) : WGM;
        u.pm = fm + ((wgid % nig) % gsz); u.pn = (wgid % nig) / gsz; u.idx = i; return true;
    }
    __device__ __forceinline__ void a_ready(const Unit&) const {}
    __device__ __forceinline__ void done(const Unit&) const {}
};
__device__ __forceinline__ unsigned cvt_pk_bf16(float lo, float hi) { unsigned r; asm volatile("v_cvt_pk_bf16_f32 %0, %1, %2" : "=v"(r) : "v"(lo), "v"(hi)); return r; }
template <class Epi, class Sched, bool ALIGN_EPI = false, bool SP2 = false>
__device__ __forceinline__ void gemm_phase(PG8_LAS unsigned char* lds, const Gemm g, const Sched& S, const Epi& E) {
    int tid_ = threadIdx.x; asm volatile("" : "+v"(tid_));
    const int tid = tid_, wid = __builtin_amdgcn_readfirstlane(tid >> 6), lane = tid & 63, wr = wid >> 2, wc = wid & 3, fr = lane & 15, fq = lane >> 4;
    const int K = g.K, nt = K / BK;
    unsigned voffA[2], voffB[2];
#pragma unroll
    for (int i = 0; i < 2; ++i) { int R, C; stage_rc(tid * 16 + i * 8192, R, C); const int Rb = Epi::PERM ? ((R & ~31) + perm32(R & 31)) : R;
        voffA[i] = (unsigned)(R * g.lda + C) * 2u; voffB[i] = (unsigned)(Rb * K + C) * 2u; }
    const size_t kstep = (size_t)(BK * 2);
    const size_t hstepB = (size_t)HALF * K * 2, hstepA = (size_t)HALF * g.lda * 2;
    const size_t tstepA = 2 * hstepA, tstepB = 2 * hstepB;
    const unsigned ldsw = (unsigned)wid * 1024u;
    const int aoff = lds_byte(wr * 64 + fr, fq * 8), boff = lds_byte(wc * 32 + fr, fq * 8);
#define PG8_SA(b, h) (((b) * 2 + (h)) * HTB)
#define PG8_SB(b, h) ((4 + (b) * 2 + (h)) * HTB)
#define PG8_STAGE(bufoff, gbase, voff) do { _Pragma("unroll") for (int _i = 0; _i < 2; ++_i) \
        __builtin_amdgcn_global_load_lds((const unsigned*)((const char*)(gbase) + (voff)[_i]), (PG8_LAS unsigned*)(lds + (bufoff) + ldsw + _i * 8192), 16, 0, 0); } while (0)
#define PG8_LDA(dst, b, h) do { _Pragma("unroll") for (int m = 0; m < 4; ++m) _Pragma("unroll") for (int k = 0; k < 2; ++k) dst[m][k] = *(const PG8_LAS bf16x8*)(lds + PG8_SA(b, h) + aoff + m * 2048 + k * 1024); } while (0)
#define PG8_LDB(dst, b, h) do { _Pragma("unroll") for (int n = 0; n < 2; ++n) _Pragma("unroll") for (int k = 0; k < 2; ++k) dst[n][k] = *(const PG8_LAS bf16x8*)(lds + PG8_SB(b, h) + boff + n * 2048 + k * 1024); } while (0)
#define PG8_MMA(ai, bj, At, Bt) do { __builtin_amdgcn_s_setprio(1); _Pragma("unroll") for (int m = 0; m < 4; ++m) _Pragma("unroll") for (int n = 0; n < 2; ++n) _Pragma("unroll") for (int k = 0; k < 2; ++k) \
        acc[ai][bj][m][n] = __builtin_amdgcn_mfma_f32_16x16x32_bf16(Bt[n][k], At[m][k], acc[ai][bj][m][n], 0, 0, 0); __builtin_amdgcn_s_setprio(0); } while (0)
#define PG8_WAIT_V(n) asm volatile("s_waitcnt vmcnt(" #n ")" ::: "memory")
#define PG8_WAIT_L(n) asm volatile("s_waitcnt lgkmcnt(" #n ")" ::: "memory")
#define PG8_BAR __builtin_amdgcn_s_barrier()
#define PG8_SCHED __builtin_amdgcn_sched_barrier(0)
    Unit cur, nxt; int ui = 0;
    if (!S.next(0, cur)) return;
    f32x4 acc[2][2][4][2];
#pragma unroll
    for (int a = 0; a < 2; ++a)
#pragma unroll
        for (int b = 0; b < 2; ++b)
#pragma unroll
            for (int m = 0; m < 4; ++m)
#pragma unroll
                for (int n = 0; n < 2; ++n) acc[a][b][m][n] = (f32x4){0.f, 0.f, 0.f, 0.f};
    bf16x8 At[4][2], B0[2][2], B1[2][2];
    const char* cA = (const char*)g.A + (size_t)cur.pm * tstepA; const char* cB = (const char*)g.Bt + (size_t)cur.pn * tstepB;
    S.a_ready(cur);
    if constexpr (SP2) {
        PG8_STAGE(PG8_SB(0, 0), cB, voffB); PG8_STAGE(PG8_SB(0, 1), cB + hstepB, voffB); PG8_STAGE(PG8_SA(0, 0), cA, voffA); PG8_STAGE(PG8_SA(0, 1), cA + hstepA, voffA);
        if (wr == 1) PG8_BAR;
        PG8_WAIT_V(2); PG8_BAR;
        PG8_STAGE(PG8_SB(1, 0), cB + kstep, voffB); PG8_STAGE(PG8_SA(1, 0), cA + kstep, voffA); PG8_STAGE(PG8_SB(1, 1), cB + hstepB + kstep, voffB);
        PG8_WAIT_V(6); PG8_BAR;
    } else {
        PG8_STAGE(PG8_SB(0, 0), cB, voffB); PG8_STAGE(PG8_SA(0, 0), cA, voffA); PG8_STAGE(PG8_SB(0, 1), cB + hstepB, voffB); PG8_STAGE(PG8_SA(0, 1), cA + hstepA, voffA);
        if (wr == 1) PG8_BAR;
        PG8_WAIT_V(4); PG8_BAR;
        PG8_STAGE(PG8_SB(1, 0), cB + kstep, voffB); PG8_STAGE(PG8_SA(1, 0), cA + kstep, voffA); PG8_STAGE(PG8_SB(1, 1), cB + hstepB + kstep, voffB);
        PG8_WAIT_V(6); PG8_BAR;
    }
    for (;;) {
        const bool has_next = S.next(ui + 1, nxt);
        const char* nA = has_next ? (const char*)g.A + (size_t)nxt.pm * tstepA : cA; const char* nB = has_next ? (const char*)g.Bt + (size_t)nxt.pn * tstepB : cB;
        for (int t = 0; t < nt; t += 2) {
            const bool last = (t == nt - 2);
            const char* a1 = cA + (size_t)(t + 1) * kstep;
            const char* a2 = last ? nA : cA + (size_t)(t + 2) * kstep; const char* b2 = last ? nB : cB + (size_t)(t + 2) * kstep;
            const char* a3 = a2 + kstep; const char* b3 = b2 + kstep;
            if (last && has_next) S.a_ready(nxt);
            if constexpr (SP2) {
            PG8_LDB(B0, 0, 0); PG8_LDB(B1, 0, 1); PG8_SCHED; PG8_LDA(At, 0, 0); PG8_STAGE(PG8_SA(1, 1), a1 + hstepA, voffA);
            PG8_WAIT_V(8); PG8_WAIT_L(0); PG8_BAR; PG8_MMA(0, 0, At, B0); PG8_MMA(0, 1, At, B1); PG8_BAR; PG8_SCHED;
            PG8_LDA(At, 0, 1); PG8_STAGE(PG8_SB(0, 0), b2, voffB); PG8_STAGE(PG8_SB(0, 1), b2 + hstepB, voffB); PG8_STAGE(PG8_SA(0, 0), a2, voffA);
            PG8_WAIT_V(8); PG8_WAIT_L(0); PG8_BAR; PG8_MMA(1, 0, At, B0); PG8_MMA(1, 1, At, B1); PG8_BAR; PG8_SCHED;
            PG8_LDB(B0, 1, 0); PG8_LDB(B1, 1, 1); PG8_SCHED; PG8_LDA(At, 1, 0); PG8_STAGE(PG8_SA(0, 1), a2 + hstepA, voffA);
            PG8_WAIT_V(8); PG8_WAIT_L(0); PG8_BAR; PG8_MMA(0, 0, At, B0); PG8_MMA(0, 1, At, B1); PG8_BAR; PG8_SCHED;
            PG8_LDA(At, 1, 1); PG8_STAGE(PG8_SB(1, 0), b3, voffB); PG8_STAGE(PG8_SB(1, 1), b3 + hstepB, voffB); PG8_STAGE(PG8_SA(1, 0), a3, voffA);
            PG8_WAIT_V(8); PG8_WAIT_L(0); PG8_BAR; PG8_MMA(1, 0, At, B0); PG8_MMA(1, 1, At, B1); PG8_BAR; PG8_SCHED;
            } else {
            PG8_LDB(B0, 0, 0); PG8_SCHED; PG8_LDA(At, 0, 0); PG8_STAGE(PG8_SA(1, 1), a1 + hstepA, voffA);
            PG8_WAIT_L(8); PG8_BAR; PG8_WAIT_L(0); PG8_MMA(0, 0, At, B0); PG8_BAR; PG8_SCHED;
            PG8_LDB(B1, 0, 1); PG8_STAGE(PG8_SB(0, 0), b2, voffB);
            PG8_BAR; PG8_WAIT_L(0); PG8_MMA(0, 1, At, B1); PG8_BAR;
            PG8_LDA(At, 0, 1); PG8_STAGE(PG8_SA(0, 0), a2, voffA);
            PG8_BAR; PG8_WAIT_L(0); PG8_MMA(1, 0, At, B0); PG8_BAR; PG8_SCHED;
            PG8_STAGE(PG8_SB(0, 1), b2 + hstepB, voffB);
            PG8_WAIT_V(6); PG8_BAR; PG8_MMA(1, 1, At, B1); PG8_BAR;
            PG8_LDB(B0, 1, 0); PG8_SCHED; PG8_LDA(At, 1, 0); PG8_STAGE(PG8_SA(0, 1), a2 + hstepA, voffA);
            PG8_WAIT_L(8); PG8_BAR; PG8_WAIT_L(0); PG8_MMA(0, 0, At, B0); PG8_BAR; PG8_SCHED;
            PG8_LDB(B1, 1, 1); PG8_STAGE(PG8_SB(1, 0), b3, voffB);
            PG8_BAR; PG8_WAIT_L(0); PG8_MMA(0, 1, At, B1); PG8_BAR;
            PG8_LDA(At, 1, 1); PG8_STAGE(PG8_SA(1, 0), a3, voffA);
            PG8_BAR; PG8_WAIT_L(0); PG8_MMA(1, 0, At, B0); PG8_BAR; PG8_SCHED;
            PG8_STAGE(PG8_SB(1, 1), b3 + hstepB, voffB);
            PG8_WAIT_V(6); PG8_BAR; PG8_MMA(1, 1, At, B1); PG8_BAR;
            }
        }
        if constexpr (ALIGN_EPI) { if (wr == 0) PG8_BAR; }
        if constexpr (!Epi::AFTER_DRAIN) { E(acc, cur, wr, wc, fr, fq); S.done(cur); }
        if (!has_next) break;
#pragma unroll
        for (int a = 0; a < 2; ++a)
#pragma unroll
            for (int b = 0; b < 2; ++b)
#pragma unroll
                for (int m = 0; m < 4; ++m)
#pragma unroll
                    for (int n = 0; n < 2; ++n) acc[a][b][m][n] = (f32x4){0.f, 0.f, 0.f, 0.f};
        cur = nxt; cA = nA; cB = nB; ++ui;
        if constexpr (ALIGN_EPI) { if (wr == 1) PG8_BAR; }
    }
    PG8_WAIT_V(0);
    if constexpr (!ALIGN_EPI) { if (wr == 0) PG8_BAR; }
    PG8_BAR;
    if constexpr (Epi::AFTER_DRAIN) { E.fused(acc, cur, wr, wc, fr, fq, lds, wid, lane); S.done(cur); }
#undef PG8_SA
#undef PG8_SB
#undef PG8_STAGE
#undef PG8_LDA
#undef PG8_LDB
#undef PG8_MMA
#undef PG8_WAIT_V
#undef PG8_WAIT_L
#undef PG8_BAR
#undef PG8_SCHED
}
}


typedef unsigned short bf16_t;
typedef float f32x4 __attribute__((ext_vector_type(4)));
typedef float f32x2 __attribute__((ext_vector_type(2)));
typedef unsigned u32x4 __attribute__((ext_vector_type(4)));
#define LAS __attribute__((address_space(3)))
#define GAS __attribute__((address_space(1)))

#ifndef PH_MASK
#define PH_MASK 0xffff
#endif
#ifndef RPT
#define RPT 0
#endif
#ifndef VARX
#define VARX 0
#endif
#ifndef NT_ST
#define NT_ST 1
#endif
#ifndef PROBE_S
#define PROBE_S -1
#endif
#ifndef PROBE_ODD
#define PROBE_ODD 0
#endif
#ifndef PROBE_BAR
#define PROBE_BAR 1
#endif
#ifndef WT_ST
#define WT_ST 0
#endif
#ifndef MK_MULTI
#define MK_MULTI 0
#endif

constexpr int BATCH = 4, SEQ = 4096, DM = 1024, M = BATCH * SEQ, DEPTH = 4;
constexpr int DFF = 2816;
constexpr int HYB_IN = 3096, HYB_N = 3072, HYB_PAD = 3104;
constexpr int NCH = 64, CH = 64;
constexpr float EPS = 1e-6f;
constexpr int PP = 3072;
constexpr int C_GQ = 0, C_GK = 256, C_GV = 512, C_MQ = 1024, C_MK = 1280, C_MV = 1536, C_GR = 2048, C_MO = 2560;
constexpr int SMALLP = 32;

constexpr size_t MiB = 1u << 20;
constexpr size_t WS_CTL = 0, CTL_ZERO_BYTES = 65536, WS_RSS = 1 * MiB, WS_SMALL = 2 * MiB, WS_KMEAN = 4 * MiB, WS_DEC = 5 * MiB, WS_NS = 6 * MiB, WS_SIDE = 7 * MiB, WS_Z = 240 * MiB;
constexpr size_t WS_XB = 8 * MiB, WS_P = 40 * MiB, WS_W = 136 * MiB;
constexpr size_t W_IN = 0, W_OUT = W_IN + (size_t)HYB_PAD * DM * 2, W_QKV = W_OUT + (size_t)DM * DM * 2, W_O = W_QKV + (size_t)3 * DM * DM * 2, W_MIXSZ = W_O + (size_t)DM * DM * 2;
constexpr size_t W_FFN0 = 2 * W_MIXSZ, W_GU = 0, W_D = (size_t)2 * DFF * DM * 2, W_FFNSZ = W_D + (size_t)DM * DFF * 2;
constexpr size_t WS_END = WS_W + W_FFN0 + 4 * W_FFNSZ;
static_assert(WS_END <= WS_Z && WS_Z + (size_t)M * 256 * 2 <= 256 * MiB, "workspace map");

constexpr int RING_BYTES = 131072, LDS_BYTES = 147456, MISC_OFF = LDS_BYTES - 256;
constexpr int NWAVES = 8, NTHR = 512;

__device__ __forceinline__ float bf2f(bf16_t v) { return __uint_as_float((unsigned)v << 16); }
typedef __bf16 bf16x2_t __attribute__((ext_vector_type(2)));
__device__ __forceinline__ unsigned pk2(float lo, float hi) { const f32x2 v = {lo, hi}; const bf16x2_t b = __builtin_convertvector(v, bf16x2_t); return __builtin_bit_cast(unsigned, b); }
__device__ __forceinline__ unsigned f2bf(float f) { return pk2(f, f) & 0xffffu; }
__device__ __forceinline__ float sigmoidf_(float x) { return __builtin_amdgcn_rcpf(1.f + __builtin_amdgcn_exp2f(-1.4426950408889634f * x)); }
__device__ __forceinline__ float siluf_(float x) { return x * __builtin_amdgcn_rcpf(1.f + __builtin_amdgcn_exp2f(-1.4426950408889634f * x)); }
__device__ __forceinline__ float logsigmoidf_(float x) { return fminf(x, 0.f) - 0.6931471805599453f * __builtin_amdgcn_logf(1.f + __builtin_amdgcn_exp2f(-1.4426950408889634f * fabsf(x))); }
__device__ __forceinline__ float wave_sum(float v) {
#pragma unroll
    for (int o = 1; o < 64; o <<= 1) v += __shfl_xor(v, o);
    return v;
}
__device__ __forceinline__ float wave_max(float v) {
#pragma unroll
    for (int o = 1; o < 64; o <<= 1) v = fmaxf(v, __shfl_xor(v, o));
    return v;
}
__device__ __forceinline__ int opaque_i(int v) { asm volatile("" : "+v"(v)); return v; }
__device__ __forceinline__ float row16_sum(float v) {
    v += __builtin_bit_cast(float, __builtin_amdgcn_update_dpp(0, __builtin_bit_cast(int, v), 0xB1, 0xF, 0xF, true));
    v += __builtin_bit_cast(float, __builtin_amdgcn_update_dpp(0, __builtin_bit_cast(int, v), 0x4E, 0xF, 0xF, true));
    v += __builtin_bit_cast(float, __builtin_amdgcn_update_dpp(0, __builtin_bit_cast(int, v), 0x141, 0xF, 0xF, true));
    v += __builtin_bit_cast(float, __builtin_amdgcn_update_dpp(0, __builtin_bit_cast(int, v), 0x140, 0xF, 0xF, true));
    return v;
}
__device__ __forceinline__ float row_rstd(const float* rss, int row) {
    const f32x4* p = (const f32x4*)(rss + (size_t)row * 16);
    const f32x4 a = p[0], b = p[1], c = p[2], d = p[3];
    const float s = ((a.x + a.y) + (a.z + a.w)) + ((b.x + b.y) + (b.z + b.w)) + ((c.x + c.y) + (c.z + c.w)) + ((d.x + d.y) + (d.z + d.w));
    return __builtin_amdgcn_rsqf(s * (1.f / DM) + EPS);
}

#define XB_TMO      128
#define XB_XCNT(j)  (256  + 64 * (j))
#define XB_XSUB(j)  (1280 + 64 * (j))
#define XB_XGEN(j)  (2304 + 64 * (j))
#define XB_TOP      3328
#define XB_TOPGEN   3392
#define XCD_BAR_WORDS 3456
#define XB_SPIN_CAP (1u << 18)
__device__ __forceinline__ unsigned xb_ld(unsigned* p)              { return __hip_atomic_load(p, __ATOMIC_RELAXED, __HIP_MEMORY_SCOPE_AGENT); }
__device__ __forceinline__ unsigned xb_add(unsigned* p, unsigned v) { return __hip_atomic_fetch_add(p, v, __ATOMIC_RELAXED, __HIP_MEMORY_SCOPE_AGENT); }
__device__ __forceinline__ unsigned xb_xcc_id() { return (unsigned)__builtin_amdgcn_s_getreg((3 << 11) | 20) & 0xFu; }
#define XB_SPIN(cond, bar) do { unsigned _sp = 0; while (cond) { __builtin_amdgcn_s_sleep(1); \
    if ((++_sp & 255u) == 0u) { if (xb_ld(&(bar)[XB_TMO])) break; if (_sp > XB_SPIN_CAP) { atomicAdd(&(bar)[XB_TMO], 1u); break; } } } } while (0)
struct XcdBarrier { unsigned* bar; unsigned x; volatile LAS unsigned* st; };
__device__ __forceinline__ XcdBarrier xcd_barrier_post(unsigned* bar, volatile LAS unsigned* st) {
    XcdBarrier b; b.bar = bar; b.x = xb_xcc_id(); b.st = st;
    if (threadIdx.x == 0) (void)xb_add(&bar[XB_XCNT(b.x)], 1u);
    return b;
}
__device__ __forceinline__ void xcd_barrier_complete(unsigned* bar, unsigned x, unsigned& nloc, unsigned& nx) {
    const unsigned G = gridDim.x * gridDim.y * gridDim.z;
    unsigned sum, cnt, mine, sp = 0u;
    for (;;) {
        sum = 0u; cnt = 0u; mine = 0u;
#pragma unroll
        for (unsigned j = 0; j < 16; ++j) { const unsigned c = xb_ld(&bar[XB_XCNT(j)]); sum += c; cnt += (c > 0u) ? 1u : 0u; mine = (j == x) ? c : mine; }
        if (sum == G) break;
        __builtin_amdgcn_s_sleep(1);
        if ((++sp & 255u) == 0u) { if (xb_ld(&bar[XB_TMO])) break; if (sp > XB_SPIN_CAP) { atomicAdd(&bar[XB_TMO], 1u); break; } }
    }
    nloc = mine > 0u ? mine : 1u; nx = cnt > 0u ? cnt : 1u;
}
__device__ __forceinline__ void xcd_barrier(const XcdBarrier& b) {
    asm volatile("s_waitcnt vmcnt(0)" ::: "memory");
    __syncthreads();
    if (threadIdx.x == 0) {
        unsigned* bar = b.bar;
        __builtin_amdgcn_s_waitcnt(0);
        unsigned nloc = b.st[0], nx = b.st[1];
        if (nloc == 0u) { xcd_barrier_complete(bar, b.x, nloc, nx); b.st[0] = nloc; b.st[1] = nx; }
        const unsigned old = xb_add(&bar[XB_XSUB(b.x)], 1u);
        const unsigned gen = old / nloc;
        if (old + 1u == (gen + 1u) * nloc) {
            __builtin_amdgcn_fence(__ATOMIC_RELEASE, "agent");
            asm volatile("s_waitcnt vmcnt(0)" ::: "memory");
            const unsigned og = xb_add(&bar[XB_TOP], 1u);
            const unsigned tg = og / nx;
            if (og + 1u == (tg + 1u) * nx) xb_add(&bar[XB_TOPGEN], 1u);
            else XB_SPIN(xb_ld(&bar[XB_TOPGEN]) == tg, bar);
            __builtin_amdgcn_fence(__ATOMIC_ACQUIRE, "agent");
            xb_add(&bar[XB_XGEN(b.x)], 1u);
            asm volatile("s_waitcnt vmcnt(0)" ::: "memory");
        } else {
            XB_SPIN(xb_ld(&bar[XB_XGEN(b.x)]) == gen, bar);
            __builtin_amdgcn_fence(__ATOMIC_ACQUIRE, "agent");
            asm volatile("s_waitcnt vmcnt(0)" ::: "memory");
        }
    }
    __syncthreads();
}


__device__ __forceinline__ void stage_rstd(const pg8::StaticOrder& S, const float* rss, LAS float* lds_rs) {
    const int tid = opaque_i(threadIdx.x), half = tid >> 8, t = tid & 255;
    pg8::Unit u;
    for (int i = half; S.next(i, u); i += 2) lds_rs[i * 256 + t] = row_rstd(rss, u.pm * 256 + t);
    asm volatile("s_waitcnt lgkmcnt(0)" ::: "memory");
    __syncthreads();
}

__device__ __forceinline__ void store16_wt(void* base, unsigned nbytes, unsigned off, u32x4 v) {
    const __amdgpu_buffer_rsrc_t rs = __builtin_amdgcn_make_buffer_rsrc(base, (short)0, (int)nbytes, 0x00020000);
    __builtin_amdgcn_raw_buffer_store_b128(v, rs, (int)off, 0, 16);
}
struct EpiRowBf16 {
    static constexpr bool PERM = true, AFTER_DRAIN = false;
    bf16_t* O; int ldc; LAS const float* lrs;
    __device__ __forceinline__ void operator()(const pg8::f32x4 (&acc)[2][2][4][2], const pg8::Unit& u, int wr, int wc, int fr, int fq) const {
        const int row0 = u.pm * 256 + wr * 64 + fr;
        const int col0 = u.pn * 256 + wc * 32 + 8 * fq;
        float rs[8];
#pragma unroll
        for (int i = 0; i < 8; ++i) rs[i] = lrs[u.idx * 256 + wr * 64 + fr + (i >> 2) * 128 + (i & 3) * 16];
#pragma unroll
        for (int ai = 0; ai < 2; ++ai)
#pragma unroll
            for (int m = 0; m < 4; ++m) { const int row = row0 + ai * 128 + m * 16; const float r = rs[ai * 4 + m];
                bf16_t* rowp = O + (size_t)row * ldc + col0;
#pragma unroll
                for (int bj = 0; bj < 2; ++bj) { const f32x4 v0 = acc[ai][bj][m][0] * r, v1 = acc[ai][bj][m][1] * r;
                    u32x4 w; w.x = pg8::cvt_pk_bf16(v0[0], v0[1]); w.y = pg8::cvt_pk_bf16(v0[2], v0[3]); w.z = pg8::cvt_pk_bf16(v1[0], v1[1]); w.w = pg8::cvt_pk_bf16(v1[2], v1[3]);
                    if (NT_ST & 2) __builtin_nontemporal_store(w, (u32x4*)(rowp + bj * 128)); else *(u32x4*)(rowp + bj * 128) = w; } }
    }
};
struct EpiRes {
    static constexpr bool PERM = true, AFTER_DRAIN = false;
    bf16_t* xb; float* xout; float* rss; int dry;
    __device__ __forceinline__ void operator()(const pg8::f32x4 (&acc)[2][2][4][2], const pg8::Unit& u, int wr, int wc, int fr, int fq) const {
        if (RPT && dry) { if (acc[0][0][0][0][0] == 1.2345e-33f) rss[0] = 0.f; return; }
        const int row0 = u.pm * 256 + wr * 64 + fr, col0 = u.pn * 256 + wc * 32 + 8 * fq;
        u32x4 xo[2][4][2];
#pragma unroll
        for (int ai = 0; ai < 2; ++ai)
#pragma unroll
            for (int m = 0; m < (ai ? 2 : 4); ++m)
#pragma unroll
                for (int bj = 0; bj < 2; ++bj) xo[ai][m][bj] = *(const u32x4*)(xb + (size_t)(row0 + ai * 128 + m * 16) * DM + col0 + bj * 128);
#pragma unroll
        for (int ai = 0; ai < 2; ++ai) {
            if (ai == 1) {
#pragma unroll
                for (int m = 2; m < 4; ++m)
#pragma unroll
                    for (int bj = 0; bj < 2; ++bj) xo[1][m][bj] = *(const u32x4*)(xb + (size_t)(row0 + 128 + m * 16) * DM + col0 + bj * 128);
            }
#pragma unroll
            for (int m = 0; m < 4; ++m) { const int row = row0 + ai * 128 + m * 16; float ss = 0.f;
#pragma unroll
                for (int bj = 0; bj < 2; ++bj) { const size_t off = (size_t)row * DM + col0 + bj * 128; const u32x4 xw = xo[ai][m][bj];
                    f32x4 a, b;
                    a[0] = __uint_as_float(xw[0] << 16); a[1] = __uint_as_float(xw[0] & 0xffff0000u); a[2] = __uint_as_float(xw[1] << 16); a[3] = __uint_as_float(xw[1] & 0xffff0000u);
                    b[0] = __uint_as_float(xw[2] << 16); b[1] = __uint_as_float(xw[2] & 0xffff0000u); b[2] = __uint_as_float(xw[3] << 16); b[3] = __uint_as_float(xw[3] & 0xffff0000u);
                    a = a + acc[ai][bj][m][0]; b = b + acc[ai][bj][m][1];
                    if (xout) { *(f32x4*)(xout + off) = a; *(f32x4*)(xout + off + 4) = b; }
                    u32x4 w; w.x = pg8::cvt_pk_bf16(a[0], a[1]); w.y = pg8::cvt_pk_bf16(a[2], a[3]); w.z = pg8::cvt_pk_bf16(b[0], b[1]); w.w = pg8::cvt_pk_bf16(b[2], b[3]);
                    if (WT_ST & 4) store16_wt(xb, (unsigned)M * DM * 2u, (unsigned)(off * 2), w); else if (NT_ST & 8) __builtin_nontemporal_store(w, (u32x4*)(xb + off)); else *(u32x4*)(xb + off) = w;
                    ss += (a[0] * a[0] + a[1] * a[1]) + (a[2] * a[2] + a[3] * a[3]) + (b[0] * b[0] + b[1] * b[1]) + (b[2] * b[2] + b[3] * b[3]); }
                ss += __shfl_xor(ss, 16); ss += __shfl_xor(ss, 32);
                if (fq == 0) rss[(size_t)row * 16 + u.pn * 4 + wc] = ss; }
        }
    }
};
struct EpiFfn {
    static constexpr bool PERM = true, AFTER_DRAIN = false;
    bf16_t* H; LAS const float* lrs;
    __device__ __forceinline__ void operator()(const pg8::f32x4 (&acc)[2][2][4][2], const pg8::Unit& u, int wr, int wc, int fr, int fq) const {
        const int row0 = u.pm * 256 + wr * 64 + fr, col0 = u.pn * 128 + wc * 32 + 8 * fq;
        float rs[8];
#pragma unroll
        for (int i = 0; i < 8; ++i) rs[i] = lrs[u.idx * 256 + wr * 64 + fr + (i >> 2) * 128 + (i & 3) * 16];
#pragma unroll
        for (int ai = 0; ai < 2; ++ai)
#pragma unroll
            for (int m = 0; m < 4; ++m) { const int row = row0 + ai * 128 + m * 16; const float r = rs[ai * 4 + m];
                float hv[8]; const float nr = -1.4426950408889634f * r, ir2 = __builtin_amdgcn_rcpf(r * r);
#pragma unroll
                for (int n = 0; n < 2; ++n)
#pragma unroll
                    for (int e = 0; e < 4; e += 2) { const f32x2 g = {acc[ai][0][m][n][e], acc[ai][0][m][n][e + 1]}, uu = {acc[ai][1][m][n][e], acc[ai][1][m][n][e + 1]};
                        f32x2 t = g * nr; t.x = __builtin_amdgcn_exp2f(t.x); t.y = __builtin_amdgcn_exp2f(t.y);
                        f32x2 d = t * ir2 + ir2; d.x = __builtin_amdgcn_rcpf(d.x); d.y = __builtin_amdgcn_rcpf(d.y);
                        const f32x2 h = (g * uu) * d; hv[n * 4 + e] = h.x; hv[n * 4 + e + 1] = h.y; }
                u32x4 w; w.x = pg8::cvt_pk_bf16(hv[0], hv[1]); w.y = pg8::cvt_pk_bf16(hv[2], hv[3]); w.z = pg8::cvt_pk_bf16(hv[4], hv[5]); w.w = pg8::cvt_pk_bf16(hv[6], hv[7]);
                if (WT_ST & 8) store16_wt(H, (unsigned)M * DFF * 2u, (unsigned)(((size_t)row * DFF + col0) * 2), w); else if (NT_ST & 1) __builtin_nontemporal_store(w, (u32x4*)(H + (size_t)row * DFF + col0)); else *(u32x4*)(H + (size_t)row * DFF + col0) = w; }
    }
};


struct EpiQkv {
    static constexpr bool PERM = true, AFTER_DRAIN = false;
    bf16_t* O; LAS const float* lrs; const float* qg; const float* kg; float* kmean; LAS float* xch; LAS float* xch2; LAS float* ksum;
    __device__ __forceinline__ void operator()(const pg8::f32x4 (&acc)[2][2][4][2], const pg8::Unit& u, int wr, int wc, int fr, int fq) const {
        fr = opaque_i(fr); fq = opaque_i(fq);
        const unsigned vo_o = (unsigned)(((wr * 64 + fr) * PP + wc * 32 + 8 * fq) * 2);
        char* obase = (char*)O + ((size_t)u.pm * 256 * PP + (size_t)u.pn * 256) * 2;
        float rs[8];
#pragma unroll
        for (int i = 0; i < 8; ++i) rs[i] = lrs[u.idx * 256 + wr * 64 + fr + (i >> 2) * 128 + (i & 3) * 16];
        if (u.pn >= 8) {
#pragma unroll
            for (int ai = 0; ai < 2; ++ai)
#pragma unroll
                for (int m = 0; m < 4; ++m) { const float r = rs[ai * 4 + m];
#pragma unroll
                    for (int bj = 0; bj < 2; ++bj) { const f32x4 v0 = acc[ai][bj][m][0] * r, v1 = acc[ai][bj][m][1] * r;
                        u32x4 w; w.x = pg8::cvt_pk_bf16(v0[0], v0[1]); w.y = pg8::cvt_pk_bf16(v0[2], v0[3]); w.z = pg8::cvt_pk_bf16(v1[0], v1[1]); w.w = pg8::cvt_pk_bf16(v1[2], v1[3]);
                        if (WT_ST & 2) store16_wt(obase, (unsigned)(256 * PP * 2), (unsigned)(((ai * 128 + m * 16) * PP + bj * 128) * 2) + vo_o, w); else if (NT_ST & 4) __builtin_nontemporal_store(w, (u32x4*)(obase + ((ai * 128 + m * 16) * PP + bj * 128) * 2 + vo_o)); else *(u32x4*)(obase + ((ai * 128 + m * 16) * PP + bj * 128) * 2 + vo_o) = w; } }
            return;
        }
        const bool isq = u.pn < 4;
        LAS float* xw = xch + (wr * 64 + fr) * 8 + wc;
#pragma unroll
        for (int ai = 0; ai < 2; ++ai)
#pragma unroll
            for (int m = 0; m < 4; ++m) { const float r = rs[ai * 4 + m];
#pragma unroll
                for (int bj = 0; bj < 2; ++bj) { const f32x4 v0 = acc[ai][bj][m][0] * r, v1 = acc[ai][bj][m][1] * r;
                    float ss = (v0[0] * v0[0] + v0[1] * v0[1]) + (v0[2] * v0[2] + v0[3] * v0[3]) + (v1[0] * v1[0] + v1[1] * v1[1]) + (v1[2] * v1[2] + v1[3] * v1[3]);
                    ss += __shfl_xor(ss, 16); ss += __shfl_xor(ss, 32);
                    if (fq == 0) xw[(ai * 128 + m * 16) * 8 + bj * 4] = ss; }
                if (fq == 0 && wc == 0) xch2[wr * 64 + fr + ai * 128 + m * 16] = r; }
        asm volatile("s_waitcnt lgkmcnt(0)" ::: "memory"); __builtin_amdgcn_s_barrier(); asm volatile("" ::: "memory");
        const float* g = (isq ? qg : kg) + wc * 32 + 8 * fq;
        const f32x4 ga = *(const f32x4*)g, gb = *(const f32x4*)(g + 4);
        const float sc = isq ? 0.08838834764831845f : 1.f;
        LAS const float* xr = xch + (wr * 64 + fr) * 8;
#pragma unroll
        for (int bj = 0; bj < 2; ++bj) {
#pragma unroll
            for (int ai = 0; ai < 2; ++ai)
#pragma unroll
                for (int m = 0; m < 4; ++m) { asm volatile("" ::: "memory"); __builtin_amdgcn_sched_barrier(0); const float r = xch2[wr * 64 + fr + ai * 128 + m * 16];
                    const f32x4 p4 = *(LAS const f32x4*)(xr + (ai * 128 + m * 16) * 8 + bj * 4);
                    const float rr = __builtin_amdgcn_rsqf(((p4[0] + p4[1]) + (p4[2] + p4[3])) * (1.f / 128.f) + EPS) * sc * r;
                    const f32x4 v0 = acc[ai][bj][m][0] * rr * ga, v1 = acc[ai][bj][m][1] * rr * gb;
                    if (!isq) {
#pragma unroll
                        for (int e = 0; e < 4; ++e) { const float s0 = row16_sum(v0[e]), s1 = row16_sum(v1[e]);
                            if (fr == 0) {
                                __hip_atomic_fetch_add((LAS int*)ksum + bj * 128 + wc * 32 + 8 * fq + e, __float2int_rn(s0 * 131072.f), __ATOMIC_RELAXED, __HIP_MEMORY_SCOPE_WORKGROUP);
                                __hip_atomic_fetch_add((LAS int*)ksum + bj * 128 + wc * 32 + 8 * fq + 4 + e, __float2int_rn(s1 * 131072.f), __ATOMIC_RELAXED, __HIP_MEMORY_SCOPE_WORKGROUP); } } }
                    u32x4 w; w.x = pg8::cvt_pk_bf16(v0[0], v0[1]); w.y = pg8::cvt_pk_bf16(v0[2], v0[3]); w.z = pg8::cvt_pk_bf16(v1[0], v1[1]); w.w = pg8::cvt_pk_bf16(v1[2], v1[3]);
                    if (WT_ST & 2) store16_wt(obase, (unsigned)(256 * PP * 2), (unsigned)(((ai * 128 + m * 16) * PP + bj * 128) * 2) + vo_o, w); else if (NT_ST & 4) __builtin_nontemporal_store(w, (u32x4*)(obase + ((ai * 128 + m * 16) * PP + bj * 128) * 2 + vo_o)); else *(u32x4*)(obase + ((ai * 128 + m * 16) * PP + bj * 128) * 2 + vo_o) = w; }
        }
        if (!isq) {
            asm volatile("s_waitcnt lgkmcnt(0)" ::: "memory"); __builtin_amdgcn_s_barrier(); asm volatile("" ::: "memory");
            const int t = (wr * 4 + wc) * 64 + fq * 16 + fr;
            if (t < 256) { const int bjj = t >> 7, d = t & 127, hh = (u.pn - 4) * 2 + bjj, bb = u.pm >> 4, blk = u.pm & 15;
                float* km = kmean + ((size_t)((bb * 8 + hh) * 16 + blk)) * 256;
                km[d] = (float)((LAS int*)ksum)[t] * (1.f / (256.f * 131072.f)); km[128 + d] = 0.f; ksum[t] = 0.f; }
        }
    }
};
struct EpiAny {
    static constexpr bool PERM = true, AFTER_DRAIN = false;
    int kind;
    bf16_t* O; LAS const float* lrs;
    const float* qg; const float* kg; LAS float* xch; LAS float* xch2; float* kmean; LAS float* ksum;
    float* xout; bf16_t* xb; float* rss; int dry;
    __device__ __forceinline__ void operator()(const pg8::f32x4 (&acc)[2][2][4][2], const pg8::Unit& u, int wr, int wc, int fr, int fq) const {
        if (kind == 0) { EpiRowBf16 e{O, PP, lrs}; e(acc, u, wr, wc, fr, fq); }
        else if (kind == 1) { EpiQkv e{O, lrs, qg, kg, kmean, xch, xch2, ksum}; e(acc, u, wr, wc, fr, fq); }
        else if (kind == 2) { EpiFfn e{O, lrs}; e(acc, u, wr, wc, fr, fq); }
        else { EpiRes e{xb, xout, rss, dry}; e(acc, u, wr, wc, fr, fq); }
    }
};

struct Args { const float* in[18]; float* out; unsigned char* ws; int ph_lo, ph_hi; };
struct Frame {
    LAS unsigned char* lds; unsigned char* ldsg;
    int tid, lane, wave, G, bid;
};


typedef const __attribute__((address_space(4))) unsigned char* kargp_t;
__device__ __forceinline__ kargp_t karg_base() { kargp_t p = (kargp_t)__builtin_amdgcn_kernarg_segment_ptr(); asm volatile("" : "+s"(p)); return p; }
__device__ __forceinline__ const float* karg_in(kargp_t p, int i) { return *(const float* const __attribute__((address_space(4)))*)(p + 8 * i); }
__device__ __forceinline__ float* karg_out(kargp_t p) { return *(float* const __attribute__((address_space(4)))*)(p + 8 * 18); }
__device__ __forceinline__ unsigned char* karg_ws(kargp_t p) { return *(unsigned char* const __attribute__((address_space(4)))*)(p + 8 * 19); }

__device__ __forceinline__ int map_row(int kind, int n) {
    if (kind == 0) return n;
    if (kind == 2) return (n >> 7) * 256 + (n & 127);
    if (kind == 3) return (n >> 7) * 256 + 128 + (n & 127);
    if (n < 256) return C_GQ + n; if (n < 512) return C_GK + n - 256; if (n < 1024) return C_GV + n - 512; if (n < 1536) return C_GR + n - 1024;
    if (n < 1552) return 3072 + (n - 1536);
    if (n < 1808) return C_MQ + n - 1552; if (n < 2064) return C_MK + n - 1808; if (n < 2576) return C_MV + n - 2064; if (n < 3088) return C_MO + n - 2576;
    return 3072 + 16 + (n - 3088);
}
__device__ __forceinline__ void cvt_item(const float* W, int K, int N, const float* gain, bf16_t* WT, int kind, LAS float* scr, int item, int lane) {
    const int nblk = (N + 63) / 64, kb = item / nblk, nb = item % nblk, k0 = 64 * kb, n0 = 64 * nb;
    const int nq = n0 + 4 * (lane & 15), kr = lane >> 4;
    f32x4 v[16];
#pragma unroll
    for (int i = 0; i < 16; ++i) { v[i] = (f32x4){0.f, 0.f, 0.f, 0.f}; if (nq < N) v[i] = *(const f32x4*)(W + (size_t)(k0 + 4 * i + kr) * N + nq); }
#pragma unroll
    for (int i = 0; i < 16; ++i) { const int kk = 4 * i + kr; const float g = gain ? gain[k0 + kk] : 1.f; LAS float* d = scr + kk * 65 + 4 * (lane & 15);
        d[0] = v[i][0] * g; d[1] = v[i][1] * g; d[2] = v[i][2] * g; d[3] = v[i][3] * g; }
    asm volatile("s_waitcnt lgkmcnt(0)" ::: "memory");
    {
        const int c = lane & 7;
#pragma unroll
        for (int j = 0; j < 8; ++j) { const int nl = (lane >> 3) + 8 * j; const int mr = (n0 + nl < N) ? map_row(kind, n0 + nl) : -1;
            if (mr >= 0) { const LAS float* sp = scr + (8 * c) * 65 + nl;
                u32x4 o; o.x = pk2(sp[0 * 65], sp[1 * 65]); o.y = pk2(sp[2 * 65], sp[3 * 65]); o.z = pk2(sp[4 * 65], sp[5 * 65]); o.w = pk2(sp[6 * 65], sp[7 * 65]);
                *(u32x4*)(WT + (size_t)mr * K + k0 + 8 * c) = o; } }
    }
    asm volatile("s_waitcnt lgkmcnt(0)" ::: "memory");
}
__device__ __forceinline__ void phase_prologue(Frame& F) {
    kargp_t kp = karg_base();
    unsigned char* wsw = karg_ws(kp) + WS_W;
    LAS float* scr = (LAS float*)(F.lds + F.wave * 16640);
    const int gw = F.bid * NWAVES + F.wave, NGW = F.G * NWAVES, lane = opaque_i(F.lane);
    constexpr int I_IN = 16 * 49, I_OUT = 256, I_QKV = 16 * 48, I_O = 256, I_MIX = I_IN + I_OUT + I_QKV + I_O, I_F = 704, I_FFN = 3 * I_F, I_ALL = 2 * I_MIX + 4 * I_FFN;
    const int NFULL = (I_ALL / NGW) * NGW, NIT = I_ALL / NGW + (I_ALL - NFULL + F.G - 1) / F.G;
    for (int ii = 0; ii < NIT; ++ii) {
        int it;
        if (ii < I_ALL / NGW) it = ii * NGW + gw;
        else { const int e = (ii - I_ALL / NGW) * F.G + F.bid; if (e >= I_ALL - NFULL || F.wave != ((ii - I_ALL / NGW) & 7)) continue; it = NFULL + e; }
        if (it < 2 * I_MIX) {
            const int j = it / I_MIX; int r = it % I_MIX; unsigned char* wj = wsw + j * W_MIXSZ;
            if (r < I_IN) cvt_item(karg_in(kp, 3) + (size_t)j * DM * HYB_IN, DM, HYB_IN, karg_in(kp, 1) + (2 * j) * DM, (bf16_t*)(wj + W_IN), 1, scr, r, lane);
            else if ((r -= I_IN) < I_OUT) cvt_item(karg_in(kp, 10) + (size_t)j * DM * DM, DM, DM, nullptr, (bf16_t*)(wj + W_OUT), 0, scr, r, lane);
            else if ((r -= I_OUT) < I_QKV) cvt_item(karg_in(kp, 11) + (size_t)j * DM * 3 * DM, DM, 3 * DM, karg_in(kp, 1) + (2 * j + 1) * DM, (bf16_t*)(wj + W_QKV), 0, scr, r, lane);
            else { r -= I_QKV; cvt_item(karg_in(kp, 14) + (size_t)j * DM * DM, DM, DM, nullptr, (bf16_t*)(wj + W_O), 0, scr, r, lane); }
        } else {
            const int q = it - 2 * I_MIX, l = q / I_FFN; int r = q % I_FFN; unsigned char* wl = wsw + W_FFN0 + l * W_FFNSZ;
            if (r < I_F) cvt_item(karg_in(kp, 15) + (size_t)l * DM * DFF, DM, DFF, karg_in(kp, 2) + l * DM, (bf16_t*)(wl + W_GU), 2, scr, r, lane);
            else if ((r -= I_F) < I_F) cvt_item(karg_in(kp, 16) + (size_t)l * DM * DFF, DM, DFF, karg_in(kp, 2) + l * DM, (bf16_t*)(wl + W_GU), 3, scr, r, lane);
            else { r -= I_F; cvt_item(karg_in(kp, 17) + (size_t)l * DFF * DM, DFF, DM, nullptr, (bf16_t*)(wl + W_D), 0, scr, r, lane); }
        }
    }
    for (int j = 0; j < 2; ++j) {
        u32x4* z0 = (u32x4*)(wsw + j * W_MIXSZ + W_IN + (size_t)3096 * DM * 2);
        const int n0 = 8 * DM * 2 / 16;
        for (int i = F.bid * NTHR + F.tid; i < n0; i += F.G * NTHR) z0[i] = (u32x4){0u, 0u, 0u, 0u};
    }
    const float* x = karg_in(kp, 0); bf16_t* xb = (bf16_t*)(karg_ws(kp) + WS_XB); float* rss = (float*)(karg_ws(kp) + WS_RSS);
    LAS unsigned* xc = (LAS unsigned*)(F.lds + 8 * 16640 + 64);
    const int RPW = M / F.G;
    if (M % (2 * F.G) != 0) {
        for (int row = gw; row < M; row += NGW) {
            const float* xr = x + (size_t)row * DM; float s = 0.f;
#pragma unroll
            for (int j = 0; j < 4; ++j) { const f32x4 v = *(const f32x4*)(xr + j * 256 + lane * 4);
                s += (v.x * v.x + v.y * v.y) + (v.z * v.z + v.w * v.w);
                unsigned long long o = (unsigned long long)pk2(v.x, v.y) | ((unsigned long long)pk2(v.z, v.w) << 32);
                *(unsigned long long*)(xb + (size_t)row * DM + j * 256 + lane * 4) = o; }
            s = wave_sum(s);
            if (lane < 16) rss[(size_t)row * 16 + lane] = lane == 0 ? s : 0.f;
        }
        return;
    }
    for (;;) {
        unsigned k = 0u; if (lane == 0) k = __hip_atomic_fetch_add(xc, 2u, __ATOMIC_RELAXED, __HIP_MEMORY_SCOPE_WORKGROUP);
        k = (unsigned)__builtin_amdgcn_readfirstlane((int)k);
        if ((int)k >= RPW) break;
        const int row = F.bid * RPW + (int)k;
        const float* xr = x + (size_t)row * DM;
        f32x4 v[8];
#pragma unroll
        for (int j = 0; j < 8; ++j) v[j] = *(const f32x4*)(xr + (j >> 2) * DM + (j & 3) * 256 + lane * 4);
        float s0 = 0.f, s1 = 0.f;
#pragma unroll
        for (int j = 0; j < 8; ++j) { const f32x4 w = v[j]; const float q = (w.x * w.x + w.y * w.y) + (w.z * w.z + w.w * w.w); if (j < 4) s0 += q; else s1 += q;
            unsigned long long o = (unsigned long long)pk2(w.x, w.y) | ((unsigned long long)pk2(w.z, w.w) << 32);
            *(unsigned long long*)(xb + (size_t)(row + (j >> 2)) * DM + (j & 3) * 256 + lane * 4) = o; }
        s0 = wave_sum(s0); s1 = wave_sum(s1);
        if (lane < 32) rss[(size_t)row * 16 + lane] = (lane & 15) == 0 ? (lane == 0 ? s0 : s1) : 0.f;
    }
}

struct ScanArgs {
    const bf16_t* xb; const float* rss; const bf16_t* wsm; bf16_t* side;
    bf16_t* P;
    const float* w2; const float* bgate; const float* gla_gain; const float* convw; const float* bif; const float* ml_gain;
    bf16_t* ST; float* dec; float* NS;
};
__device__ __forceinline__ size_t st_off(int grp, int bh, int c) { return ((size_t)((grp * 16 + bh) * NCH + c)) * 8192; }
__device__ __forceinline__ int st_frag(int d0, int ks, int lane) { return ((d0 * 4 + ks) * 64 + lane) * 8; }

__device__ __forceinline__ void phase_scan2(Frame& F, const ScanArgs& a, bool dry = false) {
    for (int gid = F.bid * NTHR + opaque_i(F.tid); gid < 131072; gid += F.G * NTHR) {
        const int grp = gid >> 16, rem = gid & 65535, bh = rem >> 12, r2 = rem & 4095, eo = r2 * 2, k = 16 * ((eo >> 9) & 3) + 8 * ((eo >> 8) & 1) + (eo & 7);
        float s0 = 0.f, s1 = 0.f;
        unsigned* p0 = (unsigned*)(a.ST + st_off(grp, bh, 0) + eo);
        const float* d0 = a.dec + ((size_t)(grp * 16 + bh) * NCH) * 64 + k;
        for (int cb = 0; cb < NCH; cb += 16) {
            unsigned w[16]; float da[16], db[16];
#pragma unroll
            for (int i = 0; i < 16; ++i) { w[i] = p0[(size_t)(cb + i) * 4096]; da[i] = d0[(cb + i) * 64]; db[i] = d0[(cb + i) * 64 + 1]; }
#pragma unroll
            for (int i = 0; i < 16; ++i) {
                const float l0 = __uint_as_float(w[i] << 16), l1 = __uint_as_float(w[i] & 0xffff0000u);
                if (!dry) p0[(size_t)(cb + i) * 4096] = pk2(s0, s1);
                s0 = da[i] * (s0 + l0); s1 = db[i] * (s1 + l1);
            }
        }
        if (gid < 1024) {
            const int bh2 = gid >> 6, k2 = gid & 63; float ns = 0.f;
            float* p = a.NS + ((size_t)bh2 * NCH) * 64 + k2; const float* dd = a.dec + ((size_t)(16 + bh2) * NCH) * 64 + k2;
            for (int cb = 0; cb < NCH; cb += 16) {
                float lv[16], dv[16];
#pragma unroll
                for (int i = 0; i < 16; ++i) { lv[i] = p[(cb + i) * 64]; dv[i] = dd[(cb + i) * 64]; }
#pragma unroll
                for (int i = 0; i < 16; ++i) { if (!dry) p[(cb + i) * 64] = ns; ns = dv[i] * (ns + lv[i]); }
            }
        }
    }
}
__device__ __forceinline__ void phase_kmean(Frame& F, const bf16_t* P, float* kmean) {
    const int lane = opaque_i(F.lane), sub = lane >> 4, cl = lane & 15, tid = F.wave * 64 + lane;
    LAS float* part = (LAS float*)F.lds;
    for (int u = F.bid; u < BATCH * 8 * 16; u += F.G) {
        const int blk = u & 15, h = (u >> 4) & 7, b = u >> 7;
        const bf16_t* base = P + (size_t)(b * SEQ + blk * 256 + F.wave * 32 + sub) * PP + 1024 + h * 128 + cl * 8;
        float m[8];
#pragma unroll
        for (int e = 0; e < 8; ++e) m[e] = 0.f;
        u32x4 w[8];
#pragma unroll
        for (int it = 0; it < 8; ++it) w[it] = *(const u32x4*)(base + (size_t)it * 4 * PP);
#pragma unroll
        for (int it = 0; it < 8; ++it)
#pragma unroll
            for (int e = 0; e < 4; ++e) { m[2 * e] += __uint_as_float(w[it][e] << 16); m[2 * e + 1] += __uint_as_float(w[it][e] & 0xffff0000u); }
#pragma unroll
        for (int e = 0; e < 8; ++e) { m[e] += __shfl_xor(m[e], 16); m[e] += __shfl_xor(m[e], 32); }
        if (sub == 0) { *(LAS f32x4*)(part + F.wave * 128 + cl * 8) = (f32x4){m[0], m[1], m[2], m[3]}; *(LAS f32x4*)(part + F.wave * 128 + cl * 8 + 4) = (f32x4){m[4], m[5], m[6], m[7]}; }
        __syncthreads();
        if (tid < 128) { float sacc = 0.f;
#pragma unroll
            for (int wv = 0; wv < 8; ++wv) sacc += part[wv * 128 + tid];
            float* km = kmean + (size_t)u * 256; km[tid] = sacc * (1.f / 256.f); km[128 + tid] = 0.f; }
        __syncthreads();
    }
}

namespace att {
typedef short bf16x8 __attribute__((ext_vector_type(8)));
typedef short s16x4 __attribute__((ext_vector_type(4)));
typedef float f32x16 __attribute__((ext_vector_type(16)));
constexpr int SHM_V = 16384, SHM_K = 16384, OFF_V = 0, OFF_K = 3 * SHM_V, OFF_WS = 3 * SHM_V + 3 * SHM_K;
constexpr float THR = 8.f;
#define KSWZ(row, colB) ((row) * 256 + ((colB) ^ (((row) & 7) << 4)))
#define SBAR() __builtin_amdgcn_sched_barrier(0)
typedef LAS char* lptr;
__device__ __forceinline__ int crow(int r, int hi) { return (r & 3) + 8 * (r >> 2) + 4 * hi; }
__device__ __forceinline__ unsigned cvtpk(float lo, float hi) { unsigned r; asm volatile("v_cvt_pk_bf16_f32 %0, %1, %2" : "=v"(r) : "v"(lo), "v"(hi)); return r; }
__device__ __forceinline__ void partialSM(f32x16& p0, f32x16& p1, float& m_reg, float& mn, float& alpha, float slope, float base, bool ok, bool diag, int dq) {
    constexpr float C = 1.4426950408889634f;
#pragma unroll
    for (int r = 0; r < 16; ++r) { const int c = (r & 3) + 8 * (r >> 2); if (c) p0[r] = fmaf(slope, (float)c, p0[r]); p1[r] = fmaf(slope, (float)(c + 32), p1[r]); }
    if (diag) {
#pragma unroll
        for (int r = 0; r < 16; ++r) { const int c = (r & 3) + 8 * (r >> 2); if (c > dq) p0[r] = -INFINITY; if (c + 32 > dq) p1[r] = -INFINITY; }
    }
    const float bm = ok ? base : -INFINITY;
    mn = m_reg; alpha = 1.f;
    const float add = (bm - mn) * C;
#pragma unroll
    for (int r = 0; r < 16; ++r) p0[r] = fmaf(p0[r], C, add);
#pragma unroll
    for (int r = 0; r < 16; ++r) p1[r] = fmaf(p1[r], C, add);
#pragma unroll
    for (int r = 0; r < 16; ++r) p0[r] = __builtin_amdgcn_exp2f(p0[r]);
}
__device__ __forceinline__ void finishSM(f32x16& p0, f32x16& p1, float alpha, float& l_reg, bf16x8& pa0, bf16x8& pa1, bf16x8& pa2, bf16x8& pa3) {
#pragma unroll
    for (int r = 0; r < 16; ++r) p1[r] = __builtin_amdgcn_exp2f(p1[r]);
    float ps = 0;
#pragma unroll
    for (int r = 0; r < 16; ++r) ps += p0[r];
#pragma unroll
    for (int r = 0; r < 16; ++r) ps += p1[r];
    { auto rr = __builtin_amdgcn_permlane32_swap(__float_as_uint(ps), __float_as_uint(ps), false, false);
      ps = __uint_as_float(rr[0]) + __uint_as_float(rr[1]); }
    l_reg = l_reg * alpha + ps;
#define PK4(P, BASE, OUT) do { unsigned a0 = cvtpk(P[BASE + 0], P[BASE + 1]), a1 = cvtpk(P[BASE + 2], P[BASE + 3]);   \
    unsigned b0 = cvtpk(P[BASE + 4], P[BASE + 5]), b1 = cvtpk(P[BASE + 6], P[BASE + 7]);                              \
    auto r0 = __builtin_amdgcn_permlane32_swap(a0, b0, false, false); auto r1 = __builtin_amdgcn_permlane32_swap(a1, b1, false, false); \
    u32x4 w = {r0[0], r1[0], r0[1], r1[1]}; OUT = *reinterpret_cast<bf16x8*>(&w); } while (0)
    PK4(p0, 0, pa0); PK4(p0, 8, pa1); PK4(p1, 0, pa2); PK4(p1, 8, pa3);
#undef PK4
}
__device__ __forceinline__ void qkt(f32x16& p0, f32x16& p1, lptr Ks, const bf16x8* qr, int r32, int hi) {
    p0 = f32x16{}; p1 = f32x16{};
#pragma unroll
    for (int d0 = 0; d0 < 8; ++d0) { const int cb = (d0 * 16 + hi * 8) * 2;
        const bf16x8 b0 = *(const LAS bf16x8*)(Ks + KSWZ(r32, cb));
        const bf16x8 b1 = *(const LAS bf16x8*)(Ks + KSWZ(32 + r32, cb));
        p0 = __builtin_amdgcn_mfma_f32_32x32x16_bf16(b0, qr[d0], p0, 0, 0, 0);
        p1 = __builtin_amdgcn_mfma_f32_32x32x16_bf16(b1, qr[d0], p1, 0, 0, 0); }
}
__device__ __forceinline__ int v_st(int k, int c) { const int kk = (k & ~0xC) | ((k & 4) << 1) | ((k & 8) >> 1); return ((kk >> 3) * 4 + (c >> 5)) * 512 + ((kk & 7) * 32 + (c & 31)) * 2; }
__device__ __forceinline__ int v_rd_base(int lane) { return ((lane & 3) << 3) | (((lane >> 2) & 3) << 6) | (((lane >> 4) & 1) << 5) | (((lane >> 5) & 1) << 8); }
constexpr int v_rd_off(int d0, int ks, int half) { return d0 * 512 + ks * 4096 + half * 2048; }
template <int OFF> __device__ __forceinline__ s16x4 tr_read(int vb) {
    s16x4 r; asm volatile("ds_read_b64_tr_b16 %0, %1 offset:%2" : "=&v"(r) : "v"(vb), "i"(OFF) : "memory"); return r;
}
template <int D0> __device__ __forceinline__ void pv_one(f32x16& od, int vb, bf16x8 pa0, bf16x8 pa1, bf16x8 pa2, bf16x8 pa3) {
    const s16x4 l0 = tr_read<v_rd_off(D0, 0, 0)>(vb), h0 = tr_read<v_rd_off(D0, 0, 1)>(vb), l1 = tr_read<v_rd_off(D0, 1, 0)>(vb), h1 = tr_read<v_rd_off(D0, 1, 1)>(vb);
    const s16x4 l2 = tr_read<v_rd_off(D0, 2, 0)>(vb), h2 = tr_read<v_rd_off(D0, 2, 1)>(vb), l3 = tr_read<v_rd_off(D0, 3, 0)>(vb), h3 = tr_read<v_rd_off(D0, 3, 1)>(vb);
    asm volatile("s_waitcnt lgkmcnt(0)" ::: "memory"); SBAR();
#define PK(L, H) (bf16x8){L[0], L[1], L[2], L[3], H[0], H[1], H[2], H[3]}
    od = __builtin_amdgcn_mfma_f32_32x32x16_bf16(pa0, PK(l0, h0), od, 0, 0, 0);
    od = __builtin_amdgcn_mfma_f32_32x32x16_bf16(pa1, PK(l1, h1), od, 0, 0, 0);
    od = __builtin_amdgcn_mfma_f32_32x32x16_bf16(pa2, PK(l2, h2), od, 0, 0, 0);
    od = __builtin_amdgcn_mfma_f32_32x32x16_bf16(pa3, PK(l3, h3), od, 0, 0, 0);
#undef PK
}
__device__ __forceinline__ void pv_d0(f32x16* o, int vb, bf16x8 pa0, bf16x8 pa1, bf16x8 pa2, bf16x8 pa3) {
    pv_one<0>(o[0], vb, pa0, pa1, pa2, pa3); pv_one<1>(o[1], vb, pa0, pa1, pa2, pa3); pv_one<2>(o[2], vb, pa0, pa1, pa2, pa3); pv_one<3>(o[3], vb, pa0, pa1, pa2, pa3);
}

__device__ __forceinline__ void unit(bf16_t* P, const float* kmean, int b, int h, int qb, lptr lds, unsigned ldsaddr, float mref, bool dry) {
    int tid_ = threadIdx.x; asm volatile("" : "+v"(tid_));
    const int tid = tid_, wid = __builtin_amdgcn_readfirstlane(tid >> 6), lane = tid & 63, r32 = lane & 31, hi = lane >> 5;
    lptr V_lds = lds + OFF_V; lptr K_lds = lds + OFF_K;
    LAS float* wsl = (LAS float*)(lds + OFF_WS) + wid * 64; LAS float* li_l = wsl; LAS float* al_l = wsl + 32;
    const int q0 = qb * 256, tpos = q0 + wid * 32 + r32;
    const bf16_t* Qw = P + (size_t)(b * SEQ + tpos) * PP + h * 128 + hi * 8;
    const bf16_t* Kh = P + (size_t)(b * SEQ) * PP + 1024 + h * 128;
    const bf16_t* Vh = P + (size_t)(b * SEQ) * PP + 2048 + h * 128;
    float m_reg = mref, l_reg = 0; f32x16 o[4] = {}; bf16x8 qr[8];
#pragma unroll
    for (int d0 = 0; d0 < 8; ++d0) qr[d0] = *(const bf16x8*)(Qw + d0 * 16);
    const float slope = exp2f(-(float)(h + 1));
    const int sr = tid >> 4, sc = (tid & 15) * 8, vst0 = v_st(sr, sc), vst1 = v_st(32 + sr, sc);
    const int vb0 = (int)ldsaddr + OFF_V + v_rd_base(lane);
    struct { bf16x8 vs0, vs1, ks0, ks1; } sr_[2];
#define SLOAD(i, k0) do { sr_[i].vs0 = *(const bf16x8*)(&Vh[(size_t)((k0) + sr) * PP + sc]); sr_[i].vs1 = *(const bf16x8*)(&Vh[(size_t)((k0) + 32 + sr) * PP + sc]); \
    sr_[i].ks0 = *(const bf16x8*)(&Kh[(size_t)((k0) + sr) * PP + sc]); sr_[i].ks1 = *(const bf16x8*)(&Kh[(size_t)((k0) + 32 + sr) * PP + sc]); } while (0)
#define SWRITE(bb, i) do { *(LAS bf16x8*)(V_lds + (bb) * SHM_V + vst0) = sr_[i].vs0;          \
    *(LAS bf16x8*)(V_lds + (bb) * SHM_V + vst1) = sr_[i].vs1; const int kc = sc * 2;               \
    *(LAS bf16x8*)(K_lds + (bb) * SHM_K + KSWZ(sr, kc)) = sr_[i].ks0;                       \
    *(LAS bf16x8*)(K_lds + (bb) * SHM_K + KSWZ(32 + sr, kc)) = sr_[i].ks1; } while (0)
    SLOAD(0, 0); SLOAD(1, 64);
    unsigned selmask = 0u;
    {
        float v0 = -INFINITY, v1 = -INFINITY, v2 = -INFINITY; int i0 = -1, i1 = -1, i2 = -1;
        { const int n_ = tid >> 5, d_ = (tid & 31) * 4; const float* km = kmean + ((size_t)((b * 8 + h) * 16 + n_)) * 256 + d_;
          *(LAS f32x4*)(lds + tid * 16) = *(const f32x4*)km + *(const f32x4*)(km + 128); }
        float qf[64];
#pragma unroll
        for (int d0 = 0; d0 < 8; ++d0)
#pragma unroll
            for (int e = 0; e < 8; ++e) qf[d0 * 8 + e] = bf2f((bf16_t)qr[d0][e]);
        __syncthreads();
        for (int n = 0; n < qb; ++n) {
            LAS const float* km = (LAS const float*)(lds + n * 512) + hi * 8;
            float s = 0.f;
#pragma unroll
            for (int d0 = 0; d0 < 8; ++d0) { const f32x4 ka = *(LAS const f32x4*)(km + d0 * 16), kb = *(LAS const f32x4*)(km + d0 * 16 + 4);
                s += qf[d0 * 8 + 0] * ka[0] + qf[d0 * 8 + 1] * ka[1] + qf[d0 * 8 + 2] * ka[2] + qf[d0 * 8 + 3] * ka[3]
                   + qf[d0 * 8 + 4] * kb[0] + qf[d0 * 8 + 5] * kb[1] + qf[d0 * 8 + 6] * kb[2] + qf[d0 * 8 + 7] * kb[3]; }
            s += __shfl_xor(s, 32);
            if (s > v0) { v2 = v1; i2 = i1; v1 = v0; i1 = i0; v0 = s; i0 = n; }
            else if (s > v1) { v2 = v1; i2 = i1; v1 = s; i1 = n; }
            else if (s > v2) { v2 = s; i2 = n; }
        }
        __syncthreads();
        if (i0 >= 0) selmask |= 1u << i0; if (i1 >= 0) selmask |= 1u << i1; if (i2 >= 0) selmask |= 1u << i2;
    }
#define SWAIT() asm volatile("s_waitcnt vmcnt(4)" ::: "memory")
#define RESC(a) do { if (__any((a) < 1.f)) { if (hi == 0) al_l[r32] = (a); asm volatile("s_waitcnt lgkmcnt(0)" ::: "memory"); \
    _Pragma("unroll") for (int d = 0; d < 4; ++d) _Pragma("unroll") for (int r = 0; r < 16; ++r) o[d][r] *= al_l[crow(r, hi)]; } } while (0)
#define PSM(P0, P1, MN, AL, jj) do { const int j_ = (jj), n_ = j_ >> 2, k0_ = j_ * 64; const bool isd_ = n_ == qb; \
    const bool ok_ = isd_ || ((selmask >> n_) & 1u); const float base_ = slope * (float)(k0_ + 4 * hi - tpos); \
    const bool nm_ = isd_ && (k0_ + 63 > q0 + wid * 32); \
    partialSM(P0, P1, m_reg, MN, AL, slope, base_, ok_, nm_, tpos - k0_ - 4 * hi); } while (0)
    f32x16 pA0, pA1, pB0, pB1; float mnA, mnB, alA, alB; bf16x8 pa0, pa1, pa2, pa3; const int NT = 4 * (qb + 1);
    SWAIT(); SWRITE(0, 0); SLOAD(0, 128);
    SWAIT(); SWRITE(1, 1); SLOAD(1, 192);
    __syncthreads();
    qkt(pA0, pA1, K_lds, qr, r32, hi); PSM(pA0, pA1, mnA, alA, 0);
    int bprev = 0, bcur = 1, bnext = 2;
#define STEP(X0, X1, MNX, ALX, Y0, Y1, ALY, SETN, tt) do { const int t_ = (tt); \
        SBAR(); qkt(X0, X1, K_lds + bcur * SHM_K, qr, r32, hi); \
        finishSM(Y0, Y1, ALY, l_reg, pa0, pa1, pa2, pa3); SBAR(); \
        pv_d0(o, vb0 + bprev * SHM_V, pa0, pa1, pa2, pa3); PSM(X0, X1, MNX, ALX, t_); \
        if (t_ + 1 < NT) { if (t_ + 2 < NT) SWAIT(); else asm volatile("s_waitcnt vmcnt(0)" ::: "memory"); SWRITE(bnext, SETN); if (t_ + 3 < NT) SLOAD(SETN, (t_ + 3) * 64); } \
        __syncthreads(); \
        bprev = bcur; bcur = bnext; bnext = (bnext == 2) ? 0 : bnext + 1; } while (0)
    for (int t = 1; t + 1 < NT; t += 2) {
        STEP(pB0, pB1, mnB, alB, pA0, pA1, alA, 0, t);
        STEP(pA0, pA1, mnA, alA, pB0, pB1, alB, 1, t + 1);
    }
    STEP(pB0, pB1, mnB, alB, pA0, pA1, alA, 0, NT - 1);
#undef STEP
    finishSM(pB0, pB1, alB, l_reg, pa0, pa1, pa2, pa3); SBAR();
    pv_d0(o, vb0 + bprev * SHM_V, pa0, pa1, pa2, pa3);
    if (hi == 0) li_l[r32] = l_reg; asm volatile("s_waitcnt lgkmcnt(0)" ::: "memory");
    float rli[16];
#pragma unroll
    for (int r = 0; r < 16; ++r) rli[r] = __builtin_amdgcn_rcpf(li_l[crow(r, hi)]);
    bf16_t* Ow = P + (size_t)(b * SEQ + q0 + wid * 32) * PP + h * 128;
#pragma unroll
    for (int r = 0; r < 16; ++r) { const int orow = crow(r, hi);
#pragma unroll
        for (int d0 = 0; d0 < 4; ++d0) if (!dry) Ow[(size_t)orow * PP + d0 * 32 + r32] = (bf16_t)f2bf(o[d0][r] * rli[r]); }
    __syncthreads();
#undef SLOAD
#undef SWRITE
#undef SWAIT
#undef RESC
#undef PSM
}
}
__device__ __forceinline__ void phase_attn(Frame& F, bf16_t* P, const float* kmean, const float* qg, const float* kg, unsigned* qctr, bool dry = false) {
    const int ln_ = opaque_i(F.lane);
    float gq = fmaxf(fabsf(qg[ln_]), fabsf(qg[64 + ln_])), gk = fmaxf(fabsf(kg[ln_]), fabsf(kg[64 + ln_]));
    gq = wave_max(gq); gk = wave_max(gk);
    const float mref = __uint_as_float((unsigned)__builtin_amdgcn_readfirstlane((int)__float_as_uint(1.02f * 11.313708498984761f * gq * gk)));
    if ((F.G & 7) == 0) {
        LAS unsigned* qw = (LAS unsigned*)(F.lds + att::OFF_WS + 4096);
        const int q = F.bid & 7;
        for (;;) {
            if (F.tid == 0) *qw = __hip_atomic_fetch_add(qctr + 64 * q, 1u, __ATOMIC_RELAXED, __HIP_MEMORY_SCOPE_AGENT);
            __syncthreads();
            const unsigned r = *qw;
            __syncthreads();
            if (r >= 64u) break;
            const int qb = 15 - (int)(r >> 2), bh = q * 4 + (int)(r & 3u);
            att::unit(P, kmean, bh >> 3, bh & 7, qb, (att::lptr)F.lds, (unsigned)(uintptr_t)F.ldsg, mref, dry);
        }
    } else {
        for (int pi = F.bid; pi < 256; pi += F.G) {
            const int bh = pi >> 3, p = pi & 7;
            att::unit(P, kmean, bh >> 3, bh & 7, 15 - p, (att::lptr)F.lds, (unsigned)(uintptr_t)F.ldsg, mref, dry);
            att::unit(P, kmean, bh >> 3, bh & 7, p, (att::lptr)F.lds, (unsigned)(uintptr_t)F.ldsg, mref, dry);
        }
    }
}

namespace scn {
using att::bf16x8; using att::f32x16; using att::lptr; using att::s16x4;
constexpr int HSLOT = 32768, O_VI = 0, O_BK = 16384, O_AQ = 24576;
constexpr int X_WS = RING_BYTES + 1024, X_SMALL = RING_BYTES + 6144;
__device__ __forceinline__ int swz(int row, int chunk) { return row * 128 + ((chunk ^ ((row >> 1) & 7)) << 4); }

__device__ __forceinline__ float small_proj(const ScanArgs& a, int row0, lptr lds, int wid, int lane) {
    const int fr = lane & 15, fq = lane >> 4;
    const bf16_t* xa = a.xb + (size_t)(row0 + fr) * DM + 128 * wid + 8 * fq;
    const bf16_t* wb = a.wsm + (size_t)fr * DM + 128 * wid + 8 * fq;
    bf16x8 X[4][4], W[2][4];
#pragma unroll
    for (int rb = 0; rb < 4; ++rb)
#pragma unroll
        for (int s = 0; s < 4; ++s) X[rb][s] = *(const bf16x8*)(xa + (size_t)(16 * rb) * DM + 32 * s);
#pragma unroll
    for (int cb = 0; cb < 2; ++cb)
#pragma unroll
        for (int s = 0; s < 4; ++s) W[cb][s] = *(const bf16x8*)(wb + (size_t)(16 * cb) * DM + 32 * s);
    const float rs = row_rstd(a.rss, row0 + ((wid * 64 + lane) >> 3));
    f32x4 c[4][2];
#pragma unroll
    for (int rb = 0; rb < 4; ++rb)
#pragma unroll
        for (int cb = 0; cb < 2; ++cb) { c[rb][cb] = (f32x4){0.f, 0.f, 0.f, 0.f};
#pragma unroll
            for (int s = 0; s < 4; ++s) c[rb][cb] = __builtin_amdgcn_mfma_f32_16x16x32_bf16(W[cb][s], X[rb][s], c[rb][cb], 0, 0, 0); }
    LAS float* part = (LAS float*)(lds + (wid >> 1) * HSLOT + O_BK + (wid & 1) * 8192);
#pragma unroll
    for (int rb = 0; rb < 4; ++rb)
#pragma unroll
        for (int cb = 0; cb < 2; ++cb) *(LAS f32x4*)(part + (16 * rb + fr) * 32 + 16 * cb + 4 * fq) = c[rb][cb];
    return rs;
}
__device__ __forceinline__ void small_reduce(float rs, lptr lds, int tid) {
    f32x4 s = {0.f, 0.f, 0.f, 0.f};
#pragma unroll
    for (int w = 0; w < 8; ++w) s += *(const LAS f32x4*)(lds + (w >> 1) * HSLOT + O_BK + (w & 1) * 8192 + tid * 16);
    *(LAS f32x4*)(lds + X_SMALL + tid * 16) = s * rs;
}
__device__ __forceinline__ size_t side_off(int b, int c, int t, int mat, int h) { return ((size_t)((b * NCH + c) * 3 + (t - 61))) * 512 + mat * 256 + h * 64; }

__device__ __forceinline__ void gate_full(const ScanArgs& a, int b, int c, int grp, int h, int half, lptr lds, lptr slot, int lane, LAS float* wsl, float& bc_end, float& nsum, bool dry) {
    const int k = lane, row0 = b * SEQ + c * CH, t0 = 32 * half;
    LAS const float* sml = (LAS const float*)(lds + X_SMALL);
    nsum = 0.f;
    unsigned rq[32], rk[32]; float cs[32];
    float wk0 = 0.f, wk1 = 0.f, wk2 = 0.f, wk3 = 0.f, wq0 = 0.f, wq1 = 0.f, wq2 = 0.f, wq3 = 0.f, bi = 0.f;
    float k1 = 0.f, k2 = 0.f, k3 = 0.f, q1 = 0.f, q2 = 0.f, q3 = 0.f;
    const int cq_ = (grp == 0 ? C_GQ : C_MQ) + h * 64 + k, ck_ = (grp == 0 ? C_GK : C_MK) + h * 64 + k;
    bf16_t* prow = a.P + (size_t)(row0 + t0) * PP;
#pragma unroll
    for (int i = 0; i < 32; ++i) { rk[i] = prow[(size_t)i * PP + ck_]; rq[i] = prow[(size_t)i * PP + cq_]; }
    if (grp == 0) {
        const float bg = a.bgate[h * 64 + k];
        const int r32 = lane & 31, hi8 = (lane >> 5) * 8;
        const LAS f32x4* g4 = (const LAS f32x4*)(sml + (t0 + r32) * 32 + hi8);
        const f32x4 ga = g4[0], gb = g4[1];
        float wv0[8], wv1[8];
#pragma unroll
        for (int e = 0; e < 8; ++e) { wv0[e] = a.w2[(hi8 + e) * 256 + h * 64 + r32]; wv1[e] = a.w2[(hi8 + e) * 256 + h * 64 + 32 + r32]; }
        u32x4 aw; aw.x = pk2(ga.x, ga.y); aw.y = pk2(ga.z, ga.w); aw.z = pk2(gb.x, gb.y); aw.w = pk2(gb.z, gb.w);
        u32x4 bw0; bw0.x = pk2(wv0[0], wv0[1]); bw0.y = pk2(wv0[2], wv0[3]); bw0.z = pk2(wv0[4], wv0[5]); bw0.w = pk2(wv0[6], wv0[7]);
        u32x4 bw1; bw1.x = pk2(wv1[0], wv1[1]); bw1.y = pk2(wv1[2], wv1[3]); bw1.z = pk2(wv1[4], wv1[5]); bw1.w = pk2(wv1[6], wv1[7]);
        f32x16 d0 = {}, d1 = {};
        d0 = __builtin_amdgcn_mfma_f32_32x32x16_bf16(*reinterpret_cast<bf16x8*>(&aw), *reinterpret_cast<bf16x8*>(&bw0), d0, 0, 0, 0);
        d1 = __builtin_amdgcn_mfma_f32_32x32x16_bf16(*reinterpret_cast<bf16x8*>(&aw), *reinterpret_cast<bf16x8*>(&bw1), d1, 0, 0, 0);
#pragma unroll
        for (int r = 0; r < 16; ++r) { const int tk = (r & 3) + 8 * (r >> 2);
            auto sw = __builtin_amdgcn_permlane32_swap(__float_as_uint(d0[r]), __float_as_uint(d1[r]), false, false);
            cs[tk] = __uint_as_float(sw[0]); cs[tk + 4] = __uint_as_float(sw[1]); }
        float run = 0.f;
#pragma unroll
        for (int i = 0; i < 32; ++i) { run += logsigmoidf_(cs[i] + bg) * (1.f / 16.f); cs[i] = run; }
    } else {
        bi = a.bif[h]; const float bf = a.bif[4 + h];
        wk0 = a.convw[0 * 512 + 256 + h * 64 + k]; wk1 = a.convw[1 * 512 + 256 + h * 64 + k]; wk2 = a.convw[2 * 512 + 256 + h * 64 + k]; wk3 = a.convw[3 * 512 + 256 + h * 64 + k];
        wq0 = a.convw[0 * 512 + h * 64 + k]; wq1 = a.convw[1 * 512 + h * 64 + k]; wq2 = a.convw[2 * 512 + h * 64 + k]; wq3 = a.convw[3 * 512 + h * 64 + k];
        if (c * CH + t0 > 0) {
            const bf16_t* p1 = prow - PP; const bf16_t* p2 = p1 - PP; const bf16_t* p3 = p2 - PP;
            k1 = bf2f(p1[ck_]); k2 = bf2f(p2[ck_]); k3 = bf2f(p3[ck_]); q1 = bf2f(p1[cq_]); q2 = bf2f(p2[cq_]); q3 = bf2f(p3[cq_]);
        }
        float run = 0.f;
#pragma unroll
        for (int i = 0; i < 32; ++i) { run += logsigmoidf_(sml[(t0 + i) * 32 + 20 + h] + bf); cs[i] = run; }
    }
    wsl[lane] = cs[31];
    asm volatile("s_waitcnt vmcnt(0)" ::: "memory");
    __syncthreads();
    const float off = half ? (wsl - 128)[lane] : 0.f;
    bc_end = off + cs[31];
#pragma unroll
    for (int i8 = 0; i8 < 4; ++i8) {
        unsigned pk[8];
#pragma unroll
        for (int e = 0; e < 8; ++e) { const int i = i8 * 8 + e, t = t0 + i; const float bc = off + cs[i];
            float bv, av;
            if (grp == 0) {
                const float ex = __expf(bc);
                bv = __uint_as_float(rk[i] << 16) * __builtin_amdgcn_rcpf(ex);
                av = __uint_as_float(rq[i] << 16) * 0.125f * ex;
            } else {
                const float ip = sml[t * 32 + 16 + h] + bi;
                const float kc = __uint_as_float(rk[i] << 16);
                const float ck = wk0 * k3 + wk1 * k2 + wk2 * k1 + wk3 * kc; k3 = k2; k2 = k1; k1 = kc;
                bv = siluf_(ck) * 0.125f * __expf(ip - bc);
                const float qc = __uint_as_float(rq[i] << 16);
                const float cq = wq0 * q3 + wq1 * q2 + wq2 * q1 + wq3 * qc; q3 = q2; q2 = q1; q1 = qc;
                av = siluf_(cq) * __expf(bc);
            }
            const unsigned pkab = pk2(bv, av); nsum += bv; pk[e] = pkab & 0xffffu;
            const bf16_t ab = (bf16_t)(pkab >> 16), bb = (bf16_t)pk[e];
            if (RPT && dry) { asm volatile("" :: "v"((unsigned)ab), "v"((unsigned)bb)); }
            if (!dry) { if (grp == 1 && t >= 61) { bf16_t* sd = a.side + side_off(b, c, t, 0, h) + k; sd[0] = ab; sd[256] = bb; }
            else if (NT_ST & 32) { __builtin_nontemporal_store(ab, prow + (size_t)i * PP + cq_); __builtin_nontemporal_store(bb, prow + (size_t)i * PP + ck_); }
            else { prow[(size_t)i * PP + cq_] = ab; prow[(size_t)i * PP + ck_] = bb; if (VARX & 4) { asm volatile("" ::: "memory"); prow[(size_t)i * PP + cq_] = ab; prow[(size_t)i * PP + ck_] = bb; } } } }
        { u32x4 w; w.x = pk[0] | (pk[1] << 16); w.y = pk[2] | (pk[3] << 16); w.z = pk[4] | (pk[5] << 16); w.w = pk[6] | (pk[7] << 16);
          *(LAS u32x4*)(slot + O_BK + swz(k, (t0 >> 3) + i8)) = w; }
    }
}

struct StageRegs { bf16x8 v[8]; bf16x8 ab[8]; };
__device__ __forceinline__ void stage_v_load(StageRegs& R, const ScanArgs& a, int row0, int grp, int h, int ht) {
    const bf16_t* Vg = a.P + (size_t)row0 * PP + (grp == 0 ? C_GV : C_MV) + h * 128;
#pragma unroll
    for (int i = 0; i < 8; ++i) { const int idx = ht + 128 * i, srow = idx >> 4, sc = (idx & 15) * 8; R.v[i] = *(const bf16x8*)(Vg + (size_t)srow * PP + sc); }
}
__device__ __forceinline__ void stage_v_write(const StageRegs& R, lptr slot, int ht) {
#pragma unroll
    for (int i = 0; i < 8; ++i) { const int idx = ht + 128 * i, srow = idx >> 4, sc = (idx & 15) * 8; *(LAS bf16x8*)(slot + O_VI + att::v_st(srow, sc)) = R.v[i]; }
}
__device__ __forceinline__ void stage_ab_load(StageRegs& R, const ScanArgs& a, int b, int c, int grp, int h, int ht) {
    const int row0 = b * SEQ + c * CH;
#pragma unroll
    for (int i = 0; i < 8; ++i) { const int idx = ht + 128 * i, mat = idx >> 9, r = (idx >> 3) & 63, ch = idx & 7;
        const bf16_t* src = a.P + (size_t)(row0 + r) * PP + (grp == 0 ? (mat ? C_GK : C_GQ) : (mat ? C_MK : C_MQ)) + h * 64 + ch * 8;
        if (grp == 1 && r >= 61) src = a.side + side_off(b, c, r, mat, h) + ch * 8;
        R.ab[i] = *(const bf16x8*)src; }
}
__device__ __forceinline__ void stage_ab_write(const StageRegs& R, lptr slot, int ht) {
#pragma unroll
    for (int i = 0; i < 8; ++i) { const int idx = ht + 128 * i, mat = idx >> 9, r = (idx >> 3) & 63, ch = idx & 7;
        *(LAS bf16x8*)(slot + (mat ? O_BK : O_AQ) + swz(r, ch)) = R.ab[i]; }
}
}

__device__ __forceinline__ void phase_scan1m(Frame& F, const ScanArgs& a, bool dry = false) {
    using namespace scn;
    const int wid = __builtin_amdgcn_readfirstlane(threadIdx.x >> 6);
    const int hw = wid >> 1, half = wid & 1;
    lptr lds = (lptr)F.lds; lptr slot = lds + hw * HSLOT;
    LAS float* wsl = (LAS float*)(lds + X_WS) + wid * 128;
    const unsigned ldsaddr = (unsigned)(uintptr_t)F.ldsg;
    for (int unit = F.bid; unit < BATCH * NCH; unit += F.G) {
        const int b = unit / NCH, c = unit % NCH, row0 = b * SEQ + c * CH;
        StageRegs SR; float rs_small;
        { const int t0_ = opaque_i(threadIdx.x) & 127; stage_v_load(SR, a, row0, 0, hw, t0_);
          rs_small = small_proj(a, row0, lds, wid, opaque_i(threadIdx.x) & 63);
          stage_v_write(SR, slot, t0_); }
        __syncthreads();
        small_reduce(rs_small, lds, opaque_i(threadIdx.x));
        for (int grp = 0; grp < 2; ++grp) {
            const int tid = opaque_i(threadIdx.x), lane = tid & 63, r32 = lane & 31, hi = lane >> 5;
            const int h = hw, bh = b * 4 + h;
            if (grp == 0) stage_v_load(SR, a, row0, 1, h, tid & 127);
            __syncthreads();
            float bc_end, nsum;
            gate_full(a, b, c, grp, h, half, lds, slot, lane, wsl, bc_end, nsum, dry);
            if (half == 1 && !dry) a.dec[((size_t)(grp * 16 + bh) * NCH + c) * 64 + lane] = __expf(bc_end);
            if (grp == 1) wsl[64 + lane] = nsum;
            __syncthreads();
            if (grp == 1 && half == 0 && !dry) { LAS float* other = wsl + 128; a.NS[((size_t)bh * NCH + c) * 64 + lane] = wsl[64 + lane] + other[64 + lane]; }
            bf16x8 pa[4];
#pragma unroll
            for (int ks = 0; ks < 4; ++ks) pa[ks] = *(LAS bf16x8*)(slot + O_BK + swz(32 * half + r32, 2 * ks + hi));
            f32x16 o[4] = {};
            att::pv_d0(o, (int)ldsaddr + hw * HSLOT + O_VI + att::v_rd_base(lane), pa[0], pa[1], pa[2], pa[3]);
            bf16_t* st = a.ST + st_off(grp, bh, c);
#pragma unroll
            for (int d0 = 0; d0 < 4; ++d0)
#pragma unroll
                for (int g = 0; g < 4; ++g) {
                    const unsigned long long w = (unsigned long long)pk2(o[d0][4 * g], o[d0][4 * g + 1]) | ((unsigned long long)pk2(o[d0][4 * g + 2], o[d0][4 * g + 3]) << 32);
                    if (!dry) *(unsigned long long*)(st + st_frag(d0, 2 * half + (g >> 1), (g & 1) * 32 + r32) + 4 * hi) = w; }
            __syncthreads();
            if (grp == 0) stage_v_write(SR, slot, tid & 127);
        }
    }
}
__device__ __forceinline__ void phase_scan3m(Frame& F, const ScanArgs& a, bool dry = false) {
    using namespace scn;
    const int wid = __builtin_amdgcn_readfirstlane(threadIdx.x >> 6);
    const int hw = wid >> 1, half = wid & 1;
    lptr lds = (lptr)F.lds; lptr slot = lds + hw * HSLOT;
    LAS float* wsl = (LAS float*)(lds + X_WS) + wid * 128;
    const unsigned ldsaddr = (unsigned)(uintptr_t)F.ldsg;
    for (int unit = F.bid; unit < BATCH * NCH; unit += F.G) {
        const int b = unit / NCH, c = unit % NCH, row0 = b * SEQ + c * CH;
        StageRegs SR;
        { const int t0_ = opaque_i(threadIdx.x) & 127; stage_v_load(SR, a, row0, 0, hw, t0_); stage_ab_load(SR, a, b, c, 0, hw, t0_); stage_v_write(SR, slot, t0_); stage_ab_write(SR, slot, t0_); }
        for (int grp = 0; grp < 2; ++grp) {
            const int tid = opaque_i(threadIdx.x), lane = tid & 63, r32 = lane & 31, hi = lane >> 5;
            const int h = hw, bh = b * 4 + h;
            if (grp == 0) { stage_v_load(SR, a, row0, 1, h, tid & 127); stage_ab_load(SR, a, b, c, 1, h, tid & 127); }
            __syncthreads();
            bf16x8 qr[4];
#pragma unroll
            for (int d0 = 0; d0 < 4; ++d0) qr[d0] = *(LAS bf16x8*)(slot + O_AQ + swz(32 * half + r32, 2 * d0 + hi));
            f32x16 p0 = {}, p1 = {};
#pragma unroll
            for (int d0 = 0; d0 < 4; ++d0) {
                const bf16x8 b0 = *(LAS bf16x8*)(slot + O_BK + swz(r32, 2 * d0 + hi));
                const bf16x8 b1 = *(LAS bf16x8*)(slot + O_BK + swz(32 + r32, 2 * d0 + hi));
                p0 = __builtin_amdgcn_mfma_f32_32x32x16_bf16(b0, qr[d0], p0, 0, 0, 0);
                p1 = __builtin_amdgcn_mfma_f32_32x32x16_bf16(b1, qr[d0], p1, 0, 0, 0); }
            const int dq = 32 * half + r32 - 4 * hi;
            float ps = 0.f;
#pragma unroll
            for (int r = 0; r < 16; ++r) { const int cc = (r & 3) + 8 * (r >> 2); if (cc > dq) p0[r] = 0.f; if (cc + 32 > dq) p1[r] = 0.f; ps += p0[r] + p1[r]; }
            bf16x8 pa0, pa1, pa2, pa3;
#define PK4(P, BASE, OUT) do { unsigned a0 = att::cvtpk(P[BASE + 0], P[BASE + 1]), a1 = att::cvtpk(P[BASE + 2], P[BASE + 3]);   \
    unsigned b0_ = att::cvtpk(P[BASE + 4], P[BASE + 5]), b1_ = att::cvtpk(P[BASE + 6], P[BASE + 7]);                              \
    auto r0 = __builtin_amdgcn_permlane32_swap(a0, b0_, false, false); auto r1 = __builtin_amdgcn_permlane32_swap(a1, b1_, false, false); \
    u32x4 w = {r0[0], r1[0], r0[1], r1[1]}; OUT = *reinterpret_cast<bf16x8*>(&w); } while (0)
            PK4(p0, 0, pa0); PK4(p0, 8, pa1); PK4(p1, 0, pa2); PK4(p1, 8, pa3);
#undef PK4
            float den = 0.f;
            if (grp == 1) {
                const float* ns = a.NS + ((size_t)bh * NCH + c) * 64 + hi * 8;
#pragma unroll
                for (int d0 = 0; d0 < 4; ++d0) { const f32x4 na = *(const f32x4*)(ns + d0 * 16), nb = *(const f32x4*)(ns + d0 * 16 + 4); const bf16x8 q = qr[d0];
                    ps += bf2f((bf16_t)q[0]) * na[0] + bf2f((bf16_t)q[1]) * na[1] + bf2f((bf16_t)q[2]) * na[2] + bf2f((bf16_t)q[3]) * na[3]
                        + bf2f((bf16_t)q[4]) * nb[0] + bf2f((bf16_t)q[5]) * nb[1] + bf2f((bf16_t)q[6]) * nb[2] + bf2f((bf16_t)q[7]) * nb[3]; }
                den = ps + __shfl_xor(ps, 32);
            }
            f32x16 o[4] = {};
            att::pv_d0(o, (int)ldsaddr + hw * HSLOT + O_VI + att::v_rd_base(lane), pa0, pa1, pa2, pa3);
            const bf16_t* st = a.ST + st_off(grp, bh, c);
#pragma unroll
            for (int d0 = 0; d0 < 4; ++d0) {
                bf16x8 sv[4];
#pragma unroll
                for (int ks = 0; ks < 4; ++ks) sv[ks] = *(const bf16x8*)(st + st_frag(d0, ks, lane));
#pragma unroll
                for (int ks = 0; ks < 4; ++ks) o[d0] = __builtin_amdgcn_mfma_f32_32x32x16_bf16(qr[ks], sv[ks], o[d0], 0, 0, 0);
            }
            if (grp == 1) { if (hi == 0) wsl[64 + r32] = den; }
            __syncthreads();
            LAS float* ot = (LAS float*)(slot + half * 16384);
#pragma unroll
            for (int d0 = 0; d0 < 4; ++d0)
#pragma unroll
                for (int r = 0; r < 16; ++r) ot[att::crow(r, hi) * 128 + 32 * d0 + r32] = o[d0][r];
            asm volatile("s_waitcnt lgkmcnt(0)" ::: "memory");
            const int gcol = (grp == 0 ? C_GR : C_MO) + h * 128, ch = lane & 15;
            const float* gain = (grp == 0 ? a.gla_gain : a.ml_gain) + h * 128 + ch * 8;
            const f32x4 ga = *(const f32x4*)gain, gb = *(const f32x4*)(gain + 4);
            u32x4 gw[8];
#pragma unroll
            for (int it = 0; it < 8; ++it) gw[it] = *(const u32x4*)(a.P + (size_t)(row0 + 32 * half + it * 4 + (lane >> 4)) * PP + gcol + ch * 8);
#pragma unroll
            for (int it = 0; it < 8; ++it) {
                const int rl = it * 4 + (lane >> 4);
                const f32x4 oa = *(LAS const f32x4*)(ot + rl * 128 + ch * 8), ob = *(LAS const f32x4*)(ot + rl * 128 + ch * 8 + 4);
                float ov[8] = {oa[0], oa[1], oa[2], oa[3], ob[0], ob[1], ob[2], ob[3]}, gv[8];
#pragma unroll
                for (int e = 0; e < 4; ++e) { gv[2 * e] = __uint_as_float(gw[it][e] << 16); gv[2 * e + 1] = __uint_as_float(gw[it][e] & 0xffff0000u); }
                if (grp == 1) { const float dd = __builtin_amdgcn_rcpf(fmaxf(fabsf(wsl[64 + rl]), 1.f));
#pragma unroll
                    for (int e = 0; e < 8; ++e) ov[e] = ov[e] * dd * sigmoidf_(gv[e]); }
                float ss = 0.f;
#pragma unroll
                for (int e = 0; e < 8; ++e) ss += ov[e] * ov[e];
                ss = row16_sum(ss);
                const float rstd = __builtin_amdgcn_rsqf(ss * (1.f / 128.f) + EPS);
                float y[8];
#pragma unroll
                for (int e = 0; e < 8; ++e) { y[e] = ov[e] * rstd * (e < 4 ? ga[e] : gb[e - 4]); if (grp == 0) y[e] *= siluf_(gv[e]); }
                u32x4 w; w.x = pk2(y[0], y[1]); w.y = pk2(y[2], y[3]); w.z = pk2(y[4], y[5]); w.w = pk2(y[6], y[7]);
                if (!dry) *(u32x4*)(a.P + (size_t)(row0 + 32 * half + rl) * PP + gcol + ch * 8) = w;
            }
            __syncthreads();
            if (grp == 0) { stage_v_write(SR, slot, tid & 127); stage_ab_write(SR, slot, tid & 127); }
        }
    }
}

__global__ void __launch_bounds__(NTHR, 2) mk_fwd(Args args) {
    extern __shared__ __attribute__((aligned(16))) unsigned char lds[];
    Frame F;
    F.lds = (LAS unsigned char*)lds; F.ldsg = lds;
    F.tid = threadIdx.x; F.lane = F.tid & 63; F.wave = __builtin_amdgcn_readfirstlane(F.tid >> 6);
    F.G = gridDim.x; F.bid = blockIdx.x;
    volatile LAS unsigned* MISC = (volatile LAS unsigned*)(F.lds + MISC_OFF);
    for (int u = F.tid; u < (LDS_BYTES - RING_BYTES) / 4; u += NTHR) ((LAS unsigned*)(F.lds + RING_BYTES))[u] = 0u;
    __syncthreads();
    XcdBarrier bar; bar.bar = (unsigned*)(karg_ws(karg_base()) + WS_CTL) + 4096; bar.x = 0; bar.st = nullptr;
    if (!MK_MULTI) bar = xcd_barrier_post((unsigned*)(karg_ws(karg_base()) + WS_CTL) + 4096, MISC + 8);
    const int lo = args.ph_lo, hi = args.ph_hi;
#define IN(k) (lo <= (k) && (k) < hi)
#define SEAM(k) do { if (!MK_MULTI && (k) + 1 < hi) { xcd_barrier(bar); if (RPT & 2048) xcd_barrier(bar); } } while (0)
#define KP()     karg_base()
#define WSP()    karg_ws(KP())
#define OUTP()   karg_out(KP())
#define RSSP()   ((float*)(WSP() + WS_RSS))
#define SMALLP_() ((float*)(WSP() + WS_SMALL))
#define KMEANP() ((float*)(WSP() + WS_KMEAN))
#define XBP()    ((bf16_t*)(WSP() + WS_XB))
#define PP_()    ((bf16_t*)(WSP() + WS_P))
#define WJ()     (WSP() + WS_W + (size_t)(l >> 1) * W_MIXSZ)
#define WL()     (WSP() + WS_W + W_FFN0 + (size_t)l * W_FFNSZ)
#define XIN()    (l == 0 ? karg_in(KP(), 0) : (const float*)OUTP())
#define MKSA()   const int j = l >> 1; kargp_t kp = KP(); unsigned char* ws = karg_ws(kp); \
    ScanArgs sa{(const bf16_t*)(ws + WS_XB), (const float*)(ws + WS_RSS), (const bf16_t*)(ws + WS_W + (size_t)j * W_MIXSZ + W_IN + (size_t)HYB_N * DM * 2), (bf16_t*)(ws + WS_SIDE), (bf16_t*)(ws + WS_P), karg_in(kp, 4) + (size_t)j * 16 * 256, karg_in(kp, 5) + j * 256, karg_in(kp, 6) + j * 512, \
                karg_in(kp, 7) + (size_t)j * 4 * 512, karg_in(kp, 8) + j * 8, karg_in(kp, 9) + j * 512, (bf16_t*)karg_out(kp)  , (float*)(ws + WS_DEC), (float*)(ws + WS_NS)}

    unsigned long long tpro_ = 0ull; if (PROBE_S == 7) tpro_ = __builtin_amdgcn_s_memrealtime();
    if (lo == 0) { if (PH_MASK & 1) { phase_prologue(F); if (RPT & 1) phase_prologue(F); } if (!MK_MULTI && 1 < hi) xcd_barrier(bar); }
    if (PROBE_S == 7) tpro_ = __builtin_amdgcn_s_memrealtime() - tpro_;
    unsigned long long tacc_ = (PROBE_S == 7) ? tpro_ : 0ull, t0_ = 0ull;
    for (int ph = lo < 1 ? 1 : lo; ph < hi; ++ph) {
        const bool probe_ = PROBE_S >= 0 && PROBE_S < 7 && ((ph - 1) & 7) == PROBE_S && ((((ph - 1) >> 3) & 1) == PROBE_ODD);
        if (probe_) t0_ = __builtin_amdgcn_s_memrealtime();
        {
            const int l = (ph - 1) >> 3, sidx = (ph - 1) & 7, odd = l & 1;
            const bool isg = sidx == 0 || sidx == 5 || sidx == 6 || sidx == (odd ? 3 : 4);
            if (isg) {
                pg8::Gemm g; EpiAny E; int nrep_ = 1;
                E.kind = 3; E.O = PP_(); E.lrs = nullptr; E.qg = nullptr; E.kg = nullptr; E.xch = nullptr; E.xch2 = nullptr; E.kmean = nullptr; E.ksum = nullptr;
                E.xout = nullptr; E.xb = nullptr; E.rss = nullptr; E.dry = 0;
                if (sidx == 0 && !odd) { g = pg8::Gemm{XBP(), (const bf16_t*)(WJ() + W_IN), M, HYB_N, DM, DM}; E.kind = 0; E.lrs = (LAS float*)(F.lds + scn::X_SMALL); if (RPT & 2) nrep_ = 2; }
                else if (sidx == 0) { g = pg8::Gemm{XBP(), (const bf16_t*)(WJ() + W_QKV), M, 3 * DM, DM, DM}; E.kind = 1; E.qg = karg_in(KP(), 12) + (l >> 1) * 128; E.kg = karg_in(KP(), 13) + (l >> 1) * 128;
                    E.xch = (LAS float*)(F.lds + scn::X_SMALL); E.xch2 = (LAS float*)(F.lds + scn::X_WS); E.kmean = KMEANP(); E.ksum = (LAS float*)(F.lds + RING_BYTES + 14336); E.lrs = (LAS float*)(F.lds + RING_BYTES + 2048); if (RPT & 64) nrep_ = 2; }
                else if (sidx == 5) { g = pg8::Gemm{XBP(), (const bf16_t*)(WL() + W_GU), M, 2 * DFF, DM, DM}; E.kind = 2; E.lrs = (LAS float*)(F.lds + scn::X_SMALL); if (RPT & 512) nrep_ = 2; }
                else if (sidx == 6) { g = pg8::Gemm{PP_(), (const bf16_t*)(WL() + W_D), M, DM, DFF, DFF}; if (RPT & 1024) nrep_ = 2; }
                else if (!odd) { g = pg8::Gemm{PP_() + C_GR, (const bf16_t*)(WJ() + W_OUT), M, DM, DM, PP}; if (RPT & 32) nrep_ = 2; }
                else { g = pg8::Gemm{PP_(), (const bf16_t*)(WJ() + W_O), M, DM, DM, PP}; if (RPT & 32) nrep_ = 2; }
                if (E.kind == 3) { E.xout = (l == DEPTH - 1 && sidx == 6) ? OUTP() : nullptr; E.xb = XBP(); E.rss = RSSP(); }
                pg8::StaticOrder S; S.init(M, g.N, F.G, F.bid);
                if (PH_MASK & 64) {
                    if (E.kind != 3) stage_rstd(S, RSSP(), (LAS float*)E.lrs);
                    for (int rep_ = 0; rep_ < nrep_; ++rep_) { E.dry = RPT ? opaque_i(rep_ + 1 < nrep_ ? 1 : 0) : 0; pg8::gemm_phase<EpiAny, pg8::StaticOrder, true, true>(F.lds, g, S, E); }
                }
            } else if (!odd && sidx == 1) { if (PH_MASK & 2) { MKSA(); if (RPT & 4) phase_scan1m(F, sa, RPT && opaque_i(1) != 0); phase_scan1m(F, sa, RPT && opaque_i(0) != 0); } }
            else if (!odd && sidx == 2) { if (PH_MASK & 4) { MKSA(); if (RPT & 8) phase_scan2(F, sa, RPT && opaque_i(1) != 0); phase_scan2(F, sa, RPT && opaque_i(0) != 0); } }
            else if (!odd && sidx == 3) { if (PH_MASK & 8) { MKSA(); if (RPT & 16) phase_scan3m(F, sa, RPT && opaque_i(1) != 0); phase_scan3m(F, sa, RPT && opaque_i(0) != 0); } }
            else if (odd && sidx == 2) { if (PH_MASK & 32) { const int j = l >> 1;
                if (RPT & 256) phase_attn(F, PP_(), KMEANP(), karg_in(KP(), 12) + j * 128, karg_in(KP(), 13) + j * 128, (unsigned*)(WSP() + WS_CTL) + 12288 + j * 512, RPT && opaque_i(1) != 0);
                phase_attn(F, PP_(), KMEANP(), karg_in(KP(), 12) + j * 128, karg_in(KP(), 13) + j * 128, (unsigned*)(WSP() + WS_CTL) + 8192 + j * 512, RPT && opaque_i(0) != 0); } }
            else continue;
        }
        if (probe_ && !PROBE_BAR) tacc_ += __builtin_amdgcn_s_memrealtime() - t0_;
        if (!MK_MULTI && ph + 1 < hi) { xcd_barrier(bar); if (RPT & 2048) xcd_barrier(bar); }
        if (probe_ && PROBE_BAR) tacc_ += __builtin_amdgcn_s_memrealtime() - t0_;
    }
    if (PROBE_S >= 0 && F.bid == 0) { const unsigned long long ts_ = __builtin_amdgcn_s_memrealtime(); while (__builtin_amdgcn_s_memrealtime() - ts_ < 8ull * tacc_) __builtin_amdgcn_s_sleep(8); }
#undef IN
#undef SEAM
}

extern "C" void kernel_launch(void* const* d_in, const int* in_sizes, int n_in, void* d_out, int out_size, void* d_ws, size_t ws_size, hipStream_t stream) {
    static int grid = 0;
    if (grid == 0) {
        int dev = 0, cus = 0;
        if (n_in != 18 || ws_size < 256 * MiB) { fprintf(stderr, "kernel_launch: unexpected inputs (%d) or workspace (%zu < %zu)\n", n_in, ws_size, (size_t)WS_END); grid = -1; return; }
        if (hipGetDevice(&dev) != hipSuccess || hipDeviceGetAttribute(&cus, hipDeviceAttributeMultiprocessorCount, dev) != hipSuccess) { grid = -1; return; }
        if (hipFuncSetAttribute((const void*)mk_fwd, hipFuncAttributeMaxDynamicSharedMemorySize, LDS_BYTES) != hipSuccess) { grid = -1; return; }
        int per_cu = 0;
        if (hipOccupancyMaxActiveBlocksPerMultiprocessor(&per_cu, (const void*)mk_fwd, NTHR, LDS_BYTES) != hipSuccess || per_cu < 1) { fprintf(stderr, "kernel_launch: occupancy query says %d\n", per_cu); }
        (void)hipGetLastError();
        grid = cus;
    }
    if (grid < 0) return;
    (void)hipMemsetAsync((char*)d_ws + WS_CTL, 0, CTL_ZERO_BYTES, stream);
    Args a{};
    for (int i = 0; i < 18; ++i) a.in[i] = (const float*)d_in[i];
    a.out = (float*)d_out; a.ws = (unsigned char*)d_ws;
#if MK_MULTI
    for (int ph = 0; ph < 1 + DEPTH * 8; ++ph) {
        if (ph > 0) { const int l = (ph - 1) >> 3, s = (ph - 1) & 7; if (s == 7) continue; if ((l & 1) == 0 && s == 7) continue; if ((l & 1) == 1 && s == 4) continue; }
        a.ph_lo = ph; a.ph_hi = ph + 1;
        hipLaunchKernelGGL(mk_fwd, dim3(grid), dim3(NTHR), LDS_BYTES, stream, a);
    }
#else
    a.ph_lo = 0; a.ph_hi = DEPTH * 8;
    hipLaunchKernelGGL(mk_fwd, dim3(grid), dim3(NTHR), LDS_BYTES, stream, a);
#endif
}
```

```cpp
#include <hip/hip_runtime.h>
#include <cstdio>
#include <cstdint>

namespace pg8 {
#define PG8_LAS __attribute__((address_space(3)))
typedef unsigned short bf16_t;
typedef short bf16x8 __attribute__((ext_vector_type(8)));
typedef float f32x4 __attribute__((ext_vector_type(4)));
typedef unsigned u32x4 __attribute__((ext_vector_type(4)));
constexpr int BM = 256, BK = 64, HALF = 128, HTB = HALF * BK * 2  , STAGE_BYTES = 8 * HTB, NXCD = 8, WGM = 8;

__host__ __device__ __forceinline__ int lds_byte(int r, int c) { const int st = (r >> 4) * 2 + (c >> 5), rr = r & 15, cc = c & 31, ob = rr * 64 + cc * 2; return st * 1024 + (ob ^ (((ob >> 9) & 1) << 5)); }
__host__ __device__ __forceinline__ void stage_rc(int b, int& R, int& C) { const int st = b / 1024, sb = b % 1024, swz = sb ^ (((sb >> 9) & 1) << 5); R = (st >> 1) * 16 + swz / 64; C = (st & 1) * 32 + (swz % 64) / 2; }
__host__ __device__ __forceinline__ int perm32(int rho) { const int n = rho >> 4, i = rho & 15; return 8 * (i >> 2) + 4 * n + (i & 3); }

struct Unit { int pm, pn, idx; };
struct Gemm { const bf16_t* A; const bf16_t* Bt; int M, N, K, lda; };

struct StaticOrder {
    int nM, nN, nwg, G, c;
    __host__ __device__ void init(int M, int N, int G_, int c_) { nM = M / BM; nN = N / BM; nwg = nM * nN; G = G_; c = c_; }
    __host__ __device__ bool next(int i, Unit& u) const {
        const long L = (long)i * G + c; if (L >= nwg) return false;
        int wgid = (int)L; { const int q = nwg / NXCD, r = nwg % NXCD, xcd = wgid % NXCD, off = wgid / NXCD; wgid = (xcd < r ? xcd * (q + 1) : r * (q + 1) + (xcd - r) * q) + off; }
        const int nig = WGM * nN, gid = wgid / nig, fm = gid * WGM, gsz = (nM - fm) < WGM ? (nM - fm) : WGM;
        u.pm = fm + ((wgid % nig) % gsz); u.pn = (wgid % nig) / gsz; u.idx = i; return true;
    }
    __device__ __forceinline__ void a_ready(const Unit&) const {}
    __device__ __forceinline__ void done(const Unit&) const {}
};
__device__ __forceinline__ unsigned cvt_pk_bf16(float lo, float hi) { unsigned r; asm volatile("v_cvt_pk_bf16_f32 %0, %1, %2" : "=v"(r) : "v"(lo), "v"(hi)); return r; }
template <class Epi, class Sched, bool ALIGN_EPI = false, bool SP2 = false>
__device__ __forceinline__ void gemm_phase(PG8_LAS unsigned char* lds, const Gemm g, const Sched& S, const Epi& E) {
    int tid_ = threadIdx.x; asm volatile("" : "+v"(tid_));
    const int tid = tid_, wid = __builtin_amdgcn_readfirstlane(tid >> 6), lane = tid & 63, wr = wid >> 2, wc = wid & 3, fr = lane & 15, fq = lane >> 4;
    const int K = g.K, nt = K / BK;
    unsigned voffA[2], voffB[2];
#pragma unroll
    for (int i = 0; i < 2; ++i) { int R, C; stage_rc(tid * 16 + i * 8192, R, C); const int Rb = Epi::PERM ? ((R & ~31) + perm32(R & 31)) : R;
        voffA[i] = (unsigned)(R * g.lda + C) * 2u; voffB[i] = (unsigned)(Rb * K + C) * 2u; }
    const size_t kstep = (size_t)(BK * 2);
    const size_t hstepB = (size_t)HALF * K * 2, hstepA = (size_t)HALF * g.lda * 2;
    const size_t tstepA = 2 * hstepA, tstepB = 2 * hstepB;
    const unsigned ldsw = (unsigned)wid * 1024u;
    const int aoff = lds_byte(wr * 64 + fr, fq * 8), boff = lds_byte(wc * 32 + fr, fq * 8);
#define PG8_SA(b, h) (((b) * 2 + (h)) * HTB)
#define PG8_SB(b, h) ((4 + (b) * 2 + (h)) * HTB)
#define PG8_STAGE(bufoff, gbase, voff) do { _Pragma("unroll") for (int _i = 0; _i < 2; ++_i) \
        __builtin_amdgcn_global_load_lds((const unsigned*)((const char*)(gbase) + (voff)[_i]), (PG8_LAS unsigned*)(lds + (bufoff) + ldsw + _i * 8192), 16, 0, 0); } while (0)
#define PG8_LDA(dst, b, h) do { _Pragma("unroll") for (int m = 0; m < 4; ++m) _Pragma("unroll") for (int k = 0; k < 2; ++k) dst[m][k] = *(const PG8_LAS bf16x8*)(lds + PG8_SA(b, h) + aoff + m * 2048 + k * 1024); } while (0)
#define PG8_LDB(dst, b, h) do { _Pragma("unroll") for (int n = 0; n < 2; ++n) _Pragma("unroll") for (int k = 0; k < 2; ++k) dst[n][k] = *(const PG8_LAS bf16x8*)(lds + PG8_SB(b, h) + boff + n * 2048 + k * 1024); } while (0)
#define PG8_MMA(ai, bj, At, Bt) do { __builtin_amdgcn_s_setprio(1); _Pragma("unroll") for (int m = 0; m < 4; ++m) _Pragma("unroll") for (int n = 0; n < 2; ++n) _Pragma("unroll") for (int k = 0; k < 2; ++k) \
        acc[ai][bj][m][n] = __builtin_amdgcn_mfma_f32_16x16x32_bf16(Bt[n][k], At[m][k], acc[ai][bj][m][n], 0, 0, 0); __builtin_amdgcn_s_setprio(0); } while (0)
#define PG8_WAIT_V(n) asm volatile("s_waitcnt vmcnt(" #n ")" ::: "memory")
#define PG8_WAIT_L(n) asm volatile("s_waitcnt lgkmcnt(" #n ")" ::: "memory")
#define PG8_BAR __builtin_amdgcn_s_barrier()
#define PG8_SCHED __builtin_amdgcn_sched_barrier(0)
    Unit cur, nxt; int ui = 0;
    if (!S.next(0, cur)) return;
    f32x4 acc[2][2][4][2];
#pragma unroll
    for (int a = 0; a < 2; ++a)
#pragma unroll
        for (int b = 0; b < 2; ++b)
#pragma unroll
            for (int m = 0; m < 4; ++m)
#pragma unroll
                for (int n = 0; n < 2; ++n) acc[a][b][m][n] = (f32x4){0.f, 0.f, 0.f, 0.f};
    bf16x8 At[4][2], B0[2][2], B1[2][2];
    const char* cA = (const char*)g.A + (size_t)cur.pm * tstepA; const char* cB = (const char*)g.Bt + (size_t)cur.pn * tstepB;
    S.a_ready(cur);
    if constexpr (SP2) {
        PG8_STAGE(PG8_SB(0, 0), cB, voffB); PG8_STAGE(PG8_SB(0, 1), cB + hstepB, voffB); PG8_STAGE(PG8_SA(0, 0), cA, voffA); PG8_STAGE(PG8_SA(0, 1), cA + hstepA, voffA);
        if (wr == 1) PG8_BAR;
        PG8_WAIT_V(2); PG8_BAR;
        PG8_STAGE(PG8_SB(1, 0), cB + kstep, voffB); PG8_STAGE(PG8_SA(1, 0), cA + kstep, voffA); PG8_STAGE(PG8_SB(1, 1), cB + hstepB + kstep, voffB);
        PG8_WAIT_V(6); PG8_BAR;
    } else {
        PG8_STAGE(PG8_SB(0, 0), cB, voffB); PG8_STAGE(PG8_SA(0, 0), cA, voffA); PG8_STAGE(PG8_SB(0, 1), cB + hstepB, voffB); PG8_STAGE(PG8_SA(0, 1), cA + hstepA, voffA);
        if (wr == 1) PG8_BAR;
        PG8_WAIT_V(4); PG8_BAR;
        PG8_STAGE(PG8_SB(1, 0), cB + kstep, voffB); PG8_STAGE(PG8_SA(1, 0), cA + kstep, voffA); PG8_STAGE(PG8_SB(1, 1), cB + hstepB + kstep, voffB);
        PG8_WAIT_V(6); PG8_BAR;
    }
    for (;;) {
        const bool has_next = S.next(ui + 1, nxt);
        const char* nA = has_next ? (const char*)g.A + (size_t)nxt.pm * tstepA : cA; const char* nB = has_next ? (const char*)g.Bt + (size_t)nxt.pn * tstepB : cB;
        for (int t = 0; t < nt; t += 2) {
            const bool last = (t == nt - 2);
            const char* a1 = cA + (size_t)(t + 1) * kstep;
            const char* a2 = last ? nA : cA + (size_t)(t + 2) * kstep; const char* b2 = last ? nB : cB + (size_t)(t + 2) * kstep;
            const char* a3 = a2 + kstep; const char* b3 = b2 + kstep;
            if (last && has_next) S.a_ready(nxt);
            if constexpr (SP2) {
            PG8_LDB(B0, 0, 0); PG8_LDB(B1, 0, 1); PG8_SCHED; PG8_LDA(At, 0, 0); PG8_STAGE(PG8_SA(1, 1), a1 + hstepA, voffA);
            PG8_WAIT_V(8); PG8_WAIT_L(0); PG8_BAR; PG8_MMA(0, 0, At, B0); PG8_MMA(0, 1, At, B1); PG8_BAR; PG8_SCHED;
            PG8_LDA(At, 0, 1); PG8_STAGE(PG8_SB(0, 0), b2, voffB); PG8_STAGE(PG8_SB(0, 1), b2 + hstepB, voffB); PG8_STAGE(PG8_SA(0, 0), a2, voffA);
            PG8_WAIT_V(8); PG8_WAIT_L(0); PG8_BAR; PG8_MMA(1, 0, At, B0); PG8_MMA(1, 1, At, B1); PG8_BAR; PG8_SCHED;
            PG8_LDB(B0, 1, 0); PG8_LDB(B1, 1, 1); PG8_SCHED; PG8_LDA(At, 1, 0); PG8_STAGE(PG8_SA(0, 1), a2 + hstepA, voffA);
            PG8_WAIT_V(8); PG8_WAIT_L(0); PG8_BAR; PG8_MMA(0, 0, At, B0); PG8_MMA(0, 1, At, B1); PG8_BAR; PG8_SCHED;
            PG8_LDA(At, 1, 1); PG8_STAGE(PG8_SB(1, 0), b3, voffB); PG8_STAGE(PG8_SB(1, 1), b3 + hstepB, voffB); PG8_STAGE(PG8_SA(1, 0), a3, voffA);
            PG8_WAIT_V(8); PG8_WAIT_L(0); PG8_BAR; PG8_MMA(1, 0, At, B0); PG8_MMA(1, 1, At, B1); PG8_BAR; PG8_SCHED;
            } else {
            PG8_LDB(B0, 0, 0); PG8_SCHED; PG8_LDA(At, 0, 0); PG8_STAGE(PG8_SA(1, 1), a1 + hstepA, voffA);
            PG8_WAIT_L(8); PG8_BAR; PG8_WAIT_L(0); PG8_MMA(0, 0, At, B0); PG8_BAR; PG8_SCHED;
            PG8_LDB(B1, 0, 1); PG8_STAGE(PG8_SB(0, 0), b2, voffB);
            PG8_BAR; PG8_WAIT_L(0); PG8_MMA(0, 1, At, B1); PG8_BAR;
            PG8_LDA(At, 0, 1); PG8_STAGE(PG8_SA(0, 0), a2, voffA);
            PG8_BAR; PG8_WAIT_L(0); PG8_MMA(1, 0, At, B0); PG8_BAR; PG8_SCHED;
            PG8_STAGE(PG8_SB(0, 1), b2 + hstepB, voffB);
            PG8_WAIT_V(6); PG8_BAR; PG8_MMA(1, 1, At, B1); PG8_BAR;
            PG8_LDB(B0, 1, 0); PG8_SCHED; PG8_LDA(At, 1, 0); PG8_STAGE(PG8_SA(0, 1), a2 + hstepA, voffA);
            PG8_WAIT_L(8); PG8_BAR; PG8_WAIT_L(0); PG8_MMA(0, 0, At, B0); PG8_BAR; PG8_SCHED;
            PG8_LDB(B1, 1, 1); PG8_STAGE(PG8_SB(1, 0), b3, voffB);
            PG8_BAR; PG8_WAIT_L(0); PG8_MMA(0, 1, At, B1); PG8_BAR;
            PG8_LDA(At, 1, 1); PG8_STAGE(PG8_SA(1, 0), a3, voffA);
            PG8_BAR; PG8_WAIT_L(0); PG8_MMA(1, 0, At, B0); PG8_BAR; PG8_SCHED;
            PG8_STAGE(PG8_SB(1, 1), b3 + hstepB, voffB);
            PG8_WAIT_V(6); PG8_BAR; PG8_MMA(1, 1, At, B1); PG8_BAR;
            }
        }
        if constexpr (ALIGN_EPI) { if (wr == 0) PG8_BAR; }
        if constexpr (!Epi::AFTER_DRAIN) { E(acc, cur, wr, wc, fr, fq); S.done(cur); }
        if (!has_next) break;
#pragma unroll
        for (int a = 0; a < 2; ++a)
#pragma unroll
            for (int b = 0; b < 2; ++b)
#pragma unroll
                for (int m = 0; m < 4; ++m)
#pragma unroll
                    for (int n = 0; n < 2; ++n) acc[a][b][m][n] = (f32x4){0.f, 0.f, 0.f, 0.f};
        cur = nxt; cA = nA; cB = nB; ++ui;
        if constexpr (ALIGN_EPI) { if (wr == 1) PG8_BAR; }
    }
    PG8_WAIT_V(0);
    if constexpr (!ALIGN_EPI) { if (wr == 0) PG8_BAR; }
    PG8_BAR;
    if constexpr (Epi::AFTER_DRAIN) { E.fused(acc, cur, wr, wc, fr, fq, lds, wid, lane); S.done(cur); }
#undef PG8_SA
#undef PG8_SB
#undef PG8_STAGE
#undef PG8_LDA
#undef PG8_LDB
#undef PG8_MMA
#undef PG8_WAIT_V
#undef PG8_WAIT_L
#undef PG8_BAR
#undef PG8_SCHED
}
}


typedef unsigned short bf16_t;
typedef float f32x4 __attribute__((ext_vector_type(4)));
typedef float f32x2 __attribute__((ext_vector_type(2)));
typedef unsigned u32x4 __attribute__((ext_vector_type(4)));
#define LAS __attribute__((address_space(3)))
#define GAS __attribute__((address_space(1)))

#ifndef PH_MASK
#define PH_MASK 0xffff
#endif
#ifndef RPT
#define RPT 0
#endif
#ifndef VARX
#define VARX 0
#endif
#ifndef NT_ST
#define NT_ST 1
#endif
#ifndef PROBE_S
#define PROBE_S -1
#endif
#ifndef PROBE_ODD
#define PROBE_ODD 0
#endif
#ifndef PROBE_BAR
#define PROBE_BAR 1
#endif
#ifndef WT_ST
#define WT_ST 0
#endif
#ifndef LIGHT_SEAMS
#define LIGHT_SEAMS 1
#endif
#ifndef MK_MULTI
#define MK_MULTI 0
#endif

constexpr int BATCH = 4, SEQ = 4096, DM = 1024, M = BATCH * SEQ, DEPTH = 4;
constexpr int DFF = 2816;
constexpr int HYB_IN = 3096, HYB_N = 3072, HYB_PAD = 3104;
constexpr int NCH = 64, CH = 64;
constexpr float EPS = 1e-6f;
constexpr int PP = 3072;
constexpr int C_GQ = 0, C_GK = 256, C_GV = 512, C_MQ = 1024, C_MK = 1280, C_MV = 1536, C_GR = 2048, C_MO = 2560;
constexpr int SMALLP = 32;

constexpr size_t MiB = 1u << 20;
constexpr size_t WS_CTL = 0, CTL_ZERO_BYTES = 65536, WS_RSS = 1 * MiB, WS_SMALL = 2 * MiB, WS_KMEAN = 4 * MiB, WS_DEC = 5 * MiB, WS_NS = 6 * MiB, WS_SIDE = 7 * MiB, WS_Z = 240 * MiB;
constexpr size_t WS_XB = 8 * MiB, WS_P = 40 * MiB, WS_W = 136 * MiB;
constexpr size_t W_IN = 0, W_OUT = W_IN + (size_t)HYB_PAD * DM * 2, W_QKV = W_OUT + (size_t)DM * DM * 2, W_O = W_QKV + (size_t)3 * DM * DM * 2, W_MIXSZ = W_O + (size_t)DM * DM * 2;
constexpr size_t W_FFN0 = 2 * W_MIXSZ, W_GU = 0, W_D = (size_t)2 * DFF * DM * 2, W_FFNSZ = W_D + (size_t)DM * DFF * 2;
constexpr size_t WS_END = WS_W + W_FFN0 + 4 * W_FFNSZ;
static_assert(WS_END <= WS_Z && WS_Z + (size_t)M * 256 * 2 <= 256 * MiB, "workspace map");

constexpr int RING_BYTES = 131072, LDS_BYTES = 147456, MISC_OFF = LDS_BYTES - 256;
constexpr int NWAVES = 8, NTHR = 512;

__device__ __forceinline__ float bf2f(bf16_t v) { return __uint_as_float((unsigned)v << 16); }
typedef __bf16 bf16x2_t __attribute__((ext_vector_type(2)));
__device__ __forceinline__ unsigned pk2(float lo, float hi) { const f32x2 v = {lo, hi}; const bf16x2_t b = __builtin_convertvector(v, bf16x2_t); return __builtin_bit_cast(unsigned, b); }
__device__ __forceinline__ unsigned f2bf(float f) { return pk2(f, f) & 0xffffu; }
__device__ __forceinline__ float sigmoidf_(float x) { return __builtin_amdgcn_rcpf(1.f + __builtin_amdgcn_exp2f(-1.4426950408889634f * x)); }
__device__ __forceinline__ float siluf_(float x) { return x * __builtin_amdgcn_rcpf(1.f + __builtin_amdgcn_exp2f(-1.4426950408889634f * x)); }
__device__ __forceinline__ float logsigmoidf_(float x) { return fminf(x, 0.f) - 0.6931471805599453f * __builtin_amdgcn_logf(1.f + __builtin_amdgcn_exp2f(-1.4426950408889634f * fabsf(x))); }
__device__ __forceinline__ float wave_sum(float v) {
#pragma unroll
    for (int o = 1; o < 64; o <<= 1) v += __shfl_xor(v, o);
    return v;
}
__device__ __forceinline__ float wave_max(float v) {
#pragma unroll
    for (int o = 1; o < 64; o <<= 1) v = fmaxf(v, __shfl_xor(v, o));
    return v;
}
__device__ __forceinline__ int opaque_i(int v) { asm volatile("" : "+v"(v)); return v; }
__device__ __forceinline__ float row16_sum(float v) {
    v += __builtin_bit_cast(float, __builtin_amdgcn_update_dpp(0, __builtin_bit_cast(int, v), 0xB1, 0xF, 0xF, true));
    v += __builtin_bit_cast(float, __builtin_amdgcn_update_dpp(0, __builtin_bit_cast(int, v), 0x4E, 0xF, 0xF, true));
    v += __builtin_bit_cast(float, __builtin_amdgcn_update_dpp(0, __builtin_bit_cast(int, v), 0x141, 0xF, 0xF, true));
    v += __builtin_bit_cast(float, __builtin_amdgcn_update_dpp(0, __builtin_bit_cast(int, v), 0x140, 0xF, 0xF, true));
    return v;
}
__device__ __forceinline__ float row_rstd(const float* rss, int row) {
    const f32x4* p = (const f32x4*)(rss + (size_t)row * 16);
    const f32x4 a = p[0], b = p[1], c = p[2], d = p[3];
    const float s = ((a.x + a.y) + (a.z + a.w)) + ((b.x + b.y) + (b.z + b.w)) + ((c.x + c.y) + (c.z + c.w)) + ((d.x + d.y) + (d.z + d.w));
    return __builtin_amdgcn_rsqf(s * (1.f / DM) + EPS);
}

#define XB_TMO      128
#define XB_XCNT(j)  (256  + 64 * (j))
#define XB_XSUB(j)  (1280 + 64 * (j))
#define XB_XGEN(j)  (2304 + 64 * (j))
#define XB_TOP      3328
#define XB_TOPGEN   3392
#define XCD_BAR_WORDS 3456
#define XB_SPIN_CAP (1u << 18)
__device__ __forceinline__ unsigned xb_ld(unsigned* p)              { return __hip_atomic_load(p, __ATOMIC_RELAXED, __HIP_MEMORY_SCOPE_AGENT); }
__device__ __forceinline__ unsigned xb_add(unsigned* p, unsigned v) { return __hip_atomic_fetch_add(p, v, __ATOMIC_RELAXED, __HIP_MEMORY_SCOPE_AGENT); }
__device__ __forceinline__ unsigned xb_xcc_id() { return (unsigned)__builtin_amdgcn_s_getreg((3 << 11) | 20) & 0xFu; }
#define XB_SPIN(cond, bar) do { unsigned _sp = 0; while (cond) { __builtin_amdgcn_s_sleep(1); \
    if ((++_sp & 255u) == 0u) { if (xb_ld(&(bar)[XB_TMO])) break; if (_sp > XB_SPIN_CAP) { atomicAdd(&(bar)[XB_TMO], 1u); break; } } } } while (0)
struct XcdBarrier { unsigned* bar; unsigned x; volatile LAS unsigned* st; };
__device__ __forceinline__ XcdBarrier xcd_barrier_post(unsigned* bar, volatile LAS unsigned* st) {
    XcdBarrier b; b.bar = bar; b.x = xb_xcc_id(); b.st = st;
    if (threadIdx.x == 0) (void)xb_add(&bar[XB_XCNT(b.x)], 1u);
    return b;
}
__device__ __forceinline__ void xcd_barrier_complete(unsigned* bar, unsigned x, unsigned& nloc, unsigned& nx) {
    const unsigned G = gridDim.x * gridDim.y * gridDim.z;
    unsigned sum, cnt, mine, sp = 0u;
    for (;;) {
        sum = 0u; cnt = 0u; mine = 0u;
#pragma unroll
        for (unsigned j = 0; j < 16; ++j) { const unsigned c = xb_ld(&bar[XB_XCNT(j)]); sum += c; cnt += (c > 0u) ? 1u : 0u; mine = (j == x) ? c : mine; }
        if (sum == G) break;
        __builtin_amdgcn_s_sleep(1);
        if ((++sp & 255u) == 0u) { if (xb_ld(&bar[XB_TMO])) break; if (sp > XB_SPIN_CAP) { atomicAdd(&bar[XB_TMO], 1u); break; } }
    }
    nloc = mine > 0u ? mine : 1u; nx = cnt > 0u ? cnt : 1u;
}
__device__ __forceinline__ void xcd_barrier(const XcdBarrier& b) {
    asm volatile("s_waitcnt vmcnt(0)" ::: "memory");
    __syncthreads();
    if (threadIdx.x == 0) {
        unsigned* bar = b.bar;
        __builtin_amdgcn_s_waitcnt(0);
        unsigned nloc = b.st[0], nx = b.st[1];
        if (nloc == 0u) { xcd_barrier_complete(bar, b.x, nloc, nx); b.st[0] = nloc; b.st[1] = nx; }
        const unsigned old = xb_add(&bar[XB_XSUB(b.x)], 1u);
        const unsigned gen = old / nloc;
        if (old + 1u == (gen + 1u) * nloc) {
            __builtin_amdgcn_fence(__ATOMIC_RELEASE, "agent");
            asm volatile("s_waitcnt vmcnt(0)" ::: "memory");
            const unsigned og = xb_add(&bar[XB_TOP], 1u);
            const unsigned tg = og / nx;
            if (og + 1u == (tg + 1u) * nx) xb_add(&bar[XB_TOPGEN], 1u);
            else XB_SPIN(xb_ld(&bar[XB_TOPGEN]) == tg, bar);
            __builtin_amdgcn_fence(__ATOMIC_ACQUIRE, "agent");
            xb_add(&bar[XB_XGEN(b.x)], 1u);
            asm volatile("s_waitcnt vmcnt(0)" ::: "memory");
        } else {
            XB_SPIN(xb_ld(&bar[XB_XGEN(b.x)]) == gen, bar);
            __builtin_amdgcn_fence(__ATOMIC_ACQUIRE, "agent");
            asm volatile("s_waitcnt vmcnt(0)" ::: "memory");
        }
    }
    __syncthreads();
}


#define LX_SUB(j) (1024 + 64 * (j))
#define LX_GEN(j) (2048 + 64 * (j))
#define LX_MASK(g) (3072 + 64 * (g))
__device__ __forceinline__ void xcd_local_barrier(unsigned* ctl, unsigned x, unsigned nloc, unsigned* tmo) {
    asm volatile("s_waitcnt vmcnt(0)" ::: "memory");
    __syncthreads();
    if (threadIdx.x == 0) {
        __builtin_amdgcn_s_waitcnt(0);
        const unsigned old = xb_add(&ctl[LX_SUB(x)], 1u);
        const unsigned gen = old / nloc;
        if (old + 1u == (gen + 1u) * nloc) xb_add(&ctl[LX_GEN(x)], 1u);
        else XB_SPIN(xb_ld(&ctl[LX_GEN(x)]) == gen, tmo);
        __builtin_amdgcn_fence(__ATOMIC_ACQUIRE, "agent");
        asm volatile("s_waitcnt vmcnt(0)" ::: "memory");
    }
    __syncthreads();
}

__device__ __forceinline__ void stage_rstd(const pg8::StaticOrder& S, const float* rss, LAS float* lds_rs) {
    const int tid = opaque_i(threadIdx.x), half = tid >> 8, t = tid & 255;
    pg8::Unit u;
    for (int i = half; S.next(i, u); i += 2) lds_rs[i * 256 + t] = row_rstd(rss, u.pm * 256 + t);
    asm volatile("s_waitcnt lgkmcnt(0)" ::: "memory");
    __syncthreads();
}

__device__ __forceinline__ void store16_wt(void* base, unsigned nbytes, unsigned off, u32x4 v) {
    const __amdgpu_buffer_rsrc_t rs = __builtin_amdgcn_make_buffer_rsrc(base, (short)0, (int)nbytes, 0x00020000);
    __builtin_amdgcn_raw_buffer_store_b128(v, rs, (int)off, 0, 16);
}
struct EpiRowBf16 {
    static constexpr bool PERM = true, AFTER_DRAIN = false;
    bf16_t* O; int ldc; LAS const float* lrs; unsigned* hflag;
    __device__ __forceinline__ void operator()(const pg8::f32x4 (&acc)[2][2][4][2], const pg8::Unit& u, int wr, int wc, int fr, int fq) const {
        const int row0 = u.pm * 256 + wr * 64 + fr;
        const int col0 = u.pn * 256 + wc * 32 + 8 * fq;
        const bool wt_ = hflag != nullptr && (u.pm & 15) == 7 && (u.pn == 4 || u.pn == 5);
        float rs[8];
#pragma unroll
        for (int i = 0; i < 8; ++i) rs[i] = lrs[u.idx * 256 + wr * 64 + fr + (i >> 2) * 128 + (i & 3) * 16];
#pragma unroll
        for (int ai = 0; ai < 2; ++ai)
#pragma unroll
            for (int m = 0; m < 4; ++m) { const int row = row0 + ai * 128 + m * 16; const float r = rs[ai * 4 + m];
                bf16_t* rowp = O + (size_t)row * ldc + col0;
#pragma unroll
                for (int bj = 0; bj < 2; ++bj) { const f32x4 v0 = acc[ai][bj][m][0] * r, v1 = acc[ai][bj][m][1] * r;
                    u32x4 w; w.x = pg8::cvt_pk_bf16(v0[0], v0[1]); w.y = pg8::cvt_pk_bf16(v0[2], v0[3]); w.z = pg8::cvt_pk_bf16(v1[0], v1[1]); w.w = pg8::cvt_pk_bf16(v1[2], v1[3]);
                    if (wt_) store16_wt(O, (unsigned)M * ldc * 2u, (unsigned)(((size_t)row * ldc + col0 + bj * 128) * 2), w);
                    else if (NT_ST & 2) __builtin_nontemporal_store(w, (u32x4*)(rowp + bj * 128)); else *(u32x4*)(rowp + bj * 128) = w; } }
        if (wt_) {
            asm volatile("s_waitcnt vmcnt(0)" ::: "memory"); __builtin_amdgcn_s_barrier(); asm volatile("" ::: "memory");
            if (wr == 0 && wc == 0 && fr == 0 && fq == 0) xb_add(&hflag[(u.pm >> 4) * 16], 1u);
        }
    }
};
struct EpiRes {
    static constexpr bool PERM = true, AFTER_DRAIN = false;
    bf16_t* xb; float* xout; float* rss; int dry;
    __device__ __forceinline__ void operator()(const pg8::f32x4 (&acc)[2][2][4][2], const pg8::Unit& u, int wr, int wc, int fr, int fq) const {
        if (RPT && dry) { if (acc[0][0][0][0][0] == 1.2345e-33f) rss[0] = 0.f; return; }
        const int row0 = u.pm * 256 + wr * 64 + fr, col0 = u.pn * 256 + wc * 32 + 8 * fq;
        u32x4 xo[2][4][2];
#pragma unroll
        for (int ai = 0; ai < 2; ++ai)
#pragma unroll
            for (int m = 0; m < (ai ? 2 : 4); ++m)
#pragma unroll
                for (int bj = 0; bj < 2; ++bj) xo[ai][m][bj] = *(const u32x4*)(xb + (size_t)(row0 + ai * 128 + m * 16) * DM + col0 + bj * 128);
#pragma unroll
        for (int ai = 0; ai < 2; ++ai) {
            if (ai == 1) {
#pragma unroll
                for (int m = 2; m < 4; ++m)
#pragma unroll
                    for (int bj = 0; bj < 2; ++bj) xo[1][m][bj] = *(const u32x4*)(xb + (size_t)(row0 + 128 + m * 16) * DM + col0 + bj * 128);
            }
#pragma unroll
            for (int m = 0; m < 4; ++m) { const int row = row0 + ai * 128 + m * 16; float ss = 0.f;
#pragma unroll
                for (int bj = 0; bj < 2; ++bj) { const size_t off = (size_t)row * DM + col0 + bj * 128; const u32x4 xw = xo[ai][m][bj];
                    f32x4 a, b;
                    a[0] = __uint_as_float(xw[0] << 16); a[1] = __uint_as_float(xw[0] & 0xffff0000u); a[2] = __uint_as_float(xw[1] << 16); a[3] = __uint_as_float(xw[1] & 0xffff0000u);
                    b[0] = __uint_as_float(xw[2] << 16); b[1] = __uint_as_float(xw[2] & 0xffff0000u); b[2] = __uint_as_float(xw[3] << 16); b[3] = __uint_as_float(xw[3] & 0xffff0000u);
                    a = a + acc[ai][bj][m][0]; b = b + acc[ai][bj][m][1];
                    if (xout) { __builtin_nontemporal_store(a, (f32x4*)(xout + off)); __builtin_nontemporal_store(b, (f32x4*)(xout + off + 4)); continue; }
                    u32x4 w; w.x = pg8::cvt_pk_bf16(a[0], a[1]); w.y = pg8::cvt_pk_bf16(a[2], a[3]); w.z = pg8::cvt_pk_bf16(b[0], b[1]); w.w = pg8::cvt_pk_bf16(b[2], b[3]);
                    if (WT_ST & 4) store16_wt(xb, (unsigned)M * DM * 2u, (unsigned)(off * 2), w); else if (NT_ST & 8) __builtin_nontemporal_store(w, (u32x4*)(xb + off)); else *(u32x4*)(xb + off) = w;
                    ss += (a[0] * a[0] + a[1] * a[1]) + (a[2] * a[2] + a[3] * a[3]) + (b[0] * b[0] + b[1] * b[1]) + (b[2] * b[2] + b[3] * b[3]); }
                ss += __shfl_xor(ss, 16); ss += __shfl_xor(ss, 32);
                if (fq == 0 && !xout) rss[(size_t)row * 16 + u.pn * 4 + wc] = ss; }
        }
    }
};
struct EpiFfn {
    static constexpr bool PERM = true, AFTER_DRAIN = false;
    bf16_t* H; LAS const float* lrs;
    __device__ __forceinline__ void operator()(const pg8::f32x4 (&acc)[2][2][4][2], const pg8::Unit& u, int wr, int wc, int fr, int fq) const {
        const int row0 = u.pm * 256 + wr * 64 + fr, col0 = u.pn * 128 + wc * 32 + 8 * fq;
        float rs[8];
#pragma unroll
        for (int i = 0; i < 8; ++i) rs[i] = lrs[u.idx * 256 + wr * 64 + fr + (i >> 2) * 128 + (i & 3) * 16];
#pragma unroll
        for (int ai = 0; ai < 2; ++ai)
#pragma unroll
            for (int m = 0; m < 4; ++m) { const int row = row0 + ai * 128 + m * 16; const float r = rs[ai * 4 + m];
                float hv[8]; const float nr = -1.4426950408889634f * r, ir2 = __builtin_amdgcn_rcpf(r * r);
#pragma unroll
                for (int n = 0; n < 2; ++n)
#pragma unroll
                    for (int e = 0; e < 4; e += 2) { const f32x2 g = {acc[ai][0][m][n][e], acc[ai][0][m][n][e + 1]}, uu = {acc[ai][1][m][n][e], acc[ai][1][m][n][e + 1]};
                        f32x2 t = g * nr; t.x = __builtin_amdgcn_exp2f(t.x); t.y = __builtin_amdgcn_exp2f(t.y);
                        f32x2 d = t * ir2 + ir2; d.x = __builtin_amdgcn_rcpf(d.x); d.y = __builtin_amdgcn_rcpf(d.y);
                        const f32x2 h = (g * uu) * d; hv[n * 4 + e] = h.x; hv[n * 4 + e + 1] = h.y; }
                u32x4 w; w.x = pg8::cvt_pk_bf16(hv[0], hv[1]); w.y = pg8::cvt_pk_bf16(hv[2], hv[3]); w.z = pg8::cvt_pk_bf16(hv[4], hv[5]); w.w = pg8::cvt_pk_bf16(hv[6], hv[7]);
                if (WT_ST & 8) store16_wt(H, (unsigned)M * DFF * 2u, (unsigned)(((size_t)row * DFF + col0) * 2), w); else if (NT_ST & 1) __builtin_nontemporal_store(w, (u32x4*)(H + (size_t)row * DFF + col0)); else *(u32x4*)(H + (size_t)row * DFF + col0) = w; }
    }
};


struct EpiQkv {
    static constexpr bool PERM = true, AFTER_DRAIN = false;
    bf16_t* O; LAS const float* lrs; const float* qg; const float* kg; float* kmean; LAS float* xch; LAS float* xch2; LAS float* ksum;
    __device__ __forceinline__ void operator()(const pg8::f32x4 (&acc)[2][2][4][2], const pg8::Unit& u, int wr, int wc, int fr, int fq) const {
        fr = opaque_i(fr); fq = opaque_i(fq);
        const unsigned vo_o = (unsigned)(((wr * 64 + fr) * PP + wc * 32 + 8 * fq) * 2);
        char* obase = (char*)O + ((size_t)u.pm * 256 * PP + (size_t)u.pn * 256) * 2;
        float rs[8];
#pragma unroll
        for (int i = 0; i < 8; ++i) rs[i] = lrs[u.idx * 256 + wr * 64 + fr + (i >> 2) * 128 + (i & 3) * 16];
        if (u.pn >= 8) {
#pragma unroll
            for (int ai = 0; ai < 2; ++ai)
#pragma unroll
                for (int m = 0; m < 4; ++m) { const float r = rs[ai * 4 + m];
#pragma unroll
                    for (int bj = 0; bj < 2; ++bj) { const f32x4 v0 = acc[ai][bj][m][0] * r, v1 = acc[ai][bj][m][1] * r;
                        u32x4 w; w.x = pg8::cvt_pk_bf16(v0[0], v0[1]); w.y = pg8::cvt_pk_bf16(v0[2], v0[3]); w.z = pg8::cvt_pk_bf16(v1[0], v1[1]); w.w = pg8::cvt_pk_bf16(v1[2], v1[3]);
                        if (WT_ST & 2) store16_wt(obase, (unsigned)(256 * PP * 2), (unsigned)(((ai * 128 + m * 16) * PP + bj * 128) * 2) + vo_o, w); else if (NT_ST & 4) __builtin_nontemporal_store(w, (u32x4*)(obase + ((ai * 128 + m * 16) * PP + bj * 128) * 2 + vo_o)); else *(u32x4*)(obase + ((ai * 128 + m * 16) * PP + bj * 128) * 2 + vo_o) = w; } }
            return;
        }
        const bool isq = u.pn < 4;
        LAS float* xw = xch + (wr * 64 + fr) * 8 + wc;
#pragma unroll
        for (int ai = 0; ai < 2; ++ai)
#pragma unroll
            for (int m = 0; m < 4; ++m) { const float r = rs[ai * 4 + m];
#pragma unroll
                for (int bj = 0; bj < 2; ++bj) { const f32x4 v0 = acc[ai][bj][m][0] * r, v1 = acc[ai][bj][m][1] * r;
                    float ss = (v0[0] * v0[0] + v0[1] * v0[1]) + (v0[2] * v0[2] + v0[3] * v0[3]) + (v1[0] * v1[0] + v1[1] * v1[1]) + (v1[2] * v1[2] + v1[3] * v1[3]);
                    ss += __shfl_xor(ss, 16); ss += __shfl_xor(ss, 32);
                    if (fq == 0) xw[(ai * 128 + m * 16) * 8 + bj * 4] = ss; }
                if (fq == 0 && wc == 0) xch2[wr * 64 + fr + ai * 128 + m * 16] = r; }
        asm volatile("s_waitcnt lgkmcnt(0)" ::: "memory"); __builtin_amdgcn_s_barrier(); asm volatile("" ::: "memory");
        const float* g = (isq ? qg : kg) + wc * 32 + 8 * fq;
        const f32x4 ga = *(const f32x4*)g, gb = *(const f32x4*)(g + 4);
        const float sc = isq ? 0.08838834764831845f : 1.f;
        LAS const float* xr = xch + (wr * 64 + fr) * 8;
#pragma unroll
        for (int bj = 0; bj < 2; ++bj) {
#pragma unroll
            for (int ai = 0; ai < 2; ++ai)
#pragma unroll
                for (int m = 0; m < 4; ++m) { asm volatile("" ::: "memory"); __builtin_amdgcn_sched_barrier(0); const float r = xch2[wr * 64 + fr + ai * 128 + m * 16];
                    const f32x4 p4 = *(LAS const f32x4*)(xr + (ai * 128 + m * 16) * 8 + bj * 4);
                    const float rr = __builtin_amdgcn_rsqf(((p4[0] + p4[1]) + (p4[2] + p4[3])) * (1.f / 128.f) + EPS) * sc * r;
                    const f32x4 v0 = acc[ai][bj][m][0] * rr * ga, v1 = acc[ai][bj][m][1] * rr * gb;
                    if (!isq) {
#pragma unroll
                        for (int e = 0; e < 4; ++e) { const float s0 = row16_sum(v0[e]), s1 = row16_sum(v1[e]);
                            if (fr == 0) {
                                __hip_atomic_fetch_add((LAS int*)ksum + bj * 128 + wc * 32 + 8 * fq + e, __float2int_rn(s0 * 131072.f), __ATOMIC_RELAXED, __HIP_MEMORY_SCOPE_WORKGROUP);
                                __hip_atomic_fetch_add((LAS int*)ksum + bj * 128 + wc * 32 + 8 * fq + 4 + e, __float2int_rn(s1 * 131072.f), __ATOMIC_RELAXED, __HIP_MEMORY_SCOPE_WORKGROUP); } } }
                    u32x4 w; w.x = pg8::cvt_pk_bf16(v0[0], v0[1]); w.y = pg8::cvt_pk_bf16(v0[2], v0[3]); w.z = pg8::cvt_pk_bf16(v1[0], v1[1]); w.w = pg8::cvt_pk_bf16(v1[2], v1[3]);
                    if (WT_ST & 2) store16_wt(obase, (unsigned)(256 * PP * 2), (unsigned)(((ai * 128 + m * 16) * PP + bj * 128) * 2) + vo_o, w); else if (NT_ST & 4) __builtin_nontemporal_store(w, (u32x4*)(obase + ((ai * 128 + m * 16) * PP + bj * 128) * 2 + vo_o)); else *(u32x4*)(obase + ((ai * 128 + m * 16) * PP + bj * 128) * 2 + vo_o) = w; }
        }
        if (!isq) {
            asm volatile("s_waitcnt lgkmcnt(0)" ::: "memory"); __builtin_amdgcn_s_barrier(); asm volatile("" ::: "memory");
            const int t = (wr * 4 + wc) * 64 + fq * 16 + fr;
            if (t < 256) { const int bjj = t >> 7, d = t & 127, hh = (u.pn - 4) * 2 + bjj, bb = u.pm >> 4, blk = u.pm & 15;
                float* km = kmean + ((size_t)((bb * 8 + hh) * 16 + blk)) * 256;
                km[d] = (float)((LAS int*)ksum)[t] * (1.f / (256.f * 131072.f)); km[128 + d] = 0.f; ksum[t] = 0.f; }
        }
    }
};
struct EpiAny {
    static constexpr bool PERM = true, AFTER_DRAIN = false;
    int kind;
    bf16_t* O; LAS const float* lrs;
    const float* qg; const float* kg; LAS float* xch; LAS float* xch2; float* kmean; LAS float* ksum;
    float* xout; bf16_t* xb; float* rss; int dry;
    unsigned* hflag;
    __device__ __forceinline__ void operator()(const pg8::f32x4 (&acc)[2][2][4][2], const pg8::Unit& u, int wr, int wc, int fr, int fq) const {
        if (kind == 0) { EpiRowBf16 e{O, PP, lrs, hflag}; e(acc, u, wr, wc, fr, fq); }
        else if (kind == 1) { EpiQkv e{O, lrs, qg, kg, kmean, xch, xch2, ksum}; e(acc, u, wr, wc, fr, fq); }
        else if (kind == 2) { EpiFfn e{O, lrs}; e(acc, u, wr, wc, fr, fq); }
        else { EpiRes e{xb, xout, rss, dry}; e(acc, u, wr, wc, fr, fq); }
    }
};

struct Args { const float* in[18]; float* out; unsigned char* ws; int ph_lo, ph_hi; };
struct Frame {
    LAS unsigned char* lds; unsigned char* ldsg;
    int tid, lane, wave, G, bid;
};


typedef const __attribute__((address_space(4))) unsigned char* kargp_t;
__device__ __forceinline__ kargp_t karg_base() { kargp_t p = (kargp_t)__builtin_amdgcn_kernarg_segment_ptr(); asm volatile("" : "+s"(p)); return p; }
__device__ __forceinline__ const float* karg_in(kargp_t p, int i) { return *(const float* const __attribute__((address_space(4)))*)(p + 8 * i); }
__device__ __forceinline__ float* karg_out(kargp_t p) { return *(float* const __attribute__((address_space(4)))*)(p + 8 * 18); }
__device__ __forceinline__ unsigned char* karg_ws(kargp_t p) { return *(unsigned char* const __attribute__((address_space(4)))*)(p + 8 * 19); }

__device__ __forceinline__ int map_row(int kind, int n) {
    if (kind == 0) return n;
    if (kind == 2) return (n >> 7) * 256 + (n & 127);
    if (kind == 3) return (n >> 7) * 256 + 128 + (n & 127);
    if (n < 256) return C_GQ + n; if (n < 512) return C_GK + n - 256; if (n < 1024) return C_GV + n - 512; if (n < 1536) return C_GR + n - 1024;
    if (n < 1552) return 3072 + (n - 1536);
    if (n < 1808) return C_MQ + n - 1552; if (n < 2064) return C_MK + n - 1808; if (n < 2576) return C_MV + n - 2064; if (n < 3088) return C_MO + n - 2576;
    return 3072 + 16 + (n - 3088);
}
__device__ __forceinline__ void cvt_item(const float* W, int K, int N, const float* gain, bf16_t* WT, int kind, LAS float* scr, int item, int lane) {
    const int nblk = (N + 63) / 64, kb = item / nblk, nb = item % nblk, k0 = 64 * kb, n0 = 64 * nb;
    const int nq = n0 + 4 * (lane & 15), kr = lane >> 4;
    f32x4 v[16];
#pragma unroll
    for (int i = 0; i < 16; ++i) { v[i] = (f32x4){0.f, 0.f, 0.f, 0.f}; if (nq < N) v[i] = __builtin_nontemporal_load((const f32x4*)(W + (size_t)(k0 + 4 * i + kr) * N + nq)); }
#pragma unroll
    for (int i = 0; i < 16; ++i) { const int kk = 4 * i + kr; const float g = gain ? gain[k0 + kk] : 1.f; LAS float* d = scr + kk * 65 + 4 * (lane & 15);
        d[0] = v[i][0] * g; d[1] = v[i][1] * g; d[2] = v[i][2] * g; d[3] = v[i][3] * g; }
    asm volatile("s_waitcnt lgkmcnt(0)" ::: "memory");
    {
        const int c = lane & 7;
#pragma unroll
        for (int j = 0; j < 8; ++j) { const int nl = (lane >> 3) + 8 * j; const int mr = (n0 + nl < N) ? map_row(kind, n0 + nl) : -1;
            if (mr >= 0) { const LAS float* sp = scr + (8 * c) * 65 + nl;
                u32x4 o; o.x = pk2(sp[0 * 65], sp[1 * 65]); o.y = pk2(sp[2 * 65], sp[3 * 65]); o.z = pk2(sp[4 * 65], sp[5 * 65]); o.w = pk2(sp[6 * 65], sp[7 * 65]);
                *(u32x4*)(WT + (size_t)mr * K + k0 + 8 * c) = o; } }
    }
    asm volatile("s_waitcnt lgkmcnt(0)" ::: "memory");
}
__device__ __forceinline__ void phase_prologue(Frame& F) {
    kargp_t kp = karg_base();
    unsigned char* wsw = karg_ws(kp) + WS_W;
    LAS float* scr = (LAS float*)(F.lds + F.wave * 16640);
    const int gw = F.bid * NWAVES + F.wave, NGW = F.G * NWAVES, lane = opaque_i(F.lane);
    constexpr int I_IN = 16 * 49, I_OUT = 256, I_QKV = 16 * 48, I_O = 256, I_MIX = I_IN + I_OUT + I_QKV + I_O, I_F = 704, I_FFN = 3 * I_F, I_ALL = 2 * I_MIX + 4 * I_FFN;
    const int NFULL = (I_ALL / NGW) * NGW, NIT = I_ALL / NGW + (I_ALL - NFULL + F.G - 1) / F.G;
    for (int ii = 0; ii < NIT; ++ii) {
        int it;
        if (ii < I_ALL / NGW) it = ii * NGW + gw;
        else { const int e = (ii - I_ALL / NGW) * F.G + F.bid; if (e >= I_ALL - NFULL || F.wave != ((ii - I_ALL / NGW) & 7)) continue; it = NFULL + e; }
        if (it < 2 * I_MIX) {
            const int j = it / I_MIX; int r = it % I_MIX; unsigned char* wj = wsw + j * W_MIXSZ;
            if (r < I_IN) cvt_item(karg_in(kp, 3) + (size_t)j * DM * HYB_IN, DM, HYB_IN, karg_in(kp, 1) + (2 * j) * DM, (bf16_t*)(wj + W_IN), 1, scr, r, lane);
            else if ((r -= I_IN) < I_OUT) cvt_item(karg_in(kp, 10) + (size_t)j * DM * DM, DM, DM, nullptr, (bf16_t*)(wj + W_OUT), 0, scr, r, lane);
            else if ((r -= I_OUT) < I_QKV) cvt_item(karg_in(kp, 11) + (size_t)j * DM * 3 * DM, DM, 3 * DM, karg_in(kp, 1) + (2 * j + 1) * DM, (bf16_t*)(wj + W_QKV), 0, scr, r, lane);
            else { r -= I_QKV; cvt_item(karg_in(kp, 14) + (size_t)j * DM * DM, DM, DM, nullptr, (bf16_t*)(wj + W_O), 0, scr, r, lane); }
        } else {
            const int q = it - 2 * I_MIX, l = q / I_FFN; int r = q % I_FFN; unsigned char* wl = wsw + W_FFN0 + l * W_FFNSZ;
            if (r < I_F) cvt_item(karg_in(kp, 15) + (size_t)l * DM * DFF, DM, DFF, karg_in(kp, 2) + l * DM, (bf16_t*)(wl + W_GU), 2, scr, r, lane);
            else if ((r -= I_F) < I_F) cvt_item(karg_in(kp, 16) + (size_t)l * DM * DFF, DM, DFF, karg_in(kp, 2) + l * DM, (bf16_t*)(wl + W_GU), 3, scr, r, lane);
            else { r -= I_F; cvt_item(karg_in(kp, 17) + (size_t)l * DFF * DM, DFF, DM, nullptr, (bf16_t*)(wl + W_D), 0, scr, r, lane); }
        }
    }
    for (int j = 0; j < 2; ++j) {
        u32x4* z0 = (u32x4*)(wsw + j * W_MIXSZ + W_IN + (size_t)3096 * DM * 2);
        const int n0 = 8 * DM * 2 / 16;
        for (int i = F.bid * NTHR + F.tid; i < n0; i += F.G * NTHR) z0[i] = (u32x4){0u, 0u, 0u, 0u};
    }
    const float* x = karg_in(kp, 0); bf16_t* xb = (bf16_t*)(karg_ws(kp) + WS_XB); float* rss = (float*)(karg_ws(kp) + WS_RSS);
    LAS unsigned* xc = (LAS unsigned*)(F.lds + 8 * 16640 + 64);
    const int RPW = M / F.G;
    if (M % (2 * F.G) != 0) {
        for (int row = gw; row < M; row += NGW) {
            const float* xr = x + (size_t)row * DM; float s = 0.f;
#pragma unroll
            for (int j = 0; j < 4; ++j) { const f32x4 v = *(const f32x4*)(xr + j * 256 + lane * 4);
                s += (v.x * v.x + v.y * v.y) + (v.z * v.z + v.w * v.w);
                unsigned long long o = (unsigned long long)pk2(v.x, v.y) | ((unsigned long long)pk2(v.z, v.w) << 32);
                *(unsigned long long*)(xb + (size_t)row * DM + j * 256 + lane * 4) = o; }
            s = wave_sum(s);
            if (lane < 16) rss[(size_t)row * 16 + lane] = lane == 0 ? s : 0.f;
        }
        return;
    }
    for (;;) {
        unsigned k = 0u; if (lane == 0) k = __hip_atomic_fetch_add(xc, 2u, __ATOMIC_RELAXED, __HIP_MEMORY_SCOPE_WORKGROUP);
        k = (unsigned)__builtin_amdgcn_readfirstlane((int)k);
        if ((int)k >= RPW) break;
        const int row = F.bid * RPW + (int)k;
        const float* xr = x + (size_t)row * DM;
        f32x4 v[8];
#pragma unroll
        for (int j = 0; j < 8; ++j) v[j] = __builtin_nontemporal_load((const f32x4*)(xr + (j >> 2) * DM + (j & 3) * 256 + lane * 4));
        float s0 = 0.f, s1 = 0.f;
#pragma unroll
        for (int j = 0; j < 8; ++j) { const f32x4 w = v[j]; const float q = (w.x * w.x + w.y * w.y) + (w.z * w.z + w.w * w.w); if (j < 4) s0 += q; else s1 += q;
            unsigned long long o = (unsigned long long)pk2(w.x, w.y) | ((unsigned long long)pk2(w.z, w.w) << 32);
            *(unsigned long long*)(xb + (size_t)(row + (j >> 2)) * DM + (j & 3) * 256 + lane * 4) = o; }
        s0 = wave_sum(s0); s1 = wave_sum(s1);
        if (lane < 32) rss[(size_t)row * 16 + lane] = (lane & 15) == 0 ? (lane == 0 ? s0 : s1) : 0.f;
    }
}

struct ScanArgs {
    const bf16_t* xb; const float* rss; const bf16_t* wsm; bf16_t* side;
    bf16_t* P;
    const float* w2; const float* bgate; const float* gla_gain; const float* convw; const float* bif; const float* ml_gain;
    bf16_t* ST; float* dec; float* NS;
    unsigned* hflag; unsigned htarget; unsigned* tmo;
};
__device__ __forceinline__ size_t st_off(int grp, int bh, int c) { return ((size_t)((grp * 16 + bh) * NCH + c)) * 8192; }

__device__ __forceinline__ void phase_scan2(Frame& F, const ScanArgs& a, bool dry = false) {
    for (int gid = F.bid * NTHR + opaque_i(F.tid); gid < 131072; gid += F.G * NTHR) {
        const int grp = gid >> 16, rem = gid & 65535, bh = rem >> 12, r2 = rem & 4095, v = r2 >> 5, k = (r2 & 31) * 2;
        float s0 = 0.f, s1 = 0.f;
        unsigned* p0 = (unsigned*)(a.ST + st_off(grp, bh, 0) + v * 64 + k);
        const float* d0 = a.dec + ((size_t)(grp * 16 + bh) * NCH) * 64 + k;
        for (int cb = 0; cb < NCH; cb += 16) {
            unsigned w[16]; float da[16], db[16];
#pragma unroll
            for (int i = 0; i < 16; ++i) { w[i] = p0[(size_t)(cb + i) * 4096]; da[i] = d0[(cb + i) * 64]; db[i] = d0[(cb + i) * 64 + 1]; }
#pragma unroll
            for (int i = 0; i < 16; ++i) {
                const float l0 = __uint_as_float(w[i] << 16), l1 = __uint_as_float(w[i] & 0xffff0000u);
                if (!dry) p0[(size_t)(cb + i) * 4096] = pk2(s0, s1);
                s0 = da[i] * (s0 + l0); s1 = db[i] * (s1 + l1);
            }
        }
        if (gid < 1024) {
            const int bh2 = gid >> 6, k2 = gid & 63; float ns = 0.f;
            float* p = a.NS + ((size_t)bh2 * NCH) * 64 + k2; const float* dd = a.dec + ((size_t)(16 + bh2) * NCH) * 64 + k2;
            for (int cb = 0; cb < NCH; cb += 16) {
                float lv[16], dv[16];
#pragma unroll
                for (int i = 0; i < 16; ++i) { lv[i] = p[(cb + i) * 64]; dv[i] = dd[(cb + i) * 64]; }
#pragma unroll
                for (int i = 0; i < 16; ++i) { if (!dry) p[(cb + i) * 64] = ns; ns = dv[i] * (ns + lv[i]); }
            }
        }
    }
}
__device__ __forceinline__ void phase_kmean(Frame& F, const bf16_t* P, float* kmean) {
    const int lane = opaque_i(F.lane), sub = lane >> 4, cl = lane & 15, tid = F.wave * 64 + lane;
    LAS float* part = (LAS float*)F.lds;
    for (int u = F.bid; u < BATCH * 8 * 16; u += F.G) {
        const int blk = u & 15, h = (u >> 4) & 7, b = u >> 7;
        const bf16_t* base = P + (size_t)(b * SEQ + blk * 256 + F.wave * 32 + sub) * PP + 1024 + h * 128 + cl * 8;
        float m[8];
#pragma unroll
        for (int e = 0; e < 8; ++e) m[e] = 0.f;
        u32x4 w[8];
#pragma unroll
        for (int it = 0; it < 8; ++it) w[it] = *(const u32x4*)(base + (size_t)it * 4 * PP);
#pragma unroll
        for (int it = 0; it < 8; ++it)
#pragma unroll
            for (int e = 0; e < 4; ++e) { m[2 * e] += __uint_as_float(w[it][e] << 16); m[2 * e + 1] += __uint_as_float(w[it][e] & 0xffff0000u); }
#pragma unroll
        for (int e = 0; e < 8; ++e) { m[e] += __shfl_xor(m[e], 16); m[e] += __shfl_xor(m[e], 32); }
        if (sub == 0) { *(LAS f32x4*)(part + F.wave * 128 + cl * 8) = (f32x4){m[0], m[1], m[2], m[3]}; *(LAS f32x4*)(part + F.wave * 128 + cl * 8 + 4) = (f32x4){m[4], m[5], m[6], m[7]}; }
        __syncthreads();
        if (tid < 128) { float sacc = 0.f;
#pragma unroll
            for (int wv = 0; wv < 8; ++wv) sacc += part[wv * 128 + tid];
            float* km = kmean + (size_t)u * 256; km[tid] = sacc * (1.f / 256.f); km[128 + tid] = 0.f; }
        __syncthreads();
    }
}

namespace att {
typedef short bf16x8 __attribute__((ext_vector_type(8)));
typedef short s16x4 __attribute__((ext_vector_type(4)));
typedef float f32x16 __attribute__((ext_vector_type(16)));
constexpr int SHM_V = 16384, SHM_K = 16384, OFF_V = 0, OFF_K = 3 * SHM_V, OFF_WS = 3 * SHM_V + 3 * SHM_K;
constexpr float THR = 8.f;
#define KSWZ(row, colB) ((row) * 256 + ((colB) ^ (((row) & 7) << 4)))
#define SBAR() __builtin_amdgcn_sched_barrier(0)
typedef LAS char* lptr;
__device__ __forceinline__ int crow(int r, int hi) { return (r & 3) + 8 * (r >> 2) + 4 * hi; }
__device__ __forceinline__ unsigned cvtpk(float lo, float hi) { unsigned r; asm volatile("v_cvt_pk_bf16_f32 %0, %1, %2" : "=v"(r) : "v"(lo), "v"(hi)); return r; }
__device__ __forceinline__ void partialSM(f32x16& p0, f32x16& p1, float& m_reg, float& mn, float& alpha, float slope, float base, bool ok, bool diag, int dq) {
    constexpr float C = 1.4426950408889634f;
    if (diag) {
#pragma unroll
        for (int r = 0; r < 16; ++r) { const int c = (r & 3) + 8 * (r >> 2); if (c > dq) p0[r] = -INFINITY; if (c + 32 > dq) p1[r] = -INFINITY; }
    }
    const float bm = ok ? base : -INFINITY;
    mn = m_reg; alpha = 1.f;
    const float add = (bm - mn) * C;
#pragma unroll
    for (int r = 0; r < 16; ++r) p0[r] = fmaf(p0[r], C, add);
#pragma unroll
    for (int r = 0; r < 16; ++r) p1[r] = fmaf(p1[r], C, add);
#pragma unroll
    for (int r = 0; r < 16; ++r) p0[r] = __builtin_amdgcn_exp2f(p0[r]);
}
__device__ __forceinline__ void finishSM(f32x16& p0, f32x16& p1, float alpha, float& l_reg, bf16x8& pa0, bf16x8& pa1, bf16x8& pa2, bf16x8& pa3) {
#pragma unroll
    for (int r = 0; r < 16; ++r) p1[r] = __builtin_amdgcn_exp2f(p1[r]);
    float ps = 0;
#pragma unroll
    for (int r = 0; r < 16; ++r) ps += p0[r];
#pragma unroll
    for (int r = 0; r < 16; ++r) ps += p1[r];
    { auto rr = __builtin_amdgcn_permlane32_swap(__float_as_uint(ps), __float_as_uint(ps), false, false);
      ps = __uint_as_float(rr[0]) + __uint_as_float(rr[1]); }
    l_reg = l_reg * alpha + ps;
#define PK4(P, BASE, OUT) do { unsigned a0 = cvtpk(P[BASE + 0], P[BASE + 1]), a1 = cvtpk(P[BASE + 2], P[BASE + 3]);   \
    unsigned b0 = cvtpk(P[BASE + 4], P[BASE + 5]), b1 = cvtpk(P[BASE + 6], P[BASE + 7]);                              \
    auto r0 = __builtin_amdgcn_permlane32_swap(a0, b0, false, false); auto r1 = __builtin_amdgcn_permlane32_swap(a1, b1, false, false); \
    u32x4 w = {r0[0], r1[0], r0[1], r1[1]}; OUT = *reinterpret_cast<bf16x8*>(&w); } while (0)
    PK4(p0, 0, pa0); PK4(p0, 8, pa1); PK4(p1, 0, pa2); PK4(p1, 8, pa3);
#undef PK4
}
__device__ __forceinline__ void qkt(f32x16& p0, f32x16& p1, lptr Ks, const bf16x8* qr, int r32, int hi, bf16x8 kx0, bf16x8 kx1, bf16x8 qx) {
    p0 = f32x16{}; p1 = f32x16{};
#pragma unroll
    for (int d0 = 0; d0 < 8; ++d0) { const int cb = (d0 * 16 + hi * 8) * 2;
        const bf16x8 b0 = *(const LAS bf16x8*)(Ks + KSWZ(r32, cb));
        const bf16x8 b1 = *(const LAS bf16x8*)(Ks + KSWZ(32 + r32, cb));
        p0 = __builtin_amdgcn_mfma_f32_32x32x16_bf16(b0, qr[d0], p0, 0, 0, 0);
        p1 = __builtin_amdgcn_mfma_f32_32x32x16_bf16(b1, qr[d0], p1, 0, 0, 0); }
    p0 = __builtin_amdgcn_mfma_f32_32x32x16_bf16(kx0, qx, p0, 0, 0, 0);
    p1 = __builtin_amdgcn_mfma_f32_32x32x16_bf16(kx1, qx, p1, 0, 0, 0);
}
__device__ __forceinline__ int v_st(int k, int c) { const int kk = (k & ~0xC) | ((k & 4) << 1) | ((k & 8) >> 1); return ((kk >> 3) * 4 + (c >> 5)) * 512 + ((kk & 7) * 32 + (c & 31)) * 2; }
__device__ __forceinline__ int v_rd_base(int lane) { return ((lane & 3) << 3) | (((lane >> 2) & 3) << 6) | (((lane >> 4) & 1) << 5) | (((lane >> 5) & 1) << 8); }
constexpr int v_rd_off(int d0, int ks, int half) { return d0 * 512 + ks * 4096 + half * 2048; }
template <int OFF> __device__ __forceinline__ s16x4 tr_read(int vb) {
    s16x4 r; asm volatile("ds_read_b64_tr_b16 %0, %1 offset:%2" : "=&v"(r) : "v"(vb), "i"(OFF) : "memory"); return r;
}
template <int D0> __device__ __forceinline__ void pv_one(f32x16& od, int vb, bf16x8 pa0, bf16x8 pa1, bf16x8 pa2, bf16x8 pa3) {
    const s16x4 l0 = tr_read<v_rd_off(D0, 0, 0)>(vb), h0 = tr_read<v_rd_off(D0, 0, 1)>(vb), l1 = tr_read<v_rd_off(D0, 1, 0)>(vb), h1 = tr_read<v_rd_off(D0, 1, 1)>(vb);
    const s16x4 l2 = tr_read<v_rd_off(D0, 2, 0)>(vb), h2 = tr_read<v_rd_off(D0, 2, 1)>(vb), l3 = tr_read<v_rd_off(D0, 3, 0)>(vb), h3 = tr_read<v_rd_off(D0, 3, 1)>(vb);
    asm volatile("s_waitcnt lgkmcnt(0)" ::: "memory"); SBAR();
#define PK(L, H) (bf16x8){L[0], L[1], L[2], L[3], H[0], H[1], H[2], H[3]}
    od = __builtin_amdgcn_mfma_f32_32x32x16_bf16(pa0, PK(l0, h0), od, 0, 0, 0);
    od = __builtin_amdgcn_mfma_f32_32x32x16_bf16(pa1, PK(l1, h1), od, 0, 0, 0);
    od = __builtin_amdgcn_mfma_f32_32x32x16_bf16(pa2, PK(l2, h2), od, 0, 0, 0);
    od = __builtin_amdgcn_mfma_f32_32x32x16_bf16(pa3, PK(l3, h3), od, 0, 0, 0);
#undef PK
}
__device__ __forceinline__ void pv_d0(f32x16* o, int vb, bf16x8 pa0, bf16x8 pa1, bf16x8 pa2, bf16x8 pa3) {
    pv_one<0>(o[0], vb, pa0, pa1, pa2, pa3); pv_one<1>(o[1], vb, pa0, pa1, pa2, pa3); pv_one<2>(o[2], vb, pa0, pa1, pa2, pa3); pv_one<3>(o[3], vb, pa0, pa1, pa2, pa3);
}

__device__ __forceinline__ void unit(bf16_t* P, const float* kmean, int b, int h, int qb, lptr lds, unsigned ldsaddr, float mref, bool dry) {
    int tid_ = threadIdx.x; asm volatile("" : "+v"(tid_));
    const int tid = tid_, wid = __builtin_amdgcn_readfirstlane(tid >> 6), lane = tid & 63, r32 = lane & 31, hi = lane >> 5;
    lptr V_lds = lds + OFF_V; lptr K_lds = lds + OFF_K;
    LAS float* wsl = (LAS float*)(lds + OFF_WS) + wid * 64; LAS float* li_l = wsl; LAS float* al_l = wsl + 32;
    const int q0 = qb * 256, tpos = q0 + wid * 32 + r32;
    const bf16_t* Qw = P + (size_t)(b * SEQ + tpos) * PP + h * 128 + hi * 8;
    const bf16_t* Kh = P + (size_t)(b * SEQ) * PP + 1024 + h * 128;
    const bf16_t* Vh = P + (size_t)(b * SEQ) * PP + 2048 + h * 128;
    float m_reg = mref, l_reg = 0; f32x16 o[4] = {}; bf16x8 qr[8];
#pragma unroll
    for (int d0 = 0; d0 < 8; ++d0) qr[d0] = *(const bf16x8*)(Qw + d0 * 16);
    const float slope = exp2f(-(float)(h + 1));
    bf16x8 kx0 = {0, 0, 0, 0, 0, 0, 0, 0}, kx1 = {0, 0, 0, 0, 0, 0, 0, 0}, qx = {0, 0, 0, 0, 0, 0, 0, 0};
    if (hi == 0) { kx0[0] = (short)(__float_as_uint(slope * (float)r32) >> 16); kx1[0] = (short)(__float_as_uint(slope * (float)(32 + r32)) >> 16); qx[0] = (short)0x3F80; }
    const int sr = tid >> 4, sc = (tid & 15) * 8, vst0 = v_st(sr, sc), vst1 = v_st(32 + sr, sc);
    const int vb0 = (int)ldsaddr + OFF_V + v_rd_base(lane);
    struct { bf16x8 vs0, vs1, ks0, ks1; } sr_[2];
#define SLOAD(i, k0) do { sr_[i].vs0 = *(const bf16x8*)(&Vh[(size_t)((k0) + sr) * PP + sc]); sr_[i].vs1 = *(const bf16x8*)(&Vh[(size_t)((k0) + 32 + sr) * PP + sc]); \
    sr_[i].ks0 = *(const bf16x8*)(&Kh[(size_t)((k0) + sr) * PP + sc]); sr_[i].ks1 = *(const bf16x8*)(&Kh[(size_t)((k0) + 32 + sr) * PP + sc]); } while (0)
#define SWRITE(bb, i) do { *(LAS bf16x8*)(V_lds + (bb) * SHM_V + vst0) = sr_[i].vs0;          \
    *(LAS bf16x8*)(V_lds + (bb) * SHM_V + vst1) = sr_[i].vs1; const int kc = sc * 2;               \
    *(LAS bf16x8*)(K_lds + (bb) * SHM_K + KSWZ(sr, kc)) = sr_[i].ks0;                       \
    *(LAS bf16x8*)(K_lds + (bb) * SHM_K + KSWZ(32 + sr, kc)) = sr_[i].ks1; } while (0)
    SLOAD(0, 0); SLOAD(1, 64);
    unsigned selmask = 0u;
    {
        float v0 = -INFINITY, v1 = -INFINITY, v2 = -INFINITY; int i0 = -1, i1 = -1, i2 = -1;
        { const int n_ = tid >> 5, d_ = (tid & 31) * 4; const float* km = kmean + ((size_t)((b * 8 + h) * 16 + n_)) * 256 + d_;
          *(LAS f32x4*)(lds + tid * 16) = *(const f32x4*)km + *(const f32x4*)(km + 128); }
        float qf[64];
#pragma unroll
        for (int d0 = 0; d0 < 8; ++d0)
#pragma unroll
            for (int e = 0; e < 8; ++e) qf[d0 * 8 + e] = bf2f((bf16_t)qr[d0][e]);
        __syncthreads();
        for (int n = 0; n < qb; ++n) {
            LAS const float* km = (LAS const float*)(lds + n * 512) + hi * 8;
            float s = 0.f;
#pragma unroll
            for (int d0 = 0; d0 < 8; ++d0) { const f32x4 ka = *(LAS const f32x4*)(km + d0 * 16), kb = *(LAS const f32x4*)(km + d0 * 16 + 4);
                s += qf[d0 * 8 + 0] * ka[0] + qf[d0 * 8 + 1] * ka[1] + qf[d0 * 8 + 2] * ka[2] + qf[d0 * 8 + 3] * ka[3]
                   + qf[d0 * 8 + 4] * kb[0] + qf[d0 * 8 + 5] * kb[1] + qf[d0 * 8 + 6] * kb[2] + qf[d0 * 8 + 7] * kb[3]; }
            s += __shfl_xor(s, 32);
            if (s > v0) { v2 = v1; i2 = i1; v1 = v0; i1 = i0; v0 = s; i0 = n; }
            else if (s > v1) { v2 = v1; i2 = i1; v1 = s; i1 = n; }
            else if (s > v2) { v2 = s; i2 = n; }
        }
        __syncthreads();
        if (i0 >= 0) selmask |= 1u << i0; if (i1 >= 0) selmask |= 1u << i1; if (i2 >= 0) selmask |= 1u << i2;
    }
#define SWAIT() asm volatile("s_waitcnt vmcnt(4)" ::: "memory")
#define RESC(a) do { if (__any((a) < 1.f)) { if (hi == 0) al_l[r32] = (a); asm volatile("s_waitcnt lgkmcnt(0)" ::: "memory"); \
    _Pragma("unroll") for (int d = 0; d < 4; ++d) _Pragma("unroll") for (int r = 0; r < 16; ++r) o[d][r] *= al_l[crow(r, hi)]; } } while (0)
#define PSM(P0, P1, MN, AL, jj) do { const int j_ = (jj), n_ = j_ >> 2, k0_ = j_ * 64; const bool isd_ = n_ == qb; \
    const bool ok_ = isd_ || ((selmask >> n_) & 1u); const float base_ = slope * (float)(k0_ - tpos); \
    const bool nm_ = isd_ && (k0_ + 63 > q0 + wid * 32); \
    partialSM(P0, P1, m_reg, MN, AL, slope, base_, ok_, nm_, tpos - k0_ - 4 * hi); } while (0)
    f32x16 pA0, pA1, pB0, pB1; float mnA, mnB, alA, alB; bf16x8 pa0, pa1, pa2, pa3; const int NT = 4 * (qb + 1);
    SWAIT(); SWRITE(0, 0); SLOAD(0, 128);
    SWAIT(); SWRITE(1, 1); SLOAD(1, 192);
    __syncthreads();
    qkt(pA0, pA1, K_lds, qr, r32, hi, kx0, kx1, qx); PSM(pA0, pA1, mnA, alA, 0);
    int bprev = 0, bcur = 1, bnext = 2;
#define STEP(X0, X1, MNX, ALX, Y0, Y1, ALY, SETN, tt) do { const int t_ = (tt); \
        SBAR(); qkt(X0, X1, K_lds + bcur * SHM_K, qr, r32, hi, kx0, kx1, qx); \
        finishSM(Y0, Y1, ALY, l_reg, pa0, pa1, pa2, pa3); SBAR(); \
        pv_d0(o, vb0 + bprev * SHM_V, pa0, pa1, pa2, pa3); PSM(X0, X1, MNX, ALX, t_); \
        if (t_ + 1 < NT) { if (t_ + 2 < NT) SWAIT(); else asm volatile("s_waitcnt vmcnt(0)" ::: "memory"); SWRITE(bnext, SETN); if (t_ + 3 < NT) SLOAD(SETN, (t_ + 3) * 64); } \
        __syncthreads(); \
        bprev = bcur; bcur = bnext; bnext = (bnext == 2) ? 0 : bnext + 1; } while (0)
    for (int t = 1; t + 1 < NT; t += 2) {
        STEP(pB0, pB1, mnB, alB, pA0, pA1, alA, 0, t);
        STEP(pA0, pA1, mnA, alA, pB0, pB1, alB, 1, t + 1);
    }
    STEP(pB0, pB1, mnB, alB, pA0, pA1, alA, 0, NT - 1);
#undef STEP
    finishSM(pB0, pB1, alB, l_reg, pa0, pa1, pa2, pa3); SBAR();
    pv_d0(o, vb0 + bprev * SHM_V, pa0, pa1, pa2, pa3);
    if (hi == 0) li_l[r32] = l_reg; asm volatile("s_waitcnt lgkmcnt(0)" ::: "memory");
    float rli[16];
#pragma unroll
    for (int r = 0; r < 16; ++r) rli[r] = __builtin_amdgcn_rcpf(li_l[crow(r, hi)]);
    bf16_t* Ow = P + (size_t)(b * SEQ + q0 + wid * 32) * PP + h * 128;
#pragma unroll
    for (int r = 0; r < 16; ++r) { const int orow = crow(r, hi);
#pragma unroll
        for (int d0 = 0; d0 < 4; ++d0) if (!dry) Ow[(size_t)orow * PP + d0 * 32 + r32] = (bf16_t)f2bf(o[d0][r] * rli[r]); }
    __syncthreads();
#undef SLOAD
#undef SWRITE
#undef SWAIT
#undef RESC
#undef PSM
}
}
__device__ __forceinline__ void phase_attn(Frame& F, bf16_t* P, const float* kmean, const float* qg, const float* kg, unsigned* qctr, bool dry = false) {
    const int ln_ = opaque_i(F.lane);
    float gq = fmaxf(fabsf(qg[ln_]), fabsf(qg[64 + ln_])), gk = fmaxf(fabsf(kg[ln_]), fabsf(kg[64 + ln_]));
    gq = wave_max(gq); gk = wave_max(gk);
    const float mref = __uint_as_float((unsigned)__builtin_amdgcn_readfirstlane((int)__float_as_uint(1.02f * 11.313708498984761f * gq * gk)));
    if ((F.G & 7) == 0) {
        LAS unsigned* qw = (LAS unsigned*)(F.lds + att::OFF_WS + 4096);
        const int q = F.bid & 7;
        for (;;) {
            if (F.tid == 0) *qw = __hip_atomic_fetch_add(qctr + 64 * q, 1u, __ATOMIC_RELAXED, __HIP_MEMORY_SCOPE_AGENT);
            __syncthreads();
            const unsigned r = *qw;
            __syncthreads();
            if (r >= 64u) break;
            const int qb = 15 - (int)(r >> 2), bh = q * 4 + (int)(r & 3u);
            att::unit(P, kmean, bh >> 3, bh & 7, qb, (att::lptr)F.lds, (unsigned)(uintptr_t)F.ldsg, mref, dry);
        }
    } else {
        for (int pi = F.bid; pi < 256; pi += F.G) {
            const int bh = pi >> 3, p = pi & 7;
            att::unit(P, kmean, bh >> 3, bh & 7, 15 - p, (att::lptr)F.lds, (unsigned)(uintptr_t)F.ldsg, mref, dry);
            att::unit(P, kmean, bh >> 3, bh & 7, p, (att::lptr)F.lds, (unsigned)(uintptr_t)F.ldsg, mref, dry);
        }
    }
}

namespace scn {
using att::bf16x8; using att::f32x16; using att::lptr; using att::s16x4;
constexpr int HSLOT = 32768, O_VI = 0, O_BK = 16384, O_AQ = 24576;
constexpr int X_WS = RING_BYTES + 1024, X_SMALL = RING_BYTES + 6144;
__device__ __forceinline__ int swz(int row, int chunk) { return row * 128 + ((chunk ^ ((row >> 1) & 7)) << 4); }

__device__ __forceinline__ float small_proj(const ScanArgs& a, int row0, lptr lds, int wid, int lane) {
    const int fr = lane & 15, fq = lane >> 4;
    const bf16_t* xa = a.xb + (size_t)(row0 + fr) * DM + 128 * wid + 8 * fq;
    const bf16_t* wb = a.wsm + (size_t)fr * DM + 128 * wid + 8 * fq;
    bf16x8 X[4][4], W[2][4];
#pragma unroll
    for (int rb = 0; rb < 4; ++rb)
#pragma unroll
        for (int s = 0; s < 4; ++s) X[rb][s] = *(const bf16x8*)(xa + (size_t)(16 * rb) * DM + 32 * s);
#pragma unroll
    for (int cb = 0; cb < 2; ++cb)
#pragma unroll
        for (int s = 0; s < 4; ++s) W[cb][s] = *(const bf16x8*)(wb + (size_t)(16 * cb) * DM + 32 * s);
    const float rs = row_rstd(a.rss, row0 + ((wid * 64 + lane) >> 3));
    f32x4 c[4][2];
#pragma unroll
    for (int rb = 0; rb < 4; ++rb)
#pragma unroll
        for (int cb = 0; cb < 2; ++cb) { c[rb][cb] = (f32x4){0.f, 0.f, 0.f, 0.f};
#pragma unroll
            for (int s = 0; s < 4; ++s) c[rb][cb] = __builtin_amdgcn_mfma_f32_16x16x32_bf16(W[cb][s], X[rb][s], c[rb][cb], 0, 0, 0); }
    LAS float* part = (LAS float*)(lds + (wid >> 1) * HSLOT + O_BK + (wid & 1) * 8192);
#pragma unroll
    for (int rb = 0; rb < 4; ++rb)
#pragma unroll
        for (int cb = 0; cb < 2; ++cb) *(LAS f32x4*)(part + (16 * rb + fr) * 32 + 16 * cb + 4 * fq) = c[rb][cb];
    return rs;
}
__device__ __forceinline__ void small_reduce(float rs, lptr lds, int tid) {
    f32x4 s = {0.f, 0.f, 0.f, 0.f};
#pragma unroll
    for (int w = 0; w < 8; ++w) s += *(const LAS f32x4*)(lds + (w >> 1) * HSLOT + O_BK + (w & 1) * 8192 + tid * 16);
    *(LAS f32x4*)(lds + X_SMALL + tid * 16) = s * rs;
}
__device__ __forceinline__ size_t side_off(int b, int c, int t, int mat, int h) { return ((size_t)((b * NCH + c) * 3 + (t - 61))) * 512 + mat * 256 + h * 64; }

__device__ __forceinline__ void gate_full(const ScanArgs& a, int b, int c, int grp, int h, int half, lptr lds, lptr slot, int lane, LAS float* wsl, float& bc_end, float& nsum, bool dry) {
    const int k = lane, row0 = b * SEQ + c * CH, t0 = 32 * half;
    LAS const float* sml = (LAS const float*)(lds + X_SMALL);
    nsum = 0.f;
    unsigned rq[32], rk[32]; float cs[32];
    float wk0 = 0.f, wk1 = 0.f, wk2 = 0.f, wk3 = 0.f, wq0 = 0.f, wq1 = 0.f, wq2 = 0.f, wq3 = 0.f, bi = 0.f;
    float k1 = 0.f, k2 = 0.f, k3 = 0.f, q1 = 0.f, q2 = 0.f, q3 = 0.f;
    const int cq_ = (grp == 0 ? C_GQ : C_MQ) + h * 64 + k, ck_ = (grp == 0 ? C_GK : C_MK) + h * 64 + k;
    bf16_t* prow = a.P + (size_t)(row0 + t0) * PP;
#pragma unroll
    for (int i = 0; i < 32; ++i) { rk[i] = prow[(size_t)i * PP + ck_]; rq[i] = prow[(size_t)i * PP + cq_]; }
    if (grp == 0) {
        const float bg = a.bgate[h * 64 + k];
        const int r32 = lane & 31, hi8 = (lane >> 5) * 8;
        const LAS f32x4* g4 = (const LAS f32x4*)(sml + (t0 + r32) * 32 + hi8);
        const f32x4 ga = g4[0], gb = g4[1];
        float wv0[8], wv1[8];
#pragma unroll
        for (int e = 0; e < 8; ++e) { wv0[e] = a.w2[(hi8 + e) * 256 + h * 64 + r32]; wv1[e] = a.w2[(hi8 + e) * 256 + h * 64 + 32 + r32]; }
        u32x4 aw; aw.x = pk2(ga.x, ga.y); aw.y = pk2(ga.z, ga.w); aw.z = pk2(gb.x, gb.y); aw.w = pk2(gb.z, gb.w);
        u32x4 bw0; bw0.x = pk2(wv0[0], wv0[1]); bw0.y = pk2(wv0[2], wv0[3]); bw0.z = pk2(wv0[4], wv0[5]); bw0.w = pk2(wv0[6], wv0[7]);
        u32x4 bw1; bw1.x = pk2(wv1[0], wv1[1]); bw1.y = pk2(wv1[2], wv1[3]); bw1.z = pk2(wv1[4], wv1[5]); bw1.w = pk2(wv1[6], wv1[7]);
        f32x16 d0 = {}, d1 = {};
        d0 = __builtin_amdgcn_mfma_f32_32x32x16_bf16(*reinterpret_cast<bf16x8*>(&aw), *reinterpret_cast<bf16x8*>(&bw0), d0, 0, 0, 0);
        d1 = __builtin_amdgcn_mfma_f32_32x32x16_bf16(*reinterpret_cast<bf16x8*>(&aw), *reinterpret_cast<bf16x8*>(&bw1), d1, 0, 0, 0);
#pragma unroll
        for (int r = 0; r < 16; ++r) { const int tk = (r & 3) + 8 * (r >> 2);
            auto sw = __builtin_amdgcn_permlane32_swap(__float_as_uint(d0[r]), __float_as_uint(d1[r]), false, false);
            cs[tk] = __uint_as_float(sw[0]); cs[tk + 4] = __uint_as_float(sw[1]); }
        float run = 0.f;
#pragma unroll
        for (int i = 0; i < 32; ++i) { run += logsigmoidf_(cs[i] + bg) * (1.f / 16.f); cs[i] = run; }
    } else {
        bi = a.bif[h]; const float bf = a.bif[4 + h];
        wk0 = a.convw[0 * 512 + 256 + h * 64 + k]; wk1 = a.convw[1 * 512 + 256 + h * 64 + k]; wk2 = a.convw[2 * 512 + 256 + h * 64 + k]; wk3 = a.convw[3 * 512 + 256 + h * 64 + k];
        wq0 = a.convw[0 * 512 + h * 64 + k]; wq1 = a.convw[1 * 512 + h * 64 + k]; wq2 = a.convw[2 * 512 + h * 64 + k]; wq3 = a.convw[3 * 512 + h * 64 + k];
        if (c * CH + t0 > 0) {
            const bf16_t* p1 = prow - PP; const bf16_t* p2 = p1 - PP; const bf16_t* p3 = p2 - PP;
            k1 = bf2f(p1[ck_]); k2 = bf2f(p2[ck_]); k3 = bf2f(p3[ck_]); q1 = bf2f(p1[cq_]); q2 = bf2f(p2[cq_]); q3 = bf2f(p3[cq_]);
        }
        float run = 0.f;
#pragma unroll
        for (int i = 0; i < 32; ++i) { run += logsigmoidf_(sml[(t0 + i) * 32 + 20 + h] + bf); cs[i] = run; }
    }
    wsl[lane] = cs[31];
    asm volatile("s_waitcnt vmcnt(0)" ::: "memory");
    __syncthreads();
    const float off = half ? (wsl - 128)[lane] : 0.f;
    bc_end = off + cs[31];
#pragma unroll
    for (int i8 = 0; i8 < 4; ++i8) {
        unsigned pk[8];
#pragma unroll
        for (int e = 0; e < 8; ++e) { const int i = i8 * 8 + e, t = t0 + i; const float bc = off + cs[i];
            float bv, av;
            if (grp == 0) {
                const float ex = __expf(bc);
                bv = __uint_as_float(rk[i] << 16) * __builtin_amdgcn_rcpf(ex);
                av = __uint_as_float(rq[i] << 16) * 0.125f * ex;
            } else {
                const float ip = sml[t * 32 + 16 + h] + bi;
                const float kc = __uint_as_float(rk[i] << 16);
                const float ck = wk0 * k3 + wk1 * k2 + wk2 * k1 + wk3 * kc; k3 = k2; k2 = k1; k1 = kc;
                bv = siluf_(ck) * 0.125f * __expf(ip - bc);
                const float qc = __uint_as_float(rq[i] << 16);
                const float cq = wq0 * q3 + wq1 * q2 + wq2 * q1 + wq3 * qc; q3 = q2; q2 = q1; q1 = qc;
                av = siluf_(cq) * __expf(bc);
            }
            const unsigned pkab = pk2(bv, av); nsum += bv; pk[e] = pkab & 0xffffu;
            const bf16_t ab = (bf16_t)(pkab >> 16), bb = (bf16_t)pk[e];
            if (RPT && dry) { asm volatile("" :: "v"((unsigned)ab), "v"((unsigned)bb)); }
            if (!dry) { if (grp == 1 && t >= 61) { bf16_t* sd = a.side + side_off(b, c, t, 0, h) + k; sd[0] = ab; sd[256] = bb; }
            else if (NT_ST & 32) { __builtin_nontemporal_store(ab, prow + (size_t)i * PP + cq_); __builtin_nontemporal_store(bb, prow + (size_t)i * PP + ck_); }
            else { prow[(size_t)i * PP + cq_] = ab; prow[(size_t)i * PP + ck_] = bb; if (VARX & 4) { asm volatile("" ::: "memory"); prow[(size_t)i * PP + cq_] = ab; prow[(size_t)i * PP + ck_] = bb; } } } }
        { u32x4 w; w.x = pk[0] | (pk[1] << 16); w.y = pk[2] | (pk[3] << 16); w.z = pk[4] | (pk[5] << 16); w.w = pk[6] | (pk[7] << 16);
          *(LAS u32x4*)(slot + O_BK + swz(k, (t0 >> 3) + i8)) = w; }
    }
}

struct StageRegs { bf16x8 v[8]; bf16x8 ab[8]; };
__device__ __forceinline__ void stage_v_load(StageRegs& R, const ScanArgs& a, int row0, int grp, int h, int ht) {
    const bf16_t* Vg = a.P + (size_t)row0 * PP + (grp == 0 ? C_GV : C_MV) + h * 128;
#pragma unroll
    for (int i = 0; i < 8; ++i) { const int idx = ht + 128 * i, srow = idx >> 4, sc = (idx & 15) * 8; R.v[i] = *(const bf16x8*)(Vg + (size_t)srow * PP + sc); }
}
__device__ __forceinline__ void stage_v_write(const StageRegs& R, lptr slot, int ht) {
#pragma unroll
    for (int i = 0; i < 8; ++i) { const int idx = ht + 128 * i, srow = idx >> 4, sc = (idx & 15) * 8; *(LAS bf16x8*)(slot + O_VI + att::v_st(srow, sc)) = R.v[i]; }
}
__device__ __forceinline__ void stage_ab_load(StageRegs& R, const ScanArgs& a, int b, int c, int grp, int h, int ht) {
    const int row0 = b * SEQ + c * CH;
#pragma unroll
    for (int i = 0; i < 8; ++i) { const int idx = ht + 128 * i, mat = idx >> 9, r = (idx >> 3) & 63, ch = idx & 7;
        const bf16_t* src = a.P + (size_t)(row0 + r) * PP + (grp == 0 ? (mat ? C_GK : C_GQ) : (mat ? C_MK : C_MQ)) + h * 64 + ch * 8;
        if (grp == 1 && r >= 61) src = a.side + side_off(b, c, r, mat, h) + ch * 8;
        R.ab[i] = *(const bf16x8*)src; }
}
__device__ __forceinline__ void stage_ab_write(const StageRegs& R, lptr slot, int ht) {
#pragma unroll
    for (int i = 0; i < 8; ++i) { const int idx = ht + 128 * i, mat = idx >> 9, r = (idx >> 3) & 63, ch = idx & 7;
        *(LAS bf16x8*)(slot + (mat ? O_BK : O_AQ) + swz(r, ch)) = R.ab[i]; }
}
}

__device__ __forceinline__ void phase_scan1m(Frame& F, const ScanArgs& a, bool dry = false) {
    using namespace scn;
    const int wid = __builtin_amdgcn_readfirstlane(threadIdx.x >> 6);
    const int hw = wid >> 1, half = wid & 1;
    lptr lds = (lptr)F.lds; lptr slot = lds + hw * HSLOT;
    LAS float* wsl = (LAS float*)(lds + X_WS) + wid * 128;
    const unsigned ldsaddr = (unsigned)(uintptr_t)F.ldsg;
    for (int unit0 = F.bid; unit0 < BATCH * NCH; unit0 += F.G) {
        const int unit = (F.G == 256) ? (((unit0 & 7) >> 1) * NCH + 32 * (unit0 & 1) + (unit0 >> 3)) : unit0;
        const int b = unit / NCH, c = unit % NCH, row0 = b * SEQ + c * CH;
        if (c == 32) {
            if (threadIdx.x == 0) { XB_SPIN(xb_ld(&a.hflag[b * 16]) < a.htarget, a.tmo); __builtin_amdgcn_fence(__ATOMIC_ACQUIRE, "agent"); asm volatile("s_waitcnt vmcnt(0)" ::: "memory"); }
            __syncthreads();
        }
        StageRegs SR; float rs_small;
        { const int t0_ = opaque_i(threadIdx.x) & 127; stage_v_load(SR, a, row0, 0, hw, t0_);
          rs_small = small_proj(a, row0, lds, wid, opaque_i(threadIdx.x) & 63);
          stage_v_write(SR, slot, t0_); }
        __syncthreads();
        small_reduce(rs_small, lds, opaque_i(threadIdx.x));
        for (int grp = 0; grp < 2; ++grp) {
            const int tid = opaque_i(threadIdx.x), lane = tid & 63, r32 = lane & 31, hi = lane >> 5;
            const int h = hw, bh = b * 4 + h;
            if (grp == 0) stage_v_load(SR, a, row0, 1, h, tid & 127);
            __syncthreads();
            float bc_end, nsum;
            gate_full(a, b, c, grp, h, half, lds, slot, lane, wsl, bc_end, nsum, dry);
            if (half == 1 && !dry) a.dec[((size_t)(grp * 16 + bh) * NCH + c) * 64 + lane] = __expf(bc_end);
            if (grp == 1) wsl[64 + lane] = nsum;
            __syncthreads();
            if (grp == 1 && half == 0 && !dry) { LAS float* other = wsl + 128; a.NS[((size_t)bh * NCH + c) * 64 + lane] = wsl[64 + lane] + other[64 + lane]; }
            bf16x8 pa[4];
#pragma unroll
            for (int ks = 0; ks < 4; ++ks) pa[ks] = *(LAS bf16x8*)(slot + O_BK + swz(32 * half + r32, 2 * ks + hi));
            f32x16 o[4] = {};
            att::pv_d0(o, (int)ldsaddr + hw * HSLOT + O_VI + att::v_rd_base(lane), pa[0], pa[1], pa[2], pa[3]);
            bf16_t* st = a.ST + st_off(grp, bh, c);
#pragma unroll
            for (int d0 = 0; d0 < 4; ++d0)
#pragma unroll
                for (int g = 0; g < 4; ++g) {
                    const unsigned long long w = (unsigned long long)pk2(o[d0][4 * g], o[d0][4 * g + 1]) | ((unsigned long long)pk2(o[d0][4 * g + 2], o[d0][4 * g + 3]) << 32);
                    if (!dry) { if (NT_ST & 16) __builtin_nontemporal_store(w, (unsigned long long*)(st + (size_t)(32 * d0 + r32) * 64 + 32 * half + 8 * g + 4 * hi)); else *(unsigned long long*)(st + (size_t)(32 * d0 + r32) * 64 + 32 * half + 8 * g + 4 * hi) = w; } }
            __syncthreads();
            if (grp == 0) stage_v_write(SR, slot, tid & 127);
        }
    }
}
__device__ __forceinline__ void phase_scan3m(Frame& F, const ScanArgs& a, bool dry = false) {
    using namespace scn;
    const int wid = __builtin_amdgcn_readfirstlane(threadIdx.x >> 6);
    const int hw = wid >> 1, half = wid & 1;
    lptr lds = (lptr)F.lds; lptr slot = lds + hw * HSLOT;
    LAS float* wsl = (LAS float*)(lds + X_WS) + wid * 128;
    const unsigned ldsaddr = (unsigned)(uintptr_t)F.ldsg;
    for (int unit0 = F.bid; unit0 < BATCH * NCH; unit0 += F.G) {
        const int unit = (F.G == 256) ? (((unit0 & 7) >> 1) * NCH + 32 * (unit0 & 1) + (unit0 >> 3)) : unit0;
        const int b = unit / NCH, c = unit % NCH, row0 = b * SEQ + c * CH;
        StageRegs SR;
        { const int t0_ = opaque_i(threadIdx.x) & 127; stage_v_load(SR, a, row0, 0, hw, t0_); stage_ab_load(SR, a, b, c, 0, hw, t0_); stage_v_write(SR, slot, t0_); stage_ab_write(SR, slot, t0_); }
        for (int grp = 0; grp < 2; ++grp) {
            const int tid = opaque_i(threadIdx.x), lane = tid & 63, r32 = lane & 31, hi = lane >> 5;
            const int h = hw, bh = b * 4 + h;
            if (grp == 0) { stage_v_load(SR, a, row0, 1, h, tid & 127); stage_ab_load(SR, a, b, c, 1, h, tid & 127); }
            __syncthreads();
            bf16x8 qr[4];
#pragma unroll
            for (int d0 = 0; d0 < 4; ++d0) qr[d0] = *(LAS bf16x8*)(slot + O_AQ + swz(32 * half + r32, 2 * d0 + hi));
            f32x16 p0 = {}, p1 = {};
#pragma unroll
            for (int d0 = 0; d0 < 4; ++d0) {
                const bf16x8 b0 = *(LAS bf16x8*)(slot + O_BK + swz(r32, 2 * d0 + hi));
                const bf16x8 b1 = *(LAS bf16x8*)(slot + O_BK + swz(32 + r32, 2 * d0 + hi));
                p0 = __builtin_amdgcn_mfma_f32_32x32x16_bf16(b0, qr[d0], p0, 0, 0, 0);
                p1 = __builtin_amdgcn_mfma_f32_32x32x16_bf16(b1, qr[d0], p1, 0, 0, 0); }
            const int dq = 32 * half + r32 - 4 * hi;
            float ps = 0.f;
#pragma unroll
            for (int r = 0; r < 16; ++r) { const int cc = (r & 3) + 8 * (r >> 2); if (cc > dq) p0[r] = 0.f; if (cc + 32 > dq) p1[r] = 0.f; ps += p0[r] + p1[r]; }
            bf16x8 pa0, pa1, pa2, pa3;
#define PK4(P, BASE, OUT) do { unsigned a0 = att::cvtpk(P[BASE + 0], P[BASE + 1]), a1 = att::cvtpk(P[BASE + 2], P[BASE + 3]);   \
    unsigned b0_ = att::cvtpk(P[BASE + 4], P[BASE + 5]), b1_ = att::cvtpk(P[BASE + 6], P[BASE + 7]);                              \
    auto r0 = __builtin_amdgcn_permlane32_swap(a0, b0_, false, false); auto r1 = __builtin_amdgcn_permlane32_swap(a1, b1_, false, false); \
    u32x4 w = {r0[0], r1[0], r0[1], r1[1]}; OUT = *reinterpret_cast<bf16x8*>(&w); } while (0)
            PK4(p0, 0, pa0); PK4(p0, 8, pa1); PK4(p1, 0, pa2); PK4(p1, 8, pa3);
#undef PK4
            float den = 0.f;
            if (grp == 1) {
                const float* ns = a.NS + ((size_t)bh * NCH + c) * 64 + hi * 8;
#pragma unroll
                for (int d0 = 0; d0 < 4; ++d0) { const f32x4 na = *(const f32x4*)(ns + d0 * 16), nb = *(const f32x4*)(ns + d0 * 16 + 4); const bf16x8 q = qr[d0];
                    ps += bf2f((bf16_t)q[0]) * na[0] + bf2f((bf16_t)q[1]) * na[1] + bf2f((bf16_t)q[2]) * na[2] + bf2f((bf16_t)q[3]) * na[3]
                        + bf2f((bf16_t)q[4]) * nb[0] + bf2f((bf16_t)q[5]) * nb[1] + bf2f((bf16_t)q[6]) * nb[2] + bf2f((bf16_t)q[7]) * nb[3]; }
                den = ps + __shfl_xor(ps, 32);
            }
            f32x16 o[4] = {};
            att::pv_d0(o, (int)ldsaddr + hw * HSLOT + O_VI + att::v_rd_base(lane), pa0, pa1, pa2, pa3);
            const bf16_t* st = a.ST + st_off(grp, bh, c);
#pragma unroll
            for (int d0 = 0; d0 < 4; ++d0) {
                bf16x8 sv[4];
#pragma unroll
                for (int ks = 0; ks < 4; ++ks) sv[ks] = *(const bf16x8*)(st + (size_t)(32 * d0 + r32) * 64 + 16 * ks + 8 * hi);
#pragma unroll
                for (int ks = 0; ks < 4; ++ks) o[d0] = __builtin_amdgcn_mfma_f32_32x32x16_bf16(qr[ks], sv[ks], o[d0], 0, 0, 0);
            }
            if (grp == 1) { if (hi == 0) wsl[64 + r32] = den; }
            __syncthreads();
            LAS float* ot = (LAS float*)(slot + half * 16384);
#pragma unroll
            for (int d0 = 0; d0 < 4; ++d0)
#pragma unroll
                for (int r = 0; r < 16; ++r) ot[att::crow(r, hi) * 128 + 32 * d0 + r32] = o[d0][r];
            asm volatile("s_waitcnt lgkmcnt(0)" ::: "memory");
            const int gcol = (grp == 0 ? C_GR : C_MO) + h * 128, ch = lane & 15;
            const float* gain = (grp == 0 ? a.gla_gain : a.ml_gain) + h * 128 + ch * 8;
            const f32x4 ga = *(const f32x4*)gain, gb = *(const f32x4*)(gain + 4);
            u32x4 gw[8];
#pragma unroll
            for (int it = 0; it < 8; ++it) gw[it] = *(const u32x4*)(a.P + (size_t)(row0 + 32 * half + it * 4 + (lane >> 4)) * PP + gcol + ch * 8);
#pragma unroll
            for (int it = 0; it < 8; ++it) {
                const int rl = it * 4 + (lane >> 4);
                const f32x4 oa = *(LAS const f32x4*)(ot + rl * 128 + ch * 8), ob = *(LAS const f32x4*)(ot + rl * 128 + ch * 8 + 4);
                float ov[8] = {oa[0], oa[1], oa[2], oa[3], ob[0], ob[1], ob[2], ob[3]}, gv[8];
#pragma unroll
                for (int e = 0; e < 4; ++e) { gv[2 * e] = __uint_as_float(gw[it][e] << 16); gv[2 * e + 1] = __uint_as_float(gw[it][e] & 0xffff0000u); }
                if (grp == 1) { const float dd = __builtin_amdgcn_rcpf(fmaxf(fabsf(wsl[64 + rl]), 1.f));
#pragma unroll
                    for (int e = 0; e < 8; ++e) ov[e] = ov[e] * dd * sigmoidf_(gv[e]); }
                float ss = 0.f;
#pragma unroll
                for (int e = 0; e < 8; ++e) ss += ov[e] * ov[e];
                ss = row16_sum(ss);
                const float rstd = __builtin_amdgcn_rsqf(ss * (1.f / 128.f) + EPS);
                float y[8];
#pragma unroll
                for (int e = 0; e < 8; ++e) { y[e] = ov[e] * rstd * (e < 4 ? ga[e] : gb[e - 4]); if (grp == 0) y[e] *= siluf_(gv[e]); }
                u32x4 w; w.x = pk2(y[0], y[1]); w.y = pk2(y[2], y[3]); w.z = pk2(y[4], y[5]); w.w = pk2(y[6], y[7]);
                if (!dry) *(u32x4*)(a.P + (size_t)(row0 + 32 * half + rl) * PP + gcol + ch * 8) = w;
            }
            __syncthreads();
            if (grp == 0) { stage_v_write(SR, slot, tid & 127); stage_ab_write(SR, slot, tid & 127); }
        }
    }
}

__global__ void __launch_bounds__(NTHR, 2) mk_fwd(Args args) {
    extern __shared__ __attribute__((aligned(16))) unsigned char lds[];
    Frame F;
    F.lds = (LAS unsigned char*)lds; F.ldsg = lds;
    F.tid = threadIdx.x; F.lane = F.tid & 63; F.wave = __builtin_amdgcn_readfirstlane(F.tid >> 6);
    F.G = gridDim.x; F.bid = blockIdx.x;
    volatile LAS unsigned* MISC = (volatile LAS unsigned*)(F.lds + MISC_OFF);
    for (int u = F.tid; u < (LDS_BYTES - RING_BYTES) / 4; u += NTHR) ((LAS unsigned*)(F.lds + RING_BYTES))[u] = 0u;
    __syncthreads();
    XcdBarrier bar; bar.bar = (unsigned*)(karg_ws(karg_base()) + WS_CTL) + 4096; bar.x = 0; bar.st = nullptr;
    if (!MK_MULTI) bar = xcd_barrier_post((unsigned*)(karg_ws(karg_base()) + WS_CTL) + 4096, MISC + 8);
    if (!MK_MULTI && F.tid == 0) (void)__hip_atomic_fetch_or((unsigned*)(karg_ws(karg_base()) + WS_CTL) + LX_MASK(F.bid & 7), 1u << bar.x, __ATOMIC_RELAXED, __HIP_MEMORY_SCOPE_AGENT);
    const int lo = args.ph_lo, hi = args.ph_hi;
#define IN(k) (lo <= (k) && (k) < hi)
#define SEAM(k) do { if (!MK_MULTI && (k) + 1 < hi) { xcd_barrier(bar); if (RPT & 2048) xcd_barrier(bar); } } while (0)
#define KP()     karg_base()
#define WSP()    karg_ws(KP())
#define OUTP()   karg_out(KP())
#define RSSP()   ((float*)(WSP() + WS_RSS))
#define SMALLP_() ((float*)(WSP() + WS_SMALL))
#define KMEANP() ((float*)(WSP() + WS_KMEAN))
#define XBP()    ((bf16_t*)(WSP() + WS_XB))
#define PP_()    ((bf16_t*)(WSP() + WS_P))
#define WJ()     (WSP() + WS_W + (size_t)(l >> 1) * W_MIXSZ)
#define WL()     (WSP() + WS_W + W_FFN0 + (size_t)l * W_FFNSZ)
#define XIN()    (l == 0 ? karg_in(KP(), 0) : (const float*)OUTP())
#define MKSA()   const int j = l >> 1; kargp_t kp = KP(); unsigned char* ws = karg_ws(kp); \
    ScanArgs sa{(const bf16_t*)(ws + WS_XB), (const float*)(ws + WS_RSS), (const bf16_t*)(ws + WS_W + (size_t)j * W_MIXSZ + W_IN + (size_t)HYB_N * DM * 2), (bf16_t*)(ws + WS_SIDE), (bf16_t*)(ws + WS_P), karg_in(kp, 4) + (size_t)j * 16 * 256, karg_in(kp, 5) + j * 256, karg_in(kp, 6) + j * 512, \
                karg_in(kp, 7) + (size_t)j * 4 * 512, karg_in(kp, 8) + j * 8, karg_in(kp, 9) + j * 512, (bf16_t*)karg_out(kp)  , (float*)(ws + WS_DEC), (float*)(ws + WS_NS), (unsigned*)(ws + WS_CTL) + 14336, 2u * (unsigned)(j + 1), bar.bar}

    unsigned long long tpro_ = 0ull; if (PROBE_S == 7) tpro_ = __builtin_amdgcn_s_memrealtime();
    if (lo == 0) { if (PH_MASK & 1) { phase_prologue(F); if (RPT & 1) phase_prologue(F); } if (!MK_MULTI && 1 < hi) xcd_barrier(bar); }
    int light = 0;
    if (!MK_MULTI && LIGHT_SEAMS && lo == 0 && (F.G & 7) == 0) {
        if (F.tid == 0) { unsigned okm = 1u; unsigned* ctl_ = (unsigned*)(karg_ws(karg_base()) + WS_CTL);
            for (int g = 0; g < 8; ++g) { const unsigned m = xb_ld(&ctl_[LX_MASK(g)]); okm &= (m != 0u && (m & (m - 1u)) == 0u) ? 1u : 0u; }
            MISC[12] = okm; }
        __syncthreads();
        light = __builtin_amdgcn_readfirstlane((int)MISC[12]);
    }
    if (PROBE_S == 7) tpro_ = __builtin_amdgcn_s_memrealtime() - tpro_;
    unsigned long long tacc_ = (PROBE_S == 7) ? tpro_ : 0ull, t0_ = 0ull;
    for (int ph = lo < 1 ? 1 : lo; ph < hi; ++ph) {
        const bool probe_ = PROBE_S >= 0 && PROBE_S < 7 && ((ph - 1) & 7) == PROBE_S && ((((ph - 1) >> 3) & 1) == PROBE_ODD);
        if (probe_) t0_ = __builtin_amdgcn_s_memrealtime();
        {
            const int l = (ph - 1) >> 3, sidx = (ph - 1) & 7, odd = l & 1;
            const bool isg = sidx == 0 || sidx == 5 || sidx == 6 || sidx == (odd ? 3 : 4);
            if (isg) {
                pg8::Gemm g; EpiAny E; int nrep_ = 1;
                E.kind = 3; E.O = PP_(); E.lrs = nullptr; E.qg = nullptr; E.kg = nullptr; E.xch = nullptr; E.xch2 = nullptr; E.kmean = nullptr; E.ksum = nullptr;
                E.xout = nullptr; E.xb = nullptr; E.rss = nullptr; E.dry = 0; E.hflag = nullptr;
                if (sidx == 0 && !odd) { g = pg8::Gemm{XBP(), (const bf16_t*)(WJ() + W_IN), M, HYB_N, DM, DM}; E.kind = 0; E.lrs = (LAS float*)(F.lds + scn::X_SMALL); E.hflag = (unsigned*)(WSP() + WS_CTL) + 14336; if (RPT & 2) nrep_ = 2; }
                else if (sidx == 0) { g = pg8::Gemm{XBP(), (const bf16_t*)(WJ() + W_QKV), M, 3 * DM, DM, DM}; E.kind = 1; E.qg = karg_in(KP(), 12) + (l >> 1) * 128; E.kg = karg_in(KP(), 13) + (l >> 1) * 128;
                    E.xch = (LAS float*)(F.lds + scn::X_SMALL); E.xch2 = (LAS float*)(F.lds + scn::X_WS); E.kmean = KMEANP(); E.ksum = (LAS float*)(F.lds + RING_BYTES + 14336); E.lrs = (LAS float*)(F.lds + RING_BYTES + 2048); if (RPT & 64) nrep_ = 2; }
                else if (sidx == 5) { g = pg8::Gemm{XBP(), (const bf16_t*)(WL() + W_GU), M, 2 * DFF, DM, DM}; E.kind = 2; E.lrs = (LAS float*)(F.lds + scn::X_SMALL); if (RPT & 512) nrep_ = 2; }
                else if (sidx == 6) { g = pg8::Gemm{PP_(), (const bf16_t*)(WL() + W_D), M, DM, DFF, DFF}; if (RPT & 1024) nrep_ = 2; }
                else if (!odd) { g = pg8::Gemm{PP_() + C_GR, (const bf16_t*)(WJ() + W_OUT), M, DM, DM, PP}; if (RPT & 32) nrep_ = 2; }
                else { g = pg8::Gemm{PP_(), (const bf16_t*)(WJ() + W_O), M, DM, DM, PP}; if (RPT & 32) nrep_ = 2; }
                if (E.kind == 3) { E.xout = (l == DEPTH - 1 && sidx == 6) ? OUTP() : nullptr; E.xb = XBP(); E.rss = RSSP(); }
                pg8::StaticOrder S; S.init(M, g.N, F.G, F.bid);
                if (PH_MASK & 64) {
                    if (E.kind != 3) stage_rstd(S, RSSP(), (LAS float*)E.lrs);
                    for (int rep_ = 0; rep_ < nrep_; ++rep_) { E.dry = RPT ? opaque_i(rep_ + 1 < nrep_ ? 1 : 0) : 0; pg8::gemm_phase<EpiAny, pg8::StaticOrder, true, true>(F.lds, g, S, E); }
                }
            } else if (!odd && sidx == 1) { if (PH_MASK & 2) { MKSA(); if (RPT & 4) phase_scan1m(F, sa, RPT && opaque_i(1) != 0); phase_scan1m(F, sa, RPT && opaque_i(0) != 0); } }
            else if (!odd && sidx == 2) { if (PH_MASK & 4) { MKSA(); if (RPT & 8) phase_scan2(F, sa, RPT && opaque_i(1) != 0); phase_scan2(F, sa, RPT && opaque_i(0) != 0); } }
            else if (!odd && sidx == 3) { if (PH_MASK & 8) { MKSA(); if (RPT & 16) phase_scan3m(F, sa, RPT && opaque_i(1) != 0); phase_scan3m(F, sa, RPT && opaque_i(0) != 0); } }
            else if (odd && sidx == 2) { if (PH_MASK & 32) { const int j = l >> 1;
                if (RPT & 256) phase_attn(F, PP_(), KMEANP(), karg_in(KP(), 12) + j * 128, karg_in(KP(), 13) + j * 128, (unsigned*)(WSP() + WS_CTL) + 12288 + j * 512, RPT && opaque_i(1) != 0);
                phase_attn(F, PP_(), KMEANP(), karg_in(KP(), 12) + j * 128, karg_in(KP(), 13) + j * 128, (unsigned*)(WSP() + WS_CTL) + 8192 + j * 512, RPT && opaque_i(0) != 0); } }
            else continue;
        }
        if (probe_ && !PROBE_BAR) tacc_ += __builtin_amdgcn_s_memrealtime() - t0_;
        if (!MK_MULTI && ph + 1 < hi) {
            const int l_ = (ph - 1) >> 3, s_ = (ph - 1) & 7;
            if (light && (s_ == 5 || s_ == 6 || s_ == ((l_ & 1) ? 3 : 4) || (s_ == 3 && F.G == 256) || (s_ == 0 && !(l_ & 1) && F.G == 256))) xcd_local_barrier((unsigned*)(karg_ws(karg_base()) + WS_CTL), bar.x, MISC[8], bar.bar);
            else xcd_barrier(bar);
            if (RPT & 2048) xcd_barrier(bar); }
        if (probe_ && PROBE_BAR) tacc_ += __builtin_amdgcn_s_memrealtime() - t0_;
    }
    if (PROBE_S >= 0 && F.bid == 0) { const unsigned long long ts_ = __builtin_amdgcn_s_memrealtime(); while (__builtin_amdgcn_s_memrealtime() - ts_ < 8ull * tacc_) __builtin_amdgcn_s_sleep(8); }
#undef IN
#undef SEAM
}

extern "C" void kernel_launch(void* const* d_in, const int* in_sizes, int n_in, void* d_out, int out_size, void* d_ws, size_t ws_size, hipStream_t stream) {
    static int grid = 0;
    if (grid == 0) {
        int dev = 0, cus = 0;
        if (n_in != 18 || ws_size < 256 * MiB) { fprintf(stderr, "kernel_launch: unexpected inputs (%d) or workspace (%zu < %zu)\n", n_in, ws_size, (size_t)WS_END); grid = -1; return; }
        if (hipGetDevice(&dev) != hipSuccess || hipDeviceGetAttribute(&cus, hipDeviceAttributeMultiprocessorCount, dev) != hipSuccess) { grid = -1; return; }
        if (hipFuncSetAttribute((const void*)mk_fwd, hipFuncAttributeMaxDynamicSharedMemorySize, LDS_BYTES) != hipSuccess) { grid = -1; return; }
        int per_cu = 0;
        if (hipOccupancyMaxActiveBlocksPerMultiprocessor(&per_cu, (const void*)mk_fwd, NTHR, LDS_BYTES) != hipSuccess || per_cu < 1) { fprintf(stderr, "kernel_launch: occupancy query says %d\n", per_cu); }
        (void)hipGetLastError();
        grid = cus;
    }
    if (grid < 0) return;
    (void)hipMemsetAsync((char*)d_ws + WS_CTL, 0, CTL_ZERO_BYTES, stream);
    Args a{};
    for (int i = 0; i < 18; ++i) a.in[i] = (const float*)d_in[i];
    a.out = (float*)d_out; a.ws = (unsigned char*)d_ws;
#if MK_MULTI
    for (int ph = 0; ph < 1 + DEPTH * 8; ++ph) {
        if (ph > 0) { const int l = (ph - 1) >> 3, s = (ph - 1) & 7; if (s == 7) continue; if ((l & 1) == 0 && s == 7) continue; if ((l & 1) == 1 && s == 4) continue; }
        a.ph_lo = ph; a.ph_hi = ph + 1;
        hipLaunchKernelGGL(mk_fwd, dim3(grid), dim3(NTHR), LDS_BYTES, stream, a);
    }
#else
    a.ph_lo = 0; a.ph_hi = DEPTH * 8;
    hipLaunchKernelGGL(mk_fwd, dim3(grid), dim3(NTHR), LDS_BYTES, stream, a);
#endif
}
```
